# Optimizing an MI355X kernel written in HIP

```python
import jax
import jax.numpy as jnp
from jax import lax
import numpy as np

D_MODEL = 4096
BATCH = 2
SEQ = 8192
DEPTH = 2

GRID_W = 64
CTX_LEN = 256
ROPE_THETA = 10000.0
Q_BLOCK = 128
EPS = 1e-6

GQA_HEADS = 16
GQA_KV_HEADS = 4
GQA_HEAD_DIM = 128
MLA_HEADS = 16
MLA_Q_LORA = 1024
MLA_KV_LORA = 512
MLA_NOPE = 128
MLA_ROPE = 64
MLA_V = 128
ATT_MIX = GQA_HEADS * GQA_HEAD_DIM + MLA_HEADS * MLA_V
ATT_SIZES = [GQA_HEADS * GQA_HEAD_DIM, GQA_KV_HEADS * GQA_HEAD_DIM, GQA_KV_HEADS * GQA_HEAD_DIM,
             MLA_Q_LORA, MLA_KV_LORA, MLA_ROPE]
ATT_IN = sum(ATT_SIZES) + ATT_MIX

GLA_HEADS = 6
GLA_DK = 256
GLA_DV = 512
GLA_GATE_RANK = 16
GLA_GATE_TAU = 16.0
GLA_CHUNK = 64
FNET_GROUPS = 4
FNET_DIM = 256
REC_MIX = GLA_HEADS * GLA_DV + FNET_GROUPS * FNET_DIM
REC_SIZES = [GLA_HEADS * GLA_DK, GLA_HEADS * GLA_DK, GLA_HEADS * GLA_DV,
             GLA_GATE_RANK, GLA_GATE_RANK, FNET_GROUPS * FNET_DIM]
REC_IN = sum(REC_SIZES) + REC_MIX

N_EVEN = (DEPTH + 1) // 2
N_ODD = DEPTH // 2

kernel_name = 'hybrid_gqa_mla_gla_fnet_prefix_dit'

F32 = jnp.float32


def rms_norm(x, g):
    xf = x.astype(F32)
    y = xf * lax.rsqrt(jnp.mean(xf * xf, axis=-1, keepdims=True) + EPS)
    return (y * g.astype(F32)).astype(x.dtype)


def split_cols(p, sizes):
    return jnp.split(p, [int(s) for s in np.cumsum(sizes)], axis=-1)


def axial_rope(n, rot_dim):
    rows = n // GRID_W
    row = jnp.repeat(jnp.arange(rows, dtype=F32), GRID_W)
    col = jnp.tile(jnp.arange(GRID_W, dtype=F32), rows)
    quarter = rot_dim // 4
    inv_freq = ROPE_THETA ** (-jnp.arange(quarter, dtype=F32) / quarter)
    ang = jnp.concatenate([row[:, None] * inv_freq, col[:, None] * inv_freq], axis=-1)
    return jnp.cos(ang), jnp.sin(ang)


def apply_rope(x, rope):
    if rope is None:
        return x
    cos, sin = rope
    cos = cos[None, :, None, :]
    sin = sin[None, :, None, :]
    x1, x2 = jnp.split(x.astype(F32), 2, axis=-1)
    return jnp.concatenate([x1 * cos - x2 * sin, x1 * sin + x2 * cos], axis=-1).astype(x.dtype)


def block_attention(q, k, v, scale):
    b, sq, hkv, grp, dh = q.shape
    nb = sq // Q_BLOCK
    qb = q.reshape(b, nb, Q_BLOCK, hkv, grp, dh).transpose(1, 0, 2, 3, 4, 5)

    def one_block(qblk):
        s = jnp.einsum('bqhgd,bkhd->bhgqk', qblk, k, preferred_element_type=F32) * scale
        p = jax.nn.softmax(s, axis=-1).astype(v.dtype)
        return jnp.einsum('bhgqk,bkhd->bqhgd', p, v)

    o = lax.map(one_block, qb)
    return o.transpose(1, 0, 2, 3, 4, 5).reshape(b, sq, hkv * grp * v.shape[-1])


def attn_prep(h, w_in, qn_g, kn_g, cq_g, ckv_g, w_uq, w_ukv, rope_a, rope_b):
    b, s, _ = h.shape
    qa, ka, va, cq, ckv, kr, gate = split_cols(h @ w_in, ATT_SIZES)
    qa = apply_rope(rms_norm(qa.reshape(b, s, GQA_HEADS, GQA_HEAD_DIM), qn_g), rope_a)
    ka = apply_rope(rms_norm(ka.reshape(b, s, GQA_KV_HEADS, GQA_HEAD_DIM), kn_g), rope_a)
    va = va.reshape(b, s, GQA_KV_HEADS, GQA_HEAD_DIM)
    qb = (rms_norm(cq, cq_g) @ w_uq).reshape(b, s, MLA_HEADS, MLA_NOPE + MLA_ROPE)
    qb = jnp.concatenate([qb[..., :MLA_NOPE], apply_rope(qb[..., MLA_NOPE:], rope_b)], axis=-1)
    kv = (rms_norm(ckv, ckv_g) @ w_ukv).reshape(b, s, MLA_HEADS, MLA_NOPE + MLA_V)
    kr = apply_rope(kr.reshape(b, s, 1, MLA_ROPE), rope_b)
    kb = jnp.concatenate([kv[..., :MLA_NOPE], jnp.broadcast_to(kr, (b, s, MLA_HEADS, MLA_ROPE))], axis=-1)
    vb = kv[..., MLA_NOPE:]
    return qa, ka, va, qb, kb, vb, gate


def attn_mixer(h_lat, h_ctx, w_in, qn_g, kn_g, cq_g, ckv_g, w_uq, w_ukv, w_out, need_ctx):
    n = h_lat.shape[1]
    rope_a = axial_rope(n, GQA_HEAD_DIM)
    rope_b = axial_rope(n, MLA_ROPE)
    qa, ka, va, qb, kb, vb, g = attn_prep(h_lat, w_in, qn_g, kn_g, cq_g, ckv_g, w_uq, w_ukv, rope_a, rope_b)
    qa_c, ka_c, va_c, qb_c, kb_c, vb_c, g_c = attn_prep(h_ctx, w_in, qn_g, kn_g, cq_g, ckv_g, w_uq, w_ukv, None, None)
    group = GQA_HEADS // GQA_KV_HEADS

    def mix(qa, qb, ka, va, kb, vb, g):
        b, s = qa.shape[:2]
        oa = block_attention(qa.reshape(b, s, GQA_KV_HEADS, group, GQA_HEAD_DIM), ka, va, GQA_HEAD_DIM ** -0.5)
        ob = block_attention(qb.reshape(b, s, MLA_HEADS, 1, MLA_NOPE + MLA_ROPE), kb, vb,
                             (MLA_NOPE + MLA_ROPE) ** -0.5)
        y = jnp.concatenate([oa, ob], axis=-1) * jax.nn.silu(g)
        return y @ w_out

    out_lat = mix(qa, qb,
                  jnp.concatenate([ka, ka_c], axis=1), jnp.concatenate([va, va_c], axis=1),
                  jnp.concatenate([kb, kb_c], axis=1), jnp.concatenate([vb, vb_c], axis=1), g)
    out_ctx = mix(qa_c, qb_c, ka_c, va_c, kb_c, vb_c, g_c) if need_ctx else None
    return out_lat, out_ctx


def rec_prep(h, w_in, wg_f, bg_f, wg_b, bg_b):
    b, s, _ = h.shape
    q, k, v, gdf, gdb, u, gate = split_cols(h @ w_in, REC_SIZES)
    q = q.reshape(b, s, GLA_HEADS, GLA_DK) * (GLA_DK ** -0.5)
    k = k.reshape(b, s, GLA_HEADS, GLA_DK)
    v = v.reshape(b, s, GLA_HEADS, GLA_DV)

    def log_gate(gd, w, bias):
        z = (gd @ w + bias).astype(F32)
        return (jax.nn.log_sigmoid(z) / GLA_GATE_TAU).reshape(b, s, GLA_HEADS, GLA_DK)

    lf = log_gate(gdf, wg_f, bg_f)
    lb = log_gate(gdb, wg_b, bg_b)
    u = u.reshape(b, s, FNET_GROUPS, FNET_DIM)
    return q, k, v, lf, lb, u, gate


def gla_scan(q, k, v, lg, s0):
    b, s, h, dk = q.shape
    dv = v.shape[-1]
    nc = s // GLA_CHUNK

    def chunks(t):
        return t.reshape(b, nc, GLA_CHUNK, h, t.shape[-1]).transpose(1, 0, 3, 2, 4)

    mask = jnp.tril(jnp.ones((GLA_CHUNK, GLA_CHUNK), dtype=bool))

    def step(state, inp):
        qc, kc, vc, gc = inp
        qf = qc.astype(F32)
        kf = kc.astype(F32)
        vf = vc.astype(F32)
        cum = jnp.cumsum(gc, axis=2)
        o_inter = jnp.einsum('bhcd,bhde->bhce', qf * jnp.exp(cum), state)
        decay = jnp.exp(jnp.where(mask[:, :, None], cum[:, :, :, None, :] - cum[:, :, None, :, :], -jnp.inf))
        att = jnp.einsum('bhid,bhjd,bhijd->bhij', qf, kf, decay)
        o_intra = jnp.einsum('bhij,bhje->bhie', att, vf)
        last = cum[:, :, -1, :]
        state = jnp.exp(last)[..., None] * state + jnp.einsum(
            'bhcd,bhce->bhde', kf * jnp.exp(last[:, :, None, :] - cum), vf)
        return state, o_inter + o_intra

    state, o = lax.scan(step, s0, (chunks(q), chunks(k), chunks(v), chunks(lg)))
    o = o.transpose(1, 0, 3, 2, 4).reshape(b, s, h, dv).astype(v.dtype)
    return o, state


def gla_bidir(q, k, v, lf, lb, sf0, sb0):
    of, sf = gla_scan(q, k, v, lf, sf0)
    ob, sb = gla_scan(jnp.flip(q, 1), jnp.flip(k, 1), jnp.flip(v, 1), jnp.flip(lb, 1), sb0)
    return of + jnp.flip(ob, 1), sf, sb


def fourier_mix(u):
    return jnp.fft.fft2(u.astype(F32), axes=(1, 3), norm='ortho').real.astype(u.dtype)


def rec_mixer(h_lat, h_ctx, w_in, wg_f, bg_f, wg_b, bg_b, on_g, w_out, need_ctx):
    q, k, v, lf, lb, u, g = rec_prep(h_lat, w_in, wg_f, bg_f, wg_b, bg_b)
    qc, kc, vc, lfc, lbc, uc, gc = rec_prep(h_ctx, w_in, wg_f, bg_f, wg_b, bg_b)
    zero = jnp.zeros((h_ctx.shape[0], GLA_HEADS, GLA_DK, GLA_DV), F32)
    o_ctx, s_f, s_b = gla_bidir(qc, kc, vc, lfc, lbc, zero, zero)
    o_lat, _, _ = gla_bidir(q, k, v, lf, lb, s_f, s_b)

    def finish(o, u, g):
        b, s = o.shape[:2]
        o = rms_norm(o, on_g).reshape(b, s, GLA_HEADS * GLA_DV)
        f = fourier_mix(u).reshape(b, s, FNET_GROUPS * FNET_DIM)
        return (jnp.concatenate([o, f], axis=-1) * jax.nn.silu(g)) @ w_out

    out_lat = finish(o_lat, u, g)
    out_ctx = finish(o_ctx, uc, gc) if need_ctx else None
    return out_lat, out_ctx


def setup_inputs(seed: int = 0) -> dict:
    key = jax.random.key(seed)
    ks = iter(jax.random.split(key, 32))
    D = D_MODEL

    def nrm(shape, std):
        return jax.random.normal(next(ks), shape, jnp.float32) * std

    def gain(shape):
        return 1.0 + nrm(shape, 0.02)

    return {
        'x': nrm((BATCH, SEQ, D), 1.0),
        'c': nrm((BATCH, D), 1.0),
        'ctx': nrm((BATCH, CTX_LEN, D), 1.0),
        'c_ctx': nrm((D,), 1.0),
        'norm_g': gain((DEPTH, D)),
        'ada_w': nrm((DEPTH, D, 3 * D), 0.5 * D ** -0.5),
        'ada_b': nrm((DEPTH, 3 * D), 0.02),
        'att_w_in': nrm((N_EVEN, D, ATT_IN), D ** -0.5),
        'att_qn_g': gain((N_EVEN, GQA_HEAD_DIM)),
        'att_kn_g': gain((N_EVEN, GQA_HEAD_DIM)),
        'mla_cq_g': gain((N_EVEN, MLA_Q_LORA)),
        'mla_ckv_g': gain((N_EVEN, MLA_KV_LORA)),
        'mla_w_uq': nrm((N_EVEN, MLA_Q_LORA, MLA_HEADS * (MLA_NOPE + MLA_ROPE)), MLA_Q_LORA ** -0.5),
        'mla_w_ukv': nrm((N_EVEN, MLA_KV_LORA, MLA_HEADS * (MLA_NOPE + MLA_V)), MLA_KV_LORA ** -0.5),
        'att_w_out': nrm((N_EVEN, ATT_MIX, D), ATT_MIX ** -0.5),
        'rec_w_in': nrm((N_ODD, D, REC_IN), D ** -0.5),
        'gla_wg_f': nrm((N_ODD, GLA_GATE_RANK, GLA_HEADS * GLA_DK), GLA_GATE_RANK ** -0.5),
        'gla_bg_f': nrm((N_ODD, GLA_HEADS * GLA_DK), 0.1),
        'gla_wg_b': nrm((N_ODD, GLA_GATE_RANK, GLA_HEADS * GLA_DK), GLA_GATE_RANK ** -0.5),
        'gla_bg_b': nrm((N_ODD, GLA_HEADS * GLA_DK), 0.1),
        'gla_on_g': gain((N_ODD, GLA_DV)),
        'rec_w_out': nrm((N_ODD, REC_MIX, D), REC_MIX ** -0.5),
        'final_g': gain((D,)),
    }


def reference(x, c, ctx, c_ctx, norm_g, ada_w, ada_b, att_w_in, att_qn_g, att_kn_g, mla_cq_g, mla_ckv_g,
              mla_w_uq, mla_w_ukv, att_w_out, rec_w_in, gla_wg_f, gla_bg_f, gla_wg_b, gla_bg_b, gla_on_g,
              rec_w_out, final_g):
    x_ctx = ctx
    for layer in range(DEPTH):
        need_ctx = layer < DEPTH - 1
        mod = jax.nn.silu(c) @ ada_w[layer] + ada_b[layer]
        shift, scale, gate = jnp.split(mod[:, None, :], 3, axis=-1)
        mod_c = jax.nn.silu(c_ctx) @ ada_w[layer] + ada_b[layer]
        shift_c, scale_c, gate_c = jnp.split(mod_c, 3, axis=-1)
        h = rms_norm(x, norm_g[layer]) * (1.0 + scale) + shift
        hc = rms_norm(x_ctx, norm_g[layer]) * (1.0 + scale_c) + shift_c
        i = layer // 2
        if layer % 2 == 0:
            y, yc = attn_mixer(h, hc, att_w_in[i], att_qn_g[i], att_kn_g[i], mla_cq_g[i], mla_ckv_g[i],
                               mla_w_uq[i], mla_w_ukv[i], att_w_out[i], need_ctx)
        else:
            y, yc = rec_mixer(h, hc, rec_w_in[i], gla_wg_f[i], gla_bg_f[i], gla_wg_b[i], gla_bg_b[i],
                              gla_on_g[i], rec_w_out[i], need_ctx)
        x = x + gate * y
        if need_ctx:
            x_ctx = x_ctx + gate_c * yc
    return rms_norm(x, final_g)
```

```cpp
#define MODE 4
#include <hip/hip_runtime.h>
#include <cstdio>
#include <cstdint>
namespace fk {
#define LAS __attribute__((address_space(3)))
#define GAS __attribute__((address_space(1)))
typedef unsigned short bf16_t;
typedef short bf16x8 __attribute__((ext_vector_type(8)));
typedef short s16x4 __attribute__((ext_vector_type(4)));
typedef float f32x2 __attribute__((ext_vector_type(2)));
typedef float f32x4 __attribute__((ext_vector_type(4)));
typedef float f32x8 __attribute__((ext_vector_type(8)));
typedef float f32x16 __attribute__((ext_vector_type(16)));
typedef unsigned u32x2 __attribute__((ext_vector_type(2)));
typedef unsigned u32x4 __attribute__((ext_vector_type(4)));

constexpr int NWAVES = 8, NTHR = 512;
constexpr int D = 4096, NB = 2, S = 8192, CTX = 256, SB = S + CTX  , M = NB * SB  , NPANEL = M / 256  , PPB = SB / 256  ;
constexpr float EPS = 1e-6f;

__device__ __forceinline__ unsigned cvt_pk_bf16(float lo, float hi) { unsigned r; asm volatile("v_cvt_pk_bf16_f32 %0, %1, %2" : "=v"(r) : "v"(lo), "v"(hi)); return r; }
__device__ __forceinline__ float bf_lo(unsigned w) { return __uint_as_float(w << 16); }
__device__ __forceinline__ float bf_hi(unsigned w) { return __uint_as_float(w & 0xffff0000u); }
__device__ __forceinline__ float bf2f(bf16_t b) { return __uint_as_float(((unsigned)b) << 16); }
__device__ __forceinline__ float fast_silu(float x) { return x * __builtin_amdgcn_rcpf(1.f + __expf(-x)); }
__device__ __forceinline__ float wave_sum(float v) {
#pragma unroll
    for (int o = 1; o < 64; o <<= 1) v += __shfl_xor(v, o);
    return v;
}
#define LDS_WAIT() asm volatile("s_waitcnt lgkmcnt(0)" ::: "memory")
#define VM_WAIT() asm volatile("s_waitcnt vmcnt(0)" ::: "memory")

#define XB_TMO      128
#define XB_XCNT(j)  (256  + 64 * (j))
#define XB_XSUB(j)  (1280 + 64 * (j))
#define XB_XGEN(j)  (2304 + 64 * (j))
#define XB_TOP      3328
#define XB_TOPGEN   3392
#define XCD_BAR_WORDS 3456
#define XB_SPIN_CAP (1u << 24)
__device__ __forceinline__ unsigned xb_ld(unsigned* p)              { return __hip_atomic_load(p, __ATOMIC_RELAXED, __HIP_MEMORY_SCOPE_AGENT); }
__device__ __forceinline__ unsigned xb_add(unsigned* p, unsigned v) { return __hip_atomic_fetch_add(p, v, __ATOMIC_RELAXED, __HIP_MEMORY_SCOPE_AGENT); }
__device__ __forceinline__ unsigned xb_xcc_id() { return (unsigned)__builtin_amdgcn_s_getreg((3 << 11) | 20) & 0xFu; }
#define XB_SPIN(cond, bar) do { unsigned _sp = 0; while (cond) { __builtin_amdgcn_s_sleep(1); \
    if ((++_sp & 255u) == 0u) { if (xb_ld(&(bar)[XB_TMO])) break; if (_sp > XB_SPIN_CAP) { atomicAdd(&(bar)[XB_TMO], 1u); break; } } } } while (0)
struct XcdBarrier { unsigned* bar; unsigned x; volatile LAS unsigned* st; };
__device__ __forceinline__ XcdBarrier xcd_barrier_post(unsigned* bar, volatile LAS unsigned* st) {
    XcdBarrier b; b.bar = bar; b.x = xb_xcc_id(); b.st = st;
    if (threadIdx.x == 0) (void)xb_add(&bar[XB_XCNT(b.x)], 1u);
    return b;
}
__device__ __forceinline__ void xcd_barrier_complete(unsigned* bar, unsigned x, unsigned& nloc, unsigned& nx) {
    const unsigned G = gridDim.x * gridDim.y * gridDim.z;
    unsigned sum, cnt, mine, sp = 0u;
    for (;;) {
        sum = 0u; cnt = 0u; mine = 0u;
#pragma unroll
        for (unsigned j = 0; j < 16; ++j) { const unsigned c = xb_ld(&bar[XB_XCNT(j)]); sum += c; cnt += (c > 0u) ? 1u : 0u; mine = (j == x) ? c : mine; }
        if (sum == G) break;
        __builtin_amdgcn_s_sleep(1);
        if ((++sp & 255u) == 0u) { if (xb_ld(&bar[XB_TMO])) break; if (sp > XB_SPIN_CAP) { atomicAdd(&bar[XB_TMO], 1u); break; } }
    }
    nloc = mine > 0u ? mine : 1u; nx = cnt > 0u ? cnt : 1u;
}
__device__ __forceinline__ void xcd_barrier(const XcdBarrier& b) {
    asm volatile("s_waitcnt vmcnt(0)" ::: "memory");
    __syncthreads();
    if (threadIdx.x == 0) {
        unsigned* bar = b.bar;
        __builtin_amdgcn_s_waitcnt(0);
        unsigned nloc = b.st[0], nx = b.st[1];
        if (nloc == 0u) { xcd_barrier_complete(bar, b.x, nloc, nx); b.st[0] = nloc; b.st[1] = nx; }
        const unsigned old = xb_add(&bar[XB_XSUB(b.x)], 1u);
        const unsigned gen = old / nloc;
        if (old + 1u == (gen + 1u) * nloc) {
            __builtin_amdgcn_fence(__ATOMIC_RELEASE, "agent");
            asm volatile("s_waitcnt vmcnt(0)" ::: "memory");
            const unsigned og = xb_add(&bar[XB_TOP], 1u);
            const unsigned tg = og / nx;
            if (og + 1u == (tg + 1u) * nx) xb_add(&bar[XB_TOPGEN], 1u);
            else XB_SPIN(xb_ld(&bar[XB_TOPGEN]) == tg, bar);
            __builtin_amdgcn_fence(__ATOMIC_ACQUIRE, "agent");
            xb_add(&bar[XB_XGEN(b.x)], 1u);
            asm volatile("s_waitcnt vmcnt(0)" ::: "memory");
        } else {
            XB_SPIN(xb_ld(&bar[XB_XGEN(b.x)]) == gen, bar);
            __builtin_amdgcn_fence(__ATOMIC_ACQUIRE, "agent");
            asm volatile("s_waitcnt vmcnt(0)" ::: "memory");
        }
    }
    __syncthreads();
}

constexpr int BM = 256, BK = 64, HALF = 128, HTB = HALF * BK * 2, STAGE_BYTES = 8 * HTB, NXCD = 8, WGM = 8;
__host__ __device__ __forceinline__ int lds_byte(int r, int c) { const int st = (r >> 4) * 2 + (c >> 5), rr = r & 15, cc = c & 31, ob = rr * 64 + cc * 2; return st * 1024 + (ob ^ (((ob >> 9) & 1) << 5)); }
__host__ __device__ __forceinline__ void stage_rc(int b, int& R, int& C) { const int st = b / 1024, sb = b % 1024, swz = sb ^ (((sb >> 9) & 1) << 5); R = (st >> 1) * 16 + swz / 64; C = (st & 1) * 32 + (swz % 64) / 2; }
__host__ __device__ __forceinline__ int perm32(int rho) { const int n = rho >> 4, i = rho & 15; return 8 * (i >> 2) + 4 * n + (i & 3); }
struct Unit { int pm, pn, ko; };
struct Gemm { const bf16_t* A; const bf16_t* Bt; int K, lda, ldb; };
struct Order {
    int nM, nN, nwg, G, c, skip;
    __device__ void init(int nM_, int nN_, int G_, int c_, int skip_) { nM = nM_; nN = nN_; nwg = nM * nN; G = G_; c = c_; skip = skip_; }
    __device__ bool next(int i, Unit& u) const {
        const long L = (long)i * G + c; if (L >= nwg) return false;
        int wgid = (int)L; { const int q = nwg / NXCD, r = nwg % NXCD, xcd = wgid % NXCD, off = wgid / NXCD; wgid = (xcd < r ? xcd * (q + 1) : r * (q + 1) + (xcd - r) * q) + off; }
        const int nig = WGM * nN, gid = wgid / nig, fm = gid * WGM, gsz = (nM - fm) < WGM ? (nM - fm) : WGM;
        int pm = fm + ((wgid % nig) % gsz); if (skip && pm >= 32) pm += 1;
        u.pm = pm; u.pn = (wgid % nig) / gsz; u.ko = 0; return true;
    }
};
struct OrderKr {
    int bid;
    __device__ bool next(int i, Unit& u) const {
        int L; if (bid >= 196) { if (i >= 8) return false; L = (bid - 196) * 8 + i; } else { if (i >= 1 || bid >= 48) return false; L = 480 + bid; }
        u.pm = L >> 3; u.pn = 0; u.ko = (L & 7) * 512; return true;
    }
};
struct OrderCtx {
    int bid;
    __device__ bool next(int i, Unit& u) const { if (i >= 1) return false; u.pm = 32 + 33 * (bid >> 7); u.pn = (bid >> 3) & 15; u.ko = (bid & 7) * 512; return true; }
};
template <class Epi, class Sched>
__device__ __forceinline__ void gemm_phase(LAS unsigned char* lds, const Gemm g, const Sched& S, const Epi& E) {
    const int tid = threadIdx.x, wid = __builtin_amdgcn_readfirstlane(tid >> 6), lane = tid & 63, wr = wid >> 2, wc = wid & 3, fr = lane & 15, fq = lane >> 4;
    const int K = g.K, nt = K / BK;
    unsigned voffA[2], voffB[2];
#pragma unroll
    for (int i = 0; i < 2; ++i) { int R, C; stage_rc(tid * 16 + i * 8192, R, C); const int Rb = Epi::PERM ? ((R & ~31) + perm32(R & 31)) : R;
        voffA[i] = (unsigned)(R * g.lda + C) * 2u; voffB[i] = (unsigned)(Rb * g.ldb + C) * 2u; }
    const size_t kstep = (size_t)(BK * 2);
    const size_t hstepA = (size_t)HALF * g.lda * 2, hstepB = (size_t)HALF * g.ldb * 2;
    const size_t tstepA = 2 * hstepA, tstepB = 2 * hstepB;
    const unsigned ldsw = (unsigned)wid * 1024u;
    const int aoff = lds_byte(wr * 64 + fr, fq * 8), boff = lds_byte(wc * 32 + fr, fq * 8);
#define PG8_SA(b, h) (((b) * 2 + (h)) * HTB)
#define PG8_SB(b, h) ((4 + (b) * 2 + (h)) * HTB)
#define PG8_STAGE(bufoff, gbase, voff) do { _Pragma("unroll") for (int _i = 0; _i < 2; ++_i) \
        __builtin_amdgcn_global_load_lds((const unsigned*)((const char*)(gbase) + (voff)[_i]), (LAS unsigned*)(lds + (bufoff) + ldsw + _i * 8192), 16, 0, 0); } while (0)
#define PG8_LDA(dst, b, h) do { _Pragma("unroll") for (int m = 0; m < 4; ++m) _Pragma("unroll") for (int k = 0; k < 2; ++k) dst[m][k] = *(const LAS bf16x8*)(lds + PG8_SA(b, h) + aoff + m * 2048 + k * 1024); } while (0)
#define PG8_LDB(dst, b, h) do { _Pragma("unroll") for (int n = 0; n < 2; ++n) _Pragma("unroll") for (int k = 0; k < 2; ++k) dst[n][k] = *(const LAS bf16x8*)(lds + PG8_SB(b, h) + boff + n * 2048 + k * 1024); } while (0)
#define PG8_MMA(ai, bj, At, Bt) do { __builtin_amdgcn_s_setprio(1); _Pragma("unroll") for (int m = 0; m < 4; ++m) _Pragma("unroll") for (int n = 0; n < 2; ++n) _Pragma("unroll") for (int k = 0; k < 2; ++k) \
        acc[ai][bj][m][n] = __builtin_amdgcn_mfma_f32_16x16x32_bf16(Bt[n][k], At[m][k], acc[ai][bj][m][n], 0, 0, 0); __builtin_amdgcn_s_setprio(0); } while (0)
#define PG8_WAIT_V(n) asm volatile("s_waitcnt vmcnt(" #n ")" ::: "memory")
#define PG8_WAIT_L(n) asm volatile("s_waitcnt lgkmcnt(" #n ")" ::: "memory")
#define PG8_BAR __builtin_amdgcn_s_barrier()
#define PG8_SCHED __builtin_amdgcn_sched_barrier(0)
    Unit cur, nxt; int ui = 0;
    if (!S.next(0, cur)) return;
    f32x4 acc[2][2][4][2];
#pragma unroll
    for (int a = 0; a < 2; ++a)
#pragma unroll
        for (int b = 0; b < 2; ++b)
#pragma unroll
            for (int m = 0; m < 4; ++m)
#pragma unroll
                for (int n = 0; n < 2; ++n) acc[a][b][m][n] = (f32x4){0.f, 0.f, 0.f, 0.f};
    bf16x8 At[4][2], B0[2][2], B1[2][2];
    const char* cA = (const char*)g.A + (size_t)cur.pm * tstepA + (size_t)cur.ko * 2; const char* cB = (const char*)g.Bt + (size_t)cur.pn * tstepB + (size_t)cur.ko * 2;
    PG8_STAGE(PG8_SB(0, 0), cB, voffB); PG8_STAGE(PG8_SB(0, 1), cB + hstepB, voffB); PG8_STAGE(PG8_SA(0, 0), cA, voffA); PG8_STAGE(PG8_SA(0, 1), cA + hstepA, voffA);
    if (wr == 1) PG8_BAR;
    PG8_WAIT_V(2); PG8_BAR;
    PG8_STAGE(PG8_SB(1, 0), cB + kstep, voffB); PG8_STAGE(PG8_SA(1, 0), cA + kstep, voffA); PG8_STAGE(PG8_SB(1, 1), cB + hstepB + kstep, voffB);
    PG8_WAIT_V(6); PG8_BAR;
    for (;;) {
        const bool has_next = S.next(ui + 1, nxt);
        const char* nA = has_next ? (const char*)g.A + (size_t)nxt.pm * tstepA + (size_t)nxt.ko * 2 : cA; const char* nB = has_next ? (const char*)g.Bt + (size_t)nxt.pn * tstepB + (size_t)nxt.ko * 2 : cB;
        for (int t = 0; t < nt; t += 2) {
            const bool last = (t == nt - 2);
            const char* a1 = cA + (size_t)(t + 1) * kstep;
            const char* a2 = last ? nA : cA + (size_t)(t + 2) * kstep; const char* b2 = last ? nB : cB + (size_t)(t + 2) * kstep;
            const char* a3 = a2 + kstep; const char* b3 = b2 + kstep;
            PG8_LDB(B0, 0, 0); PG8_LDB(B1, 0, 1); PG8_SCHED; PG8_LDA(At, 0, 0); PG8_STAGE(PG8_SA(1, 1), a1 + hstepA, voffA);
            PG8_WAIT_V(8); PG8_WAIT_L(0); PG8_BAR; PG8_MMA(0, 0, At, B0); PG8_MMA(0, 1, At, B1); PG8_BAR; PG8_SCHED;
            PG8_LDA(At, 0, 1); PG8_STAGE(PG8_SB(0, 0), b2, voffB); PG8_STAGE(PG8_SB(0, 1), b2 + hstepB, voffB); PG8_STAGE(PG8_SA(0, 0), a2, voffA);
            PG8_WAIT_V(8); PG8_WAIT_L(0); PG8_BAR; PG8_MMA(1, 0, At, B0); PG8_MMA(1, 1, At, B1); PG8_BAR; PG8_SCHED;
            PG8_LDB(B0, 1, 0); PG8_LDB(B1, 1, 1); PG8_SCHED; PG8_LDA(At, 1, 0); PG8_STAGE(PG8_SA(0, 1), a2 + hstepA, voffA);
            PG8_WAIT_V(8); PG8_WAIT_L(0); PG8_BAR; PG8_MMA(0, 0, At, B0); PG8_MMA(0, 1, At, B1); PG8_BAR; PG8_SCHED;
            PG8_LDA(At, 1, 1); PG8_STAGE(PG8_SB(1, 0), b3, voffB); PG8_STAGE(PG8_SB(1, 1), b3 + hstepB, voffB); PG8_STAGE(PG8_SA(1, 0), a3, voffA);
            PG8_WAIT_V(8); PG8_WAIT_L(0); PG8_BAR; PG8_MMA(1, 0, At, B0); PG8_MMA(1, 1, At, B1); PG8_BAR; PG8_SCHED;
        }
        if (wr == 0) PG8_BAR;
        E(acc, cur, wr, wc, fr, fq);
        if (!has_next) break;
#pragma unroll
        for (int a = 0; a < 2; ++a)
#pragma unroll
            for (int b = 0; b < 2; ++b)
#pragma unroll
                for (int m = 0; m < 4; ++m)
#pragma unroll
                    for (int n = 0; n < 2; ++n) acc[a][b][m][n] = (f32x4){0.f, 0.f, 0.f, 0.f};
        cur = nxt; cA = nA; cB = nB; ++ui;
        if (wr == 1) PG8_BAR;
    }
    PG8_WAIT_V(0);
    PG8_BAR;
#undef PG8_SA
#undef PG8_SB
#undef PG8_STAGE
#undef PG8_LDA
#undef PG8_LDB
#undef PG8_MMA
#undef PG8_WAIT_V
#undef PG8_WAIT_L
#undef PG8_BAR
#undef PG8_SCHED
}
}
namespace fk {
constexpr size_t MiB = 1u << 20;
constexpr size_t WS_CTL = 0;
constexpr size_t WS_MOD = 1 * MiB;
constexpr size_t WS_ROPEA = 2 * MiB;
constexpr size_t WS_ROPEB = 2 * MiB + 64 * 1024;
constexpr size_t WS_CS = 2 * MiB + 128 * 1024;
constexpr size_t WS_SSQ = 3 * MiB;
constexpr size_t WS_KR = 4 * MiB;
constexpr size_t WS_GD = 7 * MiB;
constexpr size_t WS_GAM = 1391 * MiB;
constexpr size_t WS_AT = 14 * MiB;
constexpr size_t WS_W1T = 40 * MiB;
constexpr size_t WS_WUQ = 110 * MiB;
constexpr size_t WS_WUKV = 116 * MiB;
constexpr size_t WS_WO = 120 * MiB;
constexpr size_t WS_W4T = 152 * MiB;
constexpr size_t WS_WO2 = 242 * MiB;
constexpr size_t WS_DM = 274 * MiB;
constexpr size_t WS_H = 402 * MiB;
constexpr size_t WS_L = 534 * MiB;
constexpr size_t WS_A1 = WS_L;
constexpr size_t WS_CQKV = WS_L + 99 * MiB;
constexpr size_t WS_G0 = WS_L + 149 * MiB;
constexpr size_t WS_QB = WS_L + 281 * MiB;
constexpr size_t WS_KVB = WS_L + 380 * MiB;
constexpr size_t WS_Y0 = WS_L + 512 * MiB;
constexpr size_t WS_QK1 = WS_L;
constexpr size_t WS_V1 = WS_L + 99 * MiB;
constexpr size_t WS_U1 = WS_L + 198 * MiB;
constexpr size_t WS_G1 = WS_L + 231 * MiB;
constexpr size_t WS_QT = WS_L + 363 * MiB;
constexpr size_t WS_KT = WS_L + 462 * MiB;
constexpr size_t WS_VT = WS_L + 561 * MiB;
constexpr size_t WS_AB = WS_L + 660 * MiB;
constexpr size_t WS_VTF = WS_L + 726 * MiB;
constexpr size_t WS_O00 = WS_QK1, WS_O01 = WS_V1;
constexpr size_t WS_O10 = WS_L + 758 * MiB, WS_O11 = WS_H;
constexpr size_t WS_BF = 1398 * MiB;
constexpr size_t WS_PCS = WS_VTF;
constexpr size_t WS_F4096 = WS_SSQ;
constexpr size_t WS_Y1 = WS_QT;
constexpr size_t WS_LEND = WS_L + 758 * MiB;
constexpr size_t WS_PART = WS_L + 660 * MiB;
constexpr size_t WS_X1C = 1448 * MiB;
constexpr size_t WS_TOTAL = 1456 * MiB;
static_assert(WS_O10 + 99 * MiB <= WS_GAM && WS_GAM + 7 * MiB <= WS_BF && WS_BF + 34 * MiB <= WS_X1C && WS_QT + 132 * MiB <= WS_VT, "ws map");
constexpr int CW_BAR = 4096;

constexpr int LDS_STAGE = 0;
constexpr int LDS_X = 151552;
constexpr int LDS_MISC = 159744;
constexpr int LDS_BYTES = 160256;

struct Args { const float* in[23]; float* out; unsigned char* ws; int ph_lo, ph_hi, var, pad; };

struct Frame { LAS unsigned char* lds; int tid, lane, wave, G, bid; };

__device__ __forceinline__ int map_w1(int n) {
    if (n < 2560) { const int h = n >> 7, p = n & 127; return h * 128 + (p >> 1) + 64 * (p & 1); }
    if (n < 4608) return n;
    if (n < 8704) return 4672 + (n - 4608);
    if (n < 8768) { const int p = n - 8704; return 4608 + (p >> 1) + 32 * (p & 1); }
    return -1;
}
__device__ __forceinline__ int map_uq(int n) { const int h = n / 192, w = n % 192; if (w < 128) return n; const int p = w - 128; return h * 192 + 128 + (p >> 1) + 32 * (p & 1); }
__device__ __forceinline__ int map_w4(int n) {
    if (n < 6144) return n;
    if (n < 7168) return 6176 + (n - 6144);
    if (n < 11264) return 7200 + (n - 7168);
    if (n < 11296) return 6144 + (n - 11264);
    return -1;
}
__device__ __forceinline__ void tr_item(const float* W, int K, int Nsrc, bf16_t* WT, LAS float* scr, int k0, int n0, int lane, int srccol, const float* kscale, float cscale) {
#pragma unroll
    for (int i = 0; i < 32; ++i) { const int kk = 2 * i + (lane >> 5); float v = srccol >= 0 ? W[(size_t)(k0 + kk) * Nsrc + srccol] : 0.f;
        v *= kscale ? cscale * kscale[k0 + kk] : cscale; scr[kk * 33 + (lane & 31)] = v; }
    LDS_WAIT(); asm volatile("" ::: "memory");
    const int c = lane & 7;
#pragma unroll
    for (int j = 0; j < 4; ++j) { const int n = (lane >> 3) + 8 * j; const LAS float* s = scr + (8 * c) * 33 + n;
        u32x4 o; o.x = cvt_pk_bf16(s[0 * 33], s[1 * 33]); o.y = cvt_pk_bf16(s[2 * 33], s[3 * 33]); o.z = cvt_pk_bf16(s[4 * 33], s[5 * 33]); o.w = cvt_pk_bf16(s[6 * 33], s[7 * 33]);
        *(u32x4*)(WT + (size_t)(n0 + n) * K + k0 + 8 * c) = o; }
    LDS_WAIT(); asm volatile("" ::: "memory");
}
__device__ __forceinline__ void mod_gemv(const Frame& F, const Args& a, int l, int wg0, int nwg) {
    if (F.bid < wg0) return;
    LAS float* sc = (LAS float*)(F.lds + 72 * 1024);
    LAS float* red = (LAS float*)(F.lds + 120 * 1024);
    __syncthreads();
    for (int i = F.tid; i < 3 * D; i += NTHR) { const float v = i < 2 * D ? a.in[1][i] : a.in[3][i - 2 * D]; sc[i] = v / (1.f + expf(-v)); }
    __syncthreads();
    float* mod = (float*)(a.ws + WS_MOD);
    const int rsub = F.lane >> 3, c4 = (F.lane & 7) * 4;
    for (int u = F.bid - wg0; u < 384; u += nwg) {
        const int n0 = u * 32;
        const float* W = a.in[5] + (size_t)l * D * 12288 + n0 + c4;
        f32x4 a0 = {0.f, 0.f, 0.f, 0.f}, a1 = a0, a2 = a0;
        const int kb = F.wave * 512 + rsub;
#pragma unroll 8
        for (int k = kb; k < kb + 512; k += 8) { const f32x4 w = *(const f32x4*)(W + (size_t)k * 12288); a0 += w * sc[k]; a1 += w * sc[D + k]; a2 += w * sc[2 * D + k]; }
#pragma unroll
        for (int o = 8; o < 64; o <<= 1) {
#pragma unroll
            for (int i = 0; i < 4; ++i) { a0[i] += __shfl_xor(a0[i], o); a1[i] += __shfl_xor(a1[i], o); a2[i] += __shfl_xor(a2[i], o); } }
        if (F.lane < 8) { *(LAS f32x4*)(red + (F.wave * 3 + 0) * 32 + c4) = a0; *(LAS f32x4*)(red + (F.wave * 3 + 1) * 32 + c4) = a1; *(LAS f32x4*)(red + (F.wave * 3 + 2) * 32 + c4) = a2; }
        __syncthreads();
        if (F.tid < 96) { const int r = F.tid >> 5, cl = F.tid & 31; float sm = 0.f;
#pragma unroll
            for (int w = 0; w < 8; ++w) sm += red[(w * 3 + r) * 32 + cl];
            mod[(l * 3 + r) * 12288 + n0 + cl] = sm + a.in[6][l * 12288 + n0 + cl]; }
        __syncthreads();
    }
}
__device__ __forceinline__ void p0_prologue(const Frame& F, const Args& a) {
    unsigned char* ws = a.ws;
    mod_gemv(F, a, 0, 0, F.G);
    __syncthreads();
    {
        LAS float* scr = (LAS float*)(F.lds + F.wave * 8448);
        const int gw = F.bid * NWAVES + F.wave, NGW = F.G * NWAVES;
        constexpr int I0 = 64 * 280, I1 = 16 * 96, I2 = 8 * 128;
        constexpr int NIT = I0 + I1 + I2;
        for (int it = gw; it < NIT; it += NGW) {
            int r = it; const int cl = F.lane & 31;
            if (r < I0) { const int nb = r % 280, kb = r / 280; tr_item(a.in[7], 4096, 8768, (bf16_t*)(ws + WS_W1T), scr, kb * 64, nb * 32, F.lane, map_w1(nb * 32 + cl), nullptr, 1.f); continue; } r -= I0;
            if (r < I1) { const int nb = r % 96, kb = r / 96; tr_item(a.in[12], 1024, 3072, (bf16_t*)(ws + WS_WUQ), scr, kb * 64, nb * 32, F.lane, map_uq(nb * 32 + cl), a.in[10], 1.f); continue; } r -= I1;
            { const int nb = r % 128, kb = r / 128; tr_item(a.in[13], 512, 4096, (bf16_t*)(ws + WS_WUKV), scr, kb * 64, nb * 32, F.lane, nb * 32 + cl, a.in[11], 1.f); }
        }
    }
    {
        const int gt = F.bid * NTHR + F.tid, NGT = F.G * NTHR;
        f32x2* ra = (f32x2*)(ws + WS_ROPEA); f32x2* rb = (f32x2*)(ws + WS_ROPEB); bf16_t* cs = (bf16_t*)(ws + WS_CS);
        for (int i = gt; i < 128 * 32; i += NGT) { const int pos = i >> 5, fi = i & 31; const float ang = (float)pos * powf(10000.f, -(float)fi / 32.f); ra[i] = (f32x2){cosf(ang), sinf(ang)}; }
        for (int i = gt; i < 128 * 16; i += NGT) { const int pos = i >> 4, fi = i & 15; const float ang = (float)pos * powf(10000.f, -(float)fi / 16.f); rb[i] = (f32x2){cosf(ang), sinf(ang)}; }
        for (int i = gt; i < 512 * 256; i += NGT) { const int m = i >> 8, c = i & 255, l = m & 255; const float x = (float)((l * c) & 255) * (2.f / 256.f);
            const float v = (m < 256) ? cospif(x) : sinpif(x); cs[i] = (bf16_t)(cvt_pk_bf16(v, 0.f) & 0xffffu); }
    }
}
__device__ __forceinline__ void late_convert(const Frame& F, const Args& a, int w0, int nw, int which) {
    const int gw = F.bid * NWAVES + F.wave - w0; if (gw < 0) return;
    LAS float* scr = (LAS float*)(F.lds + F.wave * 8448);
    constexpr int I3 = 64 * 128, I4 = 64 * 360;
    if (which == 0) { for (int it = gw; it < I3; it += nw) { const int nb = it % 128, kb = it / 128; tr_item(a.in[14], 4096, 4096, (bf16_t*)(a.ws + WS_WO), scr, kb * 64, nb * 32, F.lane, nb * 32 + (F.lane & 31), nullptr, 1.f); } }
    else { for (int it = gw; it < I4; it += nw) { const int nb = it % 360, kb = it / 360; tr_item(a.in[15], 4096, 11296, (bf16_t*)(a.ws + WS_W4T), scr, kb * 64, nb * 32, F.lane, map_w4(nb * 32 + (F.lane & 31)), nullptr, nb * 32 < 1536 ? 0.0625f : 1.f); } }
}
__device__ __forceinline__ void wo2_convert(const Frame& F, const Args& a, int w0, int nw) {
    __syncthreads();
    LAS float* scr = (LAS float*)(F.lds + F.wave * 8448);
    const int gw = F.bid * NWAVES + F.wave - w0;
    for (int it = gw; it < 64 * 128; it += nw) { const int nb = it % 128, kb = it / 128; tr_item(a.in[21], 4096, 4096, (bf16_t*)(a.ws + WS_WO2), scr, kb * 64, nb * 32, F.lane, nb * 32 + (F.lane & 31), nullptr, 1.f); }
}
constexpr int FKP = 4224;
__device__ __forceinline__ void dm_gen(const Frame& F, bf16_t* dm, int w0, int nw) {
    for (int r = w0; r < 8192; r += nw) { const int half = r >> 12, k = r & 4095;
        for (int q = F.tid; q < FKP / 8; q += NTHR) { float v[8];
#pragma unroll
            for (int j = 0; j < 8; ++j) { const int kk = q * 8 + j; const float x = (float)((k * kk) & 8191) * (1.f / 8192.f);
                v[j] = half == 0 ? (kk <= 4096 ? __builtin_amdgcn_cosf(x) : 0.f) : ((kk >= 1 && kk <= 4095) ? __builtin_amdgcn_sinf(x) : 0.f); }
            u32x4 o; o.x = cvt_pk_bf16(v[0], v[1]); o.y = cvt_pk_bf16(v[2], v[3]); o.z = cvt_pk_bf16(v[4], v[5]); o.w = cvt_pk_bf16(v[6], v[7]);
            *(u32x4*)(dm + (size_t)r * FKP + q * 8) = o; }
    }
}
__device__ __forceinline__ void hnorm_phase(const Frame& F, const float* xlat, const float* xctx, const float* g, const float* modl, bf16_t* H) {
    LAS f32x4* MA = (LAS f32x4*)F.lds;
    __syncthreads();
    for (int i = F.tid; i < 3 * 1024; i += NTHR) { const int r = i >> 10, n4 = i & 1023;
        const f32x4 gg = *((const f32x4*)g + n4), scl = *((const f32x4*)(modl + (size_t)r * 12288 + D) + n4), sh = *((const f32x4*)(modl + (size_t)r * 12288) + n4);
        MA[(r * 2 + 0) * 1024 + n4] = gg * (scl + 1.f); MA[(r * 2 + 1) * 1024 + n4] = sh; }
    __syncthreads();
    const int base = F.bid * (M / 256);
    for (int i0 = F.wave; i0 < M / 256; i0 += 16) {
        const int rot = (F.bid * 5) % (M / 256);
        const bool hasB = (i0 + 8) < M / 256;
        const int mA = base + (i0 + rot) % (M / 256), mB = base + (i0 + 8 + rot) % (M / 256);
        const int bA = mA / SB, rA = mA % SB, bB = hasB ? mB / SB : bA, rB = hasB ? mB % SB : rA;
        const float* srcA = rA < S ? xlat + ((size_t)bA * S + rA) * D : xctx + ((size_t)bA * CTX + (rA - S)) * D;
        const float* srcB = rB < S ? xlat + ((size_t)bB * S + rB) * D : xctx + ((size_t)bB * CTX + (rB - S)) * D;
        const LAS f32x4* mA_ = MA + (rA < S ? bA : 2) * 2048 + F.lane; const LAS f32x4* mB_ = MA + (rB < S ? bB : 2) * 2048 + F.lane;
        const f32x4* xa = (const f32x4*)srcA + F.lane; const f32x4* xb = (const f32x4*)srcB + F.lane;
        f32x4 va[16], vb[16]; float sa = 0.f, sb = 0.f;
#pragma unroll
        for (int j = 0; j < 16; ++j) va[j] = xa[64 * j];
#pragma unroll
        for (int j = 0; j < 16; ++j) vb[j] = xb[64 * j];
#pragma unroll
        for (int j = 0; j < 16; ++j) sa += (va[j].x * va[j].x + va[j].y * va[j].y) + (va[j].z * va[j].z + va[j].w * va[j].w);
#pragma unroll
        for (int j = 0; j < 16; ++j) sb += (vb[j].x * vb[j].x + vb[j].y * vb[j].y) + (vb[j].z * vb[j].z + vb[j].w * vb[j].w);
        const float rsa = 1.0f / sqrtf(wave_sum(sa) * (1.f / D) + EPS), rsb = 1.0f / sqrtf(wave_sum(sb) * (1.f / D) + EPS);
        u32x2* oa = (u32x2*)(H + (size_t)mA * D) + F.lane; u32x2* ob = (u32x2*)(H + (size_t)(hasB ? mB : mA) * D) + F.lane;
#pragma unroll
        for (int j = 0; j < 16; ++j) {
            { const f32x4 h = va[j] * rsa * mA_[64 * j] + mA_[1024 + 64 * j]; u32x2 w; w.x = cvt_pk_bf16(h.x, h.y); w.y = cvt_pk_bf16(h.z, h.w); oa[64 * j] = w; }
            if (hasB) { const f32x4 h = vb[j] * rsb * mB_[64 * j] + mB_[1024 + 64 * j]; u32x2 w; w.x = cvt_pk_bf16(h.x, h.y); w.y = cvt_pk_bf16(h.z, h.w); ob[64 * j] = w; } }
    }
    __syncthreads();
}
__device__ __forceinline__ u32x4 pack8(const f32x4 a, const f32x4 b) { u32x4 w; w.x = cvt_pk_bf16(a[0], a[1]); w.y = cvt_pk_bf16(a[2], a[3]); w.z = cvt_pk_bf16(b[0], b[1]); w.w = cvt_pk_bf16(b[2], b[3]); return w; }
__device__ __forceinline__ f32x4 rope2(const f32x4 v, const f32x4 cs) {
    return (f32x4){v[0] * cs[0] - v[1] * cs[1], v[0] * cs[1] + v[1] * cs[0], v[2] * cs[2] - v[3] * cs[3], v[2] * cs[3] + v[3] * cs[2]};
}
struct EpiL0 {
    static constexpr bool PERM = true;
    bf16_t* A1; bf16_t* CQKV; bf16_t* G0; bf16_t* KRb; float* SSQ; const float* qn_g; const float* kn_g; const float* ropeA; const float* ropeB; LAS float* X;
    __device__ __forceinline__ void operator()(const f32x4 (&acc)[2][2][4][2], const Unit& u, int wr, int wc, int fr, int fq) const {
        const int pn = u.pn, pb = u.pm % PPB; const bool lat = pb < 32;
        const int rowl0 = wr * 64 + fr; const size_t row0 = (size_t)u.pm * 256 + rowl0; const int cl = wc * 32 + 8 * fq;
        if (pn < 10) {
            const float* g = pn < 8 ? qn_g : kn_g; f32x4 gv[2];
#pragma unroll
            for (int n = 0; n < 2; ++n)
#pragma unroll
                for (int i = 0; i < 4; ++i) { const int p = cl + 4 * n + i; gv[n][i] = g[(p >> 1) + 64 * (p & 1)]; }
#pragma unroll
            for (int ai = 0; ai < 2; ++ai)
#pragma unroll
                for (int m = 0; m < 4; ++m)
#pragma unroll
                    for (int bj = 0; bj < 2; ++bj) { const f32x4 x0 = acc[ai][bj][m][0], x1 = acc[ai][bj][m][1];
                        float s = (x0[0] * x0[0] + x0[1] * x0[1]) + (x0[2] * x0[2] + x0[3] * x0[3]) + (x1[0] * x1[0] + x1[1] * x1[1]) + (x1[2] * x1[2] + x1[3] * x1[3]);
                        s += __shfl_xor(s, 16); s += __shfl_xor(s, 32);
                        if (fq == 0) X[((ai * 128 + rowl0 + 16 * m) * 2 + bj) * 4 + wc] = s; }
            LDS_WAIT(); __builtin_amdgcn_s_barrier(); asm volatile("" ::: "memory");
#pragma unroll
            for (int ai = 0; ai < 2; ++ai)
#pragma unroll
                for (int m = 0; m < 4; ++m) { const int rowl = ai * 128 + rowl0 + 16 * m; const int grow = 4 * pb + 2 * ai + wr, gcol = 16 * m + fr;
                    const int pos = wc < 2 ? grow : gcol;
#pragma unroll
                    for (int bj = 0; bj < 2; ++bj) { const f32x4 p4 = *(const LAS f32x4*)&X[(rowl * 2 + bj) * 4];
                        const float rs = 1.0f / sqrtf(((p4[0] + p4[1]) + (p4[2] + p4[3])) * (1.f / 128.f) + EPS);
                        f32x4 v0 = acc[ai][bj][m][0] * rs * gv[0], v1 = acc[ai][bj][m][1] * rs * gv[1];
                        if (lat) { const int fi = (16 * wc + 4 * fq) & 31; const f32x4 c0 = *(const f32x4*)(ropeA + (pos * 32 + fi) * 2), c1 = *(const f32x4*)(ropeA + (pos * 32 + fi + 2) * 2);
                            v0 = rope2(v0, c0); v1 = rope2(v1, c1); }
                        *(u32x4*)(A1 + (row0 + ai * 128 + 16 * m) * 3072 + pn * 256 + bj * 128 + cl) = pack8(v0, v1); } }
        } else if (pn < 12) {
#pragma unroll
            for (int ai = 0; ai < 2; ++ai)
#pragma unroll
                for (int m = 0; m < 4; ++m)
#pragma unroll
                    for (int bj = 0; bj < 2; ++bj) *(u32x4*)(A1 + (row0 + ai * 128 + 16 * m) * 3072 + pn * 256 + bj * 128 + cl) = pack8(acc[ai][bj][m][0], acc[ai][bj][m][1]);
        } else if (pn < 18) {
#pragma unroll
            for (int ai = 0; ai < 2; ++ai)
#pragma unroll
                for (int m = 0; m < 4; ++m) { float s = 0.f;
#pragma unroll
                    for (int bj = 0; bj < 2; ++bj) { const f32x4 x0 = acc[ai][bj][m][0], x1 = acc[ai][bj][m][1];
                        s += (x0[0] * x0[0] + x0[1] * x0[1]) + (x0[2] * x0[2] + x0[3] * x0[3]) + (x1[0] * x1[0] + x1[1] * x1[1]) + (x1[2] * x1[2] + x1[3] * x1[3]);
                        *(u32x4*)(CQKV + (row0 + ai * 128 + 16 * m) * 1536 + (pn - 12) * 256 + bj * 128 + cl) = pack8(x0, x1); }
                    s += __shfl_xor(s, 16); s += __shfl_xor(s, 32);
                    if (fq == 0) X[(ai * 128 + rowl0 + 16 * m) * 4 + wc] = s; }
            LDS_WAIT(); __builtin_amdgcn_s_barrier(); asm volatile("" ::: "memory");
            if (wc == 0 && fq == 0) {
#pragma unroll
                for (int ai = 0; ai < 2; ++ai)
#pragma unroll
                    for (int m = 0; m < 4; ++m) { const f32x4 p4 = *(const LAS f32x4*)&X[(ai * 128 + rowl0 + 16 * m) * 4];
                        SSQ[(row0 + ai * 128 + 16 * m) * 8 + (pn - 12)] = (p4[0] + p4[1]) + (p4[2] + p4[3]); } }
        } else if (pn < 34) {
#pragma unroll
            for (int ai = 0; ai < 2; ++ai)
#pragma unroll
                for (int m = 0; m < 4; ++m)
#pragma unroll
                    for (int bj = 0; bj < 2; ++bj) { f32x4 x0 = acc[ai][bj][m][0], x1 = acc[ai][bj][m][1];
#pragma unroll
                        for (int i = 0; i < 4; ++i) { x0[i] = fast_silu(x0[i]); x1[i] = fast_silu(x1[i]); }
                        *(u32x4*)(G0 + (row0 + ai * 128 + 16 * m) * 4096 + (pn - 18) * 256 + bj * 128 + cl) = pack8(x0, x1); }
        } else {
            if (wc < 2) {
#pragma unroll
                for (int ai = 0; ai < 2; ++ai)
#pragma unroll
                    for (int m = 0; m < 4; ++m) { const int grow = 4 * pb + 2 * ai + wr, gcol = 16 * m + fr; const int pos = wc < 1 ? grow : gcol;
                        f32x4 v0 = acc[ai][0][m][0], v1 = acc[ai][0][m][1];
                        if (lat) { const int fi = (4 * fq) & 15; const f32x4 c0 = *(const f32x4*)(ropeB + (pos * 16 + fi) * 2), c1 = *(const f32x4*)(ropeB + (pos * 16 + fi + 2) * 2);
                            v0 = rope2(v0, c0); v1 = rope2(v1, c1); }
                        *(u32x4*)(KRb + (row0 + ai * 128 + 16 * m) * 64 + cl) = pack8(v0, v1); } }
        }
    }
};
template <int UPM> struct EpiUp {
    static constexpr bool PERM = true;
    bf16_t* O; int ld; const float* SSQ; const float* ropeB;
    __device__ __forceinline__ void operator()(const f32x4 (&acc)[2][2][4][2], const Unit& u, int wr, int wc, int fr, int fq) const {
        const int pb = u.pm % PPB; const bool lat = pb < 32;
        const int rowl0 = wr * 64 + fr; const size_t row0 = (size_t)u.pm * 256 + rowl0;
#pragma unroll
        for (int ai = 0; ai < 2; ++ai)
#pragma unroll
            for (int m = 0; m < 4; ++m) { const size_t row = row0 + ai * 128 + 16 * m; float rs;
                if (UPM == 0) { const f32x4 p4 = *(const f32x4*)(SSQ + row * 8); rs = 1.0f / sqrtf(((p4[0] + p4[1]) + (p4[2] + p4[3])) * (1.f / 1024.f) + EPS); }
                else { const f32x2 p2 = *(const f32x2*)(SSQ + row * 8 + 4); rs = 1.0f / sqrtf((p2[0] + p2[1]) * (1.f / 512.f) + EPS); }
                const int grow = 4 * pb + 2 * ai + wr, gcol = 16 * m + fr;
#pragma unroll
                for (int bj = 0; bj < 2; ++bj) { const int c0 = u.pn * 256 + bj * 128 + wc * 32 + 8 * fq;
                    f32x4 v0 = acc[ai][bj][m][0] * rs, v1 = acc[ai][bj][m][1] * rs;
                    if (UPM == 0) { const int w = c0 % 192;
                        if (lat && w >= 128) { const int p = w - 128; const int pos = p < 32 ? grow : gcol; const int fi = (p >> 1) & 15;
                            const f32x4 c0v = *(const f32x4*)(ropeB + (pos * 16 + fi) * 2), c1v = *(const f32x4*)(ropeB + (pos * 16 + fi + 2) * 2);
                            v0 = rope2(v0, c0v); v1 = rope2(v1, c1v); } }
                    *(u32x4*)(O + row * ld + c0) = pack8(v0, v1); } }
    }
};
struct EpiPartKr {
    static constexpr bool PERM = true;
    float* P;
    __device__ __forceinline__ void operator()(const f32x4 (&acc)[2][2][4][2], const Unit& u, int wr, int wc, int fr, int fq) const {
        if (wc >= 2) return;
        float* base = P + ((size_t)(u.ko >> 9) * M + (size_t)u.pm * 256 + wr * 64 + fr) * 64 + wc * 32 + 8 * fq;
#pragma unroll
        for (int ai = 0; ai < 2; ++ai)
#pragma unroll
            for (int m = 0; m < 4; ++m) { float* p = base + (size_t)(ai * 128 + 16 * m) * 64; *(f32x4*)p = acc[ai][0][m][0]; *(f32x4*)(p + 4) = acc[ai][0][m][1]; }
    }
};
struct EpiPartCtx {
    static constexpr bool PERM = false;
    float* P;
    __device__ __forceinline__ void operator()(const f32x4 (&acc)[2][2][4][2], const Unit& u, int wr, int wc, int fr, int fq) const {
        float* base = P + ((size_t)(u.ko >> 9) * 512 + (size_t)(u.pm / PPB) * 256 + wr * 64 + fr) * D + u.pn * 256 + wc * 32 + 4 * fq;
#pragma unroll
        for (int ai = 0; ai < 2; ++ai)
#pragma unroll
            for (int m = 0; m < 4; ++m)
#pragma unroll
                for (int bj = 0; bj < 2; ++bj)
#pragma unroll
                    for (int n = 0; n < 2; ++n) *(f32x4*)(base + (size_t)(ai * 128 + 16 * m) * D + bj * 128 + n * 16) = acc[ai][bj][m][n];
    }
};
__device__ __forceinline__ void kr_finalize(const Frame& F, const float* P, const float* ropeB, bf16_t* KRb) {
    for (int it = F.bid * NTHR + F.tid; it < M * 8; it += F.G * NTHR) {
        const int m = it >> 3, c8 = it & 7; f32x4 v0 = {0.f, 0.f, 0.f, 0.f}, v1 = v0;
#pragma unroll
        for (int ks = 0; ks < 8; ++ks) { const float* p = P + ((size_t)ks * M + m) * 64 + c8 * 8; v0 += *(const f32x4*)p; v1 += *(const f32x4*)(p + 4); }
        const int r = m % SB;
        if (r < S) { const int pos = c8 < 4 ? (r >> 6) : (r & 63), fi = (4 * c8) & 15;
            v0 = rope2(v0, *(const f32x4*)(ropeB + (pos * 16 + fi) * 2)); v1 = rope2(v1, *(const f32x4*)(ropeB + (pos * 16 + fi + 2) * 2)); }
        *(u32x4*)(KRb + (size_t)m * 64 + c8 * 8) = pack8(v0, v1);
    }
}
struct EpiRes {
    static constexpr bool PERM = false;
    const float* xlat; const float* xctx; const float* modl; float* olat; float* octx;
    __device__ __forceinline__ void operator()(const f32x4 (&acc)[2][2][4][2], const Unit& u, int wr, int wc, int fr, int fq) const {
        const int b = u.pm / PPB, pb = u.pm % PPB; const bool lat = pb < 32;
        const size_t r0 = lat ? ((size_t)b * S + 256 * pb) : ((size_t)b * CTX);
        const float* src = (lat ? xlat : xctx) + r0 * D; float* dst = (lat ? olat : octx) + r0 * D;
        const float* gt = modl + (size_t)(lat ? b : 2) * 12288 + 2 * D;
        const int rowl0 = wr * 64 + fr, col0 = u.pn * 256 + wc * 32 + 4 * fq;
        f32x4 gv[2][2];
#pragma unroll
        for (int bj = 0; bj < 2; ++bj)
#pragma unroll
            for (int n = 0; n < 2; ++n) gv[bj][n] = *(const f32x4*)(gt + col0 + bj * 128 + n * 16);
#pragma unroll
        for (int ai = 0; ai < 2; ++ai)
#pragma unroll
            for (int m = 0; m < 4; ++m) { const size_t off = (size_t)(ai * 128 + rowl0 + 16 * m) * D + col0;
#pragma unroll
                for (int bj = 0; bj < 2; ++bj)
#pragma unroll
                    for (int n = 0; n < 2; ++n) { const f32x4 xs = *(const f32x4*)(src + off + bj * 128 + n * 16);
                        *(f32x4*)(dst + off + bj * 128 + n * 16) = xs + gv[bj][n] * acc[ai][bj][m][n]; }
                if (m & 1) asm volatile("" ::: "memory"); }
    }
};

namespace att {
using bf16 = unsigned short;
constexpr int   D = 128, NW = 8, QBLK = 32, KVBLK = 64;
constexpr float THR = 8.f;
constexpr size_t SHM_V = KVBLK * D * 2;
#define KSWZ(row, colB) ((row) * 256 + ((colB) ^ (((row) & 7) << 4)))
#define SBAR() __builtin_amdgcn_sched_barrier(0)
__device__ __forceinline__ int crow(int r, int hi) { return (r & 3) + 8 * (r >> 2) + 4 * hi; }
__device__ __forceinline__ unsigned cvtpk(float lo, float hi) {
  unsigned r; asm volatile("v_cvt_pk_bf16_f32 %0, %1, %2" : "=v"(r) : "v"(lo), "v"(hi)); return r;
}
template <typename TIn> struct Stage;
template <> struct Stage<bf16>  { using T = bf16x8;
  __device__ static __forceinline__ T ld8(const bf16* p) { return *reinterpret_cast<const bf16x8*>(p); }
  __device__ static __forceinline__ bf16x8 tobf(T x) { return x; } };
template <> struct Stage<float> { using T = f32x8;
  __device__ static __forceinline__ T ld8(const float* p) { return *reinterpret_cast<const f32x8*>(p); }
  __device__ static __forceinline__ bf16x8 tobf(T x) {
    u32x4 w = {cvtpk(x[0], x[1]), cvtpk(x[2], x[3]), cvtpk(x[4], x[5]), cvtpk(x[6], x[7])}; return *reinterpret_cast<bf16x8*>(&w); } };

template <int DQK> __device__ __forceinline__ void partialSM(f32x16& p0, f32x16& p1, float& m_reg, float& mn, float& alpha) {
  constexpr float SCALE = DQK == 128 ? 0.088388347648318440f : 0.072168783648703220f;
  constexpr float C = SCALE * 1.4426950408889634f;
  float pmax = p0[0]; for (int r = 1; r < 16; ++r) pmax = fmaxf(pmax, p0[r]); for (int r = 0; r < 16; ++r) pmax = fmaxf(pmax, p1[r]);
  { auto rr = __builtin_amdgcn_permlane32_swap(__float_as_uint(pmax), __float_as_uint(pmax), false, false);
    pmax = fmaxf(__uint_as_float(rr[0]), __uint_as_float(rr[1])); }
  if (__builtin_expect(__all(pmax - m_reg <= THR / SCALE), 1)) { mn = m_reg; alpha = 1.f; }
  else { mn = fmaxf(m_reg, pmax); alpha = __builtin_amdgcn_exp2f((m_reg - mn) * C); m_reg = mn; }
  float mnC = -mn * C;
  for (int r = 0; r < 16; ++r) p0[r] = fmaf(p0[r], C, mnC); for (int r = 0; r < 16; ++r) p1[r] = fmaf(p1[r], C, mnC);
  for (int r = 0; r < 16; ++r) p0[r] = __builtin_amdgcn_exp2f(p0[r]);
}
__device__ __forceinline__ void finishSM(f32x16& p0, f32x16& p1, float alpha, float& l_reg, bf16x8& pa0, bf16x8& pa1, bf16x8& pa2, bf16x8& pa3) {
  for (int r = 0; r < 16; ++r) p1[r] = __builtin_amdgcn_exp2f(p1[r]);
  float ps = 0; for (int r = 0; r < 16; ++r) ps += p0[r]; for (int r = 0; r < 16; ++r) ps += p1[r];
  { auto rr = __builtin_amdgcn_permlane32_swap(__float_as_uint(ps), __float_as_uint(ps), false, false);
    ps = __uint_as_float(rr[0]) + __uint_as_float(rr[1]); }
  l_reg = l_reg * alpha + ps;
#define PK4(P, BASE, OUT) do { unsigned a0 = cvtpk(P[BASE + 0], P[BASE + 1]), a1 = cvtpk(P[BASE + 2], P[BASE + 3]);   \
    unsigned b0 = cvtpk(P[BASE + 4], P[BASE + 5]), b1 = cvtpk(P[BASE + 6], P[BASE + 7]);                              \
    auto r0 = __builtin_amdgcn_permlane32_swap(a0, b0, false, false); auto r1 = __builtin_amdgcn_permlane32_swap(a1, b1, false, false); \
    u32x4 w = {r0[0], r1[0], r0[1], r1[1]}; OUT = *reinterpret_cast<bf16x8*>(&w); } while (0)
  PK4(p0, 0, pa0); PK4(p0, 8, pa1); PK4(p1, 0, pa2); PK4(p1, 8, pa3);
#undef PK4
}
#define KSWZP(row, colB, KP) ((row) * (KP) + ((colB) ^ (((row) & 7) << 4)))
template <int DQK, int NQR> __device__ __forceinline__ void qkt(f32x16& p0, f32x16& p1, const bf16* Ks, const bf16x8* qr, int r32, int hi, const char* qx) {
  p0 = f32x16{}; p1 = f32x16{};
  for (int d0 = NQR; d0 < DQK / 16; ++d0) { int cb = (d0 * 16 + hi * 8) * 2;
    bf16x8 qv = *reinterpret_cast<const bf16x8*>(qx + (d0 - NQR) * 1024);
    bf16x8 b0 = *reinterpret_cast<const bf16x8*>((const char*)Ks + KSWZP(r32, cb, DQK * 2));
    bf16x8 b1 = *reinterpret_cast<const bf16x8*>((const char*)Ks + KSWZP(32 + r32, cb, DQK * 2));
    p0 = __builtin_amdgcn_mfma_f32_32x32x16_bf16(b0, qv, p0, 0, 0, 0);
    p1 = __builtin_amdgcn_mfma_f32_32x32x16_bf16(b1, qv, p1, 0, 0, 0); }
  for (int d0 = 0; d0 < NQR; ++d0) { int cb = (d0 * 16 + hi * 8) * 2;
    bf16x8 b0 = *reinterpret_cast<const bf16x8*>((const char*)Ks + KSWZP(r32, cb, DQK * 2));
    bf16x8 b1 = *reinterpret_cast<const bf16x8*>((const char*)Ks + KSWZP(32 + r32, cb, DQK * 2));
    p0 = __builtin_amdgcn_mfma_f32_32x32x16_bf16(b0, qr[d0], p0, 0, 0, 0);
    p1 = __builtin_amdgcn_mfma_f32_32x32x16_bf16(b1, qr[d0], p1, 0, 0, 0); }
}
__device__ __forceinline__ int v_st(int k, int c) { const int kk = (k & ~0xC) | ((k & 4) << 1) | ((k & 8) >> 1); return ((kk >> 3) * 4 + (c >> 5)) * 512 + ((kk & 7) * 32 + (c & 31)) * 2; }
__device__ __forceinline__ int v_rd_base(int lane) { return ((lane & 3) << 3) | (((lane >> 2) & 3) << 6) | (((lane >> 4) & 1) << 5) | (((lane >> 5) & 1) << 8); }
constexpr int v_rd_off(int d0, int ks, int half) { return d0 * 512 + ks * 4096 + half * 2048; }
template <int OFF> __device__ __forceinline__ s16x4 tr_read(int vb) {
  s16x4 r; asm volatile("ds_read_b64_tr_b16 %0, %1 offset:%2" : "=&v"(r) : "v"(vb), "i"(OFF) : "memory"); return r;
}
template <int D0> __device__ __forceinline__ void pv_one(f32x16& od, int vb, bf16x8 pa0, bf16x8 pa1, bf16x8 pa2, bf16x8 pa3) {
  const s16x4 l0 = tr_read<v_rd_off(D0, 0, 0)>(vb), h0 = tr_read<v_rd_off(D0, 0, 1)>(vb), l1 = tr_read<v_rd_off(D0, 1, 0)>(vb), h1 = tr_read<v_rd_off(D0, 1, 1)>(vb);
  const s16x4 l2 = tr_read<v_rd_off(D0, 2, 0)>(vb), h2 = tr_read<v_rd_off(D0, 2, 1)>(vb), l3 = tr_read<v_rd_off(D0, 3, 0)>(vb), h3 = tr_read<v_rd_off(D0, 3, 1)>(vb);
  asm volatile("s_waitcnt lgkmcnt(0)" ::: "memory"); SBAR();
#define PK(L, H) (bf16x8){L[0], L[1], L[2], L[3], H[0], H[1], H[2], H[3]}
  od = __builtin_amdgcn_mfma_f32_32x32x16_bf16(pa0, PK(l0, h0), od, 0, 0, 0);
  od = __builtin_amdgcn_mfma_f32_32x32x16_bf16(pa1, PK(l1, h1), od, 0, 0, 0);
  od = __builtin_amdgcn_mfma_f32_32x32x16_bf16(pa2, PK(l2, h2), od, 0, 0, 0);
  od = __builtin_amdgcn_mfma_f32_32x32x16_bf16(pa3, PK(l3, h3), od, 0, 0, 0);
#undef PK
}
__device__ __forceinline__ void pv_d0(f32x16* o, int vb, bf16x8 pa0, bf16x8 pa1, bf16x8 pa2, bf16x8 pa3) {
  pv_one<0>(o[0], vb, pa0, pa1, pa2, pa3); pv_one<1>(o[1], vb, pa0, pa1, pa2, pa3); pv_one<2>(o[2], vb, pa0, pa1, pa2, pa3); pv_one<3>(o[3], vb, pa0, pa1, pa2, pa3);
}

template <typename TQ, int LDQ, int LDK, int LDO, int DQK, int LDK2, int SDEPTH, int NQR>
__device__ __forceinline__ void attn_dense_body(const TQ* __restrict__ Qb, const bf16* __restrict__ Kh, const bf16* __restrict__ K2h, const bf16* __restrict__ Vh,
                                                bf16* __restrict__ Ob, const bf16* __restrict__ Gb, int seq, char* lds) {
  constexpr size_t SHM_K = 64 * DQK * 2; constexpr bool X = DQK == 192;
  using St = Stage<bf16>; using SQ = Stage<TQ>;
  int tid_o = threadIdx.x; asm volatile("" : "+v"(tid_o));
  const int tid = tid_o, wid = __builtin_amdgcn_readfirstlane(tid >> 6), lane = tid & 63, r32 = lane & 31, hi = lane >> 5;
  bf16* V_lds = (bf16*)lds; bf16* K_lds = (bf16*)(lds + 2 * SHM_V);
  float* ws = (float*)(lds + 2 * SHM_V + 2 * SHM_K) + wid * 64; float* li_l = ws; float* al_l = ws + 32;
  float m_reg = -1e30f, l_reg = 0; f32x16 o[4] = {}; bf16x8 qr[NQR]; char* qx = lds + 2 * SHM_V + 2 * SHM_K + 2048 + wid * ((DQK / 16 - NQR) * 1024) + lane * 16;
  const TQ* Qw = Qb + (long)(wid * QBLK + r32) * LDQ + hi * 8;
#pragma unroll
  for (int d0 = 0; d0 < NQR; ++d0) qr[d0] = SQ::tobf(SQ::ld8(Qw + d0 * 16));
#pragma unroll
  for (int d0 = NQR; d0 < DQK / 16; ++d0) *reinterpret_cast<bf16x8*>(qx + (d0 - NQR) * 1024) = SQ::tobf(SQ::ld8(Qw + d0 * 16));
  const int sr = tid >> 4, sc = (tid & 15) * 8, vst0 = v_st(sr, sc), vst1 = v_st(32 + sr, sc);
  const int vb0 = (int)(uintptr_t)V_lds + v_rd_base(lane);
  const int sr2 = tid >> 3, sc2 = (tid & 7) * 8;
  struct { typename St::T vs0, vs1, ks0, ks1, ks2; } sr_[SDEPTH];
  const unsigned voff = (unsigned)(sr * LDK + sc) * 2u, k2off = (unsigned)(sr2 * LDK2 + sc2) * 2u;
#define SLOAD(i, k0) do { const char* vb_ = (const char*)Vh + (size_t)(k0) * (LDK * 2); const char* kb_ = (const char*)Kh + (size_t)(k0) * (LDK * 2); \
    sr_[i].vs0 = *(const bf16x8*)(vb_ + voff); sr_[i].vs1 = *(const bf16x8*)(vb_ + 32 * LDK * 2 + voff); \
    sr_[i].ks0 = *(const bf16x8*)(kb_ + voff); sr_[i].ks1 = *(const bf16x8*)(kb_ + 32 * LDK * 2 + voff); \
    if constexpr (X) sr_[i].ks2 = *(const bf16x8*)((const char*)K2h + (size_t)(k0) * (LDK2 * 2) + k2off); } while (0)
#define SWRITE(b, i) do { *(bf16x8*)((char*)V_lds + (b) * SHM_V + vst0) = St::tobf(sr_[i].vs0);          \
    *(bf16x8*)((char*)V_lds + (b) * SHM_V + vst1) = St::tobf(sr_[i].vs1); int kc = sc * 2;               \
    *(bf16x8*)((char*)K_lds + (b) * SHM_K + KSWZP(sr, kc, DQK * 2)) = St::tobf(sr_[i].ks0);                       \
    *(bf16x8*)((char*)K_lds + (b) * SHM_K + KSWZP(32 + sr, kc, DQK * 2)) = St::tobf(sr_[i].ks1); \
    if constexpr (X) *(bf16x8*)((char*)K_lds + (b) * SHM_K + KSWZP(sr2, 256 + sc2 * 2, DQK * 2)) = St::tobf(sr_[i].ks2); } while (0)
#define SWAIT() do { if constexpr (SDEPTH == 2) { if constexpr (X) asm volatile("s_waitcnt vmcnt(5)" ::: "memory"); else asm volatile("s_waitcnt vmcnt(4)" ::: "memory"); } else asm volatile("s_waitcnt vmcnt(0)" ::: "memory"); } while (0)
#define RESC(a) do { if (__any((a) < 1.f)) { if (hi == 0) al_l[r32] = (a); asm volatile("s_waitcnt lgkmcnt(0)" ::: "memory"); \
    for (int d = 0; d < 4; ++d) for (int r = 0; r < 16; ++r) o[d][r] *= al_l[crow(r, hi)]; } } while (0)
  f32x16 pA0, pA1, pB0, pB1; float mnA, mnB, alA, alB; bf16x8 pa0, pa1, pa2, pa3; const int NT = seq / KVBLK;
  constexpr int SE = 0, SO = SDEPTH - 1;
  SLOAD(SE, 0); asm volatile("s_waitcnt vmcnt(0)" ::: "memory"); SWRITE(0, SE); __syncthreads();
  qkt<DQK, NQR>(pA0, pA1, K_lds, qr, r32, hi, qx); partialSM<DQK>(pA0, pA1, m_reg, mnA, alA);
  SLOAD(SO, KVBLK); if constexpr (SDEPTH == 2) { if (2 < NT) SLOAD(SE, 2 * KVBLK); }
  SWAIT(); SWRITE(1, SO); __syncthreads();
  for (int j = 1; j + 1 < NT; j += 2) {
    SBAR(); qkt<DQK, NQR>(pB0, pB1, (bf16*)((char*)K_lds + SHM_K), qr, r32, hi, qx);
    finishSM(pA0, pA1, alA, l_reg, pa0, pa1, pa2, pa3); SBAR();
    SLOAD(SO, (j + SDEPTH) * KVBLK); SBAR();
    pv_d0(o, vb0, pa0, pa1, pa2, pa3); partialSM<DQK>(pB0, pB1, m_reg, mnB, alB);
    __syncthreads(); SWAIT(); SWRITE(0, SE);
    RESC(alB); __syncthreads();
    SBAR(); qkt<DQK, NQR>(pA0, pA1, K_lds, qr, r32, hi, qx);
    finishSM(pB0, pB1, alB, l_reg, pa0, pa1, pa2, pa3); SBAR();
    if (SDEPTH == 1 || j + 3 < NT) SLOAD(SE, (j + 1 + SDEPTH) * KVBLK); SBAR();
    pv_d0(o, vb0 + (int)SHM_V, pa0, pa1, pa2, pa3); partialSM<DQK>(pA0, pA1, m_reg, mnA, alA);
    __syncthreads(); SWAIT(); SWRITE(1, SO);
    RESC(alA); __syncthreads();
  }
  SBAR(); qkt<DQK, NQR>(pB0, pB1, (bf16*)((char*)K_lds + SHM_K), qr, r32, hi, qx);
  finishSM(pA0, pA1, alA, l_reg, pa0, pa1, pa2, pa3); SBAR();
  pv_d0(o, vb0, pa0, pa1, pa2, pa3); partialSM<DQK>(pB0, pB1, m_reg, mnB, alB);
  __syncthreads(); RESC(alB);
  finishSM(pB0, pB1, alB, l_reg, pa0, pa1, pa2, pa3); SBAR();
  pv_d0(o, vb0 + (int)SHM_V, pa0, pa1, pa2, pa3);
  if (hi == 0) li_l[r32] = l_reg; asm volatile("s_waitcnt lgkmcnt(0)" ::: "memory");
  float rli[16];
#pragma unroll
  for (int r = 0; r < 16; ++r) rli[r] = __builtin_amdgcn_rcpf(li_l[crow(r, hi)]);
  __syncthreads();
  {
    char* ep = lds + wid * 8704;
    int lane_e = hi * 4 * 272 + r32 * 2; asm volatile("" : "+v"(lane_e));
#pragma unroll
    for (int r = 0; r < 16; ++r) { const int ro = ((r & 3) + 8 * (r >> 2)) * 272;
#pragma unroll
      for (int d0 = 0; d0 < 4; ++d0) *(unsigned short*)(ep + lane_e + ro + d0 * 64) = (unsigned short)(cvtpk(o[d0][r] * rli[r], 0.f) & 0xffffu); }
    asm volatile("s_waitcnt lgkmcnt(0)" ::: "memory");
    int lane_q = lane; asm volatile("" : "+v"(lane_q));
    const int row0 = lane_q >> 4, ch = lane_q & 15;
    unsigned short* Yw = Ob + (long)(wid * QBLK + row0) * LDO + ch * 8; const unsigned short* Gw = Gb + (long)(wid * QBLK + row0) * LDO + ch * 8;
#pragma unroll
    for (int hf = 0; hf < 2; ++hf) { u32x4 gv[4], ov[4];
#pragma unroll
      for (int i = 0; i < 4; ++i) gv[i] = *(const u32x4*)(Gw + (long)(4 * (4 * hf + i)) * LDO);
#pragma unroll
      for (int i = 0; i < 4; ++i) ov[i] = *(const u32x4*)(ep + (row0 + 4 * (4 * hf + i)) * 272 + ch * 16);
#pragma unroll
      for (int i = 0; i < 4; ++i) { u32x4 w;
#pragma unroll
        for (int j = 0; j < 4; ++j) { const float lo = __uint_as_float(ov[i][j] << 16) * __uint_as_float(gv[i][j] << 16), hi2 = __uint_as_float(ov[i][j] & 0xffff0000u) * __uint_as_float(gv[i][j] & 0xffff0000u); w[j] = cvtpk(lo, hi2); }
        *(u32x4*)(Yw + (long)(4 * (4 * hf + i)) * LDO) = w; }
      asm volatile("" ::: "memory"); }
  }
  __syncthreads();
#undef SLOAD
#undef SWRITE
#undef SWAIT
#undef RESC
}

}

#ifndef ATT_NQR_A
#define ATT_NQR_A 6
#endif
#ifndef ATT_NQR_B
#define ATT_NQR_B 10
#endif
#ifndef ATT_SD_A
#define ATT_SD_A 2
#endif
#ifndef ATT_SD_B
#define ATT_SD_B 1
#endif
__device__ __forceinline__ void attn_phase(const Frame& F, const Args& a, unsigned char* lds_generic) {
    unsigned char* ws = a.ws;
    const bf16_t* A1 = (const bf16_t*)(ws + WS_A1); const bf16_t* QB = (const bf16_t*)(ws + WS_QB); const bf16_t* KVB = (const bf16_t*)(ws + WS_KVB);
    const bf16_t* KRb = (const bf16_t*)(ws + WS_KR); const bf16_t* G0 = (const bf16_t*)(ws + WS_G0); bf16_t* Y0 = (bf16_t*)(ws + WS_Y0);
    char* lds = (char*)lds_generic;
    const int x = F.bid & 7, slot = F.bid >> 3;
    for (int ii = 0; ii < ((a.var & 1) ? 0 : 5); ++ii) {
        int b, hd, q0, kb, seq;
        if (ii < 4) { const int i = (ii & 1) + 4 * (ii >> 1); const int p = i * 8 + x; b = p >> 5; hd = p & 31; q0 = b * SB + slot * 256; kb = b * SB; seq = SB; }
        else { if (F.bid >= 32) break; b = F.bid >> 4; hd = F.bid & 15; q0 = b * SB + S; kb = q0; seq = CTX; }
        att::attn_dense_body<att::bf16, 3072, 3072, 4096, 128, 64, ATT_SD_A, ATT_NQR_A>(A1 + (size_t)q0 * 3072 + hd * 128, A1 + (size_t)kb * 3072 + 2048 + (hd >> 2) * 128, nullptr,
                            A1 + (size_t)kb * 3072 + 2560 + (hd >> 2) * 128, Y0 + (size_t)q0 * 4096 + hd * 128, G0 + (size_t)q0 * 4096 + hd * 128, seq, lds);
        __syncthreads();
    }
    for (int ii = 0; ii < ((a.var & 2) ? 0 : 5); ++ii) {
        int b, h, q0, kb, seq;
        if (ii < 4) { const int i = 2 + (ii & 1) + 4 * (ii >> 1); const int p = i * 8 + x; b = p >> 5; h = (p & 31) - 16; q0 = b * SB + slot * 256; kb = b * SB; seq = SB; }
        else { if (F.bid >= 32) break; b = F.bid >> 4; h = F.bid & 15; q0 = b * SB + S; kb = q0; seq = CTX; }
        att::attn_dense_body<att::bf16, 3072, 4096, 4096, 192, 64, ATT_SD_B, ATT_NQR_B>(QB + (size_t)q0 * 3072 + h * 192, KVB + (size_t)kb * 4096 + h * 256, KRb + (size_t)kb * 64,
                            KVB + (size_t)kb * 4096 + h * 256 + 128, Y0 + (size_t)q0 * 4096 + 2048 + h * 128, G0 + (size_t)q0 * 4096 + 2048 + h * 128, seq, lds);
        __syncthreads();
    }
}
}
namespace fk {
constexpr int NCH = SB / 64;
constexpr int NC2_ = SB / 32;
struct EpiL1 {
    static constexpr bool PERM = true;
    bf16_t* QK1; bf16_t* VT; bf16_t* U1; bf16_t* G1; float* GD; int skip; LAS unsigned char* vx;
    __device__ __forceinline__ void operator()(const f32x4 (&acc)[2][2][4][2], const Unit& u, int wr, int wc, int fr, int fq) const {
        if (skip) return;
        const int pn = u.pn; const int rowl0 = wr * 64 + fr; const size_t row0 = (size_t)u.pm * 256 + rowl0; const int cl = wc * 32 + 8 * fq;
        if (pn >= 12 && pn < 24) {
            const int b = u.pm / PPB, pb = u.pm % PPB; const int cv = (pn - 12) * 256, h = cv >> 9; const int lane = fq * 16 + fr;
            LAS bf16_t* w = (LAS bf16_t*)(vx + (wr * 4 + wc) * 2048);
#pragma unroll
            for (int ai = 0; ai < 2; ++ai)
#pragma unroll
                for (int bj = 0; bj < 2; ++bj)
#pragma unroll
                    for (int mh = 0; mh < 2; ++mh) {
#pragma unroll
                        for (int mm = 0; mm < 2; ++mm) { const int m = 2 * mh + mm; const f32x4 x0 = acc[ai][bj][m][0], x1 = acc[ai][bj][m][1]; const int tl = 16 * mm + fr;
#pragma unroll
                            for (int j = 0; j < 4; ++j) { w[(8 * fq + j) * 32 + tl] = (bf16_t)(cvt_pk_bf16(x0[j], 0.f) & 0xffffu); w[(8 * fq + 4 + j) * 32 + tl] = (bf16_t)(cvt_pk_bf16(x1[j], 0.f) & 0xffffu); } }
                        LDS_WAIT(); asm volatile("" ::: "memory");
                        const int c32 = pb * 8 + 4 * ai + 2 * wr + mh; const int e0 = (cv & 511) + bj * 128 + wc * 32;
                        bf16_t* dst = VT + ((size_t)((b * 6 + h) * NC2_ + c32) * 512 + e0) * 32;
#pragma unroll
                        for (int i = 0; i < 2; ++i) { const int q = lane + 64 * i, el = q >> 2, tc = q & 3; *(u32x4*)(dst + el * 32 + tc * 8) = *(const LAS u32x4*)(w + el * 32 + tc * 8); }
                        LDS_WAIT(); asm volatile("" ::: "memory");
                    }
        } else if (pn < 28) {
            bf16_t* base; int ld, c0;
            if (pn < 12) { base = QK1; ld = 3072; c0 = pn * 256; } else { base = U1; ld = 1024; c0 = (pn - 24) * 256; }
#pragma unroll
            for (int ai = 0; ai < 2; ++ai)
#pragma unroll
                for (int m = 0; m < 4; ++m)
#pragma unroll
                    for (int bj = 0; bj < 2; ++bj) *(u32x4*)(base + (row0 + ai * 128 + 16 * m) * ld + c0 + bj * 128 + cl) = pack8(acc[ai][bj][m][0], acc[ai][bj][m][1]);
        } else if (pn < 44) {
#pragma unroll
            for (int ai = 0; ai < 2; ++ai)
#pragma unroll
                for (int m = 0; m < 4; ++m)
#pragma unroll
                    for (int bj = 0; bj < 2; ++bj) { f32x4 x0 = acc[ai][bj][m][0], x1 = acc[ai][bj][m][1];
#pragma unroll
                        for (int i = 0; i < 4; ++i) { x0[i] = fast_silu(x0[i]); x1[i] = fast_silu(x1[i]); }
                        *(u32x4*)(G1 + (row0 + ai * 128 + 16 * m) * 4096 + (pn - 28) * 256 + bj * 128 + cl) = pack8(x0, x1); }
        } else {
            if (wc == 0) {
#pragma unroll
                for (int ai = 0; ai < 2; ++ai)
#pragma unroll
                    for (int m = 0; m < 4; ++m) { float* g = GD + (row0 + ai * 128 + 16 * m) * 32 + 8 * fq; *(f32x4*)g = acc[ai][0][m][0]; *(f32x4*)(g + 4) = acc[ai][0][m][1]; } }
        }
    }
};
struct EpiPlain {
    static constexpr bool PERM = true;
    bf16_t* O; int ld;
    __device__ __forceinline__ void operator()(const f32x4 (&acc)[2][2][4][2], const Unit& u, int wr, int wc, int fr, int fq) const {
        const size_t row0 = (size_t)u.pm * 256 + wr * 64 + fr; const int c0 = u.pn * 256 + wc * 32 + 8 * fq;
#pragma unroll
        for (int ai = 0; ai < 2; ++ai)
#pragma unroll
            for (int m = 0; m < 4; ++m)
#pragma unroll
                for (int bj = 0; bj < 2; ++bj) *(u32x4*)(O + (row0 + ai * 128 + 16 * m) * ld + c0 + bj * 128) = pack8(acc[ai][bj][m][0], acc[ai][bj][m][1]);
    }
};
struct OrderFn {
    int bid;
    __device__ bool next(int i, Unit& u) const { if (i >= 1) return false; const int half = bid >> 7, t = bid & 127; u.pm = (t >> 3) + 16 * half; u.pn = (t & 7) + 8 * half; u.ko = 0; return true; }
};
struct EpiPcs {
    static constexpr bool PERM = true;
    bf16_t* P; float scale;
    __device__ __forceinline__ void operator()(const f32x4 (&acc)[2][2][4][2], const Unit& u, int wr, int wc, int fr, int fq) const {
        const size_t row0 = (size_t)(u.pm >> 4) * 4096 + (size_t)(u.pm & 15) * 256 + wr * 64 + fr; const int c0 = (u.pn & 7) * 256 + wc * 32 + 8 * fq;
#pragma unroll
        for (int ai = 0; ai < 2; ++ai)
#pragma unroll
            for (int m = 0; m < 4; ++m)
#pragma unroll
                for (int bj = 0; bj < 2; ++bj) *(u32x4*)(P + (row0 + ai * 128 + 16 * m) * 2048 + c0 + bj * 128) = pack8(acc[ai][bj][m][0] * scale, acc[ai][bj][m][1] * scale);
    }
};
__device__ __forceinline__ void fold_phase(const Frame& F, const bf16_t* AB, bf16_t* BF, int w0, int nw) {
    const int gw = F.bid * NWAVES + F.wave - w0; if (gw < 0 || gw >= nw) return;
    LAS float* scr = (LAS float*)(F.lds + 4096 + F.wave * (64 * 65 * 4));
    const int lane = F.lane, rr = lane >> 3, c8 = (lane & 7) * 8;
    for (int it = gw; it < 2 * 2 * 66 * 16; it += nw) {
        const int half = it / 2112, r0 = it % 2112, b = r0 / 1056, r = r0 % 1056, kb = r / 16, cb = r % 16;
        const int ch = cb * 64 + c8, g = ch >> 8, l = ch & 255;
        const bf16_t* base = AB + (size_t)b * SB * 2048 + g * 512 + half * 256 + l;
        u32x4 p0[8], p1[8];
#pragma unroll
        for (int jj = 0; jj < 8; ++jj) { const int kk = kb * 64 + jj * 8 + rr; const u32x4 z = {0u, 0u, 0u, 0u};
            const bool v0 = half == 0 ? (kk <= 4096) : (kk >= 1 && kk <= 4095), v1 = (kk >= 1 && kk <= 4095);
            p0[jj] = v0 ? *(const u32x4*)(base + (size_t)kk * 2048) : z; p1[jj] = v1 ? *(const u32x4*)(base + (size_t)(8192 - kk) * 2048) : z; }
        const float sg = half == 0 ? 1.f : -1.f;
#pragma unroll
        for (int jj = 0; jj < 8; ++jj) { const int j = jj * 8 + rr; LAS float* dst = scr + j * 65 + c8;
            const unsigned a[4] = {p0[jj].x, p0[jj].y, p0[jj].z, p0[jj].w}, m[4] = {p1[jj].x, p1[jj].y, p1[jj].z, p1[jj].w};
#pragma unroll
            for (int i = 0; i < 4; ++i) { dst[2 * i] = bf_lo(a[i]) + sg * bf_lo(m[i]); dst[2 * i + 1] = bf_hi(a[i]) + sg * bf_hi(m[i]); } }
        LDS_WAIT(); asm volatile("" ::: "memory");
#pragma unroll
        for (int t = 0; t < 8; ++t) { const int cr = (lane >> 3) + 8 * t, k8 = (lane & 7) * 8; float v[8];
#pragma unroll
            for (int i = 0; i < 8; ++i) v[i] = scr[(k8 + i) * 65 + cr];
            u32x4 o; o.x = cvt_pk_bf16(v[0], v[1]); o.y = cvt_pk_bf16(v[2], v[3]); o.z = cvt_pk_bf16(v[4], v[5]); o.w = cvt_pk_bf16(v[6], v[7]);
            *(u32x4*)(BF + ((size_t)half * 2048 + b * 1024 + cb * 64 + cr) * FKP + kb * 64 + k8) = o; }
        LDS_WAIT(); asm volatile("" ::: "memory");
    }
}
__device__ __forceinline__ void f4096_phase(const Frame& F, const bf16_t* AB, float* F4, int item, float scale) {
    const int b = item >> 4, cb = item & 15, lane = F.lane, rr = lane >> 3, c8 = (lane & 7) * 8;
    const int ch = cb * 64 + c8, g = ch >> 8, l = ch & 255;
    const bf16_t* base = AB + ((size_t)b * SB + F.wave * 1024 + rr) * 2048 + g * 512 + l;
    float acc[8] = {0.f, 0.f, 0.f, 0.f, 0.f, 0.f, 0.f, 0.f};
#pragma unroll 8
    for (int i = 0; i < 128; ++i) { const u32x4 v = *(const u32x4*)(base + (size_t)(8 * i) * 2048);
        acc[0] += bf_lo(v.x); acc[1] += bf_hi(v.x); acc[2] += bf_lo(v.y); acc[3] += bf_hi(v.y); acc[4] += bf_lo(v.z); acc[5] += bf_hi(v.z); acc[6] += bf_lo(v.w); acc[7] += bf_hi(v.w); }
    const float sg = (rr & 1) ? -1.f : 1.f;
#pragma unroll
    for (int i = 0; i < 8; ++i) { float v = acc[i] * sg; v += __shfl_xor(v, 8); v += __shfl_xor(v, 16); v += __shfl_xor(v, 32); acc[i] = v; }
    LAS float* red = (LAS float*)F.lds;
    __syncthreads();
    if (lane < 8) {
#pragma unroll
        for (int i = 0; i < 8; ++i) red[F.wave * 64 + lane * 8 + i] = acc[i]; }
    __syncthreads();
    if (F.tid < 64) { float s = 0.f;
#pragma unroll
        for (int w = 0; w < 8; ++w) s += red[w * 64 + F.tid];
        F4[b * 1024 + cb * 64 + F.tid] = s * scale; }
    __syncthreads();
}
__device__ __forceinline__ void fnet_finish_phase(const Frame& F, const bf16_t* PCS, const float* F4, const bf16_t* G1, bf16_t* Y1) {
    const int gw = F.bid * NWAVES + F.wave, NGW = F.G * NWAVES; const int ch = F.lane * 16;
    for (int it = gw; it < 2 * 1024; it += NGW) { const int b = it >> 10, k0 = (it & 1023) * 4;
        u32x4 pc[4][2], ps[4][2], ga[4][2], gb[4][2];
#pragma unroll
        for (int i = 0; i < 4; ++i) { const int k = k0 + i; const int km = k ? 8192 - k : 0;
#pragma unroll
            for (int hh = 0; hh < 2; ++hh) { pc[i][hh] = *(const u32x4*)(PCS + (size_t)k * 2048 + b * 1024 + ch + hh * 8); ps[i][hh] = *(const u32x4*)(PCS + (size_t)(4096 + k) * 2048 + b * 1024 + ch + hh * 8);
                ga[i][hh] = *(const u32x4*)(G1 + ((size_t)b * SB + k) * 4096 + 3072 + ch + hh * 8); gb[i][hh] = *(const u32x4*)(G1 + ((size_t)b * SB + km) * 4096 + 3072 + ch + hh * 8); } }
#pragma unroll
        for (int i = 0; i < 4; ++i) { const int k = k0 + i; const size_t ya = ((size_t)b * SB + k) * 4096 + 3072 + ch, yb = ((size_t)b * SB + (8192 - k)) * 4096 + 3072 + ch;
#pragma unroll
            for (int hh = 0; hh < 2; ++hh) { u32x4 oa, ob;
#pragma unroll
                for (int j = 0; j < 4; ++j) { const float cl = bf_lo(pc[i][hh][j]), chh = bf_hi(pc[i][hh][j]), sl = bf_lo(ps[i][hh][j]), sh = bf_hi(ps[i][hh][j]);
                    oa[j] = cvt_pk_bf16((cl - sl) * bf_lo(ga[i][hh][j]), (chh - sh) * bf_hi(ga[i][hh][j])); ob[j] = cvt_pk_bf16((cl + sl) * bf_lo(gb[i][hh][j]), (chh + sh) * bf_hi(gb[i][hh][j])); }
                *(u32x4*)(Y1 + ya + hh * 8) = oa; if (k) *(u32x4*)(Y1 + yb + hh * 8) = ob; } }
    }
    if (gw < 2) { const int b = gw; const size_t ya = ((size_t)b * SB + 4096) * 4096 + 3072 + ch;
#pragma unroll
        for (int hh = 0; hh < 2; ++hh) { const u32x4 g = *(const u32x4*)(G1 + ya + hh * 8); const f32x4 f0 = *(const f32x4*)(F4 + b * 1024 + ch + hh * 8), f1 = *(const f32x4*)(F4 + b * 1024 + ch + hh * 8 + 4);
            f32x4 x0 = f0, x1 = f1; x0[0] *= bf_lo(g.x); x0[1] *= bf_hi(g.x); x0[2] *= bf_lo(g.y); x0[3] *= bf_hi(g.y); x1[0] *= bf_lo(g.z); x1[1] *= bf_hi(g.z); x1[2] *= bf_lo(g.w); x1[3] *= bf_hi(g.w);
            *(u32x4*)(Y1 + ya + hh * 8) = pack8(x0, x1); } }
}
__device__ __forceinline__ void gla_finish_phase(const Frame& F, const bf16_t* O0, const bf16_t* O1, const bf16_t* O2, const bf16_t* O3, const bf16_t* G1, const float* on_g, bf16_t* Y1) {
    const int base = F.bid * (NB * S / 256);
    const f32x4 o0 = *(const f32x4*)(on_g + F.lane * 8), o1 = *(const f32x4*)(on_g + F.lane * 8 + 4);
    for (int i0 = F.wave; i0 < NB * S / 256; i0 += 8) {
        const int ml = base + i0; const size_t row = (size_t)(ml / S) * SB + (ml % S);
        u32x4 pa[6], pb[6], pc[6], pd[6], gg[6];
#pragma unroll
        for (int h = 0; h < 6; ++h) { const size_t ix = row * 3072 + h * 512 + F.lane * 8;
            pa[h] = *(const u32x4*)(O0 + ix); pb[h] = *(const u32x4*)(O1 + ix); pc[h] = *(const u32x4*)(O2 + ix); pd[h] = *(const u32x4*)(O3 + ix);
            gg[h] = *(const u32x4*)(G1 + row * 4096 + h * 512 + F.lane * 8); }
#pragma unroll
        for (int h = 0; h < 6; ++h) { float v[8];
#pragma unroll
            for (int j = 0; j < 4; ++j) { v[2 * j] = (bf_lo(pa[h][j]) + bf_lo(pb[h][j])) + (bf_lo(pc[h][j]) + bf_lo(pd[h][j])); v[2 * j + 1] = (bf_hi(pa[h][j]) + bf_hi(pb[h][j])) + (bf_hi(pc[h][j]) + bf_hi(pd[h][j])); }
            float ss = 0.f;
#pragma unroll
            for (int i = 0; i < 8; ++i) ss += v[i] * v[i];
            const float rs = 1.0f / sqrtf(wave_sum(ss) * (1.f / 512.f) + EPS);
            f32x4 x0 = (f32x4){v[0], v[1], v[2], v[3]} * rs * o0, x1 = (f32x4){v[4], v[5], v[6], v[7]} * rs * o1; const u32x4 g = gg[h];
            x0[0] *= bf_lo(g.x); x0[1] *= bf_hi(g.x); x0[2] *= bf_lo(g.y); x0[3] *= bf_hi(g.y); x1[0] *= bf_lo(g.z); x1[1] *= bf_hi(g.z); x1[2] *= bf_lo(g.w); x1[3] *= bf_hi(g.w);
            *(u32x4*)(Y1 + row * 4096 + h * 512 + F.lane * 8) = pack8(x0, x1); }
    }
}
__device__ __forceinline__ void final_norm_phase(const Frame& F, float* out, const float* fg) {
    const int base = F.bid * (NB * S / 256);
    for (int i0 = F.wave; i0 < NB * S / 256; i0 += 16) {
        const int rot = (F.bid * 5) & 63;
        f32x4* xa = (f32x4*)(out + (size_t)(base + ((i0 + rot) & 63)) * D) + F.lane; f32x4* xb = (f32x4*)(out + (size_t)(base + ((i0 + 8 + rot) & 63)) * D) + F.lane;
        f32x4 va[16], vb[16]; float sa = 0.f, sb = 0.f;
#pragma unroll
        for (int j = 0; j < 16; ++j) va[j] = xa[64 * j];
#pragma unroll
        for (int j = 0; j < 16; ++j) vb[j] = xb[64 * j];
#pragma unroll
        for (int j = 0; j < 16; ++j) sa += (va[j].x * va[j].x + va[j].y * va[j].y) + (va[j].z * va[j].z + va[j].w * va[j].w);
#pragma unroll
        for (int j = 0; j < 16; ++j) sb += (vb[j].x * vb[j].x + vb[j].y * vb[j].y) + (vb[j].z * vb[j].z + vb[j].w * vb[j].w);
        const float rsa = 1.0f / sqrtf(wave_sum(sa) * (1.f / D) + EPS), rsb = 1.0f / sqrtf(wave_sum(sb) * (1.f / D) + EPS);
#pragma unroll
        for (int j = 0; j < 16; ++j) { const f32x4 gg = *(const f32x4*)(fg + 4 * (F.lane + 64 * j)); xa[64 * j] = va[j] * rsa * gg; xb[64 * j] = vb[j] * rsb * gg; }
    }
}
}
namespace fk {
constexpr int NC2 = SB / 32;
__device__ __forceinline__ size_t gla_idx2(int dir, int b, int h, int c) { return (size_t)(((dir * 2 + b) * 6 + h) * NC2 + c); }
__device__ __forceinline__ int swz4(int x) { return (0x1320 >> (4 * x)) & 3; }
__device__ __forceinline__ void gla_prep_unit(const Frame& F, const Args& a, int b, int h, int ci) {
    unsigned char* ws = a.ws;
    const bf16_t* QK1 = (const bf16_t*)(ws + WS_QK1); const float* GD = (const float*)(ws + WS_GD);
    bf16_t* QT = (bf16_t*)(ws + WS_QT); bf16_t* KT = (bf16_t*)(ws + WS_KT); bf16_t* AT = (bf16_t*)(ws + WS_AT); float* GAM = (float*)(ws + WS_GAM);
    const int tid = F.tid, lane = F.lane, wid = F.wave;
    const size_t r0 = (size_t)b * SB + 64 * ci;
    LAS float* gds = (LAS float*)(F.lds);
    LAS bf16_t* qs = (LAS bf16_t*)(F.lds + 8192);
    LAS bf16_t* ks = (LAS bf16_t*)(F.lds + 8192 + 33792);
    LAS bf16_t* ktl = (LAS bf16_t*)(F.lds + 8192 + 2 * 33792);
    __syncthreads();
    *(LAS f32x4*)(gds + tid * 4) = *(const f32x4*)(GD + (r0 + (tid >> 3)) * 32 + (tid & 7) * 4);
    __syncthreads();
    if (a.var & 8) return;
    const int r32 = lane & 31, hi = lane >> 5, d = 32 * wid + r32;
#pragma unroll
    for (int dir = 0; dir < 2; ++dir) {
        constexpr float L2E = 1.4426950408889634f;
        const float* wg = a.in[dir ? 18 : 16] + h * 256 + d; const float bias = a.in[dir ? 19 : 17][h * 256 + d] * L2E;
        float wgv[8];
#pragma unroll
        for (int kk = 0; kk < 8; ++kk) wgv[kk] = wg[(2 * kk + hi) * 1536] * L2E;
        u32x4 rq[4], rk[4];
#pragma unroll
        for (int i = 0; i < 4; ++i) { const int q = tid + 512 * i, tok = q >> 5, dc = q & 31; const bf16_t* src = QK1 + (r0 + tok) * 3072 + h * 256 + dc * 8;
            rq[i] = *(const u32x4*)src; rk[i] = *(const u32x4*)(src + 1536); }
        float cum[2][16], last[2];
#pragma unroll
        for (int tt = 0; tt < 2; ++tt) {
            f32x16 z;
#pragma unroll
            for (int r = 0; r < 16; ++r) z[r] = bias;
            const LAS float* gp = gds + (tt * 32 + r32) * 32 + 16 * dir + hi;
#pragma unroll
            for (int kk = 0; kk < 8; ++kk) z = __builtin_amdgcn_mfma_f32_32x32x2f32(gp[2 * kk], wgv[kk], z, 0, 0, 0);
            float lg[16];
#pragma unroll
            for (int r = 0; r < 16; ++r) lg[r] = (fminf(z[r], 0.f) - __builtin_amdgcn_logf(1.f + __builtin_amdgcn_exp2f(-fabsf(z[r])))) * 0.0625f;
            float T[4], PT[4];
#pragma unroll
            for (int q = 0; q < 4; ++q) {
                if (dir == 0) { lg[4 * q + 1] += lg[4 * q]; lg[4 * q + 2] += lg[4 * q + 1]; lg[4 * q + 3] += lg[4 * q + 2]; T[q] = lg[4 * q + 3]; }
                else { lg[4 * q + 2] += lg[4 * q + 3]; lg[4 * q + 1] += lg[4 * q + 2]; lg[4 * q] += lg[4 * q + 1]; T[q] = lg[4 * q]; }
                PT[q] = __shfl_xor(T[q], 32); }
            float offs[4];
            if (dir == 0) { float run = 0.f;
#pragma unroll
                for (int q = 0; q < 4; ++q) { const float t0 = hi ? PT[q] : T[q], t1 = hi ? T[q] : PT[q]; offs[q] = run + (hi ? t0 : 0.f); run += t0 + t1; }
                last[tt] = run; }
            else { float run = 0.f;
#pragma unroll
                for (int q = 3; q >= 0; --q) { const float t0 = hi ? PT[q] : T[q], t1 = hi ? T[q] : PT[q]; offs[q] = run + (hi ? 0.f : t1); run += t0 + t1; }
                last[tt] = run; }
#pragma unroll
            for (int r = 0; r < 16; ++r) cum[tt][r] = lg[r] + offs[r >> 2];
        }
#pragma unroll
        for (int i = 0; i < 4; ++i) { const int q = tid + 512 * i, tok = q >> 5, dc = q & 31; *(LAS u32x4*)(qs + tok * 264 + dc * 8) = rq[i]; *(LAS u32x4*)(ks + tok * 264 + dc * 8) = rk[i]; }
        float el[2];
#pragma unroll
        for (int tt = 0; tt < 2; ++tt) { el[tt] = __builtin_amdgcn_exp2f(last[tt]); if (hi == 0) GAM[gla_idx2(dir, b, h, 2 * ci + tt) * 256 + d] = el[tt]; }
        __syncthreads();
#pragma unroll
        for (int tt = 0; tt < 2; ++tt)
#pragma unroll
            for (int j = 0; j < 8; ++j) { float kh2[2]; const int tl0 = ((2 * j) & 3) + 8 * ((2 * j) >> 2) + 4 * hi;
#pragma unroll
                for (int u = 0; u < 2; ++u) { const int t = 32 * tt + tl0 + u; const float e1 = __builtin_amdgcn_exp2f(cum[tt][2 * j + u]), e2 = __builtin_amdgcn_rcpf(e1);
                    const float qv = bf2f(qs[t * 264 + d]), kv = bf2f(ks[t * 264 + d]); const float kt = kv * e2;
                    qs[t * 264 + d] = (bf16_t)(cvt_pk_bf16(qv * e1, 0.f) & 0xffffu); ks[t * 264 + d] = (bf16_t)(cvt_pk_bf16(kt, 0.f) & 0xffffu); kh2[u] = kt * el[tt]; }
                *(LAS unsigned*)(ktl + (tt * 256 + d) * 34 + tl0) = cvt_pk_bf16(kh2[0], kh2[1]); }
        __syncthreads();
#pragma unroll
        for (int i = 0; i < 4; ++i) { const int q = tid + 512 * i, t2 = q >> 10, rem = q & 1023, dd = rem >> 2, c4 = rem & 3; const LAS unsigned* src = (const LAS unsigned*)(ktl + (t2 * 256 + dd) * 34 + c4 * 8);
            *(u32x4*)(KT + gla_idx2(dir, b, h, 2 * ci + t2) * 8192 + dd * 32 + c4 * 8) = (u32x4){src[0], src[1], src[2], src[3]}; }
#pragma unroll
        for (int i = 0; i < 4; ++i) { const int q = tid + 512 * i, t2 = q >> 10, rem = q & 1023, tl = rem >> 5, pc = rem & 31, blk = pc >> 2, gg = pc & 3;
            const LAS u32x2* s0 = (const LAS u32x2*)(qs + (32 * t2 + tl) * 264 + blk * 32 + 4 * gg); const LAS u32x2* s1 = (const LAS u32x2*)(qs + (32 * t2 + tl) * 264 + blk * 32 + 16 + 4 * gg);
            const u32x2 lo = *s0, hi2 = *s1;
            *(u32x4*)(QT + gla_idx2(dir, b, h, 2 * ci + t2) * 8192 + (blk >> 2) * 4096 + tl * 128 + (pc & 15) * 8) = (u32x4){lo.x, lo.y, hi2.x, hi2.y}; }
        if (wid < 2) { f32x16 acc = {};
#pragma unroll
            for (int kk = 0; kk < 16; ++kk) { const bf16x8 A = *(const LAS bf16x8*)(qs + (wid * 32 + r32) * 264 + kk * 16 + hi * 8), Bv = *(const LAS bf16x8*)(ks + (wid * 32 + r32) * 264 + kk * 16 + hi * 8);
                acc = __builtin_amdgcn_mfma_f32_32x32x16_bf16(A, Bv, acc, 0, 0, 0); }
            bf16_t* at = AT + gla_idx2(dir, b, h, 2 * ci + wid) * 1024;
#pragma unroll
            for (int r = 0; r < 16; ++r) { const int itok = (r & 3) + 8 * (r >> 2) + 4 * hi; const bool keep = dir ? (r32 >= itok) : (r32 <= itok);
                at[itok * 32 + r32] = (bf16_t)(cvt_pk_bf16(keep ? acc[r] : 0.f, 0.f) & 0xffffu); } }
        __syncthreads();
    }
}
__device__ __forceinline__ void gla_prep_phase(const Frame& F, const Args& a) {
    for (int u = F.bid; u < NB * 6 * NCH; u += F.G) { const int ci = u % NCH, bh = u / NCH; gla_prep_unit(F, a, bh / 6, bh % 6, ci); }
}
#ifndef SC_SYNC
#define SC_SYNC 0
#endif
template <int NBE>
__device__ __forceinline__ void gla_scan_wg(const Frame& F, const Args& a, int dir, int b, int h, int dhalf, int esl) {
    constexpr int SC_QT = 0, SC_KT = 8192, SC_VT = 16384, SC_AT = SC_VT + 8192 * NBE, SC_GAM = SC_AT + 2048, SC_STAGE = SC_GAM + 512, SC_NS = NBE == 2 ? 4 : 5, EW = 128 * NBE;
    unsigned char* ws = a.ws;
    const bf16_t* QT = (const bf16_t*)(ws + WS_QT); const bf16_t* KT = (const bf16_t*)(ws + WS_KT); const bf16_t* AT = (const bf16_t*)(ws + WS_AT); const float* GAM = (const float*)(ws + WS_GAM);
    const bf16_t* VT = (const bf16_t*)(ws + WS_VT);
    bf16_t* O = (bf16_t*)(ws + (dir ? (dhalf ? WS_O11 : WS_O10) : (dhalf ? WS_O01 : WS_O00)));
    const int lane = F.lane, wid = F.wave, c = lane & 15, g = lane >> 4;
    LAS unsigned char* lds = F.lds;
    unsigned qsrc, ksrc, vsrc[NBE], asrc;
    { const int P = wid * 64 + lane;
      { const int r = P >> 4, sp = P & 15; qsrc = (unsigned)(dhalf * 4096 + r * 128 + (sp ^ (r & 15)) * 8); }
      { const int dd = P >> 2, sp = P & 3; ksrc = (unsigned)(dhalf * 4096 + dd * 32 + (sp ^ swz4((dd >> 2) & 3)) * 8); }
#pragma unroll
      for (int be = 0; be < NBE; ++be) { const int Pv = (wid + 8 * be) * 64 + lane; const int e = Pv >> 2, sp = Pv & 3; vsrc[be] = (unsigned)((esl * EW + e) * 32 + (sp ^ swz4((e >> 2) & 3)) * 8); }
      { const int i = (P >> 2) & 31, sp = P & 3; asrc = (unsigned)(i * 32 + (sp ^ swz4((i >> 2) & 3)) * 8); } }
    const int sw = swz4(c >> 2);
    const int q_rd = c * 256;
    const int k_rd = SC_KT + c * 64 + ((g ^ sw) * 16);
    const int v_rd = SC_VT + (16 * wid + c) * 64 + ((g ^ sw) * 16);
    const int a_rd = SC_AT + c * 64 + ((g ^ sw) * 16);
    const int g_rd = SC_GAM + 16 * g;
    f32x4 St[NBE][8];
#pragma unroll
    for (int be = 0; be < NBE; ++be)
#pragma unroll
        for (int t = 0; t < 8; ++t) St[be][t] = (f32x4){0.f, 0.f, 0.f, 0.f};
#define SC_CI(s) (dir ? (NC2 - 1 - (s)) : (((s) + 256) % NC2))
#define SC_DMA(slot, ci_) do { const size_t x_ = gla_idx2(dir, b, h, (ci_)); const int so_ = (slot) * SC_STAGE; \
        __builtin_amdgcn_global_load_lds((const unsigned*)(QT + x_ * 8192 + qsrc), (LAS unsigned*)(lds + so_ + SC_QT + wid * 1024), 16, 0, 0); \
        __builtin_amdgcn_global_load_lds((const unsigned*)(KT + x_ * 8192 + ksrc), (LAS unsigned*)(lds + so_ + SC_KT + wid * 1024), 16, 0, 0); \
        _Pragma("unroll") for (int be = 0; be < NBE; ++be) \
            __builtin_amdgcn_global_load_lds((const unsigned*)(VT + ((size_t)((b * 6 + h) * NC2 + (ci_))) * 16384 + vsrc[be]), (LAS unsigned*)(lds + so_ + SC_VT + (wid + 8 * be) * 1024), 16, 0, 0); \
        if (wid < 2) __builtin_amdgcn_global_load_lds((const unsigned*)(AT + x_ * 1024 + asrc), (LAS unsigned*)(lds + so_ + SC_AT + wid * 1024), 16, 0, 0); \
        if (wid == 2) { if (lane < 32) __builtin_amdgcn_global_load_lds((const unsigned*)(GAM + x_ * 256 + dhalf * 128 + lane * 4), (LAS unsigned*)(lds + so_ + SC_GAM), 16, 0, 0); } } while (0)
    __syncthreads();
#pragma unroll
    for (int p = 0; p < SC_NS - 1; ++p) SC_DMA(p, SC_CI(p));
    for (int s = 0; s < NC2; ++s) {
        const int ci = SC_CI(s); const int so = (s % SC_NS) * SC_STAGE;
        if (s < SC_NS || SC_SYNC || (a.var & 56)) __builtin_amdgcn_s_waitcnt(0x0F70);
        else if (NBE == 1) { if (wid < 3) __builtin_amdgcn_s_waitcnt(0x4F74); else __builtin_amdgcn_s_waitcnt(0x4F71); }
        else { if (wid < 3) __builtin_amdgcn_s_waitcnt(0x4F76); else __builtin_amdgcn_s_waitcnt(0x4F74); }
        __builtin_amdgcn_s_barrier(); asm volatile("" ::: "memory");
        if (!(a.var & 8)) { const int sn = s + SC_NS - 1; const int cn = SC_CI(sn < NC2 ? sn : NC2 - 1); SC_DMA(sn % SC_NS, cn); }
        if (a.var & 16) continue;
        bf16x8 vf[NBE], qf[4][2], af[2], kf[8]; f32x4 gmv[8];
#pragma unroll
        for (int be = 0; be < NBE; ++be) vf[be] = *(const LAS bf16x8*)(lds + so + v_rd + be * 8192);
#pragma unroll
        for (int ks = 0; ks < 4; ++ks) { const int chk = ((4 * ks + g) ^ c) * 16;
#pragma unroll
            for (int tt = 0; tt < 2; ++tt) qf[ks][tt] = *(const LAS bf16x8*)(lds + so + SC_QT + q_rd + tt * 4096 + chk); }
        if (dhalf == 0) {
#pragma unroll
            for (int tt = 0; tt < 2; ++tt) af[tt] = *(const LAS bf16x8*)(lds + so + a_rd + tt * 1024); }
#pragma unroll
        for (int t = 0; t < 8; ++t) { kf[t] = *(const LAS bf16x8*)(lds + so + k_rd + t * 1024); gmv[t] = *(const LAS f32x4*)(lds + so + g_rd + t * 64); }
        __builtin_amdgcn_sched_barrier(0);
#pragma unroll
        for (int be = 0; be < NBE; ++be) {
            f32x4 oT[2] = {(f32x4){0.f, 0.f, 0.f, 0.f}, (f32x4){0.f, 0.f, 0.f, 0.f}};
#pragma unroll
            for (int ks = 0; ks < 4; ++ks) {
                u32x4 aw; aw.x = cvt_pk_bf16(St[be][2 * ks][0], St[be][2 * ks][1]); aw.y = cvt_pk_bf16(St[be][2 * ks][2], St[be][2 * ks][3]);
                aw.z = cvt_pk_bf16(St[be][2 * ks + 1][0], St[be][2 * ks + 1][1]); aw.w = cvt_pk_bf16(St[be][2 * ks + 1][2], St[be][2 * ks + 1][3]);
                const bf16x8 Af = *reinterpret_cast<bf16x8*>(&aw);
#pragma unroll
                for (int tt = 0; tt < 2; ++tt) oT[tt] = __builtin_amdgcn_mfma_f32_16x16x32_bf16(Af, qf[ks][tt], oT[tt], 0, 0, 0); }
            if (dhalf == 0) {
#pragma unroll
                for (int tt = 0; tt < 2; ++tt) oT[tt] = __builtin_amdgcn_mfma_f32_16x16x32_bf16(vf[be], af[tt], oT[tt], 0, 0, 0); }
            if (!(a.var & 32)) { bf16_t* orow = O + ((size_t)b * SB + 32 * ci + c) * 3072 + h * 512 + esl * EW + be * 128 + 16 * wid + 4 * g;
#pragma unroll
              for (int tt = 0; tt < 2; ++tt) { u32x2 w; w.x = cvt_pk_bf16(oT[tt][0], oT[tt][1]); w.y = cvt_pk_bf16(oT[tt][2], oT[tt][3]); *(u32x2*)(orow + (size_t)(16 * tt) * 3072) = w; } }
#pragma unroll
            for (int t = 0; t < 8; ++t) St[be][t] = __builtin_amdgcn_mfma_f32_16x16x32_bf16(kf[t], vf[be], St[be][t] * gmv[t], 0, 0, 0);
        }
    }
    __builtin_amdgcn_s_waitcnt(0x0F70); __syncthreads();
#undef SC_CI
#undef SC_DMA
}
}
namespace fk {
constexpr int NPHASE = 14;
__global__ void __launch_bounds__(NTHR, 2) fwd(Args args) {
    extern __shared__ __attribute__((aligned(16))) unsigned char lds_raw[];
    Frame F; F.lds = (LAS unsigned char*)lds_raw; F.tid = threadIdx.x; F.lane = F.tid & 63; F.wave = __builtin_amdgcn_readfirstlane(F.tid >> 6); F.G = gridDim.x; F.bid = blockIdx.x;
    unsigned char* ws = args.ws;
    volatile LAS unsigned* MISC = (volatile LAS unsigned*)(F.lds + LDS_MISC);
    if (F.tid < 64) MISC[F.tid] = 0u;
    __syncthreads();
    const int lo = args.ph_lo, hi = args.ph_hi;
    XcdBarrier bar; bar.bar = (unsigned*)(ws + WS_CTL) + CW_BAR; bar.x = 0; bar.st = MISC + 8;
    if (hi - lo > 1) bar = xcd_barrier_post((unsigned*)(ws + WS_CTL) + CW_BAR, MISC + 8);
#ifndef PHMASK
#define PHMASK 0xFFFF
#endif
#define IN(k) (((PHMASK >> (k)) & 1) && lo <= (k) && (k) < hi)
#define SEAM(k) do { if (IN(k) && IN((k) + 1)) xcd_barrier(bar); } while (0)
    float* mod = (float*)(ws + WS_MOD);
    float* x1c = (float*)(ws + WS_X1C);
    LAS float* XCH = (LAS float*)(F.lds + LDS_X);
    if (IN(0)) { p0_prologue(F, args); }
    SEAM(0);
    if (IN(1)) { hnorm_phase(F, args.in[0], args.in[2], args.in[4], mod, (bf16_t*)(ws + WS_H)); }
    SEAM(1);
    if (IN(2)) {
        Gemm g{(const bf16_t*)(ws + WS_H), (const bf16_t*)(ws + WS_W1T), 4096, 4096, 4096}; Order S_; S_.init(NPANEL, 35, F.G, F.bid, 0);
        EpiL0 E{(bf16_t*)(ws + WS_A1), (bf16_t*)(ws + WS_CQKV), (bf16_t*)(ws + WS_G0), (bf16_t*)(ws + WS_KR), (float*)(ws + WS_SSQ), args.in[8], args.in[9],
                (const float*)(ws + WS_ROPEA), (const float*)(ws + WS_ROPEB), XCH};
        gemm_phase<EpiL0>(F.lds + LDS_STAGE, g, S_, E);
        late_convert(F, args, 6 * NWAVES, (F.G - 6) * NWAVES, 0);
        mod_gemv(F, args, 1, 6, F.G - 6);
    }
    SEAM(2);
    if (IN(3)) {
        { Gemm g{(const bf16_t*)(ws + WS_CQKV), (const bf16_t*)(ws + WS_WUQ), 1024, 1536, 1024}; Order S_; S_.init(NPANEL, 12, F.G, F.bid, 0);
          EpiUp<0> E{(bf16_t*)(ws + WS_QB), 3072, (const float*)(ws + WS_SSQ), (const float*)(ws + WS_ROPEB)};
          gemm_phase<EpiUp<0>>(F.lds + LDS_STAGE, g, S_, E); }
        { Gemm g{(const bf16_t*)(ws + WS_CQKV) + 1024, (const bf16_t*)(ws + WS_WUKV), 512, 1536, 512}; Order S_; S_.init(NPANEL, 16, F.G, F.bid, 0);
          EpiUp<1> E{(bf16_t*)(ws + WS_KVB), 4096, (const float*)(ws + WS_SSQ), (const float*)(ws + WS_ROPEB)};
          gemm_phase<EpiUp<1>>(F.lds + LDS_STAGE, g, S_, E); }
    }
    SEAM(3);
    if (IN(4)) { attn_phase(F, args, lds_raw); }
    SEAM(4);
    if (IN(5)) {
        Gemm g{(const bf16_t*)(ws + WS_Y0), (const bf16_t*)(ws + WS_WO), 4096, 4096, 4096}; Order S_; S_.init(NPANEL, 16, F.G, F.bid, 0);
        EpiRes E{args.in[0], args.in[2], mod, args.out, x1c};
        gemm_phase<EpiRes>(F.lds + LDS_STAGE, g, S_, E);
        late_convert(F, args, 32 * NWAVES, (F.G - 32) * NWAVES, 1);
    }
    SEAM(5);
    const float* mod1 = mod + 3 * 12288;
    if (IN(6)) { hnorm_phase(F, args.out, x1c, args.in[4] + D, mod1, (bf16_t*)(ws + WS_H)); }
    SEAM(6);
    if (IN(7)) {
        Gemm g{(const bf16_t*)(ws + WS_H), (const bf16_t*)(ws + WS_W4T), 4096, 4096, 4096}; Order S_; S_.init(NPANEL, 45, F.G, F.bid, 0);
        EpiL1 E{(bf16_t*)(ws + WS_QK1), (bf16_t*)(ws + WS_VT), (bf16_t*)(ws + WS_U1), (bf16_t*)(ws + WS_G1), (float*)(ws + WS_GD), args.var & 1, F.lds + 131072};
        gemm_phase<EpiL1>(F.lds + LDS_STAGE, g, S_, E);
    }
    SEAM(7);
    if (IN(8)) {
        if (!(args.var & 1)) gla_prep_phase(F, args);
        __syncthreads();
        if (!(args.var & 2)) {
        int k8 = 256; asm volatile("" : "+s"(k8));
        Gemm g{(const bf16_t*)(ws + WS_U1), (const bf16_t*)(ws + WS_CS), k8, 256, 256}; Order S_; S_.init(M * 4 / 256, 2, F.G, F.bid, 0);
        EpiPlain E{(bf16_t*)(ws + WS_AB), 512};
        gemm_phase<EpiPlain>(F.lds + LDS_STAGE, g, S_, E); }
    }
    SEAM(8);
    if (IN(9)) {
#ifndef SCAN_NBE
#define SCAN_NBE 1
#endif
        constexpr int NSCAN = 192 / SCAN_NBE;
        const int x = F.bid & 7, j = F.bid >> 3;
        if (j < NSCAN / 8) { if (!(args.var & 1)) { constexpr int SPC = 8 / SCAN_NBE; const int combo = x * 3 + j / SPC, sub = j % SPC;
            gla_scan_wg<SCAN_NBE>(F, args, combo / 12, (combo % 12) / 6, combo % 6, sub / (SPC / 2), sub % (SPC / 2)); } }
        else { const int fw = F.bid - NSCAN;
            if (!(args.var & 2)) { if (fw < 32) f4096_phase(F, (const bf16_t*)(ws + WS_AB), (float*)(ws + WS_F4096), fw, 1.0f / 1448.1546878700494f);
                fold_phase(F, (const bf16_t*)(ws + WS_AB), (bf16_t*)(ws + WS_BF), NSCAN * NWAVES, (256 - NSCAN) * NWAVES); }
            if (!(args.var & 4)) dm_gen(F, (bf16_t*)(ws + WS_DM), fw, 256 - NSCAN);
            wo2_convert(F, args, NSCAN * NWAVES, (256 - NSCAN) * NWAVES); }
    }
    SEAM(9);
    if (IN(10)) {
        Gemm g{(const bf16_t*)(ws + WS_DM), (const bf16_t*)(ws + WS_BF), FKP, FKP, FKP}; OrderFn S_{F.bid};
        EpiPcs E{(bf16_t*)(ws + WS_PCS), 1.0f / 1448.1546878700494f};
        gemm_phase<EpiPcs>(F.lds + LDS_STAGE, g, S_, E);
        gla_finish_phase(F, (const bf16_t*)(ws + WS_O00), (const bf16_t*)(ws + WS_O01), (const bf16_t*)(ws + WS_O10), (const bf16_t*)(ws + WS_O11), (const bf16_t*)(ws + WS_G1), args.in[20], (bf16_t*)(ws + WS_Y1));
    }
    SEAM(10);
    if (IN(11)) { fnet_finish_phase(F, (const bf16_t*)(ws + WS_PCS), (const float*)(ws + WS_F4096), (const bf16_t*)(ws + WS_G1), (bf16_t*)(ws + WS_Y1)); }
    SEAM(11);
    if (IN(12)) {
        Gemm g{(const bf16_t*)(ws + WS_Y1), (const bf16_t*)(ws + WS_WO2), 4096, 4096, 4096}; Order S_; S_.init(64, 16, F.G, F.bid, 1);
        EpiRes E{args.out, x1c, mod1, args.out, x1c};
        gemm_phase<EpiRes>(F.lds + LDS_STAGE, g, S_, E);
    }
    SEAM(12);
    if (IN(13)) { final_norm_phase(F, args.out, args.in[22]); }
#undef IN
#undef SEAM
}

static int g_state = 0;
static bool host_init(int n_in, size_t ws_size) {
    if (g_state == 0) {
        g_state = -1;
        if (n_in != 23 || ws_size < WS_TOTAL) { fprintf(stderr, "kernel_launch: n_in %d ws %zu (need %zu)\n", n_in, ws_size, (size_t)WS_TOTAL); return false; }
        int dev = 0, cus = 0;
        if (hipGetDevice(&dev) != hipSuccess || hipDeviceGetAttribute(&cus, hipDeviceAttributeMultiprocessorCount, dev) != hipSuccess || cus != 256) { fprintf(stderr, "kernel_launch: needs a 256-CU device (got %d)\n", cus); return false; }
        if (hipFuncSetAttribute((const void*)fwd, hipFuncAttributeMaxDynamicSharedMemorySize, LDS_BYTES) != hipSuccess) { fprintf(stderr, "hipFuncSetAttribute(fwd) failed\n"); return false; }
        int per_cu = 0;
        if (hipOccupancyMaxActiveBlocksPerMultiprocessor(&per_cu, (const void*)fwd, NTHR, LDS_BYTES) != hipSuccess || per_cu < 1) fprintf(stderr, "kernel_launch: occupancy query reports %d blocks per CU\n", per_cu);
        (void)hipGetLastError();
#if MODE != 4 && MODE != 3 && MODE != 5
        if (hipFuncSetAttribute((const void*)orc::k_attn, hipFuncAttributeMaxDynamicSharedMemorySize, 160 * 1024 - 256) != hipSuccess) { fprintf(stderr, "hipFuncSetAttribute(k_attn) failed\n"); return false; }
#endif
        g_state = 1;
    }
    return g_state > 0;
}
static void launch_phases(void* const* d_in, void* d_out, void* d_ws, hipStream_t stream, int lo, int hi, bool one_launch, int var = 0) {
    (void)hipMemsetAsync((char*)d_ws + WS_CTL, 0, MiB, stream);
    Args a{};
    for (int i = 0; i < 23; ++i) a.in[i] = (const float*)d_in[i];
    a.out = (float*)d_out; a.ws = (unsigned char*)d_ws; a.var = var;
    if (one_launch) { a.ph_lo = lo; a.ph_hi = hi; hipLaunchKernelGGL(fwd, dim3(256), dim3(NTHR), LDS_BYTES, stream, a); }
    else for (int p = lo; p < hi; ++p) { a.ph_lo = p; a.ph_hi = p + 1; hipLaunchKernelGGL(fwd, dim3(256), dim3(NTHR), LDS_BYTES, stream, a); }
    const hipError_t le = hipPeekAtLastError();
    if (le != hipSuccess) fprintf(stderr, "kernel_launch: launch failed: %s\n", hipGetErrorName(le));
}
}

#ifndef MODE
#define MODE 1
#endif
extern "C" void kernel_launch(void* const* d_in, const int* in_sizes, int n_in, void* d_out, int out_size, void* d_ws, size_t ws_size, hipStream_t stream) {
    if (!fk::host_init(n_in, ws_size)) return;
#if MODE != 4 && MODE != 3 && MODE != 5
    const orc::Ptrs p = orc::ptrs(d_in); (void)p;
#endif
#if MODE == 0
    orc::setup(p, (unsigned char*)d_ws, stream); orc::layer0(p, (float*)d_out, (unsigned char*)d_ws, stream); orc::layer1(p, (float*)d_out, (unsigned char*)d_ws, stream);
#elif MODE == 1
    fk::launch_phases(d_in, d_out, d_ws, stream, 0, 6, false);
    orc::setup(p, (unsigned char*)d_ws, stream); orc::layer1(p, (float*)d_out, (unsigned char*)d_ws, stream);
#elif MODE == 2
    orc::setup(p, (unsigned char*)d_ws, stream); orc::layer0(p, (float*)d_out, (unsigned char*)d_ws, stream);
    fk::launch_phases(d_in, d_out, d_ws, stream, 0, 1, false); fk::launch_phases(d_in, d_out, d_ws, stream, 6, 14, false);
#elif MODE == 3
    fk::launch_phases(d_in, d_out, d_ws, stream, 0, 14, false);
#elif MODE == 5
    { const int lst[] = {PHLIST}; for (unsigned i = 0; i < sizeof(lst) / sizeof(lst[0]); ++i) fk::launch_phases(d_in, d_out, d_ws, stream, lst[i] % 100, lst[i] % 100 + 1, false, lst[i] / 100); }
#elif MODE == 4
    fk::launch_phases(d_in, d_out, d_ws, stream, 0, 14, true);
#endif
}
```

```cpp
#define MODE 4
#include <hip/hip_runtime.h>
#include <cstdio>
#include <cstdint>
namespace fk {
#define LAS __attribute__((address_space(3)))
#define GAS __attribute__((address_space(1)))
typedef unsigned short bf16_t;
typedef short bf16x8 __attribute__((ext_vector_type(8)));
typedef short s16x4 __attribute__((ext_vector_type(4)));
typedef float f32x2 __attribute__((ext_vector_type(2)));
typedef float f32x4 __attribute__((ext_vector_type(4)));
typedef float f32x8 __attribute__((ext_vector_type(8)));
typedef float f32x16 __attribute__((ext_vector_type(16)));
typedef unsigned u32x2 __attribute__((ext_vector_type(2)));
typedef unsigned u32x4 __attribute__((ext_vector_type(4)));

constexpr int NWAVES = 8, NTHR = 512;
constexpr int D = 4096, NB = 2, S = 8192, CTX = 256, SB = S + CTX  , M = NB * SB  , NPANEL = M / 256  , PPB = SB / 256  ;
constexpr float EPS = 1e-6f;

__device__ __forceinline__ unsigned cvt_pk_bf16(float lo, float hi) { unsigned r; asm volatile("v_cvt_pk_bf16_f32 %0, %1, %2" : "=v"(r) : "v"(lo), "v"(hi)); return r; }
__device__ __forceinline__ float bf_lo(unsigned w) { return __uint_as_float(w << 16); }
__device__ __forceinline__ float bf_hi(unsigned w) { return __uint_as_float(w & 0xffff0000u); }
__device__ __forceinline__ float bf2f(bf16_t b) { return __uint_as_float(((unsigned)b) << 16); }
__device__ __forceinline__ float fast_silu(float x) { return x * __builtin_amdgcn_rcpf(1.f + __expf(-x)); }
__device__ __forceinline__ float wave_sum(float v) {
#pragma unroll
    for (int o = 1; o < 64; o <<= 1) v += __shfl_xor(v, o);
    return v;
}
#define LDS_WAIT() asm volatile("s_waitcnt lgkmcnt(0)" ::: "memory")
#define VM_WAIT() asm volatile("s_waitcnt vmcnt(0)" ::: "memory")

#define XB_TMO      128
#define XB_XCNT(j)  (256  + 64 * (j))
#define XB_XSUB(j)  (1280 + 64 * (j))
#define XB_XGEN(j)  (2304 + 64 * (j))
#define XB_TOP      3328
#define XB_TOPGEN   3392
#define XCD_BAR_WORDS 3456
#define XB_SPIN_CAP (1u << 24)
__device__ __forceinline__ unsigned xb_ld(unsigned* p)              { return __hip_atomic_load(p, __ATOMIC_RELAXED, __HIP_MEMORY_SCOPE_AGENT); }
__device__ __forceinline__ unsigned xb_add(unsigned* p, unsigned v) { return __hip_atomic_fetch_add(p, v, __ATOMIC_RELAXED, __HIP_MEMORY_SCOPE_AGENT); }
__device__ __forceinline__ unsigned xb_xcc_id() { return (unsigned)__builtin_amdgcn_s_getreg((3 << 11) | 20) & 0xFu; }
#define XB_SPIN(cond, bar) do { unsigned _sp = 0; while (cond) { __builtin_amdgcn_s_sleep(1); \
    if ((++_sp & 255u) == 0u) { if (xb_ld(&(bar)[XB_TMO])) break; if (_sp > XB_SPIN_CAP) { atomicAdd(&(bar)[XB_TMO], 1u); break; } } } } while (0)
struct XcdBarrier { unsigned* bar; unsigned x; volatile LAS unsigned* st; };
__device__ __forceinline__ XcdBarrier xcd_barrier_post(unsigned* bar, volatile LAS unsigned* st) {
    XcdBarrier b; b.bar = bar; b.x = xb_xcc_id(); b.st = st;
    if (threadIdx.x == 0) (void)xb_add(&bar[XB_XCNT(b.x)], 1u);
    return b;
}
__device__ __forceinline__ void xcd_barrier_complete(unsigned* bar, unsigned x, unsigned& nloc, unsigned& nx) {
    const unsigned G = gridDim.x * gridDim.y * gridDim.z;
    unsigned sum, cnt, mine, sp = 0u;
    for (;;) {
        sum = 0u; cnt = 0u; mine = 0u;
#pragma unroll
        for (unsigned j = 0; j < 16; ++j) { const unsigned c = xb_ld(&bar[XB_XCNT(j)]); sum += c; cnt += (c > 0u) ? 1u : 0u; mine = (j == x) ? c : mine; }
        if (sum == G) break;
        __builtin_amdgcn_s_sleep(1);
        if ((++sp & 255u) == 0u) { if (xb_ld(&bar[XB_TMO])) break; if (sp > XB_SPIN_CAP) { atomicAdd(&bar[XB_TMO], 1u); break; } }
    }
    nloc = mine > 0u ? mine : 1u; nx = cnt > 0u ? cnt : 1u;
}
__device__ __forceinline__ void xcd_barrier(const XcdBarrier& b) {
    asm volatile("s_waitcnt vmcnt(0)" ::: "memory");
    __syncthreads();
    if (threadIdx.x == 0) {
        unsigned* bar = b.bar;
        __builtin_amdgcn_s_waitcnt(0);
        unsigned nloc = b.st[0], nx = b.st[1];
        if (nloc == 0u) { xcd_barrier_complete(bar, b.x, nloc, nx); b.st[0] = nloc; b.st[1] = nx; }
        const unsigned old = xb_add(&bar[XB_XSUB(b.x)], 1u);
        const unsigned gen = old / nloc;
        if (old + 1u == (gen + 1u) * nloc) {
            __builtin_amdgcn_fence(__ATOMIC_RELEASE, "agent");
            asm volatile("s_waitcnt vmcnt(0)" ::: "memory");
            const unsigned og = xb_add(&bar[XB_TOP], 1u);
            const unsigned tg = og / nx;
            if (og + 1u == (tg + 1u) * nx) xb_add(&bar[XB_TOPGEN], 1u);
            else XB_SPIN(xb_ld(&bar[XB_TOPGEN]) == tg, bar);
            __builtin_amdgcn_fence(__ATOMIC_ACQUIRE, "agent");
            xb_add(&bar[XB_XGEN(b.x)], 1u);
            asm volatile("s_waitcnt vmcnt(0)" ::: "memory");
        } else {
            XB_SPIN(xb_ld(&bar[XB_XGEN(b.x)]) == gen, bar);
            __builtin_amdgcn_fence(__ATOMIC_ACQUIRE, "agent");
            asm volatile("s_waitcnt vmcnt(0)" ::: "memory");
        }
    }
    __syncthreads();
}

constexpr int BM = 256, BK = 64, HALF = 128, HTB = HALF * BK * 2, STAGE_BYTES = 8 * HTB, NXCD = 8, WGM = 8;
__host__ __device__ __forceinline__ int lds_byte(int r, int c) { const int st = (r >> 4) * 2 + (c >> 5), rr = r & 15, cc = c & 31, ob = rr * 64 + cc * 2; return st * 1024 + (ob ^ (((ob >> 9) & 1) << 5)); }
__host__ __device__ __forceinline__ void stage_rc(int b, int& R, int& C) { const int st = b / 1024, sb = b % 1024, swz = sb ^ (((sb >> 9) & 1) << 5); R = (st >> 1) * 16 + swz / 64; C = (st & 1) * 32 + (swz % 64) / 2; }
__host__ __device__ __forceinline__ int perm32(int rho) { const int n = rho >> 4, i = rho & 15; return 8 * (i >> 2) + 4 * n + (i & 3); }
struct Unit { int pm, pn, ko; };
struct Gemm { const bf16_t* A; const bf16_t* Bt; int K, lda, ldb; };
struct Order {
    int nM, nN, nwg, G, c, skip;
    __device__ void init(int nM_, int nN_, int G_, int c_, int skip_) { nM = nM_; nN = nN_; nwg = nM * nN; G = G_; c = c_; skip = skip_; }
    __device__ bool next(int i, Unit& u) const {
        const long L = (long)i * G + c; if (L >= nwg) return false;
        int wgid = (int)L; { const int q = nwg / NXCD, r = nwg % NXCD, xcd = wgid % NXCD, off = wgid / NXCD; wgid = (xcd < r ? xcd * (q + 1) : r * (q + 1) + (xcd - r) * q) + off; }
        const int nig = WGM * nN, gid = wgid / nig, fm = gid * WGM, gsz = (nM - fm) < WGM ? (nM - fm) : WGM;
        int pm = fm + ((wgid % nig) % gsz); if (skip && pm >= 32) pm += 1;
        u.pm = pm; u.pn = (wgid % nig) / gsz; u.ko = 0; return true;
    }
};
struct OrderKr {
    int bid;
    __device__ bool next(int i, Unit& u) const {
        int L; if (bid >= 196) { if (i >= 8) return false; L = (bid - 196) * 8 + i; } else { if (i >= 1 || bid >= 48) return false; L = 480 + bid; }
        u.pm = L >> 3; u.pn = 0; u.ko = (L & 7) * 512; return true;
    }
};
struct OrderL0t {
    Order base; int G, c;
    __device__ bool next(int i, Unit& u) const { const int L = i * G + c; if (L < 2244) return base.next(i, u); if (L < 2304) { u.pm = L - 2244; u.pn = 34; u.ko = 0; return true; } return false; }
};
struct OrderKr6 {
    int bid;
    __device__ bool next(int i, Unit& u) const { if (i >= 1 || bid >= 48) return false; u.pm = 60 + (bid >> 3); u.pn = 0; u.ko = (bid & 7) * 512; return true; }
};
struct OrderCtx {
    int bid;
    __device__ bool next(int i, Unit& u) const { if (i >= 1) return false; u.pm = 32 + 33 * (bid >> 7); u.pn = (bid >> 3) & 15; u.ko = (bid & 7) * 512; return true; }
};
template <class Epi, class Sched>
__device__ __forceinline__ void gemm_phase(LAS unsigned char* lds, const Gemm g, const Sched& S, const Epi& E) {
    const int tid = threadIdx.x, wid = __builtin_amdgcn_readfirstlane(tid >> 6), lane = tid & 63, wr = wid >> 2, wc = wid & 3, fr = lane & 15, fq = lane >> 4;
    const int K = g.K, nt = K / BK;
    unsigned voffA[2], voffB[2];
#pragma unroll
    for (int i = 0; i < 2; ++i) { int R, C; stage_rc(tid * 16 + i * 8192, R, C); const int Rb = Epi::PERM ? ((R & ~31) + perm32(R & 31)) : R;
        voffA[i] = (unsigned)(R * g.lda + C) * 2u; voffB[i] = (unsigned)(Rb * g.ldb + C) * 2u; }
    const size_t kstep = (size_t)(BK * 2);
    const size_t hstepA = (size_t)HALF * g.lda * 2, hstepB = (size_t)HALF * g.ldb * 2;
    const size_t tstepA = 2 * hstepA, tstepB = 2 * hstepB;
    const unsigned ldsw = (unsigned)wid * 1024u;
    const int aoff = lds_byte(wr * 64 + fr, fq * 8), boff = lds_byte(wc * 32 + fr, fq * 8);
#define PG8_SA(b, h) (((b) * 2 + (h)) * HTB)
#define PG8_SB(b, h) ((4 + (b) * 2 + (h)) * HTB)
#define PG8_STAGE(bufoff, gbase, voff) do { _Pragma("unroll") for (int _i = 0; _i < 2; ++_i) \
        __builtin_amdgcn_global_load_lds((const unsigned*)((const char*)(gbase) + (voff)[_i]), (LAS unsigned*)(lds + (bufoff) + ldsw + _i * 8192), 16, 0, 0); } while (0)
#define PG8_LDA(dst, b, h) do { _Pragma("unroll") for (int m = 0; m < 4; ++m) _Pragma("unroll") for (int k = 0; k < 2; ++k) dst[m][k] = *(const LAS bf16x8*)(lds + PG8_SA(b, h) + aoff + m * 2048 + k * 1024); } while (0)
#define PG8_LDB(dst, b, h) do { _Pragma("unroll") for (int n = 0; n < 2; ++n) _Pragma("unroll") for (int k = 0; k < 2; ++k) dst[n][k] = *(const LAS bf16x8*)(lds + PG8_SB(b, h) + boff + n * 2048 + k * 1024); } while (0)
#define PG8_MMA(ai, bj, At, Bt) do { __builtin_amdgcn_s_setprio(1); _Pragma("unroll") for (int m = 0; m < 4; ++m) _Pragma("unroll") for (int n = 0; n < 2; ++n) _Pragma("unroll") for (int k = 0; k < 2; ++k) \
        acc[ai][bj][m][n] = __builtin_amdgcn_mfma_f32_16x16x32_bf16(Bt[n][k], At[m][k], acc[ai][bj][m][n], 0, 0, 0); __builtin_amdgcn_s_setprio(0); } while (0)
#define PG8_WAIT_V(n) asm volatile("s_waitcnt vmcnt(" #n ")" ::: "memory")
#define PG8_WAIT_L(n) asm volatile("s_waitcnt lgkmcnt(" #n ")" ::: "memory")
#define PG8_BAR __builtin_amdgcn_s_barrier()
#define PG8_SCHED __builtin_amdgcn_sched_barrier(0)
    Unit cur, nxt; int ui = 0;
    if (!S.next(0, cur)) return;
    f32x4 acc[2][2][4][2];
#pragma unroll
    for (int a = 0; a < 2; ++a)
#pragma unroll
        for (int b = 0; b < 2; ++b)
#pragma unroll
            for (int m = 0; m < 4; ++m)
#pragma unroll
                for (int n = 0; n < 2; ++n) acc[a][b][m][n] = (f32x4){0.f, 0.f, 0.f, 0.f};
    bf16x8 At[4][2], B0[2][2], B1[2][2];
    const char* cA = (const char*)g.A + (size_t)cur.pm * tstepA + (size_t)cur.ko * 2; const char* cB = (const char*)g.Bt + (size_t)cur.pn * tstepB + (size_t)cur.ko * 2;
    PG8_STAGE(PG8_SB(0, 0), cB, voffB); PG8_STAGE(PG8_SB(0, 1), cB + hstepB, voffB); PG8_STAGE(PG8_SA(0, 0), cA, voffA); PG8_STAGE(PG8_SA(0, 1), cA + hstepA, voffA);
    if (wr == 1) PG8_BAR;
    PG8_WAIT_V(2); PG8_BAR;
    PG8_STAGE(PG8_SB(1, 0), cB + kstep, voffB); PG8_STAGE(PG8_SA(1, 0), cA + kstep, voffA); PG8_STAGE(PG8_SB(1, 1), cB + hstepB + kstep, voffB);
    PG8_WAIT_V(6); PG8_BAR;
    for (;;) {
        const bool has_next = S.next(ui + 1, nxt);
        const char* nA = has_next ? (const char*)g.A + (size_t)nxt.pm * tstepA + (size_t)nxt.ko * 2 : cA; const char* nB = has_next ? (const char*)g.Bt + (size_t)nxt.pn * tstepB + (size_t)nxt.ko * 2 : cB;
        for (int t = 0; t < nt; t += 2) {
            const bool last = (t == nt - 2);
            const char* a1 = cA + (size_t)(t + 1) * kstep;
            const char* a2 = last ? nA : cA + (size_t)(t + 2) * kstep; const char* b2 = last ? nB : cB + (size_t)(t + 2) * kstep;
            const char* a3 = a2 + kstep; const char* b3 = b2 + kstep;
            PG8_LDB(B0, 0, 0); PG8_LDB(B1, 0, 1); PG8_SCHED; PG8_LDA(At, 0, 0); PG8_STAGE(PG8_SA(1, 1), a1 + hstepA, voffA);
            PG8_WAIT_V(8); PG8_WAIT_L(0); PG8_BAR; PG8_MMA(0, 0, At, B0); PG8_MMA(0, 1, At, B1); PG8_BAR; PG8_SCHED;
            PG8_LDA(At, 0, 1); PG8_STAGE(PG8_SB(0, 0), b2, voffB); PG8_STAGE(PG8_SB(0, 1), b2 + hstepB, voffB); PG8_STAGE(PG8_SA(0, 0), a2, voffA);
            PG8_WAIT_V(8); PG8_WAIT_L(0); PG8_BAR; PG8_MMA(1, 0, At, B0); PG8_MMA(1, 1, At, B1); PG8_BAR; PG8_SCHED;
            PG8_LDB(B0, 1, 0); PG8_LDB(B1, 1, 1); PG8_SCHED; PG8_LDA(At, 1, 0); PG8_STAGE(PG8_SA(0, 1), a2 + hstepA, voffA);
            PG8_WAIT_V(8); PG8_WAIT_L(0); PG8_BAR; PG8_MMA(0, 0, At, B0); PG8_MMA(0, 1, At, B1); PG8_BAR; PG8_SCHED;
            PG8_LDA(At, 1, 1); PG8_STAGE(PG8_SB(1, 0), b3, voffB); PG8_STAGE(PG8_SB(1, 1), b3 + hstepB, voffB); PG8_STAGE(PG8_SA(1, 0), a3, voffA);
            PG8_WAIT_V(8); PG8_WAIT_L(0); PG8_BAR; PG8_MMA(1, 0, At, B0); PG8_MMA(1, 1, At, B1); PG8_BAR; PG8_SCHED;
        }
        if (wr == 0) PG8_BAR;
        E(acc, cur, wr, wc, fr, fq);
        if (!has_next) break;
#pragma unroll
        for (int a = 0; a < 2; ++a)
#pragma unroll
            for (int b = 0; b < 2; ++b)
#pragma unroll
                for (int m = 0; m < 4; ++m)
#pragma unroll
                    for (int n = 0; n < 2; ++n) acc[a][b][m][n] = (f32x4){0.f, 0.f, 0.f, 0.f};
        cur = nxt; cA = nA; cB = nB; ++ui;
        if (wr == 1) PG8_BAR;
    }
    PG8_WAIT_V(0);
    PG8_BAR;
#undef PG8_SA
#undef PG8_SB
#undef PG8_STAGE
#undef PG8_LDA
#undef PG8_LDB
#undef PG8_MMA
#undef PG8_WAIT_V
#undef PG8_WAIT_L
#undef PG8_BAR
#undef PG8_SCHED
}
}
namespace fk {
constexpr size_t MiB = 1u << 20;
constexpr size_t WS_CTL = 0;
constexpr size_t WS_MOD = 1 * MiB;
constexpr size_t WS_ROPEA = 2 * MiB;
constexpr size_t WS_ROPEB = 2 * MiB + 64 * 1024;
constexpr size_t WS_CS = 2 * MiB + 128 * 1024;
constexpr size_t WS_SSQ = 3 * MiB;
constexpr size_t WS_KR = 4 * MiB;
constexpr size_t WS_GD = 7 * MiB;
constexpr size_t WS_GAM = 1391 * MiB;
constexpr size_t WS_AT = 14 * MiB;
constexpr size_t WS_W1T = 40 * MiB;
constexpr size_t WS_WUQ = 110 * MiB;
constexpr size_t WS_WUKV = 116 * MiB;
constexpr size_t WS_WO = 120 * MiB;
constexpr size_t WS_W4T = 152 * MiB;
constexpr size_t WS_WO2 = 242 * MiB;
constexpr size_t WS_DM = 274 * MiB;
constexpr size_t WS_H = 402 * MiB;
constexpr size_t WS_L = 534 * MiB;
constexpr size_t WS_A1 = WS_L;
constexpr size_t WS_CQKV = WS_L + 99 * MiB;
constexpr size_t WS_G0 = WS_L + 149 * MiB;
constexpr size_t WS_QB = WS_L + 281 * MiB;
constexpr size_t WS_KVB = WS_L + 380 * MiB;
constexpr size_t WS_Y0 = WS_L + 512 * MiB;
constexpr size_t WS_QK1 = WS_L;
constexpr size_t WS_V1 = WS_L + 99 * MiB;
constexpr size_t WS_U1 = WS_L + 198 * MiB;
constexpr size_t WS_G1 = WS_L + 231 * MiB;
constexpr size_t WS_QT = WS_L + 363 * MiB;
constexpr size_t WS_KT = WS_L + 462 * MiB;
constexpr size_t WS_VT = WS_L + 561 * MiB;
constexpr size_t WS_AB = WS_L + 660 * MiB;
constexpr size_t WS_VTF = WS_L + 726 * MiB;
constexpr size_t WS_O00 = WS_QK1, WS_O01 = WS_V1;
constexpr size_t WS_O10 = WS_L + 758 * MiB, WS_O11 = WS_H;
constexpr size_t WS_BF = 1398 * MiB;
constexpr size_t WS_PCS = WS_VTF;
constexpr size_t WS_F4096 = WS_SSQ;
constexpr size_t WS_Y1 = WS_QT;
constexpr size_t WS_LEND = WS_L + 758 * MiB;
constexpr size_t WS_PART = WS_L + 660 * MiB;
constexpr size_t WS_X1C = 1448 * MiB;
constexpr size_t WS_TOTAL = 1456 * MiB;
static_assert(WS_O10 + 99 * MiB <= WS_GAM && WS_GAM + 7 * MiB <= WS_BF && WS_BF + 34 * MiB <= WS_X1C && WS_QT + 132 * MiB <= WS_VT, "ws map");
constexpr int CW_BAR = 4096;

constexpr int LDS_STAGE = 0;
constexpr int LDS_X = 151552;
constexpr int LDS_MISC = 159744;
constexpr int LDS_BYTES = 160256;

struct Args { const float* in[23]; float* out; unsigned char* ws; int ph_lo, ph_hi, var, pad; };

struct Frame { LAS unsigned char* lds; int tid, lane, wave, G, bid; };

__device__ __forceinline__ int map_w1(int n) {
    if (n < 2560) { const int h = n >> 7, p = n & 127; return h * 128 + (p >> 1) + 64 * (p & 1); }
    if (n < 4608) return n;
    if (n < 8704) return 4672 + (n - 4608);
    if (n < 8768) { const int p = n - 8704; return 4608 + (p >> 1) + 32 * (p & 1); }
    return -1;
}
__device__ __forceinline__ int map_uq(int n) { const int h = n / 192, w = n % 192; if (w < 128) return n; const int p = w - 128; return h * 192 + 128 + (p >> 1) + 32 * (p & 1); }
__device__ __forceinline__ int map_w4(int n) {
    if (n < 6144) return n;
    if (n < 7168) return 6176 + (n - 6144);
    if (n < 11264) return 7200 + (n - 7168);
    if (n < 11296) return 6144 + (n - 11264);
    return -1;
}
__device__ __forceinline__ void tr_item(const float* W, int K, int Nsrc, bf16_t* WT, LAS float* scr, int k0, int n0, int lane, int srccol, const float* kscale, float cscale) {
#pragma unroll
    for (int i = 0; i < 32; ++i) { const int kk = 2 * i + (lane >> 5); float v = srccol >= 0 ? W[(size_t)(k0 + kk) * Nsrc + srccol] : 0.f;
        v *= kscale ? cscale * kscale[k0 + kk] : cscale; scr[kk * 33 + (lane & 31)] = v; }
    LDS_WAIT(); asm volatile("" ::: "memory");
    const int c = lane & 7;
#pragma unroll
    for (int j = 0; j < 4; ++j) { const int n = (lane >> 3) + 8 * j; const LAS float* s = scr + (8 * c) * 33 + n;
        u32x4 o; o.x = cvt_pk_bf16(s[0 * 33], s[1 * 33]); o.y = cvt_pk_bf16(s[2 * 33], s[3 * 33]); o.z = cvt_pk_bf16(s[4 * 33], s[5 * 33]); o.w = cvt_pk_bf16(s[6 * 33], s[7 * 33]);
        *(u32x4*)(WT + (size_t)(n0 + n) * K + k0 + 8 * c) = o; }
    LDS_WAIT(); asm volatile("" ::: "memory");
}
__device__ __forceinline__ void mod_gemv(const Frame& F, const Args& a, int l0, int nl, int wg0, int nwg) {
    if (F.bid < wg0) return;
    LAS float* sc = (LAS float*)(F.lds + 72 * 1024);
    LAS float* red = (LAS float*)(F.lds + 120 * 1024);
    __syncthreads();
    for (int i = F.tid; i < 3 * D; i += NTHR) { const float v = i < 2 * D ? a.in[1][i] : a.in[3][i - 2 * D]; sc[i] = v / (1.f + expf(-v)); }
    __syncthreads();
    float* mod = (float*)(a.ws + WS_MOD);
    const int rsub = F.lane >> 3, c4 = (F.lane & 7) * 4;
    for (int u = F.bid - wg0; u < 384 * nl; u += nwg) {
        const int l = l0 + u / 384, n0 = (u % 384) * 32;
        const float* W = a.in[5] + (size_t)l * D * 12288 + n0 + c4;
        f32x4 a0 = {0.f, 0.f, 0.f, 0.f}, a1 = a0, a2 = a0;
        const int kb = F.wave * 512 + rsub;
#pragma unroll 8
        for (int k = kb; k < kb + 512; k += 8) { const f32x4 w = *(const f32x4*)(W + (size_t)k * 12288); a0 += w * sc[k]; a1 += w * sc[D + k]; a2 += w * sc[2 * D + k]; }
#pragma unroll
        for (int o = 8; o < 64; o <<= 1) {
#pragma unroll
            for (int i = 0; i < 4; ++i) { a0[i] += __shfl_xor(a0[i], o); a1[i] += __shfl_xor(a1[i], o); a2[i] += __shfl_xor(a2[i], o); } }
        if (F.lane < 8) { *(LAS f32x4*)(red + (F.wave * 3 + 0) * 32 + c4) = a0; *(LAS f32x4*)(red + (F.wave * 3 + 1) * 32 + c4) = a1; *(LAS f32x4*)(red + (F.wave * 3 + 2) * 32 + c4) = a2; }
        __syncthreads();
        if (F.tid < 96) { const int r = F.tid >> 5, cl = F.tid & 31; float sm = 0.f;
#pragma unroll
            for (int w = 0; w < 8; ++w) sm += red[(w * 3 + r) * 32 + cl];
            mod[(l * 3 + r) * 12288 + n0 + cl] = sm + a.in[6][l * 12288 + n0 + cl]; }
        __syncthreads();
    }
}
__device__ __forceinline__ void p0_prologue(const Frame& F, const Args& a) {
    unsigned char* ws = a.ws;
    mod_gemv(F, a, 0, 2, 0, F.G);
    __syncthreads();
    {
        LAS float* scr = (LAS float*)(F.lds + F.wave * 8448);
        const int gw = F.bid * NWAVES + F.wave, NGW = F.G * NWAVES;
        constexpr int I0 = 64 * 280, I1 = 16 * 96, I2 = 8 * 128;
        constexpr int NIT = I0 + I1 + I2;
        for (int it = gw; it < NIT; it += NGW) {
            int r = it; const int cl = F.lane & 31;
            if (r < I0) { const int nb = r % 280, kb = r / 280; tr_item(a.in[7], 4096, 8768, (bf16_t*)(ws + WS_W1T), scr, kb * 64, nb * 32, F.lane, map_w1(nb * 32 + cl), nullptr, 1.f); continue; } r -= I0;
            if (r < I1) { const int nb = r % 96, kb = r / 96; tr_item(a.in[12], 1024, 3072, (bf16_t*)(ws + WS_WUQ), scr, kb * 64, nb * 32, F.lane, map_uq(nb * 32 + cl), a.in[10], 1.f); continue; } r -= I1;
            { const int nb = r % 128, kb = r / 128; tr_item(a.in[13], 512, 4096, (bf16_t*)(ws + WS_WUKV), scr, kb * 64, nb * 32, F.lane, nb * 32 + cl, a.in[11], 1.f); }
        }
    }
    {
        const int gt = F.bid * NTHR + F.tid, NGT = F.G * NTHR;
        f32x2* ra = (f32x2*)(ws + WS_ROPEA); f32x2* rb = (f32x2*)(ws + WS_ROPEB); bf16_t* cs = (bf16_t*)(ws + WS_CS);
        for (int i = gt; i < 128 * 32; i += NGT) { const int pos = i >> 5, fi = i & 31; const float ang = (float)pos * powf(10000.f, -(float)fi / 32.f); ra[i] = (f32x2){cosf(ang), sinf(ang)}; }
        for (int i = gt; i < 128 * 16; i += NGT) { const int pos = i >> 4, fi = i & 15; const float ang = (float)pos * powf(10000.f, -(float)fi / 16.f); rb[i] = (f32x2){cosf(ang), sinf(ang)}; }
        for (int i = gt; i < 512 * 256; i += NGT) { const int m = i >> 8, c = i & 255, l = m & 255; const float x = (float)((l * c) & 255) * (2.f / 256.f);
            const float v = (m < 256) ? cospif(x) : sinpif(x); cs[i] = (bf16_t)(cvt_pk_bf16(v, 0.f) & 0xffffu); }
    }
}
__device__ __forceinline__ void late_convert(const Frame& F, const Args& a, int w0, int nw, int which) {
    const int gw = F.bid * NWAVES + F.wave - w0; if (gw < 0) return;
    LAS float* scr = (LAS float*)(F.lds + F.wave * 8448);
    constexpr int I3 = 64 * 128, I4 = 64 * 360;
    if (which == 0) { for (int it = gw; it < I3; it += nw) { const int nb = it % 128, kb = it / 128; tr_item(a.in[14], 4096, 4096, (bf16_t*)(a.ws + WS_WO), scr, kb * 64, nb * 32, F.lane, nb * 32 + (F.lane & 31), nullptr, 1.f); } }
    else { for (int it = gw; it < I4; it += nw) { const int nb = it % 360, kb = it / 360; tr_item(a.in[15], 4096, 11296, (bf16_t*)(a.ws + WS_W4T), scr, kb * 64, nb * 32, F.lane, map_w4(nb * 32 + (F.lane & 31)), nullptr, nb * 32 < 1536 ? 0.0625f : 1.f); } }
}
__device__ __forceinline__ void wo2_convert(const Frame& F, const Args& a, int w0, int nw) {
    __syncthreads();
    LAS float* scr = (LAS float*)(F.lds + F.wave * 8448);
    const int gw = F.bid * NWAVES + F.wave - w0;
    for (int it = gw; it < 64 * 128; it += nw) { const int nb = it % 128, kb = it / 128; tr_item(a.in[21], 4096, 4096, (bf16_t*)(a.ws + WS_WO2), scr, kb * 64, nb * 32, F.lane, nb * 32 + (F.lane & 31), nullptr, 1.f); }
}
constexpr int FKP = 4224;
__device__ __forceinline__ void dm_gen(const Frame& F, bf16_t* dm, int w0, int nw) {
    for (int r = w0; r < 8192; r += nw) { const int half = r >> 12, k = r & 4095;
        for (int q = F.tid; q < FKP / 8; q += NTHR) { float v[8];
#pragma unroll
            for (int j = 0; j < 8; ++j) { const int kk = q * 8 + j; const float x = (float)((k * kk) & 8191) * (1.f / 8192.f);
                v[j] = half == 0 ? (kk <= 4096 ? __builtin_amdgcn_cosf(x) : 0.f) : ((kk >= 1 && kk <= 4095) ? __builtin_amdgcn_sinf(x) : 0.f); }
            u32x4 o; o.x = cvt_pk_bf16(v[0], v[1]); o.y = cvt_pk_bf16(v[2], v[3]); o.z = cvt_pk_bf16(v[4], v[5]); o.w = cvt_pk_bf16(v[6], v[7]);
            *(u32x4*)(dm + (size_t)r * FKP + q * 8) = o; }
    }
}
__device__ __forceinline__ void hnorm_phase(const Frame& F, const float* xlat, const float* xctx, const float* g, const float* modl, bf16_t* H) {
    LAS f32x4* MA = (LAS f32x4*)F.lds;
    __syncthreads();
    for (int i = F.tid; i < 3 * 1024; i += NTHR) { const int r = i >> 10, n4 = i & 1023;
        const f32x4 gg = *((const f32x4*)g + n4), scl = *((const f32x4*)(modl + (size_t)r * 12288 + D) + n4), sh = *((const f32x4*)(modl + (size_t)r * 12288) + n4);
        MA[(r * 2 + 0) * 1024 + n4] = gg * (scl + 1.f); MA[(r * 2 + 1) * 1024 + n4] = sh; }
    __syncthreads();
    const int base = F.bid * (M / 256);
    for (int i0 = F.wave; i0 < M / 256; i0 += 16) {
        const int rot = (F.bid * 5) % (M / 256);
        const bool hasB = (i0 + 8) < M / 256;
        const int mA = base + (i0 + rot) % (M / 256), mB = base + (i0 + 8 + rot) % (M / 256);
        const int bA = mA / SB, rA = mA % SB, bB = hasB ? mB / SB : bA, rB = hasB ? mB % SB : rA;
        const float* srcA = rA < S ? xlat + ((size_t)bA * S + rA) * D : xctx + ((size_t)bA * CTX + (rA - S)) * D;
        const float* srcB = rB < S ? xlat + ((size_t)bB * S + rB) * D : xctx + ((size_t)bB * CTX + (rB - S)) * D;
        const LAS f32x4* mA_ = MA + (rA < S ? bA : 2) * 2048 + F.lane; const LAS f32x4* mB_ = MA + (rB < S ? bB : 2) * 2048 + F.lane;
        const f32x4* xa = (const f32x4*)srcA + F.lane; const f32x4* xb = (const f32x4*)srcB + F.lane;
        f32x4 va[16], vb[16]; float sa = 0.f, sb = 0.f;
#pragma unroll
        for (int j = 0; j < 16; ++j) va[j] = __builtin_nontemporal_load(xa + 64 * j);
#pragma unroll
        for (int j = 0; j < 16; ++j) vb[j] = __builtin_nontemporal_load(xb + 64 * j);
#pragma unroll
        for (int j = 0; j < 16; ++j) sa += (va[j].x * va[j].x + va[j].y * va[j].y) + (va[j].z * va[j].z + va[j].w * va[j].w);
#pragma unroll
        for (int j = 0; j < 16; ++j) sb += (vb[j].x * vb[j].x + vb[j].y * vb[j].y) + (vb[j].z * vb[j].z + vb[j].w * vb[j].w);
        const float rsa = 1.0f / sqrtf(wave_sum(sa) * (1.f / D) + EPS), rsb = 1.0f / sqrtf(wave_sum(sb) * (1.f / D) + EPS);
        u32x2* oa = (u32x2*)(H + (size_t)mA * D) + F.lane; u32x2* ob = (u32x2*)(H + (size_t)(hasB ? mB : mA) * D) + F.lane;
#pragma unroll
        for (int j = 0; j < 16; ++j) {
            { const f32x4 h = va[j] * rsa * mA_[64 * j] + mA_[1024 + 64 * j]; u32x2 w; w.x = cvt_pk_bf16(h.x, h.y); w.y = cvt_pk_bf16(h.z, h.w); oa[64 * j] = w; }
            if (hasB) { const f32x4 h = vb[j] * rsb * mB_[64 * j] + mB_[1024 + 64 * j]; u32x2 w; w.x = cvt_pk_bf16(h.x, h.y); w.y = cvt_pk_bf16(h.z, h.w); ob[64 * j] = w; } }
    }
    __syncthreads();
}
__device__ __forceinline__ u32x4 pack8(const f32x4 a, const f32x4 b) { u32x4 w; w.x = cvt_pk_bf16(a[0], a[1]); w.y = cvt_pk_bf16(a[2], a[3]); w.z = cvt_pk_bf16(b[0], b[1]); w.w = cvt_pk_bf16(b[2], b[3]); return w; }
__device__ __forceinline__ f32x4 rope2(const f32x4 v, const f32x4 cs) {
    return (f32x4){v[0] * cs[0] - v[1] * cs[1], v[0] * cs[1] + v[1] * cs[0], v[2] * cs[2] - v[3] * cs[3], v[2] * cs[3] + v[3] * cs[2]};
}
struct EpiL0 {
    static constexpr bool PERM = true;
    bf16_t* A1; bf16_t* CQKV; bf16_t* G0; bf16_t* KRb; float* SSQ; const float* qn_g; const float* kn_g; const float* ropeA; const float* ropeB; LAS float* X;
    __device__ __forceinline__ void operator()(const f32x4 (&acc)[2][2][4][2], const Unit& u, int wr, int wc, int fr, int fq) const {
        const int pn = u.pn, pb = u.pm % PPB; const bool lat = pb < 32;
        const int rowl0 = wr * 64 + fr; const size_t row0 = (size_t)u.pm * 256 + rowl0; const int cl = wc * 32 + 8 * fq;
        if (pn < 10) {
            const float* g = pn < 8 ? qn_g : kn_g; f32x4 gv[2];
#pragma unroll
            for (int n = 0; n < 2; ++n)
#pragma unroll
                for (int i = 0; i < 4; ++i) { const int p = cl + 4 * n + i; gv[n][i] = g[(p >> 1) + 64 * (p & 1)]; }
#pragma unroll
            for (int ai = 0; ai < 2; ++ai)
#pragma unroll
                for (int m = 0; m < 4; ++m)
#pragma unroll
                    for (int bj = 0; bj < 2; ++bj) { const f32x4 x0 = acc[ai][bj][m][0], x1 = acc[ai][bj][m][1];
                        float s = (x0[0] * x0[0] + x0[1] * x0[1]) + (x0[2] * x0[2] + x0[3] * x0[3]) + (x1[0] * x1[0] + x1[1] * x1[1]) + (x1[2] * x1[2] + x1[3] * x1[3]);
                        s += __shfl_xor(s, 16); s += __shfl_xor(s, 32);
                        if (fq == 0) X[((ai * 128 + rowl0 + 16 * m) * 2 + bj) * 4 + wc] = s; }
            LDS_WAIT(); __builtin_amdgcn_s_barrier(); asm volatile("" ::: "memory");
#pragma unroll
            for (int ai = 0; ai < 2; ++ai)
#pragma unroll
                for (int m = 0; m < 4; ++m) { const int rowl = ai * 128 + rowl0 + 16 * m; const int grow = 4 * pb + 2 * ai + wr, gcol = 16 * m + fr;
                    const int pos = wc < 2 ? grow : gcol;
#pragma unroll
                    for (int bj = 0; bj < 2; ++bj) { const f32x4 p4 = *(const LAS f32x4*)&X[(rowl * 2 + bj) * 4];
                        const float rs = 1.0f / sqrtf(((p4[0] + p4[1]) + (p4[2] + p4[3])) * (1.f / 128.f) + EPS);
                        f32x4 v0 = acc[ai][bj][m][0] * rs * gv[0], v1 = acc[ai][bj][m][1] * rs * gv[1];
                        if (lat) { const int fi = (16 * wc + 4 * fq) & 31; const f32x4 c0 = *(const f32x4*)(ropeA + (pos * 32 + fi) * 2), c1 = *(const f32x4*)(ropeA + (pos * 32 + fi + 2) * 2);
                            v0 = rope2(v0, c0); v1 = rope2(v1, c1); }
                        *(u32x4*)(A1 + (row0 + ai * 128 + 16 * m) * 3072 + pn * 256 + bj * 128 + cl) = pack8(v0, v1); } }
        } else if (pn < 12) {
#pragma unroll
            for (int ai = 0; ai < 2; ++ai)
#pragma unroll
                for (int m = 0; m < 4; ++m)
#pragma unroll
                    for (int bj = 0; bj < 2; ++bj) *(u32x4*)(A1 + (row0 + ai * 128 + 16 * m) * 3072 + pn * 256 + bj * 128 + cl) = pack8(acc[ai][bj][m][0], acc[ai][bj][m][1]);
        } else if (pn < 18) {
#pragma unroll
            for (int ai = 0; ai < 2; ++ai)
#pragma unroll
                for (int m = 0; m < 4; ++m) { float s = 0.f;
#pragma unroll
                    for (int bj = 0; bj < 2; ++bj) { const f32x4 x0 = acc[ai][bj][m][0], x1 = acc[ai][bj][m][1];
                        s += (x0[0] * x0[0] + x0[1] * x0[1]) + (x0[2] * x0[2] + x0[3] * x0[3]) + (x1[0] * x1[0] + x1[1] * x1[1]) + (x1[2] * x1[2] + x1[3] * x1[3]);
                        *(u32x4*)(CQKV + (row0 + ai * 128 + 16 * m) * 1536 + (pn - 12) * 256 + bj * 128 + cl) = pack8(x0, x1); }
                    s += __shfl_xor(s, 16); s += __shfl_xor(s, 32);
                    if (fq == 0) X[(ai * 128 + rowl0 + 16 * m) * 4 + wc] = s; }
            LDS_WAIT(); __builtin_amdgcn_s_barrier(); asm volatile("" ::: "memory");
            if (wc == 0 && fq == 0) {
#pragma unroll
                for (int ai = 0; ai < 2; ++ai)
#pragma unroll
                    for (int m = 0; m < 4; ++m) { const f32x4 p4 = *(const LAS f32x4*)&X[(ai * 128 + rowl0 + 16 * m) * 4];
                        SSQ[(row0 + ai * 128 + 16 * m) * 8 + (pn - 12)] = (p4[0] + p4[1]) + (p4[2] + p4[3]); } }
        } else if (pn < 34) {
#pragma unroll
            for (int ai = 0; ai < 2; ++ai)
#pragma unroll
                for (int m = 0; m < 4; ++m)
#pragma unroll
                    for (int bj = 0; bj < 2; ++bj) { f32x4 x0 = acc[ai][bj][m][0], x1 = acc[ai][bj][m][1];
#pragma unroll
                        for (int i = 0; i < 4; ++i) { x0[i] = fast_silu(x0[i]); x1[i] = fast_silu(x1[i]); }
                        *(u32x4*)(G0 + (row0 + ai * 128 + 16 * m) * 4096 + (pn - 18) * 256 + bj * 128 + cl) = pack8(x0, x1); }
        } else {
            if (wc < 2) {
#pragma unroll
                for (int ai = 0; ai < 2; ++ai)
#pragma unroll
                    for (int m = 0; m < 4; ++m) { const int grow = 4 * pb + 2 * ai + wr, gcol = 16 * m + fr; const int pos = wc < 1 ? grow : gcol;
                        f32x4 v0 = acc[ai][0][m][0], v1 = acc[ai][0][m][1];
                        if (lat) { const int fi = (4 * fq) & 15; const f32x4 c0 = *(const f32x4*)(ropeB + (pos * 16 + fi) * 2), c1 = *(const f32x4*)(ropeB + (pos * 16 + fi + 2) * 2);
                            v0 = rope2(v0, c0); v1 = rope2(v1, c1); }
                        *(u32x4*)(KRb + (row0 + ai * 128 + 16 * m) * 64 + cl) = pack8(v0, v1); } }
        }
    }
};
template <int UPM> struct EpiUp {
    static constexpr bool PERM = true;
    bf16_t* O; int ld; const float* SSQ; const float* ropeB;
    __device__ __forceinline__ void operator()(const f32x4 (&acc)[2][2][4][2], const Unit& u, int wr, int wc, int fr, int fq) const {
        const int pb = u.pm % PPB; const bool lat = pb < 32;
        const int rowl0 = wr * 64 + fr; const size_t row0 = (size_t)u.pm * 256 + rowl0;
#pragma unroll
        for (int ai = 0; ai < 2; ++ai)
#pragma unroll
            for (int m = 0; m < 4; ++m) { const size_t row = row0 + ai * 128 + 16 * m; float rs;
                if (UPM == 0) { const f32x4 p4 = *(const f32x4*)(SSQ + row * 8); rs = 1.0f / sqrtf(((p4[0] + p4[1]) + (p4[2] + p4[3])) * (1.f / 1024.f) + EPS); }
                else { const f32x2 p2 = *(const f32x2*)(SSQ + row * 8 + 4); rs = 1.0f / sqrtf((p2[0] + p2[1]) * (1.f / 512.f) + EPS); }
                const int grow = 4 * pb + 2 * ai + wr, gcol = 16 * m + fr;
#pragma unroll
                for (int bj = 0; bj < 2; ++bj) { const int c0 = u.pn * 256 + bj * 128 + wc * 32 + 8 * fq;
                    f32x4 v0 = acc[ai][bj][m][0] * rs, v1 = acc[ai][bj][m][1] * rs;
                    if (UPM == 0) { const int w = c0 % 192;
                        if (lat && w >= 128) { const int p = w - 128; const int pos = p < 32 ? grow : gcol; const int fi = (p >> 1) & 15;
                            const f32x4 c0v = *(const f32x4*)(ropeB + (pos * 16 + fi) * 2), c1v = *(const f32x4*)(ropeB + (pos * 16 + fi + 2) * 2);
                            v0 = rope2(v0, c0v); v1 = rope2(v1, c1v); } }
                    *(u32x4*)(O + row * ld + c0) = pack8(v0, v1); } }
    }
};
struct EpiPartKr {
    static constexpr bool PERM = true;
    float* P;
    __device__ __forceinline__ void operator()(const f32x4 (&acc)[2][2][4][2], const Unit& u, int wr, int wc, int fr, int fq) const {
        if (wc >= 2) return;
        float* base = P + ((size_t)(u.ko >> 9) * M + (size_t)u.pm * 256 + wr * 64 + fr) * 64 + wc * 32 + 8 * fq;
#pragma unroll
        for (int ai = 0; ai < 2; ++ai)
#pragma unroll
            for (int m = 0; m < 4; ++m) { float* p = base + (size_t)(ai * 128 + 16 * m) * 64; *(f32x4*)p = acc[ai][0][m][0]; *(f32x4*)(p + 4) = acc[ai][0][m][1]; }
    }
};
struct EpiPartCtx {
    static constexpr bool PERM = false;
    float* P;
    __device__ __forceinline__ void operator()(const f32x4 (&acc)[2][2][4][2], const Unit& u, int wr, int wc, int fr, int fq) const {
        float* base = P + ((size_t)(u.ko >> 9) * 512 + (size_t)(u.pm / PPB) * 256 + wr * 64 + fr) * D + u.pn * 256 + wc * 32 + 4 * fq;
#pragma unroll
        for (int ai = 0; ai < 2; ++ai)
#pragma unroll
            for (int m = 0; m < 4; ++m)
#pragma unroll
                for (int bj = 0; bj < 2; ++bj)
#pragma unroll
                    for (int n = 0; n < 2; ++n) *(f32x4*)(base + (size_t)(ai * 128 + 16 * m) * D + bj * 128 + n * 16) = acc[ai][bj][m][n];
    }
};
__device__ __forceinline__ void kr_finalize(const Frame& F, const float* P, const float* ropeB, bf16_t* KRb, int m0, int nrows) {
    for (int it = F.bid * NTHR + F.tid; it < nrows * 8; it += F.G * NTHR) {
        const int m = m0 + (it >> 3), c8 = it & 7; f32x4 v0 = {0.f, 0.f, 0.f, 0.f}, v1 = v0;
#pragma unroll
        for (int ks = 0; ks < 8; ++ks) { const float* p = P + ((size_t)ks * M + m) * 64 + c8 * 8; v0 += *(const f32x4*)p; v1 += *(const f32x4*)(p + 4); }
        const int r = m % SB;
        if (r < S) { const int pos = c8 < 4 ? (r >> 6) : (r & 63), fi = (4 * c8) & 15;
            v0 = rope2(v0, *(const f32x4*)(ropeB + (pos * 16 + fi) * 2)); v1 = rope2(v1, *(const f32x4*)(ropeB + (pos * 16 + fi + 2) * 2)); }
        *(u32x4*)(KRb + (size_t)m * 64 + c8 * 8) = pack8(v0, v1);
    }
}
struct EpiRes {
    static constexpr bool PERM = false;
    const float* xlat; const float* xctx; const float* modl; float* olat; float* octx;
    __device__ __forceinline__ void operator()(const f32x4 (&acc)[2][2][4][2], const Unit& u, int wr, int wc, int fr, int fq) const {
        const int b = u.pm / PPB, pb = u.pm % PPB; const bool lat = pb < 32;
        const size_t r0 = lat ? ((size_t)b * S + 256 * pb) : ((size_t)b * CTX);
        const float* src = (lat ? xlat : xctx) + r0 * D; float* dst = (lat ? olat : octx) + r0 * D;
        const float* gt = modl + (size_t)(lat ? b : 2) * 12288 + 2 * D;
        const int rowl0 = wr * 64 + fr, col0 = u.pn * 256 + wc * 32 + 4 * fq;
        f32x4 gv[2][2];
#pragma unroll
        for (int bj = 0; bj < 2; ++bj)
#pragma unroll
            for (int n = 0; n < 2; ++n) gv[bj][n] = *(const f32x4*)(gt + col0 + bj * 128 + n * 16);
#pragma unroll
        for (int ai = 0; ai < 2; ++ai)
#pragma unroll
            for (int m = 0; m < 4; ++m) { const size_t off = (size_t)(ai * 128 + rowl0 + 16 * m) * D + col0;
#pragma unroll
                for (int bj = 0; bj < 2; ++bj)
#pragma unroll
                    for (int n = 0; n < 2; ++n) { const f32x4 xs = *(const f32x4*)(src + off + bj * 128 + n * 16);
                        *(f32x4*)(dst + off + bj * 128 + n * 16) = xs + gv[bj][n] * acc[ai][bj][m][n]; }
                if (m & 1) asm volatile("" ::: "memory"); }
    }
};

namespace att {
using bf16 = unsigned short;
constexpr int   D = 128, NW = 8, QBLK = 32, KVBLK = 64;
constexpr float THR = 8.f;
constexpr size_t SHM_V = KVBLK * D * 2;
#define KSWZ(row, colB) ((row) * 256 + ((colB) ^ (((row) & 7) << 4)))
#define SBAR() __builtin_amdgcn_sched_barrier(0)
__device__ __forceinline__ int crow(int r, int hi) { return (r & 3) + 8 * (r >> 2) + 4 * hi; }
__device__ __forceinline__ unsigned cvtpk(float lo, float hi) {
  unsigned r; asm volatile("v_cvt_pk_bf16_f32 %0, %1, %2" : "=v"(r) : "v"(lo), "v"(hi)); return r;
}
template <typename TIn> struct Stage;
template <> struct Stage<bf16>  { using T = bf16x8;
  __device__ static __forceinline__ T ld8(const bf16* p) { return *reinterpret_cast<const bf16x8*>(p); }
  __device__ static __forceinline__ bf16x8 tobf(T x) { return x; } };
template <> struct Stage<float> { using T = f32x8;
  __device__ static __forceinline__ T ld8(const float* p) { return *reinterpret_cast<const f32x8*>(p); }
  __device__ static __forceinline__ bf16x8 tobf(T x) {
    u32x4 w = {cvtpk(x[0], x[1]), cvtpk(x[2], x[3]), cvtpk(x[4], x[5]), cvtpk(x[6], x[7])}; return *reinterpret_cast<bf16x8*>(&w); } };

template <int DQK> __device__ __forceinline__ void partialSM(f32x16& p0, f32x16& p1, float& m_reg, float& mn, float& alpha) {
  constexpr float SCALE = DQK == 128 ? 0.088388347648318440f : 0.072168783648703220f;
  constexpr float C = SCALE * 1.4426950408889634f;
  float pmax = p0[0]; for (int r = 1; r < 16; ++r) pmax = fmaxf(pmax, p0[r]); for (int r = 0; r < 16; ++r) pmax = fmaxf(pmax, p1[r]);
  { auto rr = __builtin_amdgcn_permlane32_swap(__float_as_uint(pmax), __float_as_uint(pmax), false, false);
    pmax = fmaxf(__uint_as_float(rr[0]), __uint_as_float(rr[1])); }
  if (__builtin_expect(__all(pmax - m_reg <= THR / SCALE), 1)) { mn = m_reg; alpha = 1.f; }
  else { mn = fmaxf(m_reg, pmax); alpha = __builtin_amdgcn_exp2f((m_reg - mn) * C); m_reg = mn; }
  float mnC = -mn * C;
  for (int r = 0; r < 16; ++r) p0[r] = fmaf(p0[r], C, mnC); for (int r = 0; r < 16; ++r) p1[r] = fmaf(p1[r], C, mnC);
  for (int r = 0; r < 16; ++r) p0[r] = __builtin_amdgcn_exp2f(p0[r]);
}
__device__ __forceinline__ void finishSM(f32x16& p0, f32x16& p1, float alpha, float& l_reg, bf16x8& pa0, bf16x8& pa1, bf16x8& pa2, bf16x8& pa3) {
  for (int r = 0; r < 16; ++r) p1[r] = __builtin_amdgcn_exp2f(p1[r]);
  float ps = 0; for (int r = 0; r < 16; ++r) ps += p0[r]; for (int r = 0; r < 16; ++r) ps += p1[r];
  { auto rr = __builtin_amdgcn_permlane32_swap(__float_as_uint(ps), __float_as_uint(ps), false, false);
    ps = __uint_as_float(rr[0]) + __uint_as_float(rr[1]); }
  l_reg = l_reg * alpha + ps;
#define PK4(P, BASE, OUT) do { unsigned a0 = cvtpk(P[BASE + 0], P[BASE + 1]), a1 = cvtpk(P[BASE + 2], P[BASE + 3]);   \
    unsigned b0 = cvtpk(P[BASE + 4], P[BASE + 5]), b1 = cvtpk(P[BASE + 6], P[BASE + 7]);                              \
    auto r0 = __builtin_amdgcn_permlane32_swap(a0, b0, false, false); auto r1 = __builtin_amdgcn_permlane32_swap(a1, b1, false, false); \
    u32x4 w = {r0[0], r1[0], r0[1], r1[1]}; OUT = *reinterpret_cast<bf16x8*>(&w); } while (0)
  PK4(p0, 0, pa0); PK4(p0, 8, pa1); PK4(p1, 0, pa2); PK4(p1, 8, pa3);
#undef PK4
}
#define KSWZP(row, colB, KP) ((row) * (KP) + ((colB) ^ (((row) & 7) << 4)))
template <int DQK, int NQR> __device__ __forceinline__ void qkt(f32x16& p0, f32x16& p1, const bf16* Ks, const bf16x8* qr, int r32, int hi, const char* qx) {
  p0 = f32x16{}; p1 = f32x16{};
  for (int d0 = NQR; d0 < DQK / 16; ++d0) { int cb = (d0 * 16 + hi * 8) * 2;
    bf16x8 qv = *reinterpret_cast<const bf16x8*>(qx + (d0 - NQR) * 1024);
    bf16x8 b0 = *reinterpret_cast<const bf16x8*>((const char*)Ks + KSWZP(r32, cb, DQK * 2));
    bf16x8 b1 = *reinterpret_cast<const bf16x8*>((const char*)Ks + KSWZP(32 + r32, cb, DQK * 2));
    p0 = __builtin_amdgcn_mfma_f32_32x32x16_bf16(b0, qv, p0, 0, 0, 0);
    p1 = __builtin_amdgcn_mfma_f32_32x32x16_bf16(b1, qv, p1, 0, 0, 0); }
  for (int d0 = 0; d0 < NQR; ++d0) { int cb = (d0 * 16 + hi * 8) * 2;
    bf16x8 b0 = *reinterpret_cast<const bf16x8*>((const char*)Ks + KSWZP(r32, cb, DQK * 2));
    bf16x8 b1 = *reinterpret_cast<const bf16x8*>((const char*)Ks + KSWZP(32 + r32, cb, DQK * 2));
    p0 = __builtin_amdgcn_mfma_f32_32x32x16_bf16(b0, qr[d0], p0, 0, 0, 0);
    p1 = __builtin_amdgcn_mfma_f32_32x32x16_bf16(b1, qr[d0], p1, 0, 0, 0); }
}
__device__ __forceinline__ int v_st(int k, int c) { const int kk = (k & ~0xC) | ((k & 4) << 1) | ((k & 8) >> 1); return ((kk >> 3) * 4 + (c >> 5)) * 512 + ((kk & 7) * 32 + (c & 31)) * 2; }
__device__ __forceinline__ int v_rd_base(int lane) { return ((lane & 3) << 3) | (((lane >> 2) & 3) << 6) | (((lane >> 4) & 1) << 5) | (((lane >> 5) & 1) << 8); }
constexpr int v_rd_off(int d0, int ks, int half) { return d0 * 512 + ks * 4096 + half * 2048; }
template <int OFF> __device__ __forceinline__ s16x4 tr_read(int vb) {
  s16x4 r; asm volatile("ds_read_b64_tr_b16 %0, %1 offset:%2" : "=&v"(r) : "v"(vb), "i"(OFF) : "memory"); return r;
}
template <int D0> __device__ __forceinline__ void pv_one(f32x16& od, int vb, bf16x8 pa0, bf16x8 pa1, bf16x8 pa2, bf16x8 pa3) {
  const s16x4 l0 = tr_read<v_rd_off(D0, 0, 0)>(vb), h0 = tr_read<v_rd_off(D0, 0, 1)>(vb), l1 = tr_read<v_rd_off(D0, 1, 0)>(vb), h1 = tr_read<v_rd_off(D0, 1, 1)>(vb);
  const s16x4 l2 = tr_read<v_rd_off(D0, 2, 0)>(vb), h2 = tr_read<v_rd_off(D0, 2, 1)>(vb), l3 = tr_read<v_rd_off(D0, 3, 0)>(vb), h3 = tr_read<v_rd_off(D0, 3, 1)>(vb);
  asm volatile("s_waitcnt lgkmcnt(0)" ::: "memory"); SBAR();
#define PK(L, H) (bf16x8){L[0], L[1], L[2], L[3], H[0], H[1], H[2], H[3]}
  od = __builtin_amdgcn_mfma_f32_32x32x16_bf16(pa0, PK(l0, h0), od, 0, 0, 0);
  od = __builtin_amdgcn_mfma_f32_32x32x16_bf16(pa1, PK(l1, h1), od, 0, 0, 0);
  od = __builtin_amdgcn_mfma_f32_32x32x16_bf16(pa2, PK(l2, h2), od, 0, 0, 0);
  od = __builtin_amdgcn_mfma_f32_32x32x16_bf16(pa3, PK(l3, h3), od, 0, 0, 0);
#undef PK
}
__device__ __forceinline__ void pv_d0(f32x16* o, int vb, bf16x8 pa0, bf16x8 pa1, bf16x8 pa2, bf16x8 pa3) {
  pv_one<0>(o[0], vb, pa0, pa1, pa2, pa3); pv_one<1>(o[1], vb, pa0, pa1, pa2, pa3); pv_one<2>(o[2], vb, pa0, pa1, pa2, pa3); pv_one<3>(o[3], vb, pa0, pa1, pa2, pa3);
}

template <typename TQ, int LDQ, int LDK, int LDO, int DQK, int LDK2, int SDEPTH, int NQR>
__device__ __forceinline__ void attn_dense_body(const TQ* __restrict__ Qb, const bf16* __restrict__ Kh, const bf16* __restrict__ K2h, const bf16* __restrict__ Vh,
                                                bf16* __restrict__ Ob, const bf16* __restrict__ Gb, int seq, char* lds) {
  constexpr size_t SHM_K = 64 * DQK * 2; constexpr bool X = DQK == 192;
  using St = Stage<bf16>; using SQ = Stage<TQ>;
  int tid_o = threadIdx.x; asm volatile("" : "+v"(tid_o));
  const int tid = tid_o, wid = __builtin_amdgcn_readfirstlane(tid >> 6), lane = tid & 63, r32 = lane & 31, hi = lane >> 5;
  bf16* V_lds = (bf16*)lds; bf16* K_lds = (bf16*)(lds + 2 * SHM_V);
  float* ws = (float*)(lds + 2 * SHM_V + 2 * SHM_K) + wid * 64; float* li_l = ws; float* al_l = ws + 32;
  float m_reg = -1e30f, l_reg = 0; f32x16 o[4] = {}; bf16x8 qr[NQR]; char* qx = lds + 2 * SHM_V + 2 * SHM_K + 2048 + wid * ((DQK / 16 - NQR) * 1024) + lane * 16;
  const TQ* Qw = Qb + (long)(wid * QBLK + r32) * LDQ + hi * 8;
#pragma unroll
  for (int d0 = 0; d0 < NQR; ++d0) qr[d0] = SQ::tobf(SQ::ld8(Qw + d0 * 16));
#pragma unroll
  for (int d0 = NQR; d0 < DQK / 16; ++d0) *reinterpret_cast<bf16x8*>(qx + (d0 - NQR) * 1024) = SQ::tobf(SQ::ld8(Qw + d0 * 16));
  const int sr = tid >> 4, sc = (tid & 15) * 8, vst0 = v_st(sr, sc), vst1 = v_st(32 + sr, sc);
  const int vb0 = (int)(uintptr_t)V_lds + v_rd_base(lane);
  const int sr2 = tid >> 3, sc2 = (tid & 7) * 8;
  struct { typename St::T vs0, vs1, ks0, ks1, ks2; } sr_[SDEPTH];
  const unsigned voff = (unsigned)(sr * LDK + sc) * 2u, k2off = (unsigned)(sr2 * LDK2 + sc2) * 2u;
#define SLOAD(i, k0) do { const char* vb_ = (const char*)Vh + (size_t)(k0) * (LDK * 2); const char* kb_ = (const char*)Kh + (size_t)(k0) * (LDK * 2); \
    sr_[i].vs0 = *(const bf16x8*)(vb_ + voff); sr_[i].vs1 = *(const bf16x8*)(vb_ + 32 * LDK * 2 + voff); \
    sr_[i].ks0 = *(const bf16x8*)(kb_ + voff); sr_[i].ks1 = *(const bf16x8*)(kb_ + 32 * LDK * 2 + voff); \
    if constexpr (X) sr_[i].ks2 = *(const bf16x8*)((const char*)K2h + (size_t)(k0) * (LDK2 * 2) + k2off); } while (0)
#define SWRITE(b, i) do { *(bf16x8*)((char*)V_lds + (b) * SHM_V + vst0) = St::tobf(sr_[i].vs0);          \
    *(bf16x8*)((char*)V_lds + (b) * SHM_V + vst1) = St::tobf(sr_[i].vs1); int kc = sc * 2;               \
    *(bf16x8*)((char*)K_lds + (b) * SHM_K + KSWZP(sr, kc, DQK * 2)) = St::tobf(sr_[i].ks0);                       \
    *(bf16x8*)((char*)K_lds + (b) * SHM_K + KSWZP(32 + sr, kc, DQK * 2)) = St::tobf(sr_[i].ks1); \
    if constexpr (X) *(bf16x8*)((char*)K_lds + (b) * SHM_K + KSWZP(sr2, 256 + sc2 * 2, DQK * 2)) = St::tobf(sr_[i].ks2); } while (0)
#define SWAIT() do { if constexpr (SDEPTH == 2) { if constexpr (X) asm volatile("s_waitcnt vmcnt(5)" ::: "memory"); else asm volatile("s_waitcnt vmcnt(4)" ::: "memory"); } else asm volatile("s_waitcnt vmcnt(0)" ::: "memory"); } while (0)
#define RESC(a) do { if (__any((a) < 1.f)) { if (hi == 0) al_l[r32] = (a); asm volatile("s_waitcnt lgkmcnt(0)" ::: "memory"); \
    for (int d = 0; d < 4; ++d) for (int r = 0; r < 16; ++r) o[d][r] *= al_l[crow(r, hi)]; } } while (0)
  f32x16 pA0, pA1, pB0, pB1; float mnA, mnB, alA, alB; bf16x8 pa0, pa1, pa2, pa3; const int NT = seq / KVBLK;
  constexpr int SE = 0, SO = SDEPTH - 1;
  SLOAD(SE, 0); asm volatile("s_waitcnt vmcnt(0)" ::: "memory"); SWRITE(0, SE); __syncthreads();
  qkt<DQK, NQR>(pA0, pA1, K_lds, qr, r32, hi, qx); partialSM<DQK>(pA0, pA1, m_reg, mnA, alA);
  SLOAD(SO, KVBLK); if constexpr (SDEPTH == 2) { if (2 < NT) SLOAD(SE, 2 * KVBLK); }
  SWAIT(); SWRITE(1, SO); __syncthreads();
  for (int j = 1; j + 1 < NT; j += 2) {
    SBAR(); qkt<DQK, NQR>(pB0, pB1, (bf16*)((char*)K_lds + SHM_K), qr, r32, hi, qx);
    finishSM(pA0, pA1, alA, l_reg, pa0, pa1, pa2, pa3); SBAR();
    SLOAD(SO, (j + SDEPTH) * KVBLK); SBAR();
    pv_d0(o, vb0, pa0, pa1, pa2, pa3); partialSM<DQK>(pB0, pB1, m_reg, mnB, alB);
    __syncthreads(); SWAIT(); SWRITE(0, SE);
    RESC(alB); __syncthreads();
    SBAR(); qkt<DQK, NQR>(pA0, pA1, K_lds, qr, r32, hi, qx);
    finishSM(pB0, pB1, alB, l_reg, pa0, pa1, pa2, pa3); SBAR();
    if (SDEPTH == 1 || j + 3 < NT) SLOAD(SE, (j + 1 + SDEPTH) * KVBLK); SBAR();
    pv_d0(o, vb0 + (int)SHM_V, pa0, pa1, pa2, pa3); partialSM<DQK>(pA0, pA1, m_reg, mnA, alA);
    __syncthreads(); SWAIT(); SWRITE(1, SO);
    RESC(alA); __syncthreads();
  }
  SBAR(); qkt<DQK, NQR>(pB0, pB1, (bf16*)((char*)K_lds + SHM_K), qr, r32, hi, qx);
  finishSM(pA0, pA1, alA, l_reg, pa0, pa1, pa2, pa3); SBAR();
  pv_d0(o, vb0, pa0, pa1, pa2, pa3); partialSM<DQK>(pB0, pB1, m_reg, mnB, alB);
  __syncthreads(); RESC(alB);
  finishSM(pB0, pB1, alB, l_reg, pa0, pa1, pa2, pa3); SBAR();
  pv_d0(o, vb0 + (int)SHM_V, pa0, pa1, pa2, pa3);
  if (hi == 0) li_l[r32] = l_reg; asm volatile("s_waitcnt lgkmcnt(0)" ::: "memory");
  float rli[16];
#pragma unroll
  for (int r = 0; r < 16; ++r) rli[r] = __builtin_amdgcn_rcpf(li_l[crow(r, hi)]);
  __syncthreads();
  {
    char* ep = lds + wid * 8704;
    int lane_e = hi * 4 * 272 + r32 * 2; asm volatile("" : "+v"(lane_e));
#pragma unroll
    for (int r = 0; r < 16; ++r) { const int ro = ((r & 3) + 8 * (r >> 2)) * 272;
#pragma unroll
      for (int d0 = 0; d0 < 4; ++d0) *(unsigned short*)(ep + lane_e + ro + d0 * 64) = (unsigned short)(cvtpk(o[d0][r] * rli[r], 0.f) & 0xffffu); }
    asm volatile("s_waitcnt lgkmcnt(0)" ::: "memory");
    int lane_q = lane; asm volatile("" : "+v"(lane_q));
    const int row0 = lane_q >> 4, ch = lane_q & 15;
    unsigned short* Yw = Ob + (long)(wid * QBLK + row0) * LDO + ch * 8; const unsigned short* Gw = Gb + (long)(wid * QBLK + row0) * LDO + ch * 8;
#pragma unroll
    for (int hf = 0; hf < 2; ++hf) { u32x4 gv[4], ov[4];
#pragma unroll
      for (int i = 0; i < 4; ++i) gv[i] = *(const u32x4*)(Gw + (long)(4 * (4 * hf + i)) * LDO);
#pragma unroll
      for (int i = 0; i < 4; ++i) ov[i] = *(const u32x4*)(ep + (row0 + 4 * (4 * hf + i)) * 272 + ch * 16);
#pragma unroll
      for (int i = 0; i < 4; ++i) { u32x4 w;
#pragma unroll
        for (int j = 0; j < 4; ++j) { const float lo = __uint_as_float(ov[i][j] << 16) * __uint_as_float(gv[i][j] << 16), hi2 = __uint_as_float(ov[i][j] & 0xffff0000u) * __uint_as_float(gv[i][j] & 0xffff0000u); w[j] = cvtpk(lo, hi2); }
        *(u32x4*)(Yw + (long)(4 * (4 * hf + i)) * LDO) = w; }
      asm volatile("" ::: "memory"); }
  }
  __syncthreads();
#undef SLOAD
#undef SWRITE
#undef SWAIT
#undef RESC
}

}

#ifndef ATT_NQR_A
#define ATT_NQR_A 6
#endif
#ifndef ATT_NQR_B
#define ATT_NQR_B 10
#endif
#ifndef ATT_SD_A
#define ATT_SD_A 2
#endif
#ifndef ATT_SD_B
#define ATT_SD_B 1
#endif
__device__ __forceinline__ void attn_phase(const Frame& F, const Args& a, unsigned char* lds_generic) {
    unsigned char* ws = a.ws;
    const bf16_t* A1 = (const bf16_t*)(ws + WS_A1); const bf16_t* QB = (const bf16_t*)(ws + WS_QB); const bf16_t* KVB = (const bf16_t*)(ws + WS_KVB);
    const bf16_t* KRb = (const bf16_t*)(ws + WS_KR); const bf16_t* G0 = (const bf16_t*)(ws + WS_G0); bf16_t* Y0 = (bf16_t*)(ws + WS_Y0);
    char* lds = (char*)lds_generic;
    const int x = F.bid & 7, slot = F.bid >> 3;
    for (int ii = 0; ii < ((a.var & 1) ? 0 : 5); ++ii) {
        int b, hd, q0, kb, seq;
        if (ii < 4) { const int i = (ii & 1) + 4 * (ii >> 1); const int p = i * 8 + x; b = p >> 5; hd = p & 31; q0 = b * SB + slot * 256; kb = b * SB; seq = SB; }
        else { if (F.bid >= 32) break; b = F.bid >> 4; hd = F.bid & 15; q0 = b * SB + S; kb = q0; seq = CTX; }
        att::attn_dense_body<att::bf16, 3072, 3072, 4096, 128, 64, ATT_SD_A, ATT_NQR_A>(A1 + (size_t)q0 * 3072 + hd * 128, A1 + (size_t)kb * 3072 + 2048 + (hd >> 2) * 128, nullptr,
                            A1 + (size_t)kb * 3072 + 2560 + (hd >> 2) * 128, Y0 + (size_t)q0 * 4096 + hd * 128, G0 + (size_t)q0 * 4096 + hd * 128, seq, lds);
        __syncthreads();
    }
    for (int ii = 0; ii < ((a.var & 2) ? 0 : 5); ++ii) {
        int b, h, q0, kb, seq;
        if (ii < 4) { const int i = 2 + (ii & 1) + 4 * (ii >> 1); const int p = i * 8 + x; b = p >> 5; h = (p & 31) - 16; q0 = b * SB + slot * 256; kb = b * SB; seq = SB; }
        else { if (F.bid >= 32) break; b = F.bid >> 4; h = F.bid & 15; q0 = b * SB + S; kb = q0; seq = CTX; }
        att::attn_dense_body<att::bf16, 3072, 4096, 4096, 192, 64, ATT_SD_B, ATT_NQR_B>(QB + (size_t)q0 * 3072 + h * 192, KVB + (size_t)kb * 4096 + h * 256, KRb + (size_t)kb * 64,
                            KVB + (size_t)kb * 4096 + h * 256 + 128, Y0 + (size_t)q0 * 4096 + 2048 + h * 128, G0 + (size_t)q0 * 4096 + 2048 + h * 128, seq, lds);
        __syncthreads();
    }
}
}
namespace fk {
constexpr int NCH = SB / 64;
constexpr int NC2_ = SB / 32;
struct EpiL1 {
    static constexpr bool PERM = true;
    bf16_t* QK1; bf16_t* VT; bf16_t* U1; bf16_t* G1; float* GD; int skip; LAS unsigned char* vx;
    __device__ __forceinline__ void operator()(const f32x4 (&acc)[2][2][4][2], const Unit& u, int wr, int wc, int fr, int fq) const {
        if (skip) return;
        const int pn = u.pn; const int rowl0 = wr * 64 + fr; const size_t row0 = (size_t)u.pm * 256 + rowl0; const int cl = wc * 32 + 8 * fq;
        if (pn >= 12 && pn < 24) {
            const int b = u.pm / PPB, pb = u.pm % PPB; const int cv = (pn - 12) * 256, h = cv >> 9; const int lane = fq * 16 + fr;
            LAS bf16_t* w = (LAS bf16_t*)(vx + (wr * 4 + wc) * 2048);
#pragma unroll
            for (int ai = 0; ai < 2; ++ai)
#pragma unroll
                for (int bj = 0; bj < 2; ++bj)
#pragma unroll
                    for (int mh = 0; mh < 2; ++mh) {
#pragma unroll
                        for (int mm = 0; mm < 2; ++mm) { const int m = 2 * mh + mm; const f32x4 x0 = acc[ai][bj][m][0], x1 = acc[ai][bj][m][1]; const int tl = 16 * mm + fr;
#pragma unroll
                            for (int j = 0; j < 4; ++j) { w[(8 * fq + j) * 32 + tl] = (bf16_t)(cvt_pk_bf16(x0[j], 0.f) & 0xffffu); w[(8 * fq + 4 + j) * 32 + tl] = (bf16_t)(cvt_pk_bf16(x1[j], 0.f) & 0xffffu); } }
                        LDS_WAIT(); asm volatile("" ::: "memory");
                        const int c32 = pb * 8 + 4 * ai + 2 * wr + mh; const int e0 = (cv & 511) + bj * 128 + wc * 32;
                        bf16_t* dst = VT + ((size_t)((b * 6 + h) * NC2_ + c32) * 512 + e0) * 32;
#pragma unroll
                        for (int i = 0; i < 2; ++i) { const int q = lane + 64 * i, el = q >> 2, tc = q & 3; *(u32x4*)(dst + el * 32 + tc * 8) = *(const LAS u32x4*)(w + el * 32 + tc * 8); }
                        LDS_WAIT(); asm volatile("" ::: "memory");
                    }
        } else if (pn < 28) {
            bf16_t* base; int ld, c0;
            if (pn < 12) { base = QK1; ld = 3072; c0 = pn * 256; } else { base = U1; ld = 1024; c0 = (pn - 24) * 256; }
#pragma unroll
            for (int ai = 0; ai < 2; ++ai)
#pragma unroll
                for (int m = 0; m < 4; ++m)
#pragma unroll
                    for (int bj = 0; bj < 2; ++bj) *(u32x4*)(base + (row0 + ai * 128 + 16 * m) * ld + c0 + bj * 128 + cl) = pack8(acc[ai][bj][m][0], acc[ai][bj][m][1]);
        } else if (pn < 44) {
#pragma unroll
            for (int ai = 0; ai < 2; ++ai)
#pragma unroll
                for (int m = 0; m < 4; ++m)
#pragma unroll
                    for (int bj = 0; bj < 2; ++bj) { f32x4 x0 = acc[ai][bj][m][0], x1 = acc[ai][bj][m][1];
#pragma unroll
                        for (int i = 0; i < 4; ++i) { x0[i] = fast_silu(x0[i]); x1[i] = fast_silu(x1[i]); }
                        *(u32x4*)(G1 + (row0 + ai * 128 + 16 * m) * 4096 + (pn - 28) * 256 + bj * 128 + cl) = pack8(x0, x1); }
        } else {
            if (wc == 0) {
#pragma unroll
                for (int ai = 0; ai < 2; ++ai)
#pragma unroll
                    for (int m = 0; m < 4; ++m) { float* g = GD + (row0 + ai * 128 + 16 * m) * 32 + 8 * fq; *(f32x4*)g = acc[ai][0][m][0]; *(f32x4*)(g + 4) = acc[ai][0][m][1]; } }
        }
    }
};
struct EpiPlain {
    static constexpr bool PERM = true;
    bf16_t* O; int ld;
    __device__ __forceinline__ void operator()(const f32x4 (&acc)[2][2][4][2], const Unit& u, int wr, int wc, int fr, int fq) const {
        const size_t row0 = (size_t)u.pm * 256 + wr * 64 + fr; const int c0 = u.pn * 256 + wc * 32 + 8 * fq;
#pragma unroll
        for (int ai = 0; ai < 2; ++ai)
#pragma unroll
            for (int m = 0; m < 4; ++m)
#pragma unroll
                for (int bj = 0; bj < 2; ++bj) *(u32x4*)(O + (row0 + ai * 128 + 16 * m) * ld + c0 + bj * 128) = pack8(acc[ai][bj][m][0], acc[ai][bj][m][1]);
    }
};
struct OrderFn {
    int bid;
    __device__ bool next(int i, Unit& u) const { if (i >= 1) return false; const int half = bid >> 7, t = bid & 127; u.pm = (t >> 3) + 16 * half; u.pn = (t & 7) + 8 * half; u.ko = 0; return true; }
};
struct EpiPcs {
    static constexpr bool PERM = true;
    bf16_t* P; float scale;
    __device__ __forceinline__ void operator()(const f32x4 (&acc)[2][2][4][2], const Unit& u, int wr, int wc, int fr, int fq) const {
        const size_t row0 = (size_t)(u.pm >> 4) * 4096 + (size_t)(u.pm & 15) * 256 + wr * 64 + fr; const int c0 = (u.pn & 7) * 256 + wc * 32 + 8 * fq;
#pragma unroll
        for (int ai = 0; ai < 2; ++ai)
#pragma unroll
            for (int m = 0; m < 4; ++m)
#pragma unroll
                for (int bj = 0; bj < 2; ++bj) *(u32x4*)(P + (row0 + ai * 128 + 16 * m) * 2048 + c0 + bj * 128) = pack8(acc[ai][bj][m][0] * scale, acc[ai][bj][m][1] * scale);
    }
};
__device__ __forceinline__ void fold_phase(const Frame& F, const bf16_t* AB, bf16_t* BF, int w0, int nw) {
    const int gw = F.bid * NWAVES + F.wave - w0; if (gw < 0 || gw >= nw) return;
    LAS float* scr = (LAS float*)(F.lds + 4096 + F.wave * (64 * 65 * 4));
    const int lane = F.lane, rr = lane >> 3, c8 = (lane & 7) * 8;
    for (int it = gw; it < 2 * 2 * 66 * 16; it += nw) {
        const int half = it / 2112, r0 = it % 2112, b = r0 / 1056, r = r0 % 1056, kb = r / 16, cb = r % 16;
        const int ch = cb * 64 + c8, g = ch >> 8, l = ch & 255;
        const bf16_t* base = AB + (size_t)b * SB * 2048 + g * 512 + half * 256 + l;
        u32x4 p0[8], p1[8];
#pragma unroll
        for (int jj = 0; jj < 8; ++jj) { const int kk = kb * 64 + jj * 8 + rr; const u32x4 z = {0u, 0u, 0u, 0u};
            const bool v0 = half == 0 ? (kk <= 4096) : (kk >= 1 && kk <= 4095), v1 = (kk >= 1 && kk <= 4095);
            p0[jj] = v0 ? *(const u32x4*)(base + (size_t)kk * 2048) : z; p1[jj] = v1 ? *(const u32x4*)(base + (size_t)(8192 - kk) * 2048) : z; }
        const float sg = half == 0 ? 1.f : -1.f;
#pragma unroll
        for (int jj = 0; jj < 8; ++jj) { const int j = jj * 8 + rr; LAS float* dst = scr + j * 65 + c8;
            const unsigned a[4] = {p0[jj].x, p0[jj].y, p0[jj].z, p0[jj].w}, m[4] = {p1[jj].x, p1[jj].y, p1[jj].z, p1[jj].w};
#pragma unroll
            for (int i = 0; i < 4; ++i) { dst[2 * i] = bf_lo(a[i]) + sg * bf_lo(m[i]); dst[2 * i + 1] = bf_hi(a[i]) + sg * bf_hi(m[i]); } }
        LDS_WAIT(); asm volatile("" ::: "memory");
#pragma unroll
        for (int t = 0; t < 8; ++t) { const int cr = (lane >> 3) + 8 * t, k8 = (lane & 7) * 8; float v[8];
#pragma unroll
            for (int i = 0; i < 8; ++i) v[i] = scr[(k8 + i) * 65 + cr];
            u32x4 o; o.x = cvt_pk_bf16(v[0], v[1]); o.y = cvt_pk_bf16(v[2], v[3]); o.z = cvt_pk_bf16(v[4], v[5]); o.w = cvt_pk_bf16(v[6], v[7]);
            *(u32x4*)(BF + ((size_t)half * 2048 + b * 1024 + cb * 64 + cr) * FKP + kb * 64 + k8) = o; }
        LDS_WAIT(); asm volatile("" ::: "memory");
    }
}
__device__ __forceinline__ void f4096_phase(const Frame& F, const bf16_t* AB, float* F4, int item, float scale) {
    const int b = item >> 4, cb = item & 15, lane = F.lane, rr = lane >> 3, c8 = (lane & 7) * 8;
    const int ch = cb * 64 + c8, g = ch >> 8, l = ch & 255;
    const bf16_t* base = AB + ((size_t)b * SB + F.wave * 1024 + rr) * 2048 + g * 512 + l;
    float acc[8] = {0.f, 0.f, 0.f, 0.f, 0.f, 0.f, 0.f, 0.f};
#pragma unroll 8
    for (int i = 0; i < 128; ++i) { const u32x4 v = *(const u32x4*)(base + (size_t)(8 * i) * 2048);
        acc[0] += bf_lo(v.x); acc[1] += bf_hi(v.x); acc[2] += bf_lo(v.y); acc[3] += bf_hi(v.y); acc[4] += bf_lo(v.z); acc[5] += bf_hi(v.z); acc[6] += bf_lo(v.w); acc[7] += bf_hi(v.w); }
    const float sg = (rr & 1) ? -1.f : 1.f;
#pragma unroll
    for (int i = 0; i < 8; ++i) { float v = acc[i] * sg; v += __shfl_xor(v, 8); v += __shfl_xor(v, 16); v += __shfl_xor(v, 32); acc[i] = v; }
    LAS float* red = (LAS float*)F.lds;
    __syncthreads();
    if (lane < 8) {
#pragma unroll
        for (int i = 0; i < 8; ++i) red[F.wave * 64 + lane * 8 + i] = acc[i]; }
    __syncthreads();
    if (F.tid < 64) { float s = 0.f;
#pragma unroll
        for (int w = 0; w < 8; ++w) s += red[w * 64 + F.tid];
        F4[b * 1024 + cb * 64 + F.tid] = s * scale; }
    __syncthreads();
}
__device__ __forceinline__ void fnet_finish_phase(const Frame& F, const bf16_t* PCS, const float* F4, const bf16_t* G1, bf16_t* Y1) {
    const int gw = F.bid * NWAVES + F.wave, NGW = F.G * NWAVES; const int ch = F.lane * 16;
    for (int it = gw; it < 2 * 1024; it += NGW) { const int b = it >> 10, k0 = (it & 1023) * 4;
        u32x4 pc[4][2], ps[4][2], ga[4][2], gb[4][2];
#pragma unroll
        for (int i = 0; i < 4; ++i) { const int k = k0 + i; const int km = k ? 8192 - k : 0;
#pragma unroll
            for (int hh = 0; hh < 2; ++hh) { pc[i][hh] = *(const u32x4*)(PCS + (size_t)k * 2048 + b * 1024 + ch + hh * 8); ps[i][hh] = *(const u32x4*)(PCS + (size_t)(4096 + k) * 2048 + b * 1024 + ch + hh * 8);
                ga[i][hh] = *(const u32x4*)(G1 + ((size_t)b * SB + k) * 4096 + 3072 + ch + hh * 8); gb[i][hh] = *(const u32x4*)(G1 + ((size_t)b * SB + km) * 4096 + 3072 + ch + hh * 8); } }
#pragma unroll
        for (int i = 0; i < 4; ++i) { const int k = k0 + i; const size_t ya = ((size_t)b * SB + k) * 4096 + 3072 + ch, yb = ((size_t)b * SB + (8192 - k)) * 4096 + 3072 + ch;
#pragma unroll
            for (int hh = 0; hh < 2; ++hh) { u32x4 oa, ob;
#pragma unroll
                for (int j = 0; j < 4; ++j) { const float cl = bf_lo(pc[i][hh][j]), chh = bf_hi(pc[i][hh][j]), sl = bf_lo(ps[i][hh][j]), sh = bf_hi(ps[i][hh][j]);
                    oa[j] = cvt_pk_bf16((cl - sl) * bf_lo(ga[i][hh][j]), (chh - sh) * bf_hi(ga[i][hh][j])); ob[j] = cvt_pk_bf16((cl + sl) * bf_lo(gb[i][hh][j]), (chh + sh) * bf_hi(gb[i][hh][j])); }
                *(u32x4*)(Y1 + ya + hh * 8) = oa; if (k) *(u32x4*)(Y1 + yb + hh * 8) = ob; } }
    }
    if (gw < 2) { const int b = gw; const size_t ya = ((size_t)b * SB + 4096) * 4096 + 3072 + ch;
#pragma unroll
        for (int hh = 0; hh < 2; ++hh) { const u32x4 g = *(const u32x4*)(G1 + ya + hh * 8); const f32x4 f0 = *(const f32x4*)(F4 + b * 1024 + ch + hh * 8), f1 = *(const f32x4*)(F4 + b * 1024 + ch + hh * 8 + 4);
            f32x4 x0 = f0, x1 = f1; x0[0] *= bf_lo(g.x); x0[1] *= bf_hi(g.x); x0[2] *= bf_lo(g.y); x0[3] *= bf_hi(g.y); x1[0] *= bf_lo(g.z); x1[1] *= bf_hi(g.z); x1[2] *= bf_lo(g.w); x1[3] *= bf_hi(g.w);
            *(u32x4*)(Y1 + ya + hh * 8) = pack8(x0, x1); } }
}
__device__ __forceinline__ void gla_finish_phase(const Frame& F, const bf16_t* O0, const bf16_t* O1, const bf16_t* O2, const bf16_t* O3, const bf16_t* G1, const float* on_g, bf16_t* Y1) {
    const int base = F.bid * (NB * S / 256);
    const f32x4 o0 = *(const f32x4*)(on_g + F.lane * 8), o1 = *(const f32x4*)(on_g + F.lane * 8 + 4);
    for (int i0 = F.wave; i0 < NB * S / 256; i0 += 8) {
        const int ml = base + i0; const size_t row = (size_t)(ml / S) * SB + (ml % S);
        u32x4 pa[6], pb[6], pc[6], pd[6], gg[6];
#pragma unroll
        for (int h = 0; h < 6; ++h) { const size_t ix = row * 3072 + h * 512 + F.lane * 8;
            pa[h] = *(const u32x4*)(O0 + ix); pb[h] = *(const u32x4*)(O1 + ix); pc[h] = *(const u32x4*)(O2 + ix); pd[h] = *(const u32x4*)(O3 + ix);
            gg[h] = *(const u32x4*)(G1 + row * 4096 + h * 512 + F.lane * 8); }
#pragma unroll
        for (int h = 0; h < 6; ++h) { float v[8];
#pragma unroll
            for (int j = 0; j < 4; ++j) { v[2 * j] = (bf_lo(pa[h][j]) + bf_lo(pb[h][j])) + (bf_lo(pc[h][j]) + bf_lo(pd[h][j])); v[2 * j + 1] = (bf_hi(pa[h][j]) + bf_hi(pb[h][j])) + (bf_hi(pc[h][j]) + bf_hi(pd[h][j])); }
            float ss = 0.f;
#pragma unroll
            for (int i = 0; i < 8; ++i) ss += v[i] * v[i];
            const float rs = 1.0f / sqrtf(wave_sum(ss) * (1.f / 512.f) + EPS);
            f32x4 x0 = (f32x4){v[0], v[1], v[2], v[3]} * rs * o0, x1 = (f32x4){v[4], v[5], v[6], v[7]} * rs * o1; const u32x4 g = gg[h];
            x0[0] *= bf_lo(g.x); x0[1] *= bf_hi(g.x); x0[2] *= bf_lo(g.y); x0[3] *= bf_hi(g.y); x1[0] *= bf_lo(g.z); x1[1] *= bf_hi(g.z); x1[2] *= bf_lo(g.w); x1[3] *= bf_hi(g.w);
            *(u32x4*)(Y1 + row * 4096 + h * 512 + F.lane * 8) = pack8(x0, x1); }
    }
}
__device__ __forceinline__ void final_norm_phase(const Frame& F, float* out, const float* fg) {
    const int base = F.bid * (NB * S / 256);
    for (int i0 = F.wave; i0 < NB * S / 256; i0 += 16) {
        const int rot = (F.bid * 5) & 63;
        f32x4* xa = (f32x4*)(out + (size_t)(base + ((i0 + rot) & 63)) * D) + F.lane; f32x4* xb = (f32x4*)(out + (size_t)(base + ((i0 + 8 + rot) & 63)) * D) + F.lane;
        f32x4 va[16], vb[16]; float sa = 0.f, sb = 0.f;
#pragma unroll
        for (int j = 0; j < 16; ++j) va[j] = __builtin_nontemporal_load(xa + 64 * j);
#pragma unroll
        for (int j = 0; j < 16; ++j) vb[j] = __builtin_nontemporal_load(xb + 64 * j);
#pragma unroll
        for (int j = 0; j < 16; ++j) sa += (va[j].x * va[j].x + va[j].y * va[j].y) + (va[j].z * va[j].z + va[j].w * va[j].w);
#pragma unroll
        for (int j = 0; j < 16; ++j) sb += (vb[j].x * vb[j].x + vb[j].y * vb[j].y) + (vb[j].z * vb[j].z + vb[j].w * vb[j].w);
        const float rsa = 1.0f / sqrtf(wave_sum(sa) * (1.f / D) + EPS), rsb = 1.0f / sqrtf(wave_sum(sb) * (1.f / D) + EPS);
#pragma unroll
        for (int j = 0; j < 16; ++j) { const f32x4 gg = *(const f32x4*)(fg + 4 * (F.lane + 64 * j)); __builtin_nontemporal_store(va[j] * rsa * gg, xa + 64 * j); __builtin_nontemporal_store(vb[j] * rsb * gg, xb + 64 * j); }
    }
}
}
namespace fk {
constexpr int NC2 = SB / 32;
__device__ __forceinline__ size_t gla_idx2(int dir, int b, int h, int c) { return (size_t)(((dir * 2 + b) * 6 + h) * NC2 + c); }
__device__ __forceinline__ int swz4(int x) { return (0x1320 >> (4 * x)) & 3; }
__device__ __forceinline__ void gla_prep_unit(const Frame& F, const Args& a, int b, int h, int ci) {
    unsigned char* ws = a.ws;
    const bf16_t* QK1 = (const bf16_t*)(ws + WS_QK1); const float* GD = (const float*)(ws + WS_GD);
    bf16_t* QT = (bf16_t*)(ws + WS_QT); bf16_t* KT = (bf16_t*)(ws + WS_KT); bf16_t* AT = (bf16_t*)(ws + WS_AT); float* GAM = (float*)(ws + WS_GAM);
    const int tid = F.tid, lane = F.lane, wid = F.wave;
    const size_t r0 = (size_t)b * SB + 64 * ci;
    LAS float* gds = (LAS float*)(F.lds);
    LAS bf16_t* qs = (LAS bf16_t*)(F.lds + 8192);
    LAS bf16_t* ks = (LAS bf16_t*)(F.lds + 8192 + 33792);
    LAS bf16_t* ktl = (LAS bf16_t*)(F.lds + 8192 + 2 * 33792);
    __syncthreads();
    *(LAS f32x4*)(gds + tid * 4) = *(const f32x4*)(GD + (r0 + (tid >> 3)) * 32 + (tid & 7) * 4);
    __syncthreads();
    if (a.var & 8) return;
    const int r32 = lane & 31, hi = lane >> 5, d = 32 * wid + r32;
#pragma unroll
    for (int dir = 0; dir < 2; ++dir) {
        constexpr float L2E = 1.4426950408889634f;
        const float* wg = a.in[dir ? 18 : 16] + h * 256 + d; const float bias = a.in[dir ? 19 : 17][h * 256 + d] * L2E;
        float wgv[8];
#pragma unroll
        for (int kk = 0; kk < 8; ++kk) wgv[kk] = wg[(2 * kk + hi) * 1536] * L2E;
        u32x4 rq[4], rk[4];
#pragma unroll
        for (int i = 0; i < 4; ++i) { const int q = tid + 512 * i, tok = q >> 5, dc = q & 31; const bf16_t* src = QK1 + (r0 + tok) * 3072 + h * 256 + dc * 8;
            rq[i] = *(const u32x4*)src; rk[i] = *(const u32x4*)(src + 1536); }
        float cum[2][16], last[2];
#pragma unroll
        for (int tt = 0; tt < 2; ++tt) {
            f32x16 z;
#pragma unroll
            for (int r = 0; r < 16; ++r) z[r] = bias;
            const LAS float* gp = gds + (tt * 32 + r32) * 32 + 16 * dir + hi;
#pragma unroll
            for (int kk = 0; kk < 8; ++kk) z = __builtin_amdgcn_mfma_f32_32x32x2f32(gp[2 * kk], wgv[kk], z, 0, 0, 0);
            float lg[16];
#pragma unroll
            for (int r = 0; r < 16; ++r) lg[r] = (fminf(z[r], 0.f) - __builtin_amdgcn_logf(1.f + __builtin_amdgcn_exp2f(-fabsf(z[r])))) * 0.0625f;
            float T[4], PT[4];
#pragma unroll
            for (int q = 0; q < 4; ++q) {
                if (dir == 0) { lg[4 * q + 1] += lg[4 * q]; lg[4 * q + 2] += lg[4 * q + 1]; lg[4 * q + 3] += lg[4 * q + 2]; T[q] = lg[4 * q + 3]; }
                else { lg[4 * q + 2] += lg[4 * q + 3]; lg[4 * q + 1] += lg[4 * q + 2]; lg[4 * q] += lg[4 * q + 1]; T[q] = lg[4 * q]; }
                PT[q] = __shfl_xor(T[q], 32); }
            float offs[4];
            if (dir == 0) { float run = 0.f;
#pragma unroll
                for (int q = 0; q < 4; ++q) { const float t0 = hi ? PT[q] : T[q], t1 = hi ? T[q] : PT[q]; offs[q] = run + (hi ? t0 : 0.f); run += t0 + t1; }
                last[tt] = run; }
            else { float run = 0.f;
#pragma unroll
                for (int q = 3; q >= 0; --q) { const float t0 = hi ? PT[q] : T[q], t1 = hi ? T[q] : PT[q]; offs[q] = run + (hi ? 0.f : t1); run += t0 + t1; }
                last[tt] = run; }
#pragma unroll
            for (int r = 0; r < 16; ++r) cum[tt][r] = lg[r] + offs[r >> 2];
        }
#pragma unroll
        for (int i = 0; i < 4; ++i) { const int q = tid + 512 * i, tok = q >> 5, dc = q & 31; *(LAS u32x4*)(qs + tok * 264 + dc * 8) = rq[i]; *(LAS u32x4*)(ks + tok * 264 + dc * 8) = rk[i]; }
        float el[2];
#pragma unroll
        for (int tt = 0; tt < 2; ++tt) { el[tt] = __builtin_amdgcn_exp2f(last[tt]); if (hi == 0) GAM[gla_idx2(dir, b, h, 2 * ci + tt) * 256 + d] = el[tt]; }
        __syncthreads();
#pragma unroll
        for (int tt = 0; tt < 2; ++tt)
#pragma unroll
            for (int j = 0; j < 8; ++j) { float kh2[2]; const int tl0 = ((2 * j) & 3) + 8 * ((2 * j) >> 2) + 4 * hi;
#pragma unroll
                for (int u = 0; u < 2; ++u) { const int t = 32 * tt + tl0 + u; const float e1 = __builtin_amdgcn_exp2f(cum[tt][2 * j + u]), e2 = __builtin_amdgcn_rcpf(e1);
                    const float qv = bf2f(qs[t * 264 + d]), kv = bf2f(ks[t * 264 + d]); const float kt = kv * e2;
                    qs[t * 264 + d] = (bf16_t)(cvt_pk_bf16(qv * e1, 0.f) & 0xffffu); ks[t * 264 + d] = (bf16_t)(cvt_pk_bf16(kt, 0.f) & 0xffffu); kh2[u] = kt * el[tt]; }
                *(LAS unsigned*)(ktl + (tt * 256 + d) * 34 + tl0) = cvt_pk_bf16(kh2[0], kh2[1]); }
        __syncthreads();
#pragma unroll
        for (int i = 0; i < 4; ++i) { const int q = tid + 512 * i, t2 = q >> 10, rem = q & 1023, dd = rem >> 2, c4 = rem & 3; const LAS unsigned* src = (const LAS unsigned*)(ktl + (t2 * 256 + dd) * 34 + c4 * 8);
            *(u32x4*)(KT + gla_idx2(dir, b, h, 2 * ci + t2) * 8192 + dd * 32 + c4 * 8) = (u32x4){src[0], src[1], src[2], src[3]}; }
#pragma unroll
        for (int i = 0; i < 4; ++i) { const int q = tid + 512 * i, t2 = q >> 10, rem = q & 1023, tl = rem >> 5, pc = rem & 31, blk = pc >> 2, gg = pc & 3;
            const LAS u32x2* s0 = (const LAS u32x2*)(qs + (32 * t2 + tl) * 264 + blk * 32 + 4 * gg); const LAS u32x2* s1 = (const LAS u32x2*)(qs + (32 * t2 + tl) * 264 + blk * 32 + 16 + 4 * gg);
            const u32x2 lo = *s0, hi2 = *s1;
            *(u32x4*)(QT + gla_idx2(dir, b, h, 2 * ci + t2) * 8192 + (blk >> 2) * 4096 + tl * 128 + (pc & 15) * 8) = (u32x4){lo.x, lo.y, hi2.x, hi2.y}; }
        if (wid < 2) { f32x16 acc = {};
#pragma unroll
            for (int kk = 0; kk < 16; ++kk) { const bf16x8 A = *(const LAS bf16x8*)(qs + (wid * 32 + r32) * 264 + kk * 16 + hi * 8), Bv = *(const LAS bf16x8*)(ks + (wid * 32 + r32) * 264 + kk * 16 + hi * 8);
                acc = __builtin_amdgcn_mfma_f32_32x32x16_bf16(A, Bv, acc, 0, 0, 0); }
            bf16_t* at = AT + gla_idx2(dir, b, h, 2 * ci + wid) * 1024;
#pragma unroll
            for (int r = 0; r < 16; ++r) { const int itok = (r & 3) + 8 * (r >> 2) + 4 * hi; const bool keep = dir ? (r32 >= itok) : (r32 <= itok);
                at[itok * 32 + r32] = (bf16_t)(cvt_pk_bf16(keep ? acc[r] : 0.f, 0.f) & 0xffffu); } }
        __syncthreads();
    }
}
__device__ __forceinline__ void gla_prep_phase(const Frame& F, const Args& a) {
    for (int u = F.bid; u < NB * 6 * NCH; u += F.G) { const int ci = u % NCH, bh = u / NCH; gla_prep_unit(F, a, bh / 6, bh % 6, ci); }
}
#ifndef SC_SYNC
#define SC_SYNC 0
#endif
template <int NBE>
__device__ __forceinline__ void gla_scan_wg(const Frame& F, const Args& a, int dir, int b, int h, int dhalf, int esl) {
    constexpr int SC_QT = 0, SC_KT = 8192, SC_VT = 16384, SC_AT = SC_VT + 8192 * NBE, SC_GAM = SC_AT + 2048, SC_STAGE = SC_GAM + 512, SC_NS = NBE == 2 ? 4 : 5, EW = 128 * NBE;
    unsigned char* ws = a.ws;
    const bf16_t* QT = (const bf16_t*)(ws + WS_QT); const bf16_t* KT = (const bf16_t*)(ws + WS_KT); const bf16_t* AT = (const bf16_t*)(ws + WS_AT); const float* GAM = (const float*)(ws + WS_GAM);
    const bf16_t* VT = (const bf16_t*)(ws + WS_VT);
    bf16_t* O = (bf16_t*)(ws + (dir ? (dhalf ? WS_O11 : WS_O10) : (dhalf ? WS_O01 : WS_O00)));
    const int lane = F.lane, wid = F.wave, c = lane & 15, g = lane >> 4;
    LAS unsigned char* lds = F.lds;
    unsigned qsrc, ksrc, vsrc[NBE], asrc;
    { const int P = wid * 64 + lane;
      { const int r = P >> 4, sp = P & 15; qsrc = (unsigned)(dhalf * 4096 + r * 128 + (sp ^ (r & 15)) * 8); }
      { const int dd = P >> 2, sp = P & 3; ksrc = (unsigned)(dhalf * 4096 + dd * 32 + (sp ^ swz4((dd >> 2) & 3)) * 8); }
#pragma unroll
      for (int be = 0; be < NBE; ++be) { const int Pv = (wid + 8 * be) * 64 + lane; const int e = Pv >> 2, sp = Pv & 3; vsrc[be] = (unsigned)((esl * EW + e) * 32 + (sp ^ swz4((e >> 2) & 3)) * 8); }
      { const int i = (P >> 2) & 31, sp = P & 3; asrc = (unsigned)(i * 32 + (sp ^ swz4((i >> 2) & 3)) * 8); } }
    const int sw = swz4(c >> 2);
    const int q_rd = c * 256;
    const int k_rd = SC_KT + c * 64 + ((g ^ sw) * 16);
    const int v_rd = SC_VT + (16 * wid + c) * 64 + ((g ^ sw) * 16);
    const int a_rd = SC_AT + c * 64 + ((g ^ sw) * 16);
    const int g_rd = SC_GAM + 16 * g;
    f32x4 St[NBE][8];
#pragma unroll
    for (int be = 0; be < NBE; ++be)
#pragma unroll
        for (int t = 0; t < 8; ++t) St[be][t] = (f32x4){0.f, 0.f, 0.f, 0.f};
#define SC_CI(s) (dir ? (NC2 - 1 - (s)) : (((s) + 256) % NC2))
#define SC_DMA(slot, ci_) do { const size_t x_ = gla_idx2(dir, b, h, (ci_)); const int so_ = (slot) * SC_STAGE; \
        __builtin_amdgcn_global_load_lds((const unsigned*)(QT + x_ * 8192 + qsrc), (LAS unsigned*)(lds + so_ + SC_QT + wid * 1024), 16, 0, 0); \
        __builtin_amdgcn_global_load_lds((const unsigned*)(KT + x_ * 8192 + ksrc), (LAS unsigned*)(lds + so_ + SC_KT + wid * 1024), 16, 0, 0); \
        _Pragma("unroll") for (int be = 0; be < NBE; ++be) \
            __builtin_amdgcn_global_load_lds((const unsigned*)(VT + ((size_t)((b * 6 + h) * NC2 + (ci_))) * 16384 + vsrc[be]), (LAS unsigned*)(lds + so_ + SC_VT + (wid + 8 * be) * 1024), 16, 0, 0); \
        if (wid < 2) __builtin_amdgcn_global_load_lds((const unsigned*)(AT + x_ * 1024 + asrc), (LAS unsigned*)(lds + so_ + SC_AT + wid * 1024), 16, 0, 0); \
        if (wid == 2) { if (lane < 32) __builtin_amdgcn_global_load_lds((const unsigned*)(GAM + x_ * 256 + dhalf * 128 + lane * 4), (LAS unsigned*)(lds + so_ + SC_GAM), 16, 0, 0); } } while (0)
    __syncthreads();
#pragma unroll
    for (int p = 0; p < SC_NS - 1; ++p) SC_DMA(p, SC_CI(p));
    for (int s = 0; s < NC2; ++s) {
        const int ci = SC_CI(s); const int so = (s % SC_NS) * SC_STAGE;
        if (s < SC_NS || SC_SYNC || (a.var & 56)) __builtin_amdgcn_s_waitcnt(0x0F70);
        else if (NBE == 1) { if (wid < 3) __builtin_amdgcn_s_waitcnt(0x4F74); else __builtin_amdgcn_s_waitcnt(0x4F71); }
        else { if (wid < 3) __builtin_amdgcn_s_waitcnt(0x4F76); else __builtin_amdgcn_s_waitcnt(0x4F74); }
        __builtin_amdgcn_s_barrier(); asm volatile("" ::: "memory");
        if (!(a.var & 8)) { const int sn = s + SC_NS - 1; const int cn = SC_CI(sn < NC2 ? sn : NC2 - 1); SC_DMA(sn % SC_NS, cn); }
        if (a.var & 16) continue;
        bf16x8 vf[NBE], qf[4][2], af[2], kf[8]; f32x4 gmv[8];
#pragma unroll
        for (int be = 0; be < NBE; ++be) vf[be] = *(const LAS bf16x8*)(lds + so + v_rd + be * 8192);
#pragma unroll
        for (int ks = 0; ks < 4; ++ks) { const int chk = ((4 * ks + g) ^ c) * 16;
#pragma unroll
            for (int tt = 0; tt < 2; ++tt) qf[ks][tt] = *(const LAS bf16x8*)(lds + so + SC_QT + q_rd + tt * 4096 + chk); }
        if (dhalf == 0) {
#pragma unroll
            for (int tt = 0; tt < 2; ++tt) af[tt] = *(const LAS bf16x8*)(lds + so + a_rd + tt * 1024); }
#pragma unroll
        for (int t = 0; t < 8; ++t) { kf[t] = *(const LAS bf16x8*)(lds + so + k_rd + t * 1024); gmv[t] = *(const LAS f32x4*)(lds + so + g_rd + t * 64); }
        __builtin_amdgcn_sched_barrier(0);
#pragma unroll
        for (int be = 0; be < NBE; ++be) {
            f32x4 oT[2] = {(f32x4){0.f, 0.f, 0.f, 0.f}, (f32x4){0.f, 0.f, 0.f, 0.f}};
#pragma unroll
            for (int ks = 0; ks < 4; ++ks) {
                u32x4 aw; aw.x = cvt_pk_bf16(St[be][2 * ks][0], St[be][2 * ks][1]); aw.y = cvt_pk_bf16(St[be][2 * ks][2], St[be][2 * ks][3]);
                aw.z = cvt_pk_bf16(St[be][2 * ks + 1][0], St[be][2 * ks + 1][1]); aw.w = cvt_pk_bf16(St[be][2 * ks + 1][2], St[be][2 * ks + 1][3]);
                const bf16x8 Af = *reinterpret_cast<bf16x8*>(&aw);
#pragma unroll
                for (int tt = 0; tt < 2; ++tt) oT[tt] = __builtin_amdgcn_mfma_f32_16x16x32_bf16(Af, qf[ks][tt], oT[tt], 0, 0, 0); }
            if (dhalf == 0) {
#pragma unroll
                for (int tt = 0; tt < 2; ++tt) oT[tt] = __builtin_amdgcn_mfma_f32_16x16x32_bf16(vf[be], af[tt], oT[tt], 0, 0, 0); }
            if (!(a.var & 32)) { bf16_t* orow = O + ((size_t)b * SB + 32 * ci + c) * 3072 + h * 512 + esl * EW + be * 128 + 16 * wid + 4 * g;
#pragma unroll
              for (int tt = 0; tt < 2; ++tt) { u32x2 w; w.x = cvt_pk_bf16(oT[tt][0], oT[tt][1]); w.y = cvt_pk_bf16(oT[tt][2], oT[tt][3]); *(u32x2*)(orow + (size_t)(16 * tt) * 3072) = w; } }
#pragma unroll
            for (int t = 0; t < 8; ++t) St[be][t] = __builtin_amdgcn_mfma_f32_16x16x32_bf16(kf[t], vf[be], St[be][t] * gmv[t], 0, 0, 0);
        }
    }
    __builtin_amdgcn_s_waitcnt(0x0F70); __syncthreads();
#undef SC_CI
#undef SC_DMA
}
}
namespace fk {
constexpr int NPHASE = 14;
__global__ void __launch_bounds__(NTHR, 2) fwd(Args args) {
    extern __shared__ __attribute__((aligned(16))) unsigned char lds_raw[];
    Frame F; F.lds = (LAS unsigned char*)lds_raw; F.tid = threadIdx.x; F.lane = F.tid & 63; F.wave = __builtin_amdgcn_readfirstlane(F.tid >> 6); F.G = gridDim.x; F.bid = blockIdx.x;
    unsigned char* ws = args.ws;
    volatile LAS unsigned* MISC = (volatile LAS unsigned*)(F.lds + LDS_MISC);
    if (F.tid < 64) MISC[F.tid] = 0u;
    __syncthreads();
    const int lo = args.ph_lo, hi = args.ph_hi;
    XcdBarrier bar; bar.bar = (unsigned*)(ws + WS_CTL) + CW_BAR; bar.x = 0; bar.st = MISC + 8;
    if (hi - lo > 1) bar = xcd_barrier_post((unsigned*)(ws + WS_CTL) + CW_BAR, MISC + 8);
#ifndef PHMASK
#define PHMASK 0xFFFF
#endif
#define IN(k) (((PHMASK >> (k)) & 1) && lo <= (k) && (k) < hi)
#define SEAM(k) do { if (IN(k) && IN((k) + 1)) xcd_barrier(bar); } while (0)
    float* mod = (float*)(ws + WS_MOD);
    float* x1c = (float*)(ws + WS_X1C);
    LAS float* XCH = (LAS float*)(F.lds + LDS_X);
    if (IN(0)) { p0_prologue(F, args); }
    SEAM(0);
    if (IN(1)) { hnorm_phase(F, args.in[0], args.in[2], args.in[4], mod, (bf16_t*)(ws + WS_H)); }
    SEAM(1);
    if (IN(2)) {
        Gemm g{(const bf16_t*)(ws + WS_H), (const bf16_t*)(ws + WS_W1T), 4096, 4096, 4096}; Order S_; S_.init(NPANEL, 35, F.G, F.bid, 0);
        EpiL0 E{(bf16_t*)(ws + WS_A1), (bf16_t*)(ws + WS_CQKV), (bf16_t*)(ws + WS_G0), (bf16_t*)(ws + WS_KR), (float*)(ws + WS_SSQ), args.in[8], args.in[9],
                (const float*)(ws + WS_ROPEA), (const float*)(ws + WS_ROPEB), XCH};
        gemm_phase<EpiL0>(F.lds + LDS_STAGE, g, S_, E);
        late_convert(F, args, 6 * NWAVES, (F.G - 6) * NWAVES, 0);
    }
    SEAM(2);
    if (IN(3)) {
        { Gemm g{(const bf16_t*)(ws + WS_CQKV), (const bf16_t*)(ws + WS_WUQ), 1024, 1536, 1024}; Order S_; S_.init(NPANEL, 12, F.G, F.bid, 0);
          EpiUp<0> E{(bf16_t*)(ws + WS_QB), 3072, (const float*)(ws + WS_SSQ), (const float*)(ws + WS_ROPEB)};
          gemm_phase<EpiUp<0>>(F.lds + LDS_STAGE, g, S_, E); }
        { Gemm g{(const bf16_t*)(ws + WS_CQKV) + 1024, (const bf16_t*)(ws + WS_WUKV), 512, 1536, 512}; Order S_; S_.init(NPANEL, 16, F.G, F.bid, 0);
          EpiUp<1> E{(bf16_t*)(ws + WS_KVB), 4096, (const float*)(ws + WS_SSQ), (const float*)(ws + WS_ROPEB)};
          gemm_phase<EpiUp<1>>(F.lds + LDS_STAGE, g, S_, E); }
    }
    SEAM(3);
    if (IN(4)) { attn_phase(F, args, lds_raw); }
    SEAM(4);
    if (IN(5)) {
        Gemm g{(const bf16_t*)(ws + WS_Y0), (const bf16_t*)(ws + WS_WO), 4096, 4096, 4096}; Order S_; S_.init(NPANEL, 16, F.G, F.bid, 0);
        EpiRes E{args.in[0], args.in[2], mod, args.out, x1c};
        gemm_phase<EpiRes>(F.lds + LDS_STAGE, g, S_, E);
        late_convert(F, args, 32 * NWAVES, (F.G - 32) * NWAVES, 1);
    }
    SEAM(5);
    const float* mod1 = mod + 3 * 12288;
    if (IN(6)) { hnorm_phase(F, args.out, x1c, args.in[4] + D, mod1, (bf16_t*)(ws + WS_H)); }
    SEAM(6);
    if (IN(7)) {
        Gemm g{(const bf16_t*)(ws + WS_H), (const bf16_t*)(ws + WS_W4T), 4096, 4096, 4096}; Order S_; S_.init(NPANEL, 45, F.G, F.bid, 0);
        EpiL1 E{(bf16_t*)(ws + WS_QK1), (bf16_t*)(ws + WS_VT), (bf16_t*)(ws + WS_U1), (bf16_t*)(ws + WS_G1), (float*)(ws + WS_GD), args.var & 1, F.lds + 131072};
        gemm_phase<EpiL1>(F.lds + LDS_STAGE, g, S_, E);
    }
    SEAM(7);
    if (IN(8)) {
        if (!(args.var & 1)) gla_prep_phase(F, args);
        __syncthreads();
        if (!(args.var & 2)) {
        int k8 = 256; asm volatile("" : "+s"(k8));
        Gemm g{(const bf16_t*)(ws + WS_U1), (const bf16_t*)(ws + WS_CS), k8, 256, 256}; Order S_; S_.init(M * 4 / 256, 2, F.G, F.bid, 0);
        EpiPlain E{(bf16_t*)(ws + WS_AB), 512};
        gemm_phase<EpiPlain>(F.lds + LDS_STAGE, g, S_, E); }
    }
    SEAM(8);
    if (IN(9)) {
#ifndef SCAN_NBE
#define SCAN_NBE 1
#endif
        constexpr int NSCAN = 192 / SCAN_NBE;
        const int x = F.bid & 7, j = F.bid >> 3;
        if (j < NSCAN / 8) { if (!(args.var & 1)) { constexpr int SPC = 8 / SCAN_NBE; const int combo = x * 3 + j / SPC, sub = j % SPC;
            gla_scan_wg<SCAN_NBE>(F, args, combo / 12, (combo % 12) / 6, combo % 6, sub / (SPC / 2), sub % (SPC / 2)); } }
        else { const int fw = F.bid - NSCAN;
            if (!(args.var & 2)) { if (fw < 32) f4096_phase(F, (const bf16_t*)(ws + WS_AB), (float*)(ws + WS_F4096), fw, 1.0f / 1448.1546878700494f);
                fold_phase(F, (const bf16_t*)(ws + WS_AB), (bf16_t*)(ws + WS_BF), NSCAN * NWAVES, (256 - NSCAN) * NWAVES); }
            if (!(args.var & 4)) dm_gen(F, (bf16_t*)(ws + WS_DM), fw, 256 - NSCAN);
            wo2_convert(F, args, NSCAN * NWAVES, (256 - NSCAN) * NWAVES); }
    }
    SEAM(9);
    if (IN(10)) {
        Gemm g{(const bf16_t*)(ws + WS_DM), (const bf16_t*)(ws + WS_BF), FKP, FKP, FKP}; OrderFn S_{F.bid};
        EpiPcs E{(bf16_t*)(ws + WS_PCS), 1.0f / 1448.1546878700494f};
        gemm_phase<EpiPcs>(F.lds + LDS_STAGE, g, S_, E);
        gla_finish_phase(F, (const bf16_t*)(ws + WS_O00), (const bf16_t*)(ws + WS_O01), (const bf16_t*)(ws + WS_O10), (const bf16_t*)(ws + WS_O11), (const bf16_t*)(ws + WS_G1), args.in[20], (bf16_t*)(ws + WS_Y1));
    }
    SEAM(10);
    if (IN(11)) { fnet_finish_phase(F, (const bf16_t*)(ws + WS_PCS), (const float*)(ws + WS_F4096), (const bf16_t*)(ws + WS_G1), (bf16_t*)(ws + WS_Y1)); }
    SEAM(11);
    if (IN(12)) {
        Gemm g{(const bf16_t*)(ws + WS_Y1), (const bf16_t*)(ws + WS_WO2), 4096, 4096, 4096}; Order S_; S_.init(64, 16, F.G, F.bid, 1);
        EpiRes E{args.out, x1c, mod1, args.out, x1c};
        gemm_phase<EpiRes>(F.lds + LDS_STAGE, g, S_, E);
    }
    SEAM(12);
    if (IN(13)) { final_norm_phase(F, args.out, args.in[22]); }
#undef IN
#undef SEAM
}

static int g_state = 0;
static bool host_init(int n_in, size_t ws_size) {
    if (g_state == 0) {
        g_state = -1;
        if (n_in != 23 || ws_size < WS_TOTAL) { fprintf(stderr, "kernel_launch: n_in %d ws %zu (need %zu)\n", n_in, ws_size, (size_t)WS_TOTAL); return false; }
        int dev = 0, cus = 0;
        if (hipGetDevice(&dev) != hipSuccess || hipDeviceGetAttribute(&cus, hipDeviceAttributeMultiprocessorCount, dev) != hipSuccess || cus != 256) { fprintf(stderr, "kernel_launch: needs a 256-CU device (got %d)\n", cus); return false; }
        if (hipFuncSetAttribute((const void*)fwd, hipFuncAttributeMaxDynamicSharedMemorySize, LDS_BYTES) != hipSuccess) { fprintf(stderr, "hipFuncSetAttribute(fwd) failed\n"); return false; }
        int per_cu = 0;
        if (hipOccupancyMaxActiveBlocksPerMultiprocessor(&per_cu, (const void*)fwd, NTHR, LDS_BYTES) != hipSuccess || per_cu < 1) fprintf(stderr, "kernel_launch: occupancy query reports %d blocks per CU\n", per_cu);
        (void)hipGetLastError();
#if MODE != 4 && MODE != 3 && MODE != 5
        if (hipFuncSetAttribute((const void*)orc::k_attn, hipFuncAttributeMaxDynamicSharedMemorySize, 160 * 1024 - 256) != hipSuccess) { fprintf(stderr, "hipFuncSetAttribute(k_attn) failed\n"); return false; }
#endif
        g_state = 1;
    }
    return g_state > 0;
}
static void launch_phases(void* const* d_in, void* d_out, void* d_ws, hipStream_t stream, int lo, int hi, bool one_launch, int var = 0) {
    (void)hipMemsetAsync((char*)d_ws + WS_CTL, 0, MiB, stream);
    Args a{};
    for (int i = 0; i < 23; ++i) a.in[i] = (const float*)d_in[i];
    a.out = (float*)d_out; a.ws = (unsigned char*)d_ws; a.var = var;
    if (one_launch) { a.ph_lo = lo; a.ph_hi = hi; hipLaunchKernelGGL(fwd, dim3(256), dim3(NTHR), LDS_BYTES, stream, a); }
    else for (int p = lo; p < hi; ++p) { a.ph_lo = p; a.ph_hi = p + 1; hipLaunchKernelGGL(fwd, dim3(256), dim3(NTHR), LDS_BYTES, stream, a); }
    const hipError_t le = hipPeekAtLastError();
    if (le != hipSuccess) fprintf(stderr, "kernel_launch: launch failed: %s\n", hipGetErrorName(le));
}
}

#ifndef MODE
#define MODE 1
#endif
extern "C" void kernel_launch(void* const* d_in, const int* in_sizes, int n_in, void* d_out, int out_size, void* d_ws, size_t ws_size, hipStream_t stream) {
    if (!fk::host_init(n_in, ws_size)) return;
#if MODE != 4 && MODE != 3 && MODE != 5
    const orc::Ptrs p = orc::ptrs(d_in); (void)p;
#endif
#if MODE == 0
    orc::setup(p, (unsigned char*)d_ws, stream); orc::layer0(p, (float*)d_out, (unsigned char*)d_ws, stream); orc::layer1(p, (float*)d_out, (unsigned char*)d_ws, stream);
#elif MODE == 1
    fk::launch_phases(d_in, d_out, d_ws, stream, 0, 6, false);
    orc::setup(p, (unsigned char*)d_ws, stream); orc::layer1(p, (float*)d_out, (unsigned char*)d_ws, stream);
#elif MODE == 2
    orc::setup(p, (unsigned char*)d_ws, stream); orc::layer0(p, (float*)d_out, (unsigned char*)d_ws, stream);
    fk::launch_phases(d_in, d_out, d_ws, stream, 0, 1, false); fk::launch_phases(d_in, d_out, d_ws, stream, 6, 14, false);
#elif MODE == 3
    fk::launch_phases(d_in, d_out, d_ws, stream, 0, 14, false);
#elif MODE == 5
    { const int lst[] = {PHLIST}; for (unsigned i = 0; i < sizeof(lst) / sizeof(lst[0]); ++i) fk::launch_phases(d_in, d_out, d_ws, stream, lst[i] % 100, lst[i] % 100 + 1, false, lst[i] / 100); }
#elif MODE == 4
    fk::launch_phases(d_in, d_out, d_ws, stream, 0, 14, true);
#endif
}
```

```cpp
#define MODE 4
#define ATT_PP 0
#include <hip/hip_runtime.h>
#include <cstdio>
#include <cstdint>
namespace fk {
#define LAS __attribute__((address_space(3)))
#define GAS __attribute__((address_space(1)))
typedef unsigned short bf16_t;
typedef short bf16x8 __attribute__((ext_vector_type(8)));
typedef short s16x4 __attribute__((ext_vector_type(4)));
typedef float f32x2 __attribute__((ext_vector_type(2)));
typedef float f32x4 __attribute__((ext_vector_type(4)));
typedef float f32x8 __attribute__((ext_vector_type(8)));
typedef float f32x16 __attribute__((ext_vector_type(16)));
typedef unsigned u32x2 __attribute__((ext_vector_type(2)));
typedef unsigned u32x4 __attribute__((ext_vector_type(4)));

constexpr int NWAVES = 8, NTHR = 512;
constexpr int D = 4096, NB = 2, S = 8192, CTX = 256, SB = S + CTX  , M = NB * SB  , NPANEL = M / 256  , PPB = SB / 256  ;
constexpr float EPS = 1e-6f;

__device__ __forceinline__ unsigned cvt_pk_bf16(float lo, float hi) { unsigned r; asm volatile("v_cvt_pk_bf16_f32 %0, %1, %2" : "=v"(r) : "v"(lo), "v"(hi)); return r; }
__device__ __forceinline__ float bf_lo(unsigned w) { return __uint_as_float(w << 16); }
__device__ __forceinline__ float bf_hi(unsigned w) { return __uint_as_float(w & 0xffff0000u); }
__device__ __forceinline__ float bf2f(bf16_t b) { return __uint_as_float(((unsigned)b) << 16); }
__device__ __forceinline__ float fast_silu(float x) { return x * __builtin_amdgcn_rcpf(1.f + __expf(-x)); }
__device__ __forceinline__ float wave_sum(float v) {
#pragma unroll
    for (int o = 1; o < 64; o <<= 1) v += __shfl_xor(v, o);
    return v;
}
#define LDS_WAIT() asm volatile("s_waitcnt lgkmcnt(0)" ::: "memory")
#define VM_WAIT() asm volatile("s_waitcnt vmcnt(0)" ::: "memory")

#define XB_TMO      128
#define XB_XCNT(j)  (256  + 64 * (j))
#define XB_XSUB(j)  (1280 + 64 * (j))
#define XB_XGEN(j)  (2304 + 64 * (j))
#define XB_TOP      3328
#define XB_TOPGEN   3392
#define XCD_BAR_WORDS 3456
#define XB_SPIN_CAP (1u << 24)
__device__ __forceinline__ unsigned xb_ld(unsigned* p)              { return __hip_atomic_load(p, __ATOMIC_RELAXED, __HIP_MEMORY_SCOPE_AGENT); }
__device__ __forceinline__ unsigned xb_add(unsigned* p, unsigned v) { return __hip_atomic_fetch_add(p, v, __ATOMIC_RELAXED, __HIP_MEMORY_SCOPE_AGENT); }
__device__ __forceinline__ unsigned xb_xcc_id() { return (unsigned)__builtin_amdgcn_s_getreg((3 << 11) | 20) & 0xFu; }
#define XB_SPIN(cond, bar) do { unsigned _sp = 0; while (cond) { __builtin_amdgcn_s_sleep(1); \
    if ((++_sp & 255u) == 0u) { if (xb_ld(&(bar)[XB_TMO])) break; if (_sp > XB_SPIN_CAP) { atomicAdd(&(bar)[XB_TMO], 1u); break; } } } } while (0)
struct XcdBarrier { unsigned* bar; unsigned x; volatile LAS unsigned* st; };
__device__ __forceinline__ XcdBarrier xcd_barrier_post(unsigned* bar, volatile LAS unsigned* st) {
    XcdBarrier b; b.bar = bar; b.x = xb_xcc_id(); b.st = st;
    if (threadIdx.x == 0) (void)xb_add(&bar[XB_XCNT(b.x)], 1u);
    return b;
}
__device__ __forceinline__ void xcd_barrier_complete(unsigned* bar, unsigned x, unsigned& nloc, unsigned& nx) {
    const unsigned G = gridDim.x * gridDim.y * gridDim.z;
    unsigned sum, cnt, mine, sp = 0u;
    for (;;) {
        sum = 0u; cnt = 0u; mine = 0u;
#pragma unroll
        for (unsigned j = 0; j < 16; ++j) { const unsigned c = xb_ld(&bar[XB_XCNT(j)]); sum += c; cnt += (c > 0u) ? 1u : 0u; mine = (j == x) ? c : mine; }
        if (sum == G) break;
        __builtin_amdgcn_s_sleep(1);
        if ((++sp & 255u) == 0u) { if (xb_ld(&bar[XB_TMO])) break; if (sp > XB_SPIN_CAP) { atomicAdd(&bar[XB_TMO], 1u); break; } }
    }
    nloc = mine > 0u ? mine : 1u; nx = cnt > 0u ? cnt : 1u;
}
__device__ __forceinline__ void xcd_barrier(const XcdBarrier& b) {
    asm volatile("s_waitcnt vmcnt(0)" ::: "memory");
    __syncthreads();
    if (threadIdx.x == 0) {
        unsigned* bar = b.bar;
        __builtin_amdgcn_s_waitcnt(0);
        unsigned nloc = b.st[0], nx = b.st[1];
        if (nloc == 0u) { xcd_barrier_complete(bar, b.x, nloc, nx); b.st[0] = nloc; b.st[1] = nx; }
        const unsigned old = xb_add(&bar[XB_XSUB(b.x)], 1u);
        const unsigned gen = old / nloc;
        if (old + 1u == (gen + 1u) * nloc) {
            __builtin_amdgcn_fence(__ATOMIC_RELEASE, "agent");
            asm volatile("s_waitcnt vmcnt(0)" ::: "memory");
            const unsigned og = xb_add(&bar[XB_TOP], 1u);
            const unsigned tg = og / nx;
            if (og + 1u == (tg + 1u) * nx) xb_add(&bar[XB_TOPGEN], 1u);
            else XB_SPIN(xb_ld(&bar[XB_TOPGEN]) == tg, bar);
            __builtin_amdgcn_fence(__ATOMIC_ACQUIRE, "agent");
            xb_add(&bar[XB_XGEN(b.x)], 1u);
            asm volatile("s_waitcnt vmcnt(0)" ::: "memory");
        } else {
            XB_SPIN(xb_ld(&bar[XB_XGEN(b.x)]) == gen, bar);
            __builtin_amdgcn_fence(__ATOMIC_ACQUIRE, "agent");
            asm volatile("s_waitcnt vmcnt(0)" ::: "memory");
        }
    }
    __syncthreads();
}

constexpr int BM = 256, BK = 64, HALF = 128, HTB = HALF * BK * 2, STAGE_BYTES = 8 * HTB, NXCD = 8, WGM = 8;
__host__ __device__ __forceinline__ int lds_byte(int r, int c) { const int st = (r >> 4) * 2 + (c >> 5), rr = r & 15, cc = c & 31, ob = rr * 64 + cc * 2; return st * 1024 + (ob ^ (((ob >> 9) & 1) << 5)); }
__host__ __device__ __forceinline__ void stage_rc(int b, int& R, int& C) { const int st = b / 1024, sb = b % 1024, swz = sb ^ (((sb >> 9) & 1) << 5); R = (st >> 1) * 16 + swz / 64; C = (st & 1) * 32 + (swz % 64) / 2; }
__host__ __device__ __forceinline__ int perm32(int rho) { const int n = rho >> 4, i = rho & 15; return 8 * (i >> 2) + 4 * n + (i & 3); }
struct Unit { int pm, pn, ko; };
struct Gemm { const bf16_t* A; const bf16_t* Bt; int K, lda, ldb; };
struct Order {
    int nM, nN, nwg, G, c, skip;
    __device__ void init(int nM_, int nN_, int G_, int c_, int skip_) { nM = nM_; nN = nN_; nwg = nM * nN; G = G_; c = c_; skip = skip_; }
    __device__ bool next(int i, Unit& u) const {
        const long L = (long)i * G + c; if (L >= nwg) return false;
        int wgid = (int)L; { const int q = nwg / NXCD, r = nwg % NXCD, xcd = wgid % NXCD, off = wgid / NXCD; wgid = (xcd < r ? xcd * (q + 1) : r * (q + 1) + (xcd - r) * q) + off; }
        const int nig = WGM * nN, gid = wgid / nig, fm = gid * WGM, gsz = (nM - fm) < WGM ? (nM - fm) : WGM;
        int pm = fm + ((wgid % nig) % gsz); if (skip && pm >= 32) pm += 1;
        u.pm = pm; u.pn = (wgid % nig) / gsz; u.ko = 0; return true;
    }
};
struct OrderKr {
    int bid;
    __device__ bool next(int i, Unit& u) const {
        int L; if (bid >= 196) { if (i >= 8) return false; L = (bid - 196) * 8 + i; } else { if (i >= 1 || bid >= 48) return false; L = 480 + bid; }
        u.pm = L >> 3; u.pn = 0; u.ko = (L & 7) * 512; return true;
    }
};
struct OrderL0t {
    Order base; int G, c;
    __device__ bool next(int i, Unit& u) const { const int L = i * G + c; if (L < 2244) return base.next(i, u); if (L < 2304) { u.pm = L - 2244; u.pn = 34; u.ko = 0; return true; } return false; }
};
struct OrderKr6 {
    int bid;
    __device__ bool next(int i, Unit& u) const { if (i >= 1 || bid >= 48) return false; u.pm = 60 + (bid >> 3); u.pn = 0; u.ko = (bid & 7) * 512; return true; }
};
struct OrderCtx {
    int bid;
    __device__ bool next(int i, Unit& u) const { if (i >= 1) return false; u.pm = 32 + 33 * (bid >> 7); u.pn = (bid >> 3) & 15; u.ko = (bid & 7) * 512; return true; }
};
template <class Epi, class Sched>
__device__ __forceinline__ void gemm_phase(LAS unsigned char* lds, const Gemm g, const Sched& S, const Epi& E) {
    const int tid = threadIdx.x, wid = __builtin_amdgcn_readfirstlane(tid >> 6), lane = tid & 63, wr = wid >> 2, wc = wid & 3, fr = lane & 15, fq = lane >> 4;
    const int K = g.K, nt = K / BK;
    unsigned voffA[2], voffB[2];
#pragma unroll
    for (int i = 0; i < 2; ++i) { int R, C; stage_rc(tid * 16 + i * 8192, R, C); const int Rb = Epi::PERM ? ((R & ~31) + perm32(R & 31)) : R;
        voffA[i] = (unsigned)(R * g.lda + C) * 2u; voffB[i] = (unsigned)(Rb * g.ldb + C) * 2u; }
    const size_t kstep = (size_t)(BK * 2);
    const size_t hstepA = (size_t)HALF * g.lda * 2, hstepB = (size_t)HALF * g.ldb * 2;
    const size_t tstepA = 2 * hstepA, tstepB = 2 * hstepB;
    const unsigned ldsw = (unsigned)wid * 1024u;
    const int aoff = lds_byte(wr * 64 + fr, fq * 8), boff = lds_byte(wc * 32 + fr, fq * 8);
#define PG8_SA(b, h) (((b) * 2 + (h)) * HTB)
#define PG8_SB(b, h) ((4 + (b) * 2 + (h)) * HTB)
#define PG8_STAGE(bufoff, gbase, voff) do { _Pragma("unroll") for (int _i = 0; _i < 2; ++_i) \
        __builtin_amdgcn_global_load_lds((const unsigned*)((const char*)(gbase) + (voff)[_i]), (LAS unsigned*)(lds + (bufoff) + ldsw + _i * 8192), 16, 0, 0); } while (0)
#define PG8_LDA(dst, b, h) do { _Pragma("unroll") for (int m = 0; m < 4; ++m) _Pragma("unroll") for (int k = 0; k < 2; ++k) dst[m][k] = *(const LAS bf16x8*)(lds + PG8_SA(b, h) + aoff + m * 2048 + k * 1024); } while (0)
#define PG8_LDB(dst, b, h) do { _Pragma("unroll") for (int n = 0; n < 2; ++n) _Pragma("unroll") for (int k = 0; k < 2; ++k) dst[n][k] = *(const LAS bf16x8*)(lds + PG8_SB(b, h) + boff + n * 2048 + k * 1024); } while (0)
#define PG8_MMA(ai, bj, At, Bt) do { __builtin_amdgcn_s_setprio(1); _Pragma("unroll") for (int m = 0; m < 4; ++m) _Pragma("unroll") for (int n = 0; n < 2; ++n) _Pragma("unroll") for (int k = 0; k < 2; ++k) \
        acc[ai][bj][m][n] = __builtin_amdgcn_mfma_f32_16x16x32_bf16(Bt[n][k], At[m][k], acc[ai][bj][m][n], 0, 0, 0); __builtin_amdgcn_s_setprio(0); } while (0)
#define PG8_WAIT_V(n) asm volatile("s_waitcnt vmcnt(" #n ")" ::: "memory")
#define PG8_WAIT_L(n) asm volatile("s_waitcnt lgkmcnt(" #n ")" ::: "memory")
#define PG8_BAR __builtin_amdgcn_s_barrier()
#define PG8_SCHED __builtin_amdgcn_sched_barrier(0)
    Unit cur, nxt; int ui = 0;
    if (!S.next(0, cur)) return;
    f32x4 acc[2][2][4][2];
#pragma unroll
    for (int a = 0; a < 2; ++a)
#pragma unroll
        for (int b = 0; b < 2; ++b)
#pragma unroll
            for (int m = 0; m < 4; ++m)
#pragma unroll
                for (int n = 0; n < 2; ++n) acc[a][b][m][n] = (f32x4){0.f, 0.f, 0.f, 0.f};
    bf16x8 At[4][2], B0[2][2], B1[2][2];
    const char* cA = (const char*)g.A + (size_t)cur.pm * tstepA + (size_t)cur.ko * 2; const char* cB = (const char*)g.Bt + (size_t)cur.pn * tstepB + (size_t)cur.ko * 2;
    PG8_STAGE(PG8_SB(0, 0), cB, voffB); PG8_STAGE(PG8_SB(0, 1), cB + hstepB, voffB); PG8_STAGE(PG8_SA(0, 0), cA, voffA); PG8_STAGE(PG8_SA(0, 1), cA + hstepA, voffA);
    if (wr == 1) PG8_BAR;
    PG8_WAIT_V(2); PG8_BAR;
    PG8_STAGE(PG8_SB(1, 0), cB + kstep, voffB); PG8_STAGE(PG8_SA(1, 0), cA + kstep, voffA); PG8_STAGE(PG8_SB(1, 1), cB + hstepB + kstep, voffB);
    PG8_WAIT_V(6); PG8_BAR;
    for (;;) {
        const bool has_next = S.next(ui + 1, nxt);
        const char* nA = has_next ? (const char*)g.A + (size_t)nxt.pm * tstepA + (size_t)nxt.ko * 2 : cA; const char* nB = has_next ? (const char*)g.Bt + (size_t)nxt.pn * tstepB + (size_t)nxt.ko * 2 : cB;
        for (int t = 0; t < nt; t += 2) {
            const bool last = (t == nt - 2);
            const char* a1 = cA + (size_t)(t + 1) * kstep;
            const char* a2 = last ? nA : cA + (size_t)(t + 2) * kstep; const char* b2 = last ? nB : cB + (size_t)(t + 2) * kstep;
            const char* a3 = a2 + kstep; const char* b3 = b2 + kstep;
            PG8_LDB(B0, 0, 0); PG8_LDB(B1, 0, 1); PG8_SCHED; PG8_LDA(At, 0, 0); PG8_STAGE(PG8_SA(1, 1), a1 + hstepA, voffA);
            PG8_WAIT_V(8); PG8_WAIT_L(0); PG8_BAR; PG8_MMA(0, 0, At, B0); PG8_MMA(0, 1, At, B1); PG8_BAR; PG8_SCHED;
            PG8_LDA(At, 0, 1); PG8_STAGE(PG8_SB(0, 0), b2, voffB); PG8_STAGE(PG8_SB(0, 1), b2 + hstepB, voffB); PG8_STAGE(PG8_SA(0, 0), a2, voffA);
            PG8_WAIT_V(8); PG8_WAIT_L(0); PG8_BAR; PG8_MMA(1, 0, At, B0); PG8_MMA(1, 1, At, B1); PG8_BAR; PG8_SCHED;
            PG8_LDB(B0, 1, 0); PG8_LDB(B1, 1, 1); PG8_SCHED; PG8_LDA(At, 1, 0); PG8_STAGE(PG8_SA(0, 1), a2 + hstepA, voffA);
            PG8_WAIT_V(8); PG8_WAIT_L(0); PG8_BAR; PG8_MMA(0, 0, At, B0); PG8_MMA(0, 1, At, B1); PG8_BAR; PG8_SCHED;
            PG8_LDA(At, 1, 1); PG8_STAGE(PG8_SB(1, 0), b3, voffB); PG8_STAGE(PG8_SB(1, 1), b3 + hstepB, voffB); PG8_STAGE(PG8_SA(1, 0), a3, voffA);
            PG8_WAIT_V(8); PG8_WAIT_L(0); PG8_BAR; PG8_MMA(1, 0, At, B0); PG8_MMA(1, 1, At, B1); PG8_BAR; PG8_SCHED;
        }
        if (wr == 0) PG8_BAR;
        E(acc, cur, wr, wc, fr, fq);
        if (!has_next) break;
#pragma unroll
        for (int a = 0; a < 2; ++a)
#pragma unroll
            for (int b = 0; b < 2; ++b)
#pragma unroll
                for (int m = 0; m < 4; ++m)
#pragma unroll
                    for (int n = 0; n < 2; ++n) acc[a][b][m][n] = (f32x4){0.f, 0.f, 0.f, 0.f};
        cur = nxt; cA = nA; cB = nB; ++ui;
        if (wr == 1) PG8_BAR;
    }
    PG8_WAIT_V(0);
    PG8_BAR;
#undef PG8_SA
#undef PG8_SB
#undef PG8_STAGE
#undef PG8_LDA
#undef PG8_LDB
#undef PG8_MMA
#undef PG8_WAIT_V
#undef PG8_WAIT_L
#undef PG8_BAR
#undef PG8_SCHED
}
}
namespace fk {
constexpr size_t MiB = 1u << 20;
constexpr size_t WS_CTL = 0;
constexpr size_t WS_MOD = 1 * MiB;
constexpr size_t WS_ROPEA = 2 * MiB;
constexpr size_t WS_ROPEB = 2 * MiB + 64 * 1024;
constexpr size_t WS_CS = 2 * MiB + 128 * 1024;
constexpr size_t WS_SSQ = 3 * MiB;
constexpr size_t WS_KR = 4 * MiB;
constexpr size_t WS_GD = 7 * MiB;
constexpr size_t WS_GAM = 1391 * MiB;
constexpr size_t WS_AT = 14 * MiB;
constexpr size_t WS_W1T = 40 * MiB;
constexpr size_t WS_WUQ = 110 * MiB;
constexpr size_t WS_WUKV = 116 * MiB;
constexpr size_t WS_WO = 120 * MiB;
constexpr size_t WS_W4T = 152 * MiB;
constexpr size_t WS_WO2 = 242 * MiB;
constexpr size_t WS_DM = 274 * MiB;
constexpr size_t WS_H = 402 * MiB;
constexpr size_t WS_L = 534 * MiB;
constexpr size_t WS_A1 = WS_L;
constexpr size_t WS_CQKV = WS_L + 99 * MiB;
constexpr size_t WS_G0 = WS_L + 149 * MiB;
constexpr size_t WS_QB = WS_L + 281 * MiB;
constexpr size_t WS_KVB = WS_L + 380 * MiB;
constexpr size_t WS_Y0 = WS_L + 512 * MiB;
constexpr size_t WS_QK1 = WS_L;
constexpr size_t WS_V1 = WS_L + 99 * MiB;
constexpr size_t WS_U1 = WS_L + 198 * MiB;
constexpr size_t WS_G1 = WS_L + 231 * MiB;
constexpr size_t WS_QT = WS_L + 363 * MiB;
constexpr size_t WS_KT = WS_L + 462 * MiB;
constexpr size_t WS_VT = WS_L + 561 * MiB;
constexpr size_t WS_AB = WS_L + 660 * MiB;
constexpr size_t WS_VTF = WS_L + 726 * MiB;
constexpr size_t WS_O00 = WS_QK1, WS_O01 = WS_V1;
constexpr size_t WS_O10 = WS_L + 758 * MiB, WS_O11 = WS_H;
constexpr size_t WS_BF = 1398 * MiB;
constexpr size_t WS_PCS = WS_VTF;
constexpr size_t WS_F4096 = WS_SSQ;
constexpr size_t WS_Y1 = WS_QT;
constexpr size_t WS_LEND = WS_L + 758 * MiB;
constexpr size_t WS_PART = WS_L + 660 * MiB;
constexpr size_t WS_X1C = 1448 * MiB;
constexpr size_t WS_TOTAL = 1456 * MiB;
static_assert(WS_O10 + 99 * MiB <= WS_GAM && WS_GAM + 7 * MiB <= WS_BF && WS_BF + 34 * MiB <= WS_X1C && WS_QT + 132 * MiB <= WS_VT, "ws map");
constexpr int CW_BAR = 4096;

constexpr int LDS_STAGE = 0;
constexpr int LDS_X = 151552;
constexpr int LDS_MISC = 159744;
constexpr int LDS_BYTES = 160256;

struct Args { const float* in[23]; float* out; unsigned char* ws; int ph_lo, ph_hi, var, pad; };

struct Frame { LAS unsigned char* lds; int tid, lane, wave, G, bid; };

__device__ __forceinline__ int map_w1(int n) {
    if (n < 2560) { const int h = n >> 7, p = n & 127; return h * 128 + (p >> 1) + 64 * (p & 1); }
    if (n < 4608) return n;
    if (n < 8704) return 4672 + (n - 4608);
    if (n < 8768) { const int p = n - 8704; return 4608 + (p >> 1) + 32 * (p & 1); }
    return -1;
}
__device__ __forceinline__ int map_uq(int n) { const int h = n / 192, w = n % 192; if (w < 128) return n; const int p = w - 128; return h * 192 + 128 + (p >> 1) + 32 * (p & 1); }
__device__ __forceinline__ int map_w4(int n) {
    if (n < 6144) return n;
    if (n < 7168) return 6176 + (n - 6144);
    if (n < 11264) return 7200 + (n - 7168);
    if (n < 11296) return 6144 + (n - 11264);
    return -1;
}
__device__ __forceinline__ void tr_item(const float* W, int K, int Nsrc, bf16_t* WT, LAS float* scr, int k0, int n0, int lane, int srccol, const float* kscale, float cscale) {
#pragma unroll
    for (int i = 0; i < 32; ++i) { const int kk = 2 * i + (lane >> 5); float v = srccol >= 0 ? W[(size_t)(k0 + kk) * Nsrc + srccol] : 0.f;
        v *= kscale ? cscale * kscale[k0 + kk] : cscale; scr[kk * 33 + (lane & 31)] = v; }
    LDS_WAIT(); asm volatile("" ::: "memory");
    const int c = lane & 7;
#pragma unroll
    for (int j = 0; j < 4; ++j) { const int n = (lane >> 3) + 8 * j; const LAS float* s = scr + (8 * c) * 33 + n;
        u32x4 o; o.x = cvt_pk_bf16(s[0 * 33], s[1 * 33]); o.y = cvt_pk_bf16(s[2 * 33], s[3 * 33]); o.z = cvt_pk_bf16(s[4 * 33], s[5 * 33]); o.w = cvt_pk_bf16(s[6 * 33], s[7 * 33]);
        *(u32x4*)(WT + (size_t)(n0 + n) * K + k0 + 8 * c) = o; }
    LDS_WAIT(); asm volatile("" ::: "memory");
}
__device__ __forceinline__ void mod_gemv(const Frame& F, const Args& a, int l0, int nl, int wg0, int nwg) {
    if (F.bid < wg0) return;
    LAS float* sc = (LAS float*)(F.lds + 72 * 1024);
    LAS float* red = (LAS float*)(F.lds + 120 * 1024);
    __syncthreads();
    for (int i = F.tid; i < 3 * D; i += NTHR) { const float v = i < 2 * D ? a.in[1][i] : a.in[3][i - 2 * D]; sc[i] = v / (1.f + expf(-v)); }
    __syncthreads();
    float* mod = (float*)(a.ws + WS_MOD);
    const int rsub = F.lane >> 3, c4 = (F.lane & 7) * 4;
    for (int u = F.bid - wg0; u < 384 * nl; u += nwg) {
        const int l = l0 + u / 384, n0 = (u % 384) * 32;
        const float* W = a.in[5] + (size_t)l * D * 12288 + n0 + c4;
        f32x4 a0 = {0.f, 0.f, 0.f, 0.f}, a1 = a0, a2 = a0;
        const int kb = F.wave * 512 + rsub;
#pragma unroll 8
        for (int k = kb; k < kb + 512; k += 8) { const f32x4 w = *(const f32x4*)(W + (size_t)k * 12288); a0 += w * sc[k]; a1 += w * sc[D + k]; a2 += w * sc[2 * D + k]; }
#pragma unroll
        for (int o = 8; o < 64; o <<= 1) {
#pragma unroll
            for (int i = 0; i < 4; ++i) { a0[i] += __shfl_xor(a0[i], o); a1[i] += __shfl_xor(a1[i], o); a2[i] += __shfl_xor(a2[i], o); } }
        if (F.lane < 8) { *(LAS f32x4*)(red + (F.wave * 3 + 0) * 32 + c4) = a0; *(LAS f32x4*)(red + (F.wave * 3 + 1) * 32 + c4) = a1; *(LAS f32x4*)(red + (F.wave * 3 + 2) * 32 + c4) = a2; }
        __syncthreads();
        if (F.tid < 96) { const int r = F.tid >> 5, cl = F.tid & 31; float sm = 0.f;
#pragma unroll
            for (int w = 0; w < 8; ++w) sm += red[(w * 3 + r) * 32 + cl];
            mod[(l * 3 + r) * 12288 + n0 + cl] = sm + a.in[6][l * 12288 + n0 + cl]; }
        __syncthreads();
    }
}
__device__ __forceinline__ void p0_prologue(const Frame& F, const Args& a) {
    unsigned char* ws = a.ws;
    mod_gemv(F, a, 0, 2, 0, F.G);
    __syncthreads();
    {
        LAS float* scr = (LAS float*)(F.lds + F.wave * 8448);
        const int gw = F.bid * NWAVES + F.wave, NGW = F.G * NWAVES;
        constexpr int I0 = 64 * 280, I1 = 16 * 96, I2 = 8 * 128;
        constexpr int NIT = I0 + I1 + I2;
        for (int it = gw; it < NIT; it += NGW) {
            int r = it; const int cl = F.lane & 31;
            if (r < I0) { const int nb = r % 280, kb = r / 280; tr_item(a.in[7], 4096, 8768, (bf16_t*)(ws + WS_W1T), scr, kb * 64, nb * 32, F.lane, map_w1(nb * 32 + cl), nullptr, 1.f); continue; } r -= I0;
            if (r < I1) { const int nb = r % 96, kb = r / 96; tr_item(a.in[12], 1024, 3072, (bf16_t*)(ws + WS_WUQ), scr, kb * 64, nb * 32, F.lane, map_uq(nb * 32 + cl), a.in[10], 1.f); continue; } r -= I1;
            { const int nb = r % 128, kb = r / 128; tr_item(a.in[13], 512, 4096, (bf16_t*)(ws + WS_WUKV), scr, kb * 64, nb * 32, F.lane, nb * 32 + cl, a.in[11], 1.f); }
        }
    }
    {
        const int gt = F.bid * NTHR + F.tid, NGT = F.G * NTHR;
        f32x2* ra = (f32x2*)(ws + WS_ROPEA); f32x2* rb = (f32x2*)(ws + WS_ROPEB); bf16_t* cs = (bf16_t*)(ws + WS_CS);
        for (int i = gt; i < 128 * 32; i += NGT) { const int pos = i >> 5, fi = i & 31; const float ang = (float)pos * powf(10000.f, -(float)fi / 32.f); ra[i] = (f32x2){cosf(ang), sinf(ang)}; }
        for (int i = gt; i < 128 * 16; i += NGT) { const int pos = i >> 4, fi = i & 15; const float ang = (float)pos * powf(10000.f, -(float)fi / 16.f); rb[i] = (f32x2){cosf(ang), sinf(ang)}; }
        for (int i = gt; i < 512 * 256; i += NGT) { const int m = i >> 8, c = i & 255, l = m & 255; const float x = (float)((l * c) & 255) * (2.f / 256.f);
            const float v = (m < 256) ? cospif(x) : sinpif(x); cs[i] = (bf16_t)(cvt_pk_bf16(v, 0.f) & 0xffffu); }
    }
}
__device__ __forceinline__ void late_convert(const Frame& F, const Args& a, int w0, int nw, int which) {
    const int gw = F.bid * NWAVES + F.wave - w0; if (gw < 0) return;
    LAS float* scr = (LAS float*)(F.lds + F.wave * 8448);
    constexpr int I3 = 64 * 128, I4 = 64 * 360;
    if (which == 0) { for (int it = gw; it < I3; it += nw) { const int nb = it % 128, kb = it / 128; tr_item(a.in[14], 4096, 4096, (bf16_t*)(a.ws + WS_WO), scr, kb * 64, nb * 32, F.lane, nb * 32 + (F.lane & 31), nullptr, 1.f); } }
    else { for (int it = gw; it < I4; it += nw) { const int nb = it % 360, kb = it / 360; tr_item(a.in[15], 4096, 11296, (bf16_t*)(a.ws + WS_W4T), scr, kb * 64, nb * 32, F.lane, map_w4(nb * 32 + (F.lane & 31)), nullptr, nb * 32 < 1536 ? 0.0625f : 1.f); } }
}
__device__ __forceinline__ void wo2_convert(const Frame& F, const Args& a, int w0, int nw) {
    __syncthreads();
    LAS float* scr = (LAS float*)(F.lds + F.wave * 8448);
    const int gw = F.bid * NWAVES + F.wave - w0;
    for (int it = gw; it < 64 * 128; it += nw) { const int nb = it % 128, kb = it / 128; tr_item(a.in[21], 4096, 4096, (bf16_t*)(a.ws + WS_WO2), scr, kb * 64, nb * 32, F.lane, nb * 32 + (F.lane & 31), nullptr, 1.f); }
}
constexpr int FKP = 4224;
__device__ __forceinline__ void dm_gen(const Frame& F, bf16_t* dm, int w0, int nw) {
    for (int r = w0; r < 8192; r += nw) { const int half = r >> 12, k = r & 4095;
        for (int q = F.tid; q < FKP / 8; q += NTHR) { float v[8];
#pragma unroll
            for (int j = 0; j < 8; ++j) { const int kk = q * 8 + j; const float x = (float)((k * kk) & 8191) * (1.f / 8192.f);
                v[j] = half == 0 ? (kk <= 4096 ? __builtin_amdgcn_cosf(x) : 0.f) : ((kk >= 1 && kk <= 4095) ? __builtin_amdgcn_sinf(x) : 0.f); }
            u32x4 o; o.x = cvt_pk_bf16(v[0], v[1]); o.y = cvt_pk_bf16(v[2], v[3]); o.z = cvt_pk_bf16(v[4], v[5]); o.w = cvt_pk_bf16(v[6], v[7]);
            *(u32x4*)(dm + (size_t)r * FKP + q * 8) = o; }
    }
}
__device__ __forceinline__ void hnorm_phase(const Frame& F, const float* xlat, const float* xctx, const float* g, const float* modl, bf16_t* H) {
    LAS f32x4* MA = (LAS f32x4*)F.lds;
    __syncthreads();
    for (int i = F.tid; i < 3 * 1024; i += NTHR) { const int r = i >> 10, n4 = i & 1023;
        const f32x4 gg = *((const f32x4*)g + n4), scl = *((const f32x4*)(modl + (size_t)r * 12288 + D) + n4), sh = *((const f32x4*)(modl + (size_t)r * 12288) + n4);
        MA[(r * 2 + 0) * 1024 + n4] = gg * (scl + 1.f); MA[(r * 2 + 1) * 1024 + n4] = sh; }
    __syncthreads();
    const int base = F.bid * (M / 256);
    for (int i0 = F.wave; i0 < M / 256; i0 += 16) {
        const int rot = (F.bid * 5) % (M / 256);
        const bool hasB = (i0 + 8) < M / 256;
        const int mA = base + (i0 + rot) % (M / 256), mB = base + (i0 + 8 + rot) % (M / 256);
        const int bA = mA / SB, rA = mA % SB, bB = hasB ? mB / SB : bA, rB = hasB ? mB % SB : rA;
        const float* srcA = rA < S ? xlat + ((size_t)bA * S + rA) * D : xctx + ((size_t)bA * CTX + (rA - S)) * D;
        const float* srcB = rB < S ? xlat + ((size_t)bB * S + rB) * D : xctx + ((size_t)bB * CTX + (rB - S)) * D;
        const LAS f32x4* mA_ = MA + (rA < S ? bA : 2) * 2048 + F.lane; const LAS f32x4* mB_ = MA + (rB < S ? bB : 2) * 2048 + F.lane;
        const f32x4* xa = (const f32x4*)srcA + F.lane; const f32x4* xb = (const f32x4*)srcB + F.lane;
        f32x4 va[16], vb[16]; float sa = 0.f, sb = 0.f;
#pragma unroll
        for (int j = 0; j < 16; ++j) va[j] = __builtin_nontemporal_load(xa + 64 * j);
#pragma unroll
        for (int j = 0; j < 16; ++j) vb[j] = __builtin_nontemporal_load(xb + 64 * j);
#pragma unroll
        for (int j = 0; j < 16; ++j) sa += (va[j].x * va[j].x + va[j].y * va[j].y) + (va[j].z * va[j].z + va[j].w * va[j].w);
#pragma unroll
        for (int j = 0; j < 16; ++j) sb += (vb[j].x * vb[j].x + vb[j].y * vb[j].y) + (vb[j].z * vb[j].z + vb[j].w * vb[j].w);
        const float rsa = 1.0f / sqrtf(wave_sum(sa) * (1.f / D) + EPS), rsb = 1.0f / sqrtf(wave_sum(sb) * (1.f / D) + EPS);
        u32x2* oa = (u32x2*)(H + (size_t)mA * D) + F.lane; u32x2* ob = (u32x2*)(H + (size_t)(hasB ? mB : mA) * D) + F.lane;
#pragma unroll
        for (int j = 0; j < 16; ++j) {
            { const f32x4 h = va[j] * rsa * mA_[64 * j] + mA_[1024 + 64 * j]; u32x2 w; w.x = cvt_pk_bf16(h.x, h.y); w.y = cvt_pk_bf16(h.z, h.w); oa[64 * j] = w; }
            if (hasB) { const f32x4 h = vb[j] * rsb * mB_[64 * j] + mB_[1024 + 64 * j]; u32x2 w; w.x = cvt_pk_bf16(h.x, h.y); w.y = cvt_pk_bf16(h.z, h.w); ob[64 * j] = w; } }
    }
    __syncthreads();
}
__device__ __forceinline__ u32x4 pack8(const f32x4 a, const f32x4 b) { u32x4 w; w.x = cvt_pk_bf16(a[0], a[1]); w.y = cvt_pk_bf16(a[2], a[3]); w.z = cvt_pk_bf16(b[0], b[1]); w.w = cvt_pk_bf16(b[2], b[3]); return w; }
__device__ __forceinline__ f32x4 rope2(const f32x4 v, const f32x4 cs) {
    return (f32x4){v[0] * cs[0] - v[1] * cs[1], v[0] * cs[1] + v[1] * cs[0], v[2] * cs[2] - v[3] * cs[3], v[2] * cs[3] + v[3] * cs[2]};
}
struct EpiL0 {
    static constexpr bool PERM = true;
    bf16_t* A1; bf16_t* CQKV; bf16_t* G0; bf16_t* KRb; float* SSQ; const float* qn_g; const float* kn_g; const float* ropeA; const float* ropeB; LAS float* X;
    __device__ __forceinline__ void operator()(const f32x4 (&acc)[2][2][4][2], const Unit& u, int wr, int wc, int fr, int fq) const {
        const int pn = u.pn, pb = u.pm % PPB; const bool lat = pb < 32;
        const int rowl0 = wr * 64 + fr; const size_t row0 = (size_t)u.pm * 256 + rowl0; const int cl = wc * 32 + 8 * fq;
        if (pn < 10) {
            const float* g = pn < 8 ? qn_g : kn_g; f32x4 gv[2];
#pragma unroll
            for (int n = 0; n < 2; ++n)
#pragma unroll
                for (int i = 0; i < 4; ++i) { const int p = cl + 4 * n + i; gv[n][i] = g[(p >> 1) + 64 * (p & 1)]; }
#pragma unroll
            for (int ai = 0; ai < 2; ++ai)
#pragma unroll
                for (int m = 0; m < 4; ++m)
#pragma unroll
                    for (int bj = 0; bj < 2; ++bj) { const f32x4 x0 = acc[ai][bj][m][0], x1 = acc[ai][bj][m][1];
                        float s = (x0[0] * x0[0] + x0[1] * x0[1]) + (x0[2] * x0[2] + x0[3] * x0[3]) + (x1[0] * x1[0] + x1[1] * x1[1]) + (x1[2] * x1[2] + x1[3] * x1[3]);
                        s += __shfl_xor(s, 16); s += __shfl_xor(s, 32);
                        if (fq == 0) X[((ai * 128 + rowl0 + 16 * m) * 2 + bj) * 4 + wc] = s; }
            LDS_WAIT(); __builtin_amdgcn_s_barrier(); asm volatile("" ::: "memory");
#pragma unroll
            for (int ai = 0; ai < 2; ++ai)
#pragma unroll
                for (int m = 0; m < 4; ++m) { const int rowl = ai * 128 + rowl0 + 16 * m; const int grow = 4 * pb + 2 * ai + wr, gcol = 16 * m + fr;
                    const int pos = wc < 2 ? grow : gcol;
#pragma unroll
                    for (int bj = 0; bj < 2; ++bj) { const f32x4 p4 = *(const LAS f32x4*)&X[(rowl * 2 + bj) * 4];
                        const float rs = 1.0f / sqrtf(((p4[0] + p4[1]) + (p4[2] + p4[3])) * (1.f / 128.f) + EPS);
                        f32x4 v0 = acc[ai][bj][m][0] * rs * gv[0], v1 = acc[ai][bj][m][1] * rs * gv[1];
                        if (lat) { const int fi = (16 * wc + 4 * fq) & 31; const f32x4 c0 = *(const f32x4*)(ropeA + (pos * 32 + fi) * 2), c1 = *(const f32x4*)(ropeA + (pos * 32 + fi + 2) * 2);
                            v0 = rope2(v0, c0); v1 = rope2(v1, c1); }
                        *(u32x4*)(A1 + (row0 + ai * 128 + 16 * m) * 3072 + pn * 256 + bj * 128 + cl) = pack8(v0, v1); } }
        } else if (pn < 12) {
#pragma unroll
            for (int ai = 0; ai < 2; ++ai)
#pragma unroll
                for (int m = 0; m < 4; ++m)
#pragma unroll
                    for (int bj = 0; bj < 2; ++bj) *(u32x4*)(A1 + (row0 + ai * 128 + 16 * m) * 3072 + pn * 256 + bj * 128 + cl) = pack8(acc[ai][bj][m][0], acc[ai][bj][m][1]);
        } else if (pn < 18) {
#pragma unroll
            for (int ai = 0; ai < 2; ++ai)
#pragma unroll
                for (int m = 0; m < 4; ++m) { float s = 0.f;
#pragma unroll
                    for (int bj = 0; bj < 2; ++bj) { const f32x4 x0 = acc[ai][bj][m][0], x1 = acc[ai][bj][m][1];
                        s += (x0[0] * x0[0] + x0[1] * x0[1]) + (x0[2] * x0[2] + x0[3] * x0[3]) + (x1[0] * x1[0] + x1[1] * x1[1]) + (x1[2] * x1[2] + x1[3] * x1[3]);
                        *(u32x4*)(CQKV + (row0 + ai * 128 + 16 * m) * 1536 + (pn - 12) * 256 + bj * 128 + cl) = pack8(x0, x1); }
                    s += __shfl_xor(s, 16); s += __shfl_xor(s, 32);
                    if (fq == 0) X[(ai * 128 + rowl0 + 16 * m) * 4 + wc] = s; }
            LDS_WAIT(); __builtin_amdgcn_s_barrier(); asm volatile("" ::: "memory");
            if (wc == 0 && fq == 0) {
#pragma unroll
                for (int ai = 0; ai < 2; ++ai)
#pragma unroll
                    for (int m = 0; m < 4; ++m) { const f32x4 p4 = *(const LAS f32x4*)&X[(ai * 128 + rowl0 + 16 * m) * 4];
                        SSQ[(row0 + ai * 128 + 16 * m) * 8 + (pn - 12)] = (p4[0] + p4[1]) + (p4[2] + p4[3]); } }
        } else if (pn < 34) {
#pragma unroll
            for (int ai = 0; ai < 2; ++ai)
#pragma unroll
                for (int m = 0; m < 4; ++m)
#pragma unroll
                    for (int bj = 0; bj < 2; ++bj) { f32x4 x0 = acc[ai][bj][m][0], x1 = acc[ai][bj][m][1];
#pragma unroll
                        for (int i = 0; i < 4; ++i) { x0[i] = fast_silu(x0[i]); x1[i] = fast_silu(x1[i]); }
                        *(u32x4*)(G0 + (row0 + ai * 128 + 16 * m) * 4096 + (pn - 18) * 256 + bj * 128 + cl) = pack8(x0, x1); }
        } else {
            if (wc < 2) {
#pragma unroll
                for (int ai = 0; ai < 2; ++ai)
#pragma unroll
                    for (int m = 0; m < 4; ++m) { const int grow = 4 * pb + 2 * ai + wr, gcol = 16 * m + fr; const int pos = wc < 1 ? grow : gcol;
                        f32x4 v0 = acc[ai][0][m][0], v1 = acc[ai][0][m][1];
                        if (lat) { const int fi = (4 * fq) & 15; const f32x4 c0 = *(const f32x4*)(ropeB + (pos * 16 + fi) * 2), c1 = *(const f32x4*)(ropeB + (pos * 16 + fi + 2) * 2);
                            v0 = rope2(v0, c0); v1 = rope2(v1, c1); }
                        *(u32x4*)(KRb + (row0 + ai * 128 + 16 * m) * 64 + cl) = pack8(v0, v1); } }
        }
    }
};
template <int UPM> struct EpiUp {
    static constexpr bool PERM = true;
    bf16_t* O; int ld; const float* SSQ; const float* ropeB;
    __device__ __forceinline__ void operator()(const f32x4 (&acc)[2][2][4][2], const Unit& u, int wr, int wc, int fr, int fq) const {
        const int pb = u.pm % PPB; const bool lat = pb < 32;
        const int rowl0 = wr * 64 + fr; const size_t row0 = (size_t)u.pm * 256 + rowl0;
#pragma unroll
        for (int ai = 0; ai < 2; ++ai)
#pragma unroll
            for (int m = 0; m < 4; ++m) { const size_t row = row0 + ai * 128 + 16 * m; float rs;
                if (UPM == 0) { const f32x4 p4 = *(const f32x4*)(SSQ + row * 8); rs = 1.0f / sqrtf(((p4[0] + p4[1]) + (p4[2] + p4[3])) * (1.f / 1024.f) + EPS); }
                else { const f32x2 p2 = *(const f32x2*)(SSQ + row * 8 + 4); rs = 1.0f / sqrtf((p2[0] + p2[1]) * (1.f / 512.f) + EPS); }
                const int grow = 4 * pb + 2 * ai + wr, gcol = 16 * m + fr;
#pragma unroll
                for (int bj = 0; bj < 2; ++bj) { const int c0 = u.pn * 256 + bj * 128 + wc * 32 + 8 * fq;
                    f32x4 v0 = acc[ai][bj][m][0] * rs, v1 = acc[ai][bj][m][1] * rs;
                    if (UPM == 0) { const int w = c0 % 192;
                        if (lat && w >= 128) { const int p = w - 128; const int pos = p < 32 ? grow : gcol; const int fi = (p >> 1) & 15;
                            const f32x4 c0v = *(const f32x4*)(ropeB + (pos * 16 + fi) * 2), c1v = *(const f32x4*)(ropeB + (pos * 16 + fi + 2) * 2);
                            v0 = rope2(v0, c0v); v1 = rope2(v1, c1v); } }
                    *(u32x4*)(O + row * ld + c0) = pack8(v0, v1); } }
    }
};
struct EpiPartKr {
    static constexpr bool PERM = true;
    float* P;
    __device__ __forceinline__ void operator()(const f32x4 (&acc)[2][2][4][2], const Unit& u, int wr, int wc, int fr, int fq) const {
        if (wc >= 2) return;
        float* base = P + ((size_t)(u.ko >> 9) * M + (size_t)u.pm * 256 + wr * 64 + fr) * 64 + wc * 32 + 8 * fq;
#pragma unroll
        for (int ai = 0; ai < 2; ++ai)
#pragma unroll
            for (int m = 0; m < 4; ++m) { float* p = base + (size_t)(ai * 128 + 16 * m) * 64; *(f32x4*)p = acc[ai][0][m][0]; *(f32x4*)(p + 4) = acc[ai][0][m][1]; }
    }
};
struct EpiPartCtx {
    static constexpr bool PERM = false;
    float* P;
    __device__ __forceinline__ void operator()(const f32x4 (&acc)[2][2][4][2], const Unit& u, int wr, int wc, int fr, int fq) const {
        float* base = P + ((size_t)(u.ko >> 9) * 512 + (size_t)(u.pm / PPB) * 256 + wr * 64 + fr) * D + u.pn * 256 + wc * 32 + 4 * fq;
#pragma unroll
        for (int ai = 0; ai < 2; ++ai)
#pragma unroll
            for (int m = 0; m < 4; ++m)
#pragma unroll
                for (int bj = 0; bj < 2; ++bj)
#pragma unroll
                    for (int n = 0; n < 2; ++n) *(f32x4*)(base + (size_t)(ai * 128 + 16 * m) * D + bj * 128 + n * 16) = acc[ai][bj][m][n];
    }
};
__device__ __forceinline__ void kr_finalize(const Frame& F, const float* P, const float* ropeB, bf16_t* KRb, int m0, int nrows) {
    for (int it = F.bid * NTHR + F.tid; it < nrows * 8; it += F.G * NTHR) {
        const int m = m0 + (it >> 3), c8 = it & 7; f32x4 v0 = {0.f, 0.f, 0.f, 0.f}, v1 = v0;
#pragma unroll
        for (int ks = 0; ks < 8; ++ks) { const float* p = P + ((size_t)ks * M + m) * 64 + c8 * 8; v0 += *(const f32x4*)p; v1 += *(const f32x4*)(p + 4); }
        const int r = m % SB;
        if (r < S) { const int pos = c8 < 4 ? (r >> 6) : (r & 63), fi = (4 * c8) & 15;
            v0 = rope2(v0, *(const f32x4*)(ropeB + (pos * 16 + fi) * 2)); v1 = rope2(v1, *(const f32x4*)(ropeB + (pos * 16 + fi + 2) * 2)); }
        *(u32x4*)(KRb + (size_t)m * 64 + c8 * 8) = pack8(v0, v1);
    }
}
struct EpiRes {
    static constexpr bool PERM = false;
    const float* xlat; const float* xctx; const float* modl; float* olat; float* octx;
    __device__ __forceinline__ void operator()(const f32x4 (&acc)[2][2][4][2], const Unit& u, int wr, int wc, int fr, int fq) const {
        const int b = u.pm / PPB, pb = u.pm % PPB; const bool lat = pb < 32;
        const size_t r0 = lat ? ((size_t)b * S + 256 * pb) : ((size_t)b * CTX);
        const float* src = (lat ? xlat : xctx) + r0 * D; float* dst = (lat ? olat : octx) + r0 * D;
        const float* gt = modl + (size_t)(lat ? b : 2) * 12288 + 2 * D;
        const int rowl0 = wr * 64 + fr, col0 = u.pn * 256 + wc * 32 + 4 * fq;
        f32x4 gv[2][2];
#pragma unroll
        for (int bj = 0; bj < 2; ++bj)
#pragma unroll
            for (int n = 0; n < 2; ++n) gv[bj][n] = *(const f32x4*)(gt + col0 + bj * 128 + n * 16);
#pragma unroll
        for (int ai = 0; ai < 2; ++ai)
#pragma unroll
            for (int m = 0; m < 4; ++m) { const size_t off = (size_t)(ai * 128 + rowl0 + 16 * m) * D + col0;
#pragma unroll
                for (int bj = 0; bj < 2; ++bj)
#pragma unroll
                    for (int n = 0; n < 2; ++n) { const f32x4 xs = *(const f32x4*)(src + off + bj * 128 + n * 16);
                        *(f32x4*)(dst + off + bj * 128 + n * 16) = xs + gv[bj][n] * acc[ai][bj][m][n]; }
                if (m & 1) asm volatile("" ::: "memory"); }
    }
};

struct EpiResB {
    static constexpr bool PERM = false;
    const float* xlat; const float* modl; bf16_t* o;
    __device__ __forceinline__ void operator()(const f32x4 (&acc)[2][2][4][2], const Unit& u, int wr, int wc, int fr, int fq) const {
        const int b = u.pm / PPB, pb = u.pm % PPB;
        const size_t r0 = (size_t)b * S + 256 * pb;
        const float* src = xlat + r0 * D; bf16_t* dst = o + r0 * D;
        const float* gt = modl + (size_t)b * 12288 + 2 * D;
        const int rowl0 = wr * 64 + fr, col0 = u.pn * 256 + wc * 32 + 4 * fq;
        f32x4 gv[2][2];
#pragma unroll
        for (int bj = 0; bj < 2; ++bj)
#pragma unroll
            for (int n = 0; n < 2; ++n) gv[bj][n] = *(const f32x4*)(gt + col0 + bj * 128 + n * 16);
#pragma unroll
        for (int ai = 0; ai < 2; ++ai)
#pragma unroll
            for (int m = 0; m < 4; ++m) { const size_t off = (size_t)(ai * 128 + rowl0 + 16 * m) * D + col0;
#pragma unroll
                for (int bj = 0; bj < 2; ++bj)
#pragma unroll
                    for (int n = 0; n < 2; ++n) { const f32x4 xs = *(const f32x4*)(src + off + bj * 128 + n * 16); const f32x4 h = xs + gv[bj][n] * acc[ai][bj][m][n];
                        u32x2 w; w.x = cvt_pk_bf16(h.x, h.y); w.y = cvt_pk_bf16(h.z, h.w); *(u32x2*)(dst + off + bj * 128 + n * 16) = w; }
                if (m & 1) asm volatile("" ::: "memory"); }
    }
};

#ifndef ATT_PVSM_A
#define ATT_PVSM_A 0
#endif
#ifndef ATT_PVSM_B
#define ATT_PVSM_B 0
#endif
#ifndef ATT_PRIO
#define ATT_PRIO 0
#endif
namespace att {
using bf16 = unsigned short;
constexpr int   D = 128, NW = 8, QBLK = 32, KVBLK = 64;
constexpr float THR = 8.f;
constexpr size_t SHM_V = KVBLK * D * 2;
#define KSWZ(row, colB) ((row) * 256 + ((colB) ^ (((row) & 7) << 4)))
#define SBAR() __builtin_amdgcn_sched_barrier(0)
#define PIN(x) asm volatile("" : "+v"(x))
__device__ __forceinline__ int crow(int r, int hi) { return (r & 3) + 8 * (r >> 2) + 4 * hi; }
__device__ __forceinline__ unsigned cvtpk(float lo, float hi) {
  unsigned r; asm volatile("v_cvt_pk_bf16_f32 %0, %1, %2" : "=v"(r) : "v"(lo), "v"(hi)); return r;
}
template <typename TIn> struct Stage;
template <> struct Stage<bf16>  { using T = bf16x8;
  __device__ static __forceinline__ T ld8(const bf16* p) { return *reinterpret_cast<const bf16x8*>(p); }
  __device__ static __forceinline__ bf16x8 tobf(T x) { return x; } };
template <> struct Stage<float> { using T = f32x8;
  __device__ static __forceinline__ T ld8(const float* p) { return *reinterpret_cast<const f32x8*>(p); }
  __device__ static __forceinline__ bf16x8 tobf(T x) {
    u32x4 w = {cvtpk(x[0], x[1]), cvtpk(x[2], x[3]), cvtpk(x[4], x[5]), cvtpk(x[6], x[7])}; return *reinterpret_cast<bf16x8*>(&w); } };

template <int DQK> __device__ __forceinline__ void partialSM(f32x16& p0, f32x16& p1, float& m_reg, float& mn, float& alpha) {
  constexpr float SCALE = DQK == 128 ? 0.088388347648318440f : 0.072168783648703220f;
  constexpr float C = SCALE * 1.4426950408889634f;
  float pmax = p0[0]; for (int r = 1; r < 16; ++r) pmax = fmaxf(pmax, p0[r]); for (int r = 0; r < 16; ++r) pmax = fmaxf(pmax, p1[r]);
  { auto rr = __builtin_amdgcn_permlane32_swap(__float_as_uint(pmax), __float_as_uint(pmax), false, false);
    pmax = fmaxf(__uint_as_float(rr[0]), __uint_as_float(rr[1])); }
  if (__builtin_expect(__all(pmax - m_reg <= THR / SCALE), 1)) { mn = m_reg; alpha = 1.f; }
  else { mn = fmaxf(m_reg, pmax); alpha = __builtin_amdgcn_exp2f((m_reg - mn) * C); m_reg = mn; }
  float mnC = -mn * C;
  for (int r = 0; r < 16; ++r) p0[r] = fmaf(p0[r], C, mnC); for (int r = 0; r < 16; ++r) p1[r] = fmaf(p1[r], C, mnC);
  for (int r = 0; r < 16; ++r) p0[r] = __builtin_amdgcn_exp2f(p0[r]);
}
__device__ __forceinline__ void finishSM(f32x16& p0, f32x16& p1, float alpha, float& l_reg, bf16x8& pa0, bf16x8& pa1, bf16x8& pa2, bf16x8& pa3) {
  for (int r = 0; r < 16; ++r) p1[r] = __builtin_amdgcn_exp2f(p1[r]);
  float ps = 0; for (int r = 0; r < 16; ++r) ps += p0[r]; for (int r = 0; r < 16; ++r) ps += p1[r];
  { auto rr = __builtin_amdgcn_permlane32_swap(__float_as_uint(ps), __float_as_uint(ps), false, false);
    ps = __uint_as_float(rr[0]) + __uint_as_float(rr[1]); }
  l_reg = l_reg * alpha + ps;
#define PK4(P, BASE, OUT) do { unsigned a0 = cvtpk(P[BASE + 0], P[BASE + 1]), a1 = cvtpk(P[BASE + 2], P[BASE + 3]);   \
    unsigned b0 = cvtpk(P[BASE + 4], P[BASE + 5]), b1 = cvtpk(P[BASE + 6], P[BASE + 7]);                              \
    auto r0 = __builtin_amdgcn_permlane32_swap(a0, b0, false, false); auto r1 = __builtin_amdgcn_permlane32_swap(a1, b1, false, false); \
    u32x4 w = {r0[0], r1[0], r0[1], r1[1]}; OUT = *reinterpret_cast<bf16x8*>(&w); } while (0)
  PK4(p0, 0, pa0); PK4(p0, 8, pa1); PK4(p1, 0, pa2); PK4(p1, 8, pa3);
#undef PK4
}
__device__ __forceinline__ void fin_nop(f32x16& p0, f32x16& p1, bf16x8& pa0, bf16x8& pa1, bf16x8& pa2, bf16x8& pa3) {
#define PK4(P, BASE, OUT) do { unsigned a0 = cvtpk(P[BASE + 0], P[BASE + 1]), a1 = cvtpk(P[BASE + 2], P[BASE + 3]);   \
    unsigned b0 = cvtpk(P[BASE + 4], P[BASE + 5]), b1 = cvtpk(P[BASE + 6], P[BASE + 7]);                              \
    auto r0 = __builtin_amdgcn_permlane32_swap(a0, b0, false, false); auto r1 = __builtin_amdgcn_permlane32_swap(a1, b1, false, false); \
    u32x4 w = {r0[0], r1[0], r0[1], r1[1]}; OUT = *reinterpret_cast<bf16x8*>(&w); } while (0)
  PK4(p0, 0, pa0); PK4(p0, 8, pa1); PK4(p1, 0, pa2); PK4(p1, 8, pa3);
#undef PK4
}
#ifndef ATT_KSW15
#define ATT_KSW15 1
#endif
#define KSWZK(row, KP) (ATT_KSW15 ? ((KP) == 256 ? ((row) & 15) : (((row) >> 1) & 7)) : ((row) & 7))
#define KSWZP(row, colB, KP) ((row) * (KP) + ((colB) ^ (KSWZK(row, KP) << 4)))
template <int DQK, int NQR> __device__ __forceinline__ void qkt(f32x16& p0, f32x16& p1, const bf16* Ks, const bf16x8* qr, int r32, int hi, const char* qx) {
  p0 = f32x16{}; p1 = f32x16{};
  for (int d0 = NQR; d0 < DQK / 16; ++d0) { int cb = (d0 * 16 + hi * 8) * 2;
    bf16x8 qv = *reinterpret_cast<const bf16x8*>(qx + (d0 - NQR) * 1024);
    bf16x8 b0 = *reinterpret_cast<const bf16x8*>((const char*)Ks + KSWZP(r32, cb, DQK * 2));
    bf16x8 b1 = *reinterpret_cast<const bf16x8*>((const char*)Ks + KSWZP(32 + r32, cb, DQK * 2));
    p0 = __builtin_amdgcn_mfma_f32_32x32x16_bf16(b0, qv, p0, 0, 0, 0);
    p1 = __builtin_amdgcn_mfma_f32_32x32x16_bf16(b1, qv, p1, 0, 0, 0); }
  for (int d0 = 0; d0 < NQR; ++d0) { int cb = (d0 * 16 + hi * 8) * 2;
    bf16x8 b0 = *reinterpret_cast<const bf16x8*>((const char*)Ks + KSWZP(r32, cb, DQK * 2));
    bf16x8 b1 = *reinterpret_cast<const bf16x8*>((const char*)Ks + KSWZP(32 + r32, cb, DQK * 2));
    p0 = __builtin_amdgcn_mfma_f32_32x32x16_bf16(b0, qr[d0], p0, 0, 0, 0);
    p1 = __builtin_amdgcn_mfma_f32_32x32x16_bf16(b1, qr[d0], p1, 0, 0, 0); }
}
__device__ __forceinline__ int v_st(int k, int c) { const int kk = (k & ~0xC) | ((k & 4) << 1) | ((k & 8) >> 1); return ((kk >> 3) * 4 + (c >> 5)) * 512 + ((kk & 7) * 32 + (c & 31)) * 2; }
__device__ __forceinline__ int v_rd_base(int lane) { return ((lane & 3) << 3) | (((lane >> 2) & 3) << 6) | (((lane >> 4) & 1) << 5) | (((lane >> 5) & 1) << 8); }
constexpr int v_rd_off(int d0, int ks, int half) { return d0 * 512 + ks * 4096 + half * 2048; }
template <int OFF> __device__ __forceinline__ s16x4 tr_read(int vb) {
  s16x4 r; asm volatile("ds_read_b64_tr_b16 %0, %1 offset:%2" : "=&v"(r) : "v"(vb), "i"(OFF) : "memory"); return r;
}
template <int D0> __device__ __forceinline__ void pv_one(f32x16& od, int vb, bf16x8 pa0, bf16x8 pa1, bf16x8 pa2, bf16x8 pa3) {
  const s16x4 l0 = tr_read<v_rd_off(D0, 0, 0)>(vb), h0 = tr_read<v_rd_off(D0, 0, 1)>(vb), l1 = tr_read<v_rd_off(D0, 1, 0)>(vb), h1 = tr_read<v_rd_off(D0, 1, 1)>(vb);
  const s16x4 l2 = tr_read<v_rd_off(D0, 2, 0)>(vb), h2 = tr_read<v_rd_off(D0, 2, 1)>(vb), l3 = tr_read<v_rd_off(D0, 3, 0)>(vb), h3 = tr_read<v_rd_off(D0, 3, 1)>(vb);
  asm volatile("s_waitcnt lgkmcnt(0)" ::: "memory"); SBAR();
#define PK(L, H) (bf16x8){L[0], L[1], L[2], L[3], H[0], H[1], H[2], H[3]}
#if ATT_PRIO
  __builtin_amdgcn_s_setprio(1);
#endif
  od = __builtin_amdgcn_mfma_f32_32x32x16_bf16(pa0, PK(l0, h0), od, 0, 0, 0);
  od = __builtin_amdgcn_mfma_f32_32x32x16_bf16(pa1, PK(l1, h1), od, 0, 0, 0);
  od = __builtin_amdgcn_mfma_f32_32x32x16_bf16(pa2, PK(l2, h2), od, 0, 0, 0);
  od = __builtin_amdgcn_mfma_f32_32x32x16_bf16(pa3, PK(l3, h3), od, 0, 0, 0);
#if ATT_PRIO
  __builtin_amdgcn_s_setprio(0);
#endif
#undef PK
}
__device__ __forceinline__ void pv_d0(f32x16* o, int vb, bf16x8 pa0, bf16x8 pa1, bf16x8 pa2, bf16x8 pa3) {
  pv_one<0>(o[0], vb, pa0, pa1, pa2, pa3); pv_one<1>(o[1], vb, pa0, pa1, pa2, pa3); pv_one<2>(o[2], vb, pa0, pa1, pa2, pa3); pv_one<3>(o[3], vb, pa0, pa1, pa2, pa3);
}

struct VFrag { s16x4 l0, h0, l1, h1, l2, h2, l3, h3; };
template <int D0> __device__ __forceinline__ void pv_rd(VFrag& f, int vb) {
  f.l0 = tr_read<v_rd_off(D0, 0, 0)>(vb); f.h0 = tr_read<v_rd_off(D0, 0, 1)>(vb); f.l1 = tr_read<v_rd_off(D0, 1, 0)>(vb); f.h1 = tr_read<v_rd_off(D0, 1, 1)>(vb);
  f.l2 = tr_read<v_rd_off(D0, 2, 0)>(vb); f.h2 = tr_read<v_rd_off(D0, 2, 1)>(vb); f.l3 = tr_read<v_rd_off(D0, 3, 0)>(vb); f.h3 = tr_read<v_rd_off(D0, 3, 1)>(vb);
}
__device__ __forceinline__ void pv_mm(f32x16& od, const VFrag& f, bf16x8 pa0, bf16x8 pa1, bf16x8 pa2, bf16x8 pa3) {
#define PK(L, H) (bf16x8){L[0], L[1], L[2], L[3], H[0], H[1], H[2], H[3]}
  od = __builtin_amdgcn_mfma_f32_32x32x16_bf16(pa0, PK(f.l0, f.h0), od, 0, 0, 0);
  od = __builtin_amdgcn_mfma_f32_32x32x16_bf16(pa1, PK(f.l1, f.h1), od, 0, 0, 0);
  od = __builtin_amdgcn_mfma_f32_32x32x16_bf16(pa2, PK(f.l2, f.h2), od, 0, 0, 0);
  od = __builtin_amdgcn_mfma_f32_32x32x16_bf16(pa3, PK(f.l3, f.h3), od, 0, 0, 0);
#undef PK
}
#define PVWAIT() do { asm volatile("s_waitcnt lgkmcnt(0)" ::: "memory"); SBAR(); } while (0)
template <int DQK> __device__ __forceinline__ void pv_sm(f32x16* o, int vb, bf16x8 pa0, bf16x8 pa1, bf16x8 pa2, bf16x8 pa3, f32x16& p0, f32x16& p1, float& m_reg, float& mn, float& alpha) {
  constexpr float SCALE = DQK == 128 ? 0.088388347648318440f : 0.072168783648703220f;
  constexpr float C = SCALE * 1.4426950408889634f;
  VFrag f;
  pv_rd<0>(f, vb); PVWAIT();
  pv_mm(o[0], f, pa0, pa1, pa2, pa3); pv_rd<1>(f, vb);
  float pmax = p0[0]; for (int r = 1; r < 16; ++r) pmax = fmaxf(pmax, p0[r]); for (int r = 0; r < 16; ++r) pmax = fmaxf(pmax, p1[r]);
  { auto rr = __builtin_amdgcn_permlane32_swap(__float_as_uint(pmax), __float_as_uint(pmax), false, false);
    pmax = fmaxf(__uint_as_float(rr[0]), __uint_as_float(rr[1])); }
  if (__builtin_expect(__all(pmax - m_reg <= THR / SCALE), 1)) { mn = m_reg; alpha = 1.f; }
  else { mn = fmaxf(m_reg, pmax); alpha = __builtin_amdgcn_exp2f((m_reg - mn) * C); m_reg = mn; }
  float mnC = -mn * C; PIN(mnC); PIN(alpha);
  PVWAIT();
  pv_mm(o[1], f, pa0, pa1, pa2, pa3); pv_rd<2>(f, vb);
  { const f32x2 CC = {C, C}, MM = {mnC, mnC};
    for (int r = 0; r < 8; ++r) { f32x2 t = {p0[2 * r], p0[2 * r + 1]}; t = t * CC + MM; PIN(t); p0[2 * r] = t[0]; p0[2 * r + 1] = t[1]; }
    for (int r = 0; r < 8; ++r) { f32x2 t = {p1[2 * r], p1[2 * r + 1]}; t = t * CC + MM; PIN(t); p1[2 * r] = t[0]; p1[2 * r + 1] = t[1]; } }
  PVWAIT();
  pv_mm(o[2], f, pa0, pa1, pa2, pa3); pv_rd<3>(f, vb);
  for (int r = 0; r < 8; ++r) { float t = __builtin_amdgcn_exp2f(p0[r]); PIN(t); p0[r] = t; }
  PVWAIT();
  pv_mm(o[3], f, pa0, pa1, pa2, pa3);
  for (int r = 8; r < 16; ++r) { float t = __builtin_amdgcn_exp2f(p0[r]); PIN(t); p0[r] = t; }
  SBAR();
}

template <typename TQ, int LDQ, int LDK, int LDO, int DQK, int LDK2, int SDEPTH, int NQR, int PRB = 0>
__device__ __forceinline__ void attn_dense_body(const TQ* __restrict__ Qb, const bf16* __restrict__ Kh, const bf16* __restrict__ K2h, const bf16* __restrict__ Vh,
                                                bf16* __restrict__ Ob, const bf16* __restrict__ Gb, int seq, char* lds) {
  constexpr size_t SHM_K = 64 * DQK * 2; constexpr bool X = DQK == 192; constexpr bool PVSM = X ? (ATT_PVSM_B != 0) : (ATT_PVSM_A != 0);
  using St = Stage<bf16>; using SQ = Stage<TQ>;
  int tid_o = threadIdx.x; asm volatile("" : "+v"(tid_o));
  const int tid = tid_o, wid = __builtin_amdgcn_readfirstlane(tid >> 6), lane = tid & 63, r32 = lane & 31, hi = lane >> 5;
  bf16* V_lds = (bf16*)lds; bf16* K_lds = (bf16*)(lds + 2 * SHM_V);
  float* ws = (float*)(lds + 2 * SHM_V + 2 * SHM_K) + wid * 64; float* li_l = ws; float* al_l = ws + 32;
  float m_reg = -1e30f, l_reg = 0; f32x16 o[4] = {}; bf16x8 qr[NQR]; char* qx = lds + 2 * SHM_V + 2 * SHM_K + 2048 + wid * ((DQK / 16 - NQR) * 1024) + lane * 16;
  const TQ* Qw = Qb + (long)(wid * QBLK + r32) * LDQ + hi * 8;
#pragma unroll
  for (int d0 = 0; d0 < NQR; ++d0) qr[d0] = SQ::tobf(SQ::ld8(Qw + d0 * 16));
#pragma unroll
  for (int d0 = NQR; d0 < DQK / 16; ++d0) *reinterpret_cast<bf16x8*>(qx + (d0 - NQR) * 1024) = SQ::tobf(SQ::ld8(Qw + d0 * 16));
  const int sr = tid >> 4, sc = (tid & 15) * 8, vst0 = v_st(sr, sc), vst1 = v_st(32 + sr, sc);
  const int vb0 = (int)(uintptr_t)V_lds + v_rd_base(lane);
  const int sr2 = tid >> 3, sc2 = (tid & 7) * 8;
  struct { typename St::T vs0, vs1, ks0, ks1, ks2; } sr_[SDEPTH];
  constexpr int LDKP = (PRB & 32) ? 128 : LDK;
  const unsigned voff = (unsigned)(sr * LDKP + sc) * 2u, k2off = (unsigned)(sr2 * LDK2 + sc2) * 2u;
#define SLOAD(i, k0) do { const char* vb_ = (const char*)Vh + (size_t)(k0) * (LDKP * 2) + ((PRB & 32) ? (size_t)(k0) * 256 : 0); const char* kb_ = (const char*)Kh + (size_t)(k0) * (LDKP * 2); \
    sr_[i].vs0 = *(const bf16x8*)(vb_ + voff); sr_[i].vs1 = *(const bf16x8*)(vb_ + 32 * LDKP * 2 + voff); \
    sr_[i].ks0 = *(const bf16x8*)(kb_ + voff); sr_[i].ks1 = *(const bf16x8*)(kb_ + 32 * LDKP * 2 + voff); \
    if constexpr (X) sr_[i].ks2 = *(const bf16x8*)((const char*)K2h + (size_t)(k0) * (LDK2 * 2) + k2off); } while (0)
#define SWRITE(b, i) do { *(bf16x8*)((char*)V_lds + (b) * SHM_V + vst0) = St::tobf(sr_[i].vs0);          \
    *(bf16x8*)((char*)V_lds + (b) * SHM_V + vst1) = St::tobf(sr_[i].vs1); int kc = sc * 2;               \
    *(bf16x8*)((char*)K_lds + (b) * SHM_K + KSWZP(sr, kc, DQK * 2)) = St::tobf(sr_[i].ks0);                       \
    *(bf16x8*)((char*)K_lds + (b) * SHM_K + KSWZP(32 + sr, kc, DQK * 2)) = St::tobf(sr_[i].ks1); \
    if constexpr (X) *(bf16x8*)((char*)K_lds + (b) * SHM_K + KSWZP(sr2, 256 + sc2 * 2, DQK * 2)) = St::tobf(sr_[i].ks2); } while (0)
#define SWAIT() do { if constexpr (SDEPTH == 2) { if constexpr (X) asm volatile("s_waitcnt vmcnt(5)" ::: "memory"); else asm volatile("s_waitcnt vmcnt(4)" ::: "memory"); } else asm volatile("s_waitcnt vmcnt(0)" ::: "memory"); } while (0)
#define RESC(a) do { if (__any((a) < 1.f)) { if (hi == 0) al_l[r32] = (a); asm volatile("s_waitcnt lgkmcnt(0)" ::: "memory"); \
    for (int d = 0; d < 4; ++d) for (int r = 0; r < 16; ++r) o[d][r] *= al_l[crow(r, hi)]; } } while (0)
#define QKT_(P0, P1, KS) do { if constexpr ((PRB & 8) != 0) { P0 = f32x16{}; P1 = f32x16{}; for (int r_ = 0; r_ < 16; ++r_) { float t0_ = P0[r_], t1_ = P1[r_]; PIN(t0_); PIN(t1_); P0[r_] = t0_; P1[r_] = t1_; } } \
    else qkt<DQK, NQR>(P0, P1, KS, qr, r32, hi, qx); } while (0)
#define FIN_(P0, P1, AL) do { if constexpr ((PRB & 1) != 0) fin_nop(P0, P1, pa0, pa1, pa2, pa3); else finishSM(P0, P1, AL, l_reg, pa0, pa1, pa2, pa3); } while (0)
#define PVS_(VB, P0, P1, MN, AL) do { \
    if constexpr ((PRB & 4) != 0) { if constexpr ((PRB & 1) != 0) { MN = 0.f; AL = 1.f; } else partialSM<DQK>(P0, P1, m_reg, MN, AL); } \
    else if constexpr ((PRB & 1) != 0) { pv_d0(o, VB, pa0, pa1, pa2, pa3); MN = 0.f; AL = 1.f; } \
    else if constexpr (PVSM) pv_sm<DQK>(o, VB, pa0, pa1, pa2, pa3, P0, P1, m_reg, MN, AL); \
    else { pv_d0(o, VB, pa0, pa1, pa2, pa3); partialSM<DQK>(P0, P1, m_reg, MN, AL); } } while (0)
#define WGB_() do { if constexpr ((PRB & 2) == 0) __syncthreads(); } while (0)
#define SLD_(i, k0) do { if constexpr ((PRB & 16) == 0) SLOAD(i, k0); } while (0)
#define SWR_(bb, i) do { if constexpr ((PRB & 16) == 0) { SWAIT(); SWRITE(bb, i); } } while (0)
  f32x16 pA0, pA1, pB0, pB1; float mnA, mnB, alA, alB; bf16x8 pa0, pa1, pa2, pa3; const int NT = seq / KVBLK;
  constexpr int SE = 0, SO = SDEPTH - 1;
  SLOAD(SE, 0); asm volatile("s_waitcnt vmcnt(0)" ::: "memory"); SWRITE(0, SE); __syncthreads();
  qkt<DQK, NQR>(pA0, pA1, K_lds, qr, r32, hi, qx); partialSM<DQK>(pA0, pA1, m_reg, mnA, alA);
  SLOAD(SO, KVBLK); if constexpr (SDEPTH == 2) { if (2 < NT) SLOAD(SE, 2 * KVBLK); }
  SWAIT(); SWRITE(1, SO); __syncthreads();
  for (int j = 1; j + 1 < NT; j += 2) {
    SBAR(); QKT_(pB0, pB1, (bf16*)((char*)K_lds + SHM_K));
    FIN_(pA0, pA1, alA); SBAR();
    SLD_(SO, (j + SDEPTH) * KVBLK); SBAR();
    PVS_(vb0, pB0, pB1, mnB, alB);
    WGB_(); SWR_(0, SE);
    RESC(alB); WGB_();
    SBAR(); QKT_(pA0, pA1, K_lds);
    FIN_(pB0, pB1, alB); SBAR();
    if (SDEPTH == 1 || j + 3 < NT) SLD_(SE, (j + 1 + SDEPTH) * KVBLK); SBAR();
    PVS_(vb0 + (int)SHM_V, pA0, pA1, mnA, alA);
    WGB_(); SWR_(1, SO);
    RESC(alA); WGB_();
  }
  SBAR(); qkt<DQK, NQR>(pB0, pB1, (bf16*)((char*)K_lds + SHM_K), qr, r32, hi, qx);
  finishSM(pA0, pA1, alA, l_reg, pa0, pa1, pa2, pa3); SBAR();
  if constexpr (PVSM) pv_sm<DQK>(o, vb0, pa0, pa1, pa2, pa3, pB0, pB1, m_reg, mnB, alB); else { pv_d0(o, vb0, pa0, pa1, pa2, pa3); partialSM<DQK>(pB0, pB1, m_reg, mnB, alB); }
  __syncthreads(); RESC(alB);
  finishSM(pB0, pB1, alB, l_reg, pa0, pa1, pa2, pa3); SBAR();
  pv_d0(o, vb0 + (int)SHM_V, pa0, pa1, pa2, pa3);
  if (hi == 0) li_l[r32] = l_reg; asm volatile("s_waitcnt lgkmcnt(0)" ::: "memory");
  float rli[16];
#pragma unroll
  for (int r = 0; r < 16; ++r) rli[r] = __builtin_amdgcn_rcpf(li_l[crow(r, hi)]);
  __syncthreads();
  {
    char* ep = lds + wid * 8704;
    int lane_e = hi * 4 * 272 + r32 * 2; asm volatile("" : "+v"(lane_e));
#pragma unroll
    for (int r = 0; r < 16; ++r) { const int ro = ((r & 3) + 8 * (r >> 2)) * 272;
#pragma unroll
      for (int d0 = 0; d0 < 4; ++d0) *(unsigned short*)(ep + lane_e + ro + d0 * 64) = (unsigned short)(cvtpk(o[d0][r] * rli[r], 0.f) & 0xffffu); }
    asm volatile("s_waitcnt lgkmcnt(0)" ::: "memory");
    int lane_q = lane; asm volatile("" : "+v"(lane_q));
    const int row0 = lane_q >> 4, ch = lane_q & 15;
    unsigned short* Yw = Ob + (long)(wid * QBLK + row0) * LDO + ch * 8; const unsigned short* Gw = Gb + (long)(wid * QBLK + row0) * LDO + ch * 8;
#pragma unroll
    for (int hf = 0; hf < 2; ++hf) { u32x4 gv[4], ov[4];
#pragma unroll
      for (int i = 0; i < 4; ++i) gv[i] = *(const u32x4*)(Gw + (long)(4 * (4 * hf + i)) * LDO);
#pragma unroll
      for (int i = 0; i < 4; ++i) ov[i] = *(const u32x4*)(ep + (row0 + 4 * (4 * hf + i)) * 272 + ch * 16);
#pragma unroll
      for (int i = 0; i < 4; ++i) { u32x4 w;
#pragma unroll
        for (int j = 0; j < 4; ++j) { const float lo = __uint_as_float(ov[i][j] << 16) * __uint_as_float(gv[i][j] << 16), hi2 = __uint_as_float(ov[i][j] & 0xffff0000u) * __uint_as_float(gv[i][j] & 0xffff0000u); w[j] = cvtpk(lo, hi2); }
        *(u32x4*)(Yw + (long)(4 * (4 * hf + i)) * LDO) = w; }
      asm volatile("" ::: "memory"); }
  }
  __syncthreads();
#undef SLOAD
#undef SWRITE
#undef SWAIT
#undef RESC
#undef QKT_
#undef FIN_
#undef PVS_
#undef WGB_
#undef SLD_
#undef SWR_
}

template <typename TQ, int LDQ, int LDK, int LDO, int DQK, int LDK2, int SDEPTH, int NQR>
__device__ __forceinline__ void attn_dense_body3(const TQ* __restrict__ Qb, const bf16* __restrict__ Kh, const bf16* __restrict__ K2h, const bf16* __restrict__ Vh,
                                                bf16* __restrict__ Ob, const bf16* __restrict__ Gb, int seq, char* lds) {
  constexpr size_t SHM_K = 64 * DQK * 2; constexpr bool X = DQK == 192;
  using St = Stage<bf16>; using SQ = Stage<TQ>;
  int tid_o = threadIdx.x; asm volatile("" : "+v"(tid_o));
  const int tid = tid_o, wid = __builtin_amdgcn_readfirstlane(tid >> 6), lane = tid & 63, r32 = lane & 31, hi = lane >> 5;
  bf16* V_lds = (bf16*)lds; bf16* K_lds = (bf16*)(lds + 3 * SHM_V);
  float* ws = (float*)(lds + 3 * SHM_V + 3 * SHM_K) + wid * 64; float* li_l = ws; float* al_l = ws + 32;
  float m_reg = -1e30f, l_reg = 0; f32x16 o[4] = {}; bf16x8 qr[NQR]; char* qx = lds + 3 * SHM_V + 3 * SHM_K + 2048 + wid * ((DQK / 16 - NQR) * 1024) + lane * 16;
  const TQ* Qw = Qb + (long)(wid * QBLK + r32) * LDQ + hi * 8;
#pragma unroll
  for (int d0 = 0; d0 < NQR; ++d0) qr[d0] = SQ::tobf(SQ::ld8(Qw + d0 * 16));
#pragma unroll
  for (int d0 = NQR; d0 < DQK / 16; ++d0) *reinterpret_cast<bf16x8*>(qx + (d0 - NQR) * 1024) = SQ::tobf(SQ::ld8(Qw + d0 * 16));
  const int sr = tid >> 4, sc = (tid & 15) * 8, vst0 = v_st(sr, sc), vst1 = v_st(32 + sr, sc);
  const int vb0 = (int)(uintptr_t)V_lds + v_rd_base(lane);
  const int sr2 = tid >> 3, sc2 = (tid & 7) * 8;
  struct { typename St::T vs0, vs1, ks0, ks1, ks2; } sr_[SDEPTH];
  const unsigned voff = (unsigned)(sr * LDK + sc) * 2u, k2off = (unsigned)(sr2 * LDK2 + sc2) * 2u;
#define SLOAD(i, k0) do { const char* vb_ = (const char*)Vh + (size_t)(k0) * (LDK * 2); const char* kb_ = (const char*)Kh + (size_t)(k0) * (LDK * 2); \
    sr_[i].vs0 = *(const bf16x8*)(vb_ + voff); sr_[i].vs1 = *(const bf16x8*)(vb_ + 32 * LDK * 2 + voff); \
    sr_[i].ks0 = *(const bf16x8*)(kb_ + voff); sr_[i].ks1 = *(const bf16x8*)(kb_ + 32 * LDK * 2 + voff); \
    if constexpr (X) sr_[i].ks2 = *(const bf16x8*)((const char*)K2h + (size_t)(k0) * (LDK2 * 2) + k2off); } while (0)
#define SWRITE(b, i) do { *(bf16x8*)((char*)V_lds + (b) * SHM_V + vst0) = St::tobf(sr_[i].vs0);          \
    *(bf16x8*)((char*)V_lds + (b) * SHM_V + vst1) = St::tobf(sr_[i].vs1); int kc = sc * 2;               \
    *(bf16x8*)((char*)K_lds + (b) * SHM_K + KSWZP(sr, kc, DQK * 2)) = St::tobf(sr_[i].ks0);                       \
    *(bf16x8*)((char*)K_lds + (b) * SHM_K + KSWZP(32 + sr, kc, DQK * 2)) = St::tobf(sr_[i].ks1); \
    if constexpr (X) *(bf16x8*)((char*)K_lds + (b) * SHM_K + KSWZP(sr2, 256 + sc2 * 2, DQK * 2)) = St::tobf(sr_[i].ks2); } while (0)
#define SWAIT() do { if constexpr (SDEPTH == 2) { if constexpr (X) asm volatile("s_waitcnt vmcnt(5)" ::: "memory"); else asm volatile("s_waitcnt vmcnt(4)" ::: "memory"); } else asm volatile("s_waitcnt vmcnt(0)" ::: "memory"); } while (0)
#define RESC(a) do { if (__any((a) < 1.f)) { if (hi == 0) al_l[r32] = (a); asm volatile("s_waitcnt lgkmcnt(0)" ::: "memory"); \
    for (int d = 0; d < 4; ++d) for (int r = 0; r < 16; ++r) o[d][r] *= al_l[crow(r, hi)]; } } while (0)
  f32x16 pA0, pA1, pB0, pB1; float mnA, mnB, alA, alB; bf16x8 pa0, pa1, pa2, pa3; const int NT = seq / KVBLK;
  SLOAD(0, 0); asm volatile("s_waitcnt vmcnt(0)" ::: "memory"); SWRITE(0, 0);
  SLOAD(0, KVBLK); asm volatile("s_waitcnt vmcnt(0)" ::: "memory"); SWRITE(1, 0); __syncthreads();
  qkt<DQK, NQR>(pA0, pA1, K_lds, qr, r32, hi, qx); partialSM<DQK>(pA0, pA1, m_reg, mnA, alA);
  if (2 < NT) SLOAD(0, 2 * KVBLK);
  if constexpr (SDEPTH == 2) { if (3 < NT) SLOAD(1, 3 * KVBLK); }
  int cur = 0, nxt = 1, wr = 2;
#define HALF(t, SL, PC0, PC1, ALC, PN0, PN1, MNN, ALN) do { \
    if ((t) + 2 < NT) { if (SDEPTH == 2 && (t) + 3 < NT) SWAIT(); else asm volatile("s_waitcnt vmcnt(0)" ::: "memory"); SWRITE(wr, SL); if ((t) + 2 + SDEPTH < NT) SLOAD(SL, ((t) + 2 + SDEPTH) * KVBLK); } \
    SBAR(); if ((t) + 1 < NT) qkt<DQK, NQR>(PN0, PN1, (bf16*)((char*)K_lds + nxt * SHM_K), qr, r32, hi, qx); \
    finishSM(PC0, PC1, ALC, l_reg, pa0, pa1, pa2, pa3); SBAR(); \
    pv_d0(o, vb0 + cur * (int)SHM_V, pa0, pa1, pa2, pa3); \
    if ((t) + 1 < NT) { partialSM<DQK>(PN0, PN1, m_reg, MNN, ALN); RESC(ALN); } \
    __syncthreads(); { const int c_ = cur; cur = nxt; nxt = wr; wr = c_; } } while (0)
  for (int t = 0; t < NT; t += 2) {
    HALF(t, 0, pA0, pA1, alA, pB0, pB1, mnB, alB);
    HALF(t + 1, (SDEPTH - 1), pB0, pB1, alB, pA0, pA1, mnA, alA);
  }
#undef HALF
  if (hi == 0) li_l[r32] = l_reg; asm volatile("s_waitcnt lgkmcnt(0)" ::: "memory");
  float rli[16];
#pragma unroll
  for (int r = 0; r < 16; ++r) rli[r] = __builtin_amdgcn_rcpf(li_l[crow(r, hi)]);
  __syncthreads();
  {
    char* ep = lds + wid * 8704;
    int lane_e = hi * 4 * 272 + r32 * 2; asm volatile("" : "+v"(lane_e));
#pragma unroll
    for (int r = 0; r < 16; ++r) { const int ro = ((r & 3) + 8 * (r >> 2)) * 272;
#pragma unroll
      for (int d0 = 0; d0 < 4; ++d0) *(unsigned short*)(ep + lane_e + ro + d0 * 64) = (unsigned short)(cvtpk(o[d0][r] * rli[r], 0.f) & 0xffffu); }
    asm volatile("s_waitcnt lgkmcnt(0)" ::: "memory");
    int lane_q = lane; asm volatile("" : "+v"(lane_q));
    const int row0 = lane_q >> 4, ch = lane_q & 15;
    unsigned short* Yw = Ob + (long)(wid * QBLK + row0) * LDO + ch * 8; const unsigned short* Gw = Gb + (long)(wid * QBLK + row0) * LDO + ch * 8;
#pragma unroll
    for (int hf = 0; hf < 2; ++hf) { u32x4 gv[4], ov[4];
#pragma unroll
      for (int i = 0; i < 4; ++i) gv[i] = *(const u32x4*)(Gw + (long)(4 * (4 * hf + i)) * LDO);
#pragma unroll
      for (int i = 0; i < 4; ++i) ov[i] = *(const u32x4*)(ep + (row0 + 4 * (4 * hf + i)) * 272 + ch * 16);
#pragma unroll
      for (int i = 0; i < 4; ++i) { u32x4 w;
#pragma unroll
        for (int j = 0; j < 4; ++j) { const float lo = __uint_as_float(ov[i][j] << 16) * __uint_as_float(gv[i][j] << 16), hi2 = __uint_as_float(ov[i][j] & 0xffff0000u) * __uint_as_float(gv[i][j] & 0xffff0000u); w[j] = cvtpk(lo, hi2); }
        *(u32x4*)(Yw + (long)(4 * (4 * hf + i)) * LDO) = w; }
      asm volatile("" ::: "memory"); }
  }
  __syncthreads();
#undef SLOAD
#undef SWRITE
#undef SWAIT
#undef RESC
}

template <typename TQ, int LDQ, int LDK, int LDO, int DQK, int LDK2, int SDEPTH, int NQR>
__device__ __forceinline__ void attn_dense_body_dma(const TQ* __restrict__ Qb, const bf16* __restrict__ Kh, const bf16* __restrict__ K2h, const bf16* __restrict__ Vh,
                                                bf16* __restrict__ Ob, const bf16* __restrict__ Gb, int seq, char* lds) {
  constexpr size_t SHM_K = 64 * DQK * 2; constexpr bool X = DQK == 192; constexpr bool PVSM = X ? (ATT_PVSM_B != 0) : (ATT_PVSM_A != 0);
  using St = Stage<bf16>; using SQ = Stage<TQ>;
  int tid_o = threadIdx.x; asm volatile("" : "+v"(tid_o));
  const int tid = tid_o, wid = __builtin_amdgcn_readfirstlane(tid >> 6), lane = tid & 63, r32 = lane & 31, hi = lane >> 5;
  bf16* V_lds = (bf16*)lds; bf16* K_lds = (bf16*)(lds + 3 * SHM_V);
  float* ws = (float*)(lds + 3 * SHM_V + 4 * SHM_K) + wid * 64; float* li_l = ws; float* al_l = ws + 32;
  float m_reg = -1e30f, l_reg = 0; f32x16 o[4] = {}; bf16x8 qr[NQR]; char* qx = lds + 3 * SHM_V + 4 * SHM_K + 2048 + wid * ((DQK / 16 - NQR) * 1024) + lane * 16;
  const TQ* Qw = Qb + (long)(wid * QBLK + r32) * LDQ + hi * 8;
#pragma unroll
  for (int d0 = 0; d0 < NQR; ++d0) qr[d0] = SQ::tobf(SQ::ld8(Qw + d0 * 16));
#pragma unroll
  for (int d0 = NQR; d0 < DQK / 16; ++d0) *reinterpret_cast<bf16x8*>(qx + (d0 - NQR) * 1024) = SQ::tobf(SQ::ld8(Qw + d0 * 16));
  const int vb0 = (int)(uintptr_t)V_lds + v_rd_base(lane);
  const unsigned ldsK = (unsigned)(uintptr_t)K_lds + wid * 1024u, ldsV = (unsigned)(uintptr_t)V_lds + wid * 1024u;
  const char* kg = (const char*)Kh; const char* vg = (const char*)Vh;
  unsigned koff = 0; const char* kp[3] = {nullptr, nullptr, nullptr}; unsigned kst[3] = {0, 0, 0};
  if constexpr (!X) { const int krow = 4 * wid + (lane >> 4); koff = (unsigned)(krow * (LDK * 2) + (((lane & 15) ^ KSWZK(krow, 256)) << 4)); }
  else {
#pragma unroll
    for (int i = 0; i < 3; ++i) { const int P = (wid + 8 * i) * 64 + lane, row = P / 24, slot = P - row * 24, cb = slot ^ KSWZK(row, 384);
      if (cb < 16) { kp[i] = (const char*)Kh + (size_t)row * (LDK * 2) + cb * 16; kst[i] = 64 * LDK * 2; }
      else { kp[i] = (const char*)K2h + (size_t)row * (LDK2 * 2) + (cb - 16) * 16; kst[i] = 64 * LDK2 * 2; } } }
  unsigned voff; { const int st = 2 * wid + (lane >> 5), kk = (st >> 2) * 8 + ((lane & 31) >> 2), k = (kk & ~0xC) | ((kk & 4) << 1) | ((kk & 8) >> 1), c = (st & 3) * 32 + (lane & 3) * 8;
    voff = (unsigned)(k * (LDK * 2) + c * 2); }
#define GLDS(g, l) __builtin_amdgcn_global_load_lds((const unsigned*)(g), (LAS unsigned*)(l), 16, 0, 0)
#define DMAK(bi) do { const unsigned kd_ = ldsK + (bi) * (unsigned)SHM_K; \
    if constexpr (!X) { GLDS(kg + koff, kd_); GLDS(kg + 32 * LDK * 2 + koff, kd_ + 8192); kg += 64 * LDK * 2; } \
    else { _Pragma("unroll") for (int i_ = 0; i_ < 3; ++i_) { GLDS(kp[i_], kd_ + i_ * 8192); kp[i_] += kst[i_]; } } } while (0)
#define DMAV(bi) do { const unsigned vd_ = ldsV + (bi) * (unsigned)SHM_V; GLDS(vg + voff, vd_); GLDS(vg + 32 * LDK * 2 + voff, vd_ + 8192); vg += 64 * LDK * 2; } while (0)
#define RESC(a) do { if (__any((a) < 1.f)) { if (hi == 0) al_l[r32] = (a); asm volatile("s_waitcnt lgkmcnt(0)" ::: "memory"); \
    for (int d = 0; d < 4; ++d) for (int r = 0; r < 16; ++r) o[d][r] *= al_l[crow(r, hi)]; } } while (0)
  f32x16 pA0, pA1, pB0, pB1; float mnA, mnB, alA, alB; bf16x8 pa0, pa1, pa2, pa3; const int NT = seq / KVBLK;
  DMAK(0); DMAV(0); DMAK(1); DMAV(1); DMAK(2); asm volatile("s_waitcnt vmcnt(0)" ::: "memory"); __syncthreads();
  qkt<DQK, NQR>(pA0, pA1, K_lds, qr, r32, hi, qx); partialSM<DQK>(pA0, pA1, m_reg, mnA, alA);
  int vcur = 0, vnxt = 1, vwr = 2;
#define HALF(t, FULL, PC0, PC1, ALC, PN0, PN1, MNN, ALN) do { \
    if (FULL || (t) + 3 < NT) DMAK(((t) + 3) & 3); if (FULL || (t) + 2 < NT) DMAV(vwr); \
    SBAR(); if (FULL || (t) + 1 < NT) qkt<DQK, NQR>(PN0, PN1, (bf16*)((char*)K_lds + (((t) + 1) & 3) * SHM_K), qr, r32, hi, qx); \
    finishSM(PC0, PC1, ALC, l_reg, pa0, pa1, pa2, pa3); SBAR(); \
    pv_d0(o, vb0 + vcur * (int)SHM_V, pa0, pa1, pa2, pa3); \
    if (FULL || (t) + 1 < NT) { partialSM<DQK>(PN0, PN1, m_reg, MNN, ALN); RESC(ALN); } \
    if (FULL || (t) + 3 < NT) { if constexpr (X) asm volatile("s_waitcnt vmcnt(5)" ::: "memory"); else asm volatile("s_waitcnt vmcnt(4)" ::: "memory"); } \
    else if ((t) + 2 < NT) asm volatile("s_waitcnt vmcnt(2)" ::: "memory"); else asm volatile("s_waitcnt vmcnt(0)" ::: "memory"); \
    __syncthreads(); { const int c_ = vcur; vcur = vnxt; vnxt = vwr; vwr = c_; } } while (0)
  int t = 0;
  for (; t + 5 < NT; t += 2) {
    HALF(t, 1, pA0, pA1, alA, pB0, pB1, mnB, alB);
    HALF(t + 1, 1, pB0, pB1, alB, pA0, pA1, mnA, alA);
  }
  for (; t < NT; t += 2) {
    HALF(t, 0, pA0, pA1, alA, pB0, pB1, mnB, alB);
    HALF(t + 1, 0, pB0, pB1, alB, pA0, pA1, mnA, alA);
  }
#undef HALF
  if (hi == 0) li_l[r32] = l_reg; asm volatile("s_waitcnt lgkmcnt(0)" ::: "memory");
  float rli[16];
#pragma unroll
  for (int r = 0; r < 16; ++r) rli[r] = __builtin_amdgcn_rcpf(li_l[crow(r, hi)]);
  __syncthreads();
  {
    char* ep = lds + wid * 8704;
    int lane_e = hi * 4 * 272 + r32 * 2; asm volatile("" : "+v"(lane_e));
#pragma unroll
    for (int r = 0; r < 16; ++r) { const int ro = ((r & 3) + 8 * (r >> 2)) * 272;
#pragma unroll
      for (int d0 = 0; d0 < 4; ++d0) *(unsigned short*)(ep + lane_e + ro + d0 * 64) = (unsigned short)(cvtpk(o[d0][r] * rli[r], 0.f) & 0xffffu); }
    asm volatile("s_waitcnt lgkmcnt(0)" ::: "memory");
    int lane_q = lane; asm volatile("" : "+v"(lane_q));
    const int row0 = lane_q >> 4, ch = lane_q & 15;
    unsigned short* Yw = Ob + (long)(wid * QBLK + row0) * LDO + ch * 8; const unsigned short* Gw = Gb + (long)(wid * QBLK + row0) * LDO + ch * 8;
#pragma unroll
    for (int hf = 0; hf < 2; ++hf) { u32x4 gv[4], ov[4];
#pragma unroll
      for (int i = 0; i < 4; ++i) gv[i] = *(const u32x4*)(Gw + (long)(4 * (4 * hf + i)) * LDO);
#pragma unroll
      for (int i = 0; i < 4; ++i) ov[i] = *(const u32x4*)(ep + (row0 + 4 * (4 * hf + i)) * 272 + ch * 16);
#pragma unroll
      for (int i = 0; i < 4; ++i) { u32x4 w;
#pragma unroll
        for (int j = 0; j < 4; ++j) { const float lo = __uint_as_float(ov[i][j] << 16) * __uint_as_float(gv[i][j] << 16), hi2 = __uint_as_float(ov[i][j] & 0xffff0000u) * __uint_as_float(gv[i][j] & 0xffff0000u); w[j] = cvtpk(lo, hi2); }
        *(u32x4*)(Yw + (long)(4 * (4 * hf + i)) * LDO) = w; }
      asm volatile("" ::: "memory"); }
  }
  __syncthreads();
#undef DMAK
#undef DMAV
#undef GLDS
#undef RESC
}

template <typename TQ, int LDQ, int LDK, int LDO, int DQK, int LDK2, int SDEPTH, int NQR>
__device__ __forceinline__ void attn_dense_body_pp(const TQ* __restrict__ Qb, const bf16* __restrict__ Kh, const bf16* __restrict__ K2h, const bf16* __restrict__ Vh,
                                                bf16* __restrict__ Ob, const bf16* __restrict__ Gb, int seq, char* lds) {
  constexpr size_t SHM_K = 64 * DQK * 2; constexpr bool X = DQK == 192; constexpr bool PVSM = X ? (ATT_PVSM_B != 0) : (ATT_PVSM_A != 0);
  using St = Stage<bf16>; using SQ = Stage<TQ>;
  int tid_o = threadIdx.x; asm volatile("" : "+v"(tid_o));
  const int tid = tid_o, wid = __builtin_amdgcn_readfirstlane(tid >> 6), lane = tid & 63, r32 = lane & 31, hi = lane >> 5;
  bf16* V_lds = (bf16*)lds; bf16* K_lds = (bf16*)(lds + 3 * SHM_V);
  float* ws = (float*)(lds + 3 * SHM_V + 4 * SHM_K) + wid * 64; float* li_l = ws; float* al_l = ws + 32;
  float m_reg = -1e30f, l_reg = 0; f32x16 o[4] = {}; bf16x8 qr[NQR]; char* qx = lds + 3 * SHM_V + 4 * SHM_K + 2048 + wid * ((DQK / 16 - NQR) * 1024) + lane * 16;
  const TQ* Qw = Qb + (long)(wid * QBLK + r32) * LDQ + hi * 8;
#pragma unroll
  for (int d0 = 0; d0 < NQR; ++d0) qr[d0] = SQ::tobf(SQ::ld8(Qw + d0 * 16));
#pragma unroll
  for (int d0 = NQR; d0 < DQK / 16; ++d0) *reinterpret_cast<bf16x8*>(qx + (d0 - NQR) * 1024) = SQ::tobf(SQ::ld8(Qw + d0 * 16));
  const int vb0 = (int)(uintptr_t)V_lds + v_rd_base(lane);
  const unsigned ldsK = (unsigned)(uintptr_t)K_lds + wid * 1024u, ldsV = (unsigned)(uintptr_t)V_lds + wid * 1024u;
  const char* kg = (const char*)Kh; const char* vg = (const char*)Vh;
  unsigned koff = 0; const char* kp[3] = {nullptr, nullptr, nullptr}; unsigned kst[3] = {0, 0, 0};
  if constexpr (!X) { const int krow = 4 * wid + (lane >> 4); koff = (unsigned)(krow * (LDK * 2) + (((lane & 15) ^ KSWZK(krow, 256)) << 4)); }
  else {
#pragma unroll
    for (int i = 0; i < 3; ++i) { const int P = (wid + 8 * i) * 64 + lane, row = P / 24, slot = P - row * 24, cb = slot ^ KSWZK(row, 384);
      if (cb < 16) { kp[i] = (const char*)Kh + (size_t)row * (LDK * 2) + cb * 16; kst[i] = 64 * LDK * 2; }
      else { kp[i] = (const char*)K2h + (size_t)row * (LDK2 * 2) + (cb - 16) * 16; kst[i] = 64 * LDK2 * 2; } } }
  unsigned voff; { const int st = 2 * wid + (lane >> 5), kk = (st >> 2) * 8 + ((lane & 31) >> 2), k = (kk & ~0xC) | ((kk & 4) << 1) | ((kk & 8) >> 1), c = (st & 3) * 32 + (lane & 3) * 8;
    voff = (unsigned)(k * (LDK * 2) + c * 2); }
#define GLDS(g, l) __builtin_amdgcn_global_load_lds((const unsigned*)(g), (LAS unsigned*)(l), 16, 0, 0)
#define DMAK(bi) do { const unsigned kd_ = ldsK + (bi) * (unsigned)SHM_K; \
    if constexpr (!X) { GLDS(kg + koff, kd_); GLDS(kg + 32 * LDK * 2 + koff, kd_ + 8192); kg += 64 * LDK * 2; } \
    else { _Pragma("unroll") for (int i_ = 0; i_ < 3; ++i_) { GLDS(kp[i_], kd_ + i_ * 8192); kp[i_] += kst[i_]; } } } while (0)
#define DMAV(bi) do { const unsigned vd_ = ldsV + (bi) * (unsigned)SHM_V; GLDS(vg + voff, vd_); GLDS(vg + 32 * LDK * 2 + voff, vd_ + 8192); vg += 64 * LDK * 2; } while (0)
#define RESC(a) do { if (__any((a) < 1.f)) { if (hi == 0) al_l[r32] = (a); asm volatile("s_waitcnt lgkmcnt(0)" ::: "memory"); \
    for (int d = 0; d < 4; ++d) for (int r = 0; r < 16; ++r) o[d][r] *= al_l[crow(r, hi)]; } } while (0)
  f32x16 p0, p1; float mn, al; bf16x8 pa0, pa1, pa2, pa3; const int NT = seq / KVBLK; const int grp = wid >> 2;
  DMAK(0); DMAV(0); DMAK(1); DMAV(1); DMAK(2); asm volatile("s_waitcnt vmcnt(0)" ::: "memory"); __syncthreads();
  qkt<DQK, NQR>(p0, p1, K_lds, qr, r32, hi, qx);
  partialSM<DQK>(p0, p1, m_reg, mn, al); finishSM(p0, p1, al, l_reg, pa0, pa1, pa2, pa3);
  if (grp) __syncthreads();
  int vcur = 0, vnxt = 1, vwr = 2;
#define MSEG(t, FULL) do { \
    if (FULL || (t) + 3 < NT) DMAK(((t) + 3) & 3); if (FULL || (t) + 2 < NT) DMAV(vwr); \
    SBAR(); if (FULL || (t) + 1 < NT) qkt<DQK, NQR>(p0, p1, (bf16*)((char*)K_lds + (((t) + 1) & 3) * SHM_K), qr, r32, hi, qx); \
    pv_d0(o, vb0 + vcur * (int)SHM_V, pa0, pa1, pa2, pa3); \
    if (FULL || (t) + 3 < NT) { if constexpr (X) asm volatile("s_waitcnt vmcnt(5)" ::: "memory"); else asm volatile("s_waitcnt vmcnt(4)" ::: "memory"); } \
    else if ((t) + 2 < NT) asm volatile("s_waitcnt vmcnt(2)" ::: "memory"); else asm volatile("s_waitcnt vmcnt(0)" ::: "memory"); \
    __syncthreads(); { const int c_ = vcur; vcur = vnxt; vnxt = vwr; vwr = c_; } } while (0)
#define SSEG(t, FULL) do { \
    if (FULL || (t) + 1 < NT) { partialSM<DQK>(p0, p1, m_reg, mn, al); RESC(al); finishSM(p0, p1, al, l_reg, pa0, pa1, pa2, pa3); } \
    __syncthreads(); } while (0)
  int t = 0;
  for (; t + 3 < NT; ++t) { MSEG(t, 1); SSEG(t, 1); }
  for (; t < NT; ++t) { MSEG(t, 0); SSEG(t, 0); }
  if (!grp) __syncthreads();
#undef MSEG
#undef SSEG
  if (hi == 0) li_l[r32] = l_reg; asm volatile("s_waitcnt lgkmcnt(0)" ::: "memory");
  float rli[16];
#pragma unroll
  for (int r = 0; r < 16; ++r) rli[r] = __builtin_amdgcn_rcpf(li_l[crow(r, hi)]);
  __syncthreads();
  {
    char* ep = lds + wid * 8704;
    int lane_e = hi * 4 * 272 + r32 * 2; asm volatile("" : "+v"(lane_e));
#pragma unroll
    for (int r = 0; r < 16; ++r) { const int ro = ((r & 3) + 8 * (r >> 2)) * 272;
#pragma unroll
      for (int d0 = 0; d0 < 4; ++d0) *(unsigned short*)(ep + lane_e + ro + d0 * 64) = (unsigned short)(cvtpk(o[d0][r] * rli[r], 0.f) & 0xffffu); }
    asm volatile("s_waitcnt lgkmcnt(0)" ::: "memory");
    int lane_q = lane; asm volatile("" : "+v"(lane_q));
    const int row0 = lane_q >> 4, ch = lane_q & 15;
    unsigned short* Yw = Ob + (long)(wid * QBLK + row0) * LDO + ch * 8; const unsigned short* Gw = Gb + (long)(wid * QBLK + row0) * LDO + ch * 8;
#pragma unroll
    for (int hf = 0; hf < 2; ++hf) { u32x4 gv[4], ov[4];
#pragma unroll
      for (int i = 0; i < 4; ++i) gv[i] = *(const u32x4*)(Gw + (long)(4 * (4 * hf + i)) * LDO);
#pragma unroll
      for (int i = 0; i < 4; ++i) ov[i] = *(const u32x4*)(ep + (row0 + 4 * (4 * hf + i)) * 272 + ch * 16);
#pragma unroll
      for (int i = 0; i < 4; ++i) { u32x4 w;
#pragma unroll
        for (int j = 0; j < 4; ++j) { const float lo = __uint_as_float(ov[i][j] << 16) * __uint_as_float(gv[i][j] << 16), hi2 = __uint_as_float(ov[i][j] & 0xffff0000u) * __uint_as_float(gv[i][j] & 0xffff0000u); w[j] = cvtpk(lo, hi2); }
        *(u32x4*)(Yw + (long)(4 * (4 * hf + i)) * LDO) = w; }
      asm volatile("" ::: "memory"); }
  }
  __syncthreads();
#undef DMAK
#undef DMAV
#undef GLDS
#undef RESC
}

}

#ifndef ATT_DMA_A
#define ATT_DMA_A 0
#endif
#ifndef ATT_DMA_B
#define ATT_DMA_B 0
#endif
#ifndef ATT_PP
#define ATT_PP 1
#endif
#if ATT_PP
#define ATT_BODY attn_dense_body_pp
#ifndef ATT_NQR_A
#define ATT_NQR_A 8
#endif
#elif ATT_DMA_A
#define ATT_BODY attn_dense_body_dma
#ifndef ATT_NQR_A
#define ATT_NQR_A 8
#endif
#else
#define ATT_BODY attn_dense_body
#endif
#if ATT_DMA_B
#define ATT_BODY_B attn_dense_body_dma
#ifndef ATT_NQR_B
#define ATT_NQR_B 11
#endif
#else
#define ATT_BODY_B attn_dense_body
#endif
#ifndef ATT_NQR_A
#define ATT_NQR_A 6
#endif
#ifndef ATT_NQR_B
#define ATT_NQR_B 10
#endif
#ifndef ATT_SD_A
#define ATT_SD_A 2
#endif
#ifndef ATT_SD_B
#define ATT_SD_B 1
#endif
__device__ __forceinline__ void attn_phase(const Frame& F, const Args& a, unsigned char* lds_generic) {
    unsigned char* ws = a.ws;
    const bf16_t* A1 = (const bf16_t*)(ws + WS_A1); const bf16_t* QB = (const bf16_t*)(ws + WS_QB); const bf16_t* KVB = (const bf16_t*)(ws + WS_KVB);
    const bf16_t* KRb = (const bf16_t*)(ws + WS_KR); const bf16_t* G0 = (const bf16_t*)(ws + WS_G0); bf16_t* Y0 = (bf16_t*)(ws + WS_Y0);
    char* lds = (char*)lds_generic;
    const int x = F.bid & 7, slot = F.bid >> 3;
    for (int ii = 0; ii < ((a.var & 1) ? 0 : 5); ++ii) {
        int b, hd, q0, kb, seq;
        if (ii < 4) { const int i = (ii & 1) + 4 * (ii >> 1); const int p = i * 8 + x; b = p >> 5; hd = p & 31; q0 = b * SB + slot * 256; kb = b * SB; seq = SB; }
        else { if (F.bid >= 32) break; b = F.bid >> 4; hd = F.bid & 15; q0 = b * SB + S; kb = q0; seq = CTX; }
        att::ATT_BODY<att::bf16, 3072, 3072, 4096, 128, 64, ATT_SD_A, ATT_NQR_A>(A1 + (size_t)q0 * 3072 + hd * 128, A1 + (size_t)kb * 3072 + 2048 + (hd >> 2) * 128, nullptr,
                            A1 + (size_t)kb * 3072 + 2560 + (hd >> 2) * 128, Y0 + (size_t)q0 * 4096 + hd * 128, G0 + (size_t)q0 * 4096 + hd * 128, seq, lds);
        __syncthreads();
    }
#ifdef ATT_PRB
    if (a.var & 4) for (int ii = 0; ii < 4; ++ii) {
        const int i = (ii & 1) + 4 * (ii >> 1); const int p = i * 8 + x; const int b = p >> 5, hd = p & 31, q0 = b * SB + slot * 256, kb = b * SB;
        att::attn_dense_body<att::bf16, 3072, 3072, 4096, 128, 64, ATT_SD_A, ATT_NQR_A, ATT_PRB>(A1 + (size_t)q0 * 3072 + hd * 128, A1 + (size_t)kb * 3072 + 2048 + (hd >> 2) * 128, nullptr,
                            A1 + (size_t)kb * 3072 + 2560 + (hd >> 2) * 128, Y0 + (size_t)q0 * 4096 + hd * 128, G0 + (size_t)q0 * 4096 + hd * 128, SB, lds);
        __syncthreads();
    }
#endif
    for (int ii = 0; ii < ((a.var & 2) ? 0 : 5); ++ii) {
        int b, h, q0, kb, seq;
        if (ii < 4) { const int i = 2 + (ii & 1) + 4 * (ii >> 1); const int p = i * 8 + x; b = p >> 5; h = (p & 31) - 16; q0 = b * SB + slot * 256; kb = b * SB; seq = SB; }
        else { if (F.bid >= 32) break; b = F.bid >> 4; h = F.bid & 15; q0 = b * SB + S; kb = q0; seq = CTX; }
        att::ATT_BODY_B<att::bf16, 3072, 4096, 4096, 192, 64, ATT_SD_B, ATT_NQR_B>(QB + (size_t)q0 * 3072 + h * 192, KVB + (size_t)kb * 4096 + h * 256, KRb + (size_t)kb * 64,
                            KVB + (size_t)kb * 4096 + h * 256 + 128, Y0 + (size_t)q0 * 4096 + 2048 + h * 128, G0 + (size_t)q0 * 4096 + 2048 + h * 128, seq, lds);
        __syncthreads();
    }
}
}
namespace fk {
constexpr int NCH = SB / 64;
constexpr int NC2_ = SB / 32;
struct EpiL1 {
    static constexpr bool PERM = true;
    bf16_t* QK1; bf16_t* VT; bf16_t* U1; bf16_t* G1; float* GD; int skip; LAS unsigned char* vx;
    __device__ __forceinline__ void operator()(const f32x4 (&acc)[2][2][4][2], const Unit& u, int wr, int wc, int fr, int fq) const {
        if (skip) return;
        const int pn = u.pn; const int rowl0 = wr * 64 + fr; const size_t row0 = (size_t)u.pm * 256 + rowl0; const int cl = wc * 32 + 8 * fq;
        if (pn >= 12 && pn < 24) {
            const int b = u.pm / PPB, pb = u.pm % PPB; const int cv = (pn - 12) * 256, h = cv >> 9; const int lane = fq * 16 + fr;
            LAS bf16_t* w = (LAS bf16_t*)(vx + (wr * 4 + wc) * 2048);
#pragma unroll
            for (int ai = 0; ai < 2; ++ai)
#pragma unroll
                for (int bj = 0; bj < 2; ++bj)
#pragma unroll
                    for (int mh = 0; mh < 2; ++mh) {
#pragma unroll
                        for (int mm = 0; mm < 2; ++mm) { const int m = 2 * mh + mm; const f32x4 x0 = acc[ai][bj][m][0], x1 = acc[ai][bj][m][1]; const int tl = 16 * mm + fr;
#pragma unroll
                            for (int j = 0; j < 4; ++j) { w[(8 * fq + j) * 32 + tl] = (bf16_t)(cvt_pk_bf16(x0[j], 0.f) & 0xffffu); w[(8 * fq + 4 + j) * 32 + tl] = (bf16_t)(cvt_pk_bf16(x1[j], 0.f) & 0xffffu); } }
                        LDS_WAIT(); asm volatile("" ::: "memory");
                        const int c32 = pb * 8 + 4 * ai + 2 * wr + mh; const int e0 = (cv & 511) + bj * 128 + wc * 32;
                        bf16_t* dst = VT + ((size_t)((b * 6 + h) * NC2_ + c32) * 512 + e0) * 32;
#pragma unroll
                        for (int i = 0; i < 2; ++i) { const int q = lane + 64 * i, el = q >> 2, tc = q & 3; *(u32x4*)(dst + el * 32 + tc * 8) = *(const LAS u32x4*)(w + el * 32 + tc * 8); }
                        LDS_WAIT(); asm volatile("" ::: "memory");
                    }
        } else if (pn < 28) {
            bf16_t* base; int ld, c0;
            if (pn < 12) { base = QK1; ld = 3072; c0 = pn * 256; } else { base = U1; ld = 1024; c0 = (pn - 24) * 256; }
#pragma unroll
            for (int ai = 0; ai < 2; ++ai)
#pragma unroll
                for (int m = 0; m < 4; ++m)
#pragma unroll
                    for (int bj = 0; bj < 2; ++bj) *(u32x4*)(base + (row0 + ai * 128 + 16 * m) * ld + c0 + bj * 128 + cl) = pack8(acc[ai][bj][m][0], acc[ai][bj][m][1]);
        } else if (pn < 44) {
#pragma unroll
            for (int ai = 0; ai < 2; ++ai)
#pragma unroll
                for (int m = 0; m < 4; ++m)
#pragma unroll
                    for (int bj = 0; bj < 2; ++bj) { f32x4 x0 = acc[ai][bj][m][0], x1 = acc[ai][bj][m][1];
#pragma unroll
                        for (int i = 0; i < 4; ++i) { x0[i] = fast_silu(x0[i]); x1[i] = fast_silu(x1[i]); }
                        *(u32x4*)(G1 + (row0 + ai * 128 + 16 * m) * 4096 + (pn - 28) * 256 + bj * 128 + cl) = pack8(x0, x1); }
        } else {
            if (wc == 0) {
#pragma unroll
                for (int ai = 0; ai < 2; ++ai)
#pragma unroll
                    for (int m = 0; m < 4; ++m) { float* g = GD + (row0 + ai * 128 + 16 * m) * 32 + 8 * fq; *(f32x4*)g = acc[ai][0][m][0]; *(f32x4*)(g + 4) = acc[ai][0][m][1]; } }
        }
    }
};
struct EpiPlain {
    static constexpr bool PERM = true;
    bf16_t* O; int ld;
    __device__ __forceinline__ void operator()(const f32x4 (&acc)[2][2][4][2], const Unit& u, int wr, int wc, int fr, int fq) const {
        const size_t row0 = (size_t)u.pm * 256 + wr * 64 + fr; const int c0 = u.pn * 256 + wc * 32 + 8 * fq;
#pragma unroll
        for (int ai = 0; ai < 2; ++ai)
#pragma unroll
            for (int m = 0; m < 4; ++m)
#pragma unroll
                for (int bj = 0; bj < 2; ++bj) *(u32x4*)(O + (row0 + ai * 128 + 16 * m) * ld + c0 + bj * 128) = pack8(acc[ai][bj][m][0], acc[ai][bj][m][1]);
    }
};
struct OrderFn {
    int bid;
    __device__ bool next(int i, Unit& u) const { if (i >= 1) return false; const int half = bid >> 7, t = bid & 127; u.pm = (t >> 3) + 16 * half; u.pn = (t & 7) + 8 * half; u.ko = 0; return true; }
};
struct EpiPcs {
    static constexpr bool PERM = true;
    bf16_t* P; float scale;
    __device__ __forceinline__ void operator()(const f32x4 (&acc)[2][2][4][2], const Unit& u, int wr, int wc, int fr, int fq) const {
        const size_t row0 = (size_t)(u.pm >> 4) * 4096 + (size_t)(u.pm & 15) * 256 + wr * 64 + fr; const int c0 = (u.pn & 7) * 256 + wc * 32 + 8 * fq;
#pragma unroll
        for (int ai = 0; ai < 2; ++ai)
#pragma unroll
            for (int m = 0; m < 4; ++m)
#pragma unroll
                for (int bj = 0; bj < 2; ++bj) *(u32x4*)(P + (row0 + ai * 128 + 16 * m) * 2048 + c0 + bj * 128) = pack8(acc[ai][bj][m][0] * scale, acc[ai][bj][m][1] * scale);
    }
};
__device__ __forceinline__ void fold_phase(const Frame& F, const bf16_t* AB, bf16_t* BF, int w0, int nw) {
    const int gw = F.bid * NWAVES + F.wave - w0; if (gw < 0 || gw >= nw) return;
    LAS float* scr = (LAS float*)(F.lds + 4096 + F.wave * (64 * 65 * 4));
    const int lane = F.lane, rr = lane >> 3, c8 = (lane & 7) * 8;
    for (int it = gw; it < 2 * 2 * 66 * 16; it += nw) {
        const int half = it / 2112, r0 = it % 2112, b = r0 / 1056, r = r0 % 1056, kb = r / 16, cb = r % 16;
        const int ch = cb * 64 + c8, g = ch >> 8, l = ch & 255;
        const bf16_t* base = AB + (size_t)b * SB * 2048 + g * 512 + half * 256 + l;
        u32x4 p0[8], p1[8];
#pragma unroll
        for (int jj = 0; jj < 8; ++jj) { const int kk = kb * 64 + jj * 8 + rr; const u32x4 z = {0u, 0u, 0u, 0u};
            const bool v0 = half == 0 ? (kk <= 4096) : (kk >= 1 && kk <= 4095), v1 = (kk >= 1 && kk <= 4095);
            p0[jj] = v0 ? *(const u32x4*)(base + (size_t)kk * 2048) : z; p1[jj] = v1 ? *(const u32x4*)(base + (size_t)(8192 - kk) * 2048) : z; }
        const float sg = half == 0 ? 1.f : -1.f;
#pragma unroll
        for (int jj = 0; jj < 8; ++jj) { const int j = jj * 8 + rr; LAS float* dst = scr + j * 65 + c8;
            const unsigned a[4] = {p0[jj].x, p0[jj].y, p0[jj].z, p0[jj].w}, m[4] = {p1[jj].x, p1[jj].y, p1[jj].z, p1[jj].w};
#pragma unroll
            for (int i = 0; i < 4; ++i) { dst[2 * i] = bf_lo(a[i]) + sg * bf_lo(m[i]); dst[2 * i + 1] = bf_hi(a[i]) + sg * bf_hi(m[i]); } }
        LDS_WAIT(); asm volatile("" ::: "memory");
#pragma unroll
        for (int t = 0; t < 8; ++t) { const int cr = (lane >> 3) + 8 * t, k8 = (lane & 7) * 8; float v[8];
#pragma unroll
            for (int i = 0; i < 8; ++i) v[i] = scr[(k8 + i) * 65 + cr];
            u32x4 o; o.x = cvt_pk_bf16(v[0], v[1]); o.y = cvt_pk_bf16(v[2], v[3]); o.z = cvt_pk_bf16(v[4], v[5]); o.w = cvt_pk_bf16(v[6], v[7]);
            *(u32x4*)(BF + ((size_t)half * 2048 + b * 1024 + cb * 64 + cr) * FKP + kb * 64 + k8) = o; }
        LDS_WAIT(); asm volatile("" ::: "memory");
    }
}
__device__ __forceinline__ void f4096_phase(const Frame& F, const bf16_t* AB, float* F4, int item, float scale) {
    const int b = item >> 4, cb = item & 15, lane = F.lane, rr = lane >> 3, c8 = (lane & 7) * 8;
    const int ch = cb * 64 + c8, g = ch >> 8, l = ch & 255;
    const bf16_t* base = AB + ((size_t)b * SB + F.wave * 1024 + rr) * 2048 + g * 512 + l;
    float acc[8] = {0.f, 0.f, 0.f, 0.f, 0.f, 0.f, 0.f, 0.f};
#pragma unroll 8
    for (int i = 0; i < 128; ++i) { const u32x4 v = *(const u32x4*)(base + (size_t)(8 * i) * 2048);
        acc[0] += bf_lo(v.x); acc[1] += bf_hi(v.x); acc[2] += bf_lo(v.y); acc[3] += bf_hi(v.y); acc[4] += bf_lo(v.z); acc[5] += bf_hi(v.z); acc[6] += bf_lo(v.w); acc[7] += bf_hi(v.w); }
    const float sg = (rr & 1) ? -1.f : 1.f;
#pragma unroll
    for (int i = 0; i < 8; ++i) { float v = acc[i] * sg; v += __shfl_xor(v, 8); v += __shfl_xor(v, 16); v += __shfl_xor(v, 32); acc[i] = v; }
    LAS float* red = (LAS float*)F.lds;
    __syncthreads();
    if (lane < 8) {
#pragma unroll
        for (int i = 0; i < 8; ++i) red[F.wave * 64 + lane * 8 + i] = acc[i]; }
    __syncthreads();
    if (F.tid < 64) { float s = 0.f;
#pragma unroll
        for (int w = 0; w < 8; ++w) s += red[w * 64 + F.tid];
        F4[b * 1024 + cb * 64 + F.tid] = s * scale; }
    __syncthreads();
}
__device__ __forceinline__ void fnet_finish_phase(const Frame& F, const bf16_t* PCS, const float* F4, const bf16_t* G1, bf16_t* Y1) {
    const int gw = F.bid * NWAVES + F.wave, NGW = F.G * NWAVES; const int ch = F.lane * 16;
    for (int it = gw; it < 2 * 1024; it += NGW) { const int b = it >> 10, k0 = (it & 1023) * 4;
        u32x4 pc[4][2], ps[4][2], ga[4][2], gb[4][2];
#pragma unroll
        for (int i = 0; i < 4; ++i) { const int k = k0 + i; const int km = k ? 8192 - k : 0;
#pragma unroll
            for (int hh = 0; hh < 2; ++hh) { pc[i][hh] = *(const u32x4*)(PCS + (size_t)k * 2048 + b * 1024 + ch + hh * 8); ps[i][hh] = *(const u32x4*)(PCS + (size_t)(4096 + k) * 2048 + b * 1024 + ch + hh * 8);
                ga[i][hh] = *(const u32x4*)(G1 + ((size_t)b * SB + k) * 4096 + 3072 + ch + hh * 8); gb[i][hh] = *(const u32x4*)(G1 + ((size_t)b * SB + km) * 4096 + 3072 + ch + hh * 8); } }
#pragma unroll
        for (int i = 0; i < 4; ++i) { const int k = k0 + i; const size_t ya = ((size_t)b * SB + k) * 4096 + 3072 + ch, yb = ((size_t)b * SB + (8192 - k)) * 4096 + 3072 + ch;
#pragma unroll
            for (int hh = 0; hh < 2; ++hh) { u32x4 oa, ob;
#pragma unroll
                for (int j = 0; j < 4; ++j) { const float cl = bf_lo(pc[i][hh][j]), chh = bf_hi(pc[i][hh][j]), sl = bf_lo(ps[i][hh][j]), sh = bf_hi(ps[i][hh][j]);
                    oa[j] = cvt_pk_bf16((cl - sl) * bf_lo(ga[i][hh][j]), (chh - sh) * bf_hi(ga[i][hh][j])); ob[j] = cvt_pk_bf16((cl + sl) * bf_lo(gb[i][hh][j]), (chh + sh) * bf_hi(gb[i][hh][j])); }
                *(u32x4*)(Y1 + ya + hh * 8) = oa; if (k) *(u32x4*)(Y1 + yb + hh * 8) = ob; } }
    }
    if (gw < 2) { const int b = gw; const size_t ya = ((size_t)b * SB + 4096) * 4096 + 3072 + ch;
#pragma unroll
        for (int hh = 0; hh < 2; ++hh) { const u32x4 g = *(const u32x4*)(G1 + ya + hh * 8); const f32x4 f0 = *(const f32x4*)(F4 + b * 1024 + ch + hh * 8), f1 = *(const f32x4*)(F4 + b * 1024 + ch + hh * 8 + 4);
            f32x4 x0 = f0, x1 = f1; x0[0] *= bf_lo(g.x); x0[1] *= bf_hi(g.x); x0[2] *= bf_lo(g.y); x0[3] *= bf_hi(g.y); x1[0] *= bf_lo(g.z); x1[1] *= bf_hi(g.z); x1[2] *= bf_lo(g.w); x1[3] *= bf_hi(g.w);
            *(u32x4*)(Y1 + ya + hh * 8) = pack8(x0, x1); } }
}
__device__ __forceinline__ void gla_finish_phase(const Frame& F, const bf16_t* O0, const bf16_t* O1, const bf16_t* O2, const bf16_t* O3, const bf16_t* G1, const float* on_g, bf16_t* Y1) {
    const int base = F.bid * (NB * S / 256);
    const f32x4 o0 = *(const f32x4*)(on_g + F.lane * 8), o1 = *(const f32x4*)(on_g + F.lane * 8 + 4);
    for (int i0 = F.wave; i0 < NB * S / 256; i0 += 8) {
        const int ml = base + i0; const size_t row = (size_t)(ml / S) * SB + (ml % S);
        u32x4 pa[6], pb[6], pc[6], pd[6], gg[6];
#pragma unroll
        for (int h = 0; h < 6; ++h) { const size_t ix = row * 3072 + h * 512 + F.lane * 8;
            pa[h] = *(const u32x4*)(O0 + ix); pb[h] = *(const u32x4*)(O1 + ix); pc[h] = *(const u32x4*)(O2 + ix); pd[h] = *(const u32x4*)(O3 + ix);
            gg[h] = *(const u32x4*)(G1 + row * 4096 + h * 512 + F.lane * 8); }
#pragma unroll
        for (int h = 0; h < 6; ++h) { float v[8];
#pragma unroll
            for (int j = 0; j < 4; ++j) { v[2 * j] = (bf_lo(pa[h][j]) + bf_lo(pb[h][j])) + (bf_lo(pc[h][j]) + bf_lo(pd[h][j])); v[2 * j + 1] = (bf_hi(pa[h][j]) + bf_hi(pb[h][j])) + (bf_hi(pc[h][j]) + bf_hi(pd[h][j])); }
            float ss = 0.f;
#pragma unroll
            for (int i = 0; i < 8; ++i) ss += v[i] * v[i];
            const float rs = 1.0f / sqrtf(wave_sum(ss) * (1.f / 512.f) + EPS);
            f32x4 x0 = (f32x4){v[0], v[1], v[2], v[3]} * rs * o0, x1 = (f32x4){v[4], v[5], v[6], v[7]} * rs * o1; const u32x4 g = gg[h];
            x0[0] *= bf_lo(g.x); x0[1] *= bf_hi(g.x); x0[2] *= bf_lo(g.y); x0[3] *= bf_hi(g.y); x1[0] *= bf_lo(g.z); x1[1] *= bf_hi(g.z); x1[2] *= bf_lo(g.w); x1[3] *= bf_hi(g.w);
            *(u32x4*)(Y1 + row * 4096 + h * 512 + F.lane * 8) = pack8(x0, x1); }
    }
}
__device__ __forceinline__ void final_norm_b_phase(const Frame& F, const bf16_t* src, float* out, const float* fg) {
    const int base = F.bid * (NB * S / 256);
    for (int i0 = F.wave; i0 < NB * S / 256; i0 += 16) {
        const int rot = (F.bid * 5) & 63;
        const size_t ra = (size_t)(base + ((i0 + rot) & 63)) * D, rb = (size_t)(base + ((i0 + 8 + rot) & 63)) * D;
        const u32x2* xa = (const u32x2*)(src + ra) + F.lane; const u32x2* xb = (const u32x2*)(src + rb) + F.lane;
        u32x2 wa[16], wb[16]; float sa = 0.f, sb = 0.f;
#pragma unroll
        for (int j = 0; j < 16; ++j) wa[j] = __builtin_nontemporal_load(xa + 64 * j);
#pragma unroll
        for (int j = 0; j < 16; ++j) wb[j] = __builtin_nontemporal_load(xb + 64 * j);
#pragma unroll
        for (int j = 0; j < 16; ++j) { const float a0 = bf_lo(wa[j].x), a1 = bf_hi(wa[j].x), a2 = bf_lo(wa[j].y), a3 = bf_hi(wa[j].y); sa += (a0 * a0 + a1 * a1) + (a2 * a2 + a3 * a3); }
#pragma unroll
        for (int j = 0; j < 16; ++j) { const float a0 = bf_lo(wb[j].x), a1 = bf_hi(wb[j].x), a2 = bf_lo(wb[j].y), a3 = bf_hi(wb[j].y); sb += (a0 * a0 + a1 * a1) + (a2 * a2 + a3 * a3); }
        const float rsa = 1.0f / sqrtf(wave_sum(sa) * (1.f / D) + EPS), rsb = 1.0f / sqrtf(wave_sum(sb) * (1.f / D) + EPS);
        f32x4* oa = (f32x4*)(out + ra) + F.lane; f32x4* ob = (f32x4*)(out + rb) + F.lane;
#pragma unroll
        for (int j = 0; j < 16; ++j) { const f32x4 gg = *(const f32x4*)(fg + 4 * (F.lane + 64 * j));
            const f32x4 va = {bf_lo(wa[j].x), bf_hi(wa[j].x), bf_lo(wa[j].y), bf_hi(wa[j].y)}, vb = {bf_lo(wb[j].x), bf_hi(wb[j].x), bf_lo(wb[j].y), bf_hi(wb[j].y)};
            __builtin_nontemporal_store(va * rsa * gg, oa + 64 * j); __builtin_nontemporal_store(vb * rsb * gg, ob + 64 * j); }
    }
}
__device__ __forceinline__ void final_norm_phase(const Frame& F, float* out, const float* fg) {
    const int base = F.bid * (NB * S / 256);
    for (int i0 = F.wave; i0 < NB * S / 256; i0 += 16) {
        const int rot = (F.bid * 5) & 63;
        f32x4* xa = (f32x4*)(out + (size_t)(base + ((i0 + rot) & 63)) * D) + F.lane; f32x4* xb = (f32x4*)(out + (size_t)(base + ((i0 + 8 + rot) & 63)) * D) + F.lane;
        f32x4 va[16], vb[16]; float sa = 0.f, sb = 0.f;
#pragma unroll
        for (int j = 0; j < 16; ++j) va[j] = __builtin_nontemporal_load(xa + 64 * j);
#pragma unroll
        for (int j = 0; j < 16; ++j) vb[j] = __builtin_nontemporal_load(xb + 64 * j);
#pragma unroll
        for (int j = 0; j < 16; ++j) sa += (va[j].x * va[j].x + va[j].y * va[j].y) + (va[j].z * va[j].z + va[j].w * va[j].w);
#pragma unroll
        for (int j = 0; j < 16; ++j) sb += (vb[j].x * vb[j].x + vb[j].y * vb[j].y) + (vb[j].z * vb[j].z + vb[j].w * vb[j].w);
        const float rsa = 1.0f / sqrtf(wave_sum(sa) * (1.f / D) + EPS), rsb = 1.0f / sqrtf(wave_sum(sb) * (1.f / D) + EPS);
#pragma unroll
        for (int j = 0; j < 16; ++j) { const f32x4 gg = *(const f32x4*)(fg + 4 * (F.lane + 64 * j)); __builtin_nontemporal_store(va[j] * rsa * gg, xa + 64 * j); __builtin_nontemporal_store(vb[j] * rsb * gg, xb + 64 * j); }
    }
}
}
namespace fk {
constexpr int NC2 = SB / 32;
__device__ __forceinline__ size_t gla_idx2(int dir, int b, int h, int c) { return (size_t)(((dir * 2 + b) * 6 + h) * NC2 + c); }
__device__ __forceinline__ int swz4(int x) { return (0x1320 >> (4 * x)) & 3; }
__device__ __forceinline__ void gla_prep_unit(const Frame& F, const Args& a, int b, int h, int ci) {
    unsigned char* ws = a.ws;
    const bf16_t* QK1 = (const bf16_t*)(ws + WS_QK1); const float* GD = (const float*)(ws + WS_GD);
    bf16_t* QT = (bf16_t*)(ws + WS_QT); bf16_t* KT = (bf16_t*)(ws + WS_KT); bf16_t* AT = (bf16_t*)(ws + WS_AT); float* GAM = (float*)(ws + WS_GAM);
    const int tid = F.tid, lane = F.lane, wid = F.wave;
    const size_t r0 = (size_t)b * SB + 64 * ci;
    LAS float* gds = (LAS float*)(F.lds);
    LAS bf16_t* qs = (LAS bf16_t*)(F.lds + 8192);
    LAS bf16_t* ks = (LAS bf16_t*)(F.lds + 8192 + 33792);
    LAS bf16_t* ktl = (LAS bf16_t*)(F.lds + 8192 + 2 * 33792);
    __syncthreads();
    *(LAS f32x4*)(gds + tid * 4) = *(const f32x4*)(GD + (r0 + (tid >> 3)) * 32 + (tid & 7) * 4);
    __syncthreads();
    if (a.var & 8) return;
    const int r32 = lane & 31, hi = lane >> 5, d = 32 * wid + r32;
#pragma unroll
    for (int dir = 0; dir < 2; ++dir) {
        constexpr float L2E = 1.4426950408889634f;
        const float* wg = a.in[dir ? 18 : 16] + h * 256 + d; const float bias = a.in[dir ? 19 : 17][h * 256 + d] * L2E;
        float wgv[8];
#pragma unroll
        for (int kk = 0; kk < 8; ++kk) wgv[kk] = wg[(2 * kk + hi) * 1536] * L2E;
        u32x4 rq[4], rk[4];
#pragma unroll
        for (int i = 0; i < 4; ++i) { const int q = tid + 512 * i, tok = q >> 5, dc = q & 31; const bf16_t* src = QK1 + (r0 + tok) * 3072 + h * 256 + dc * 8;
            rq[i] = *(const u32x4*)src; rk[i] = *(const u32x4*)(src + 1536); }
        float cum[2][16], last[2];
#pragma unroll
        for (int tt = 0; tt < 2; ++tt) {
            f32x16 z;
#pragma unroll
            for (int r = 0; r < 16; ++r) z[r] = bias;
            const LAS float* gp = gds + (tt * 32 + r32) * 32 + 16 * dir + hi;
#pragma unroll
            for (int kk = 0; kk < 8; ++kk) z = __builtin_amdgcn_mfma_f32_32x32x2f32(gp[2 * kk], wgv[kk], z, 0, 0, 0);
            float lg[16];
#pragma unroll
            for (int r = 0; r < 16; ++r) lg[r] = (fminf(z[r], 0.f) - __builtin_amdgcn_logf(1.f + __builtin_amdgcn_exp2f(-fabsf(z[r])))) * 0.0625f;
            float T[4], PT[4];
#pragma unroll
            for (int q = 0; q < 4; ++q) {
                if (dir == 0) { lg[4 * q + 1] += lg[4 * q]; lg[4 * q + 2] += lg[4 * q + 1]; lg[4 * q + 3] += lg[4 * q + 2]; T[q] = lg[4 * q + 3]; }
                else { lg[4 * q + 2] += lg[4 * q + 3]; lg[4 * q + 1] += lg[4 * q + 2]; lg[4 * q] += lg[4 * q + 1]; T[q] = lg[4 * q]; }
                PT[q] = __shfl_xor(T[q], 32); }
            float offs[4];
            if (dir == 0) { float run = 0.f;
#pragma unroll
                for (int q = 0; q < 4; ++q) { const float t0 = hi ? PT[q] : T[q], t1 = hi ? T[q] : PT[q]; offs[q] = run + (hi ? t0 : 0.f); run += t0 + t1; }
                last[tt] = run; }
            else { float run = 0.f;
#pragma unroll
                for (int q = 3; q >= 0; --q) { const float t0 = hi ? PT[q] : T[q], t1 = hi ? T[q] : PT[q]; offs[q] = run + (hi ? 0.f : t1); run += t0 + t1; }
                last[tt] = run; }
#pragma unroll
            for (int r = 0; r < 16; ++r) cum[tt][r] = lg[r] + offs[r >> 2];
        }
#pragma unroll
        for (int i = 0; i < 4; ++i) { const int q = tid + 512 * i, tok = q >> 5, dc = q & 31; *(LAS u32x4*)(qs + tok * 264 + dc * 8) = rq[i]; *(LAS u32x4*)(ks + tok * 264 + dc * 8) = rk[i]; }
        float el[2];
#pragma unroll
        for (int tt = 0; tt < 2; ++tt) { el[tt] = __builtin_amdgcn_exp2f(last[tt]); if (hi == 0) GAM[gla_idx2(dir, b, h, 2 * ci + tt) * 256 + d] = el[tt]; }
        __syncthreads();
#pragma unroll
        for (int tt = 0; tt < 2; ++tt)
#pragma unroll
            for (int j = 0; j < 8; ++j) { float kh2[2]; const int tl0 = ((2 * j) & 3) + 8 * ((2 * j) >> 2) + 4 * hi;
#pragma unroll
                for (int u = 0; u < 2; ++u) { const int t = 32 * tt + tl0 + u; const float e1 = __builtin_amdgcn_exp2f(cum[tt][2 * j + u]), e2 = __builtin_amdgcn_rcpf(e1);
                    const float qv = bf2f(qs[t * 264 + d]), kv = bf2f(ks[t * 264 + d]); const float kt = kv * e2;
                    qs[t * 264 + d] = (bf16_t)(cvt_pk_bf16(qv * e1, 0.f) & 0xffffu); ks[t * 264 + d] = (bf16_t)(cvt_pk_bf16(kt, 0.f) & 0xffffu); kh2[u] = kt * el[tt]; }
                *(LAS unsigned*)(ktl + (tt * 256 + d) * 34 + tl0) = cvt_pk_bf16(kh2[0], kh2[1]); }
        __syncthreads();
#pragma unroll
        for (int i = 0; i < 4; ++i) { const int q = tid + 512 * i, t2 = q >> 10, rem = q & 1023, dd = rem >> 2, c4 = rem & 3; const LAS unsigned* src = (const LAS unsigned*)(ktl + (t2 * 256 + dd) * 34 + c4 * 8);
            *(u32x4*)(KT + gla_idx2(dir, b, h, 2 * ci + t2) * 8192 + dd * 32 + c4 * 8) = (u32x4){src[0], src[1], src[2], src[3]}; }
#pragma unroll
        for (int i = 0; i < 4; ++i) { const int q = tid + 512 * i, t2 = q >> 10, rem = q & 1023, tl = rem >> 5, pc = rem & 31, blk = pc >> 2, gg = pc & 3;
            const LAS u32x2* s0 = (const LAS u32x2*)(qs + (32 * t2 + tl) * 264 + blk * 32 + 4 * gg); const LAS u32x2* s1 = (const LAS u32x2*)(qs + (32 * t2 + tl) * 264 + blk * 32 + 16 + 4 * gg);
            const u32x2 lo = *s0, hi2 = *s1;
            *(u32x4*)(QT + gla_idx2(dir, b, h, 2 * ci + t2) * 8192 + (blk >> 2) * 4096 + tl * 128 + (pc & 15) * 8) = (u32x4){lo.x, lo.y, hi2.x, hi2.y}; }
        if (wid < 2) { f32x16 acc = {};
#pragma unroll
            for (int kk = 0; kk < 16; ++kk) { const bf16x8 A = *(const LAS bf16x8*)(qs + (wid * 32 + r32) * 264 + kk * 16 + hi * 8), Bv = *(const LAS bf16x8*)(ks + (wid * 32 + r32) * 264 + kk * 16 + hi * 8);
                acc = __builtin_amdgcn_mfma_f32_32x32x16_bf16(A, Bv, acc, 0, 0, 0); }
            bf16_t* at = AT + gla_idx2(dir, b, h, 2 * ci + wid) * 1024;
#pragma unroll
            for (int r = 0; r < 16; ++r) { const int itok = (r & 3) + 8 * (r >> 2) + 4 * hi; const bool keep = dir ? (r32 >= itok) : (r32 <= itok);
                at[itok * 32 + r32] = (bf16_t)(cvt_pk_bf16(keep ? acc[r] : 0.f, 0.f) & 0xffffu); } }
        __syncthreads();
    }
}
__device__ __forceinline__ void gla_prep_phase(const Frame& F, const Args& a) {
    for (int u = F.bid; u < NB * 6 * NCH; u += F.G) { const int ci = u % NCH, bh = u / NCH; gla_prep_unit(F, a, bh / 6, bh % 6, ci); }
}
#ifndef SC_SYNC
#define SC_SYNC 0
#endif
template <int NBE>
__device__ __forceinline__ void gla_scan_wg(const Frame& F, const Args& a, int dir, int b, int h, int dhalf, int esl) {
    constexpr int SC_QT = 0, SC_KT = 8192, SC_VT = 16384, SC_AT = SC_VT + 8192 * NBE, SC_GAM = SC_AT + 2048, SC_STAGE = SC_GAM + 512, SC_NS = NBE == 2 ? 4 : 5, EW = 128 * NBE;
    unsigned char* ws = a.ws;
    const bf16_t* QT = (const bf16_t*)(ws + WS_QT); const bf16_t* KT = (const bf16_t*)(ws + WS_KT); const bf16_t* AT = (const bf16_t*)(ws + WS_AT); const float* GAM = (const float*)(ws + WS_GAM);
    const bf16_t* VT = (const bf16_t*)(ws + WS_VT);
    bf16_t* O = (bf16_t*)(ws + (dir ? (dhalf ? WS_O11 : WS_O10) : (dhalf ? WS_O01 : WS_O00)));
    const int lane = F.lane, wid = F.wave, c = lane & 15, g = lane >> 4;
    LAS unsigned char* lds = F.lds;
    unsigned qsrc, ksrc, vsrc[NBE], asrc;
    { const int P = wid * 64 + lane;
      { const int r = P >> 4, sp = P & 15; qsrc = (unsigned)(dhalf * 4096 + r * 128 + (sp ^ (r & 15)) * 8); }
      { const int dd = P >> 2, sp = P & 3; ksrc = (unsigned)(dhalf * 4096 + dd * 32 + (sp ^ swz4((dd >> 2) & 3)) * 8); }
#pragma unroll
      for (int be = 0; be < NBE; ++be) { const int Pv = (wid + 8 * be) * 64 + lane; const int e = Pv >> 2, sp = Pv & 3; vsrc[be] = (unsigned)((esl * EW + e) * 32 + (sp ^ swz4((e >> 2) & 3)) * 8); }
      { const int i = (P >> 2) & 31, sp = P & 3; asrc = (unsigned)(i * 32 + (sp ^ swz4((i >> 2) & 3)) * 8); } }
    const int sw = swz4(c >> 2);
    const int q_rd = c * 256;
    const int k_rd = SC_KT + c * 64 + ((g ^ sw) * 16);
    const int v_rd = SC_VT + (16 * wid + c) * 64 + ((g ^ sw) * 16);
    const int a_rd = SC_AT + c * 64 + ((g ^ sw) * 16);
    const int g_rd = SC_GAM + 16 * g;
    f32x4 St[NBE][8];
#pragma unroll
    for (int be = 0; be < NBE; ++be)
#pragma unroll
        for (int t = 0; t < 8; ++t) St[be][t] = (f32x4){0.f, 0.f, 0.f, 0.f};
#define SC_CI(s) (dir ? (NC2 - 1 - (s)) : (((s) + 256) % NC2))
#define SC_DMA(slot, ci_) do { const size_t x_ = gla_idx2(dir, b, h, (ci_)); const int so_ = (slot) * SC_STAGE; \
        __builtin_amdgcn_global_load_lds((const unsigned*)(QT + x_ * 8192 + qsrc), (LAS unsigned*)(lds + so_ + SC_QT + wid * 1024), 16, 0, 0); \
        __builtin_amdgcn_global_load_lds((const unsigned*)(KT + x_ * 8192 + ksrc), (LAS unsigned*)(lds + so_ + SC_KT + wid * 1024), 16, 0, 0); \
        _Pragma("unroll") for (int be = 0; be < NBE; ++be) \
            __builtin_amdgcn_global_load_lds((const unsigned*)(VT + ((size_t)((b * 6 + h) * NC2 + (ci_))) * 16384 + vsrc[be]), (LAS unsigned*)(lds + so_ + SC_VT + (wid + 8 * be) * 1024), 16, 0, 0); \
        if (wid < 2) __builtin_amdgcn_global_load_lds((const unsigned*)(AT + x_ * 1024 + asrc), (LAS unsigned*)(lds + so_ + SC_AT + wid * 1024), 16, 0, 0); \
        if (wid == 2) { if (lane < 32) __builtin_amdgcn_global_load_lds((const unsigned*)(GAM + x_ * 256 + dhalf * 128 + lane * 4), (LAS unsigned*)(lds + so_ + SC_GAM), 16, 0, 0); } } while (0)
    __syncthreads();
#pragma unroll
    for (int p = 0; p < SC_NS - 1; ++p) SC_DMA(p, SC_CI(p));
    for (int s = 0; s < NC2; ++s) {
        const int ci = SC_CI(s); const int so = (s % SC_NS) * SC_STAGE;
        if (s < SC_NS || SC_SYNC || (a.var & 56)) __builtin_amdgcn_s_waitcnt(0x0F70);
        else if (NBE == 1) { if (wid < 3) __builtin_amdgcn_s_waitcnt(0x4F74); else __builtin_amdgcn_s_waitcnt(0x4F71); }
        else { if (wid < 3) __builtin_amdgcn_s_waitcnt(0x4F76); else __builtin_amdgcn_s_waitcnt(0x4F74); }
        __builtin_amdgcn_s_barrier(); asm volatile("" ::: "memory");
        if (!(a.var & 8)) { const int sn = s + SC_NS - 1; const int cn = SC_CI(sn < NC2 ? sn : NC2 - 1); SC_DMA(sn % SC_NS, cn); }
        if (a.var & 16) continue;
        bf16x8 vf[NBE], qf[4][2], af[2], kf[8]; f32x4 gmv[8];
#pragma unroll
        for (int be = 0; be < NBE; ++be) vf[be] = *(const LAS bf16x8*)(lds + so + v_rd + be * 8192);
#pragma unroll
        for (int ks = 0; ks < 4; ++ks) { const int chk = ((4 * ks + g) ^ c) * 16;
#pragma unroll
            for (int tt = 0; tt < 2; ++tt) qf[ks][tt] = *(const LAS bf16x8*)(lds + so + SC_QT + q_rd + tt * 4096 + chk); }
        if (dhalf == 0) {
#pragma unroll
            for (int tt = 0; tt < 2; ++tt) af[tt] = *(const LAS bf16x8*)(lds + so + a_rd + tt * 1024); }
#pragma unroll
        for (int t = 0; t < 8; ++t) { kf[t] = *(const LAS bf16x8*)(lds + so + k_rd + t * 1024); gmv[t] = *(const LAS f32x4*)(lds + so + g_rd + t * 64); }
        __builtin_amdgcn_sched_barrier(0);
#pragma unroll
        for (int be = 0; be < NBE; ++be) {
            f32x4 oT[2] = {(f32x4){0.f, 0.f, 0.f, 0.f}, (f32x4){0.f, 0.f, 0.f, 0.f}};
#pragma unroll
            for (int ks = 0; ks < 4; ++ks) {
                u32x4 aw; aw.x = cvt_pk_bf16(St[be][2 * ks][0], St[be][2 * ks][1]); aw.y = cvt_pk_bf16(St[be][2 * ks][2], St[be][2 * ks][3]);
                aw.z = cvt_pk_bf16(St[be][2 * ks + 1][0], St[be][2 * ks + 1][1]); aw.w = cvt_pk_bf16(St[be][2 * ks + 1][2], St[be][2 * ks + 1][3]);
                const bf16x8 Af = *reinterpret_cast<bf16x8*>(&aw);
#pragma unroll
                for (int tt = 0; tt < 2; ++tt) oT[tt] = __builtin_amdgcn_mfma_f32_16x16x32_bf16(Af, qf[ks][tt], oT[tt], 0, 0, 0); }
            if (dhalf == 0) {
#pragma unroll
                for (int tt = 0; tt < 2; ++tt) oT[tt] = __builtin_amdgcn_mfma_f32_16x16x32_bf16(vf[be], af[tt], oT[tt], 0, 0, 0); }
            if (!(a.var & 32)) { bf16_t* orow = O + ((size_t)b * SB + 32 * ci + c) * 3072 + h * 512 + esl * EW + be * 128 + 16 * wid + 4 * g;
#pragma unroll
              for (int tt = 0; tt < 2; ++tt) { u32x2 w; w.x = cvt_pk_bf16(oT[tt][0], oT[tt][1]); w.y = cvt_pk_bf16(oT[tt][2], oT[tt][3]); *(u32x2*)(orow + (size_t)(16 * tt) * 3072) = w; } }
#pragma unroll
            for (int t = 0; t < 8; ++t) St[be][t] = __builtin_amdgcn_mfma_f32_16x16x32_bf16(kf[t], vf[be], St[be][t] * gmv[t], 0, 0, 0);
        }
    }
    __builtin_amdgcn_s_waitcnt(0x0F70); __syncthreads();
#undef SC_CI
#undef SC_DMA
}
}
namespace fk {
constexpr int NPHASE = 14;
#ifndef BF_TAIL
#define BF_TAIL 0
#endif
#ifndef STAGGER
#define STAGGER 0
#endif
__global__ void __launch_bounds__(NTHR, 2) fwd(Args args) {
    extern __shared__ __attribute__((aligned(16))) unsigned char lds_raw[];
    Frame F; F.lds = (LAS unsigned char*)lds_raw; F.tid = threadIdx.x; F.lane = F.tid & 63; F.wave = __builtin_amdgcn_readfirstlane(F.tid >> 6); F.G = gridDim.x; F.bid = blockIdx.x;
    unsigned char* ws = args.ws;
    volatile LAS unsigned* MISC = (volatile LAS unsigned*)(F.lds + LDS_MISC);
    if (F.tid < 64) MISC[F.tid] = 0u;
    __syncthreads();
    const int lo = args.ph_lo, hi = args.ph_hi;
    XcdBarrier bar; bar.bar = (unsigned*)(ws + WS_CTL) + CW_BAR; bar.x = 0; bar.st = MISC + 8;
    if (hi - lo > 1) bar = xcd_barrier_post((unsigned*)(ws + WS_CTL) + CW_BAR, MISC + 8);
#ifndef PHMASK
#define PHMASK 0xFFFF
#endif
#define IN(k) (((PHMASK >> (k)) & 1) && lo <= (k) && (k) < hi)
#define SEAM(k) do { if (IN(k) && IN((k) + 1)) xcd_barrier(bar); } while (0)
    float* mod = (float*)(ws + WS_MOD);
    float* x1c = (float*)(ws + WS_X1C);
    LAS float* XCH = (LAS float*)(F.lds + LDS_X);
    if (IN(0)) { p0_prologue(F, args); }
    SEAM(0);
    if (IN(1)) { hnorm_phase(F, args.in[0], args.in[2], args.in[4], mod, (bf16_t*)(ws + WS_H)); }
    SEAM(1);
    if (IN(2)) {
        Gemm g{(const bf16_t*)(ws + WS_H), (const bf16_t*)(ws + WS_W1T), 4096, 4096, 4096}; Order S_; S_.init(NPANEL, 35, F.G, F.bid, 0);
        EpiL0 E{(bf16_t*)(ws + WS_A1), (bf16_t*)(ws + WS_CQKV), (bf16_t*)(ws + WS_G0), (bf16_t*)(ws + WS_KR), (float*)(ws + WS_SSQ), args.in[8], args.in[9],
                (const float*)(ws + WS_ROPEA), (const float*)(ws + WS_ROPEB), XCH};
        const bool early = STAGGER && F.bid >= 6 && ((F.bid >> 3) & 1);
        if (early) { late_convert(F, args, 6 * NWAVES, (F.G - 6) * NWAVES, 0); __syncthreads(); }
        gemm_phase<EpiL0>(F.lds + LDS_STAGE, g, S_, E);
        if (!early) late_convert(F, args, 6 * NWAVES, (F.G - 6) * NWAVES, 0);
    }
    SEAM(2);
    if (IN(3)) {
        { Gemm g{(const bf16_t*)(ws + WS_CQKV), (const bf16_t*)(ws + WS_WUQ), 1024, 1536, 1024}; Order S_; S_.init(NPANEL, 12, F.G, F.bid, 0);
          EpiUp<0> E{(bf16_t*)(ws + WS_QB), 3072, (const float*)(ws + WS_SSQ), (const float*)(ws + WS_ROPEB)};
          gemm_phase<EpiUp<0>>(F.lds + LDS_STAGE, g, S_, E); }
        { Gemm g{(const bf16_t*)(ws + WS_CQKV) + 1024, (const bf16_t*)(ws + WS_WUKV), 512, 1536, 512}; Order S_; S_.init(NPANEL, 16, F.G, (F.bid + 128) & 255, 0);
          EpiUp<1> E{(bf16_t*)(ws + WS_KVB), 4096, (const float*)(ws + WS_SSQ), (const float*)(ws + WS_ROPEB)};
          gemm_phase<EpiUp<1>>(F.lds + LDS_STAGE, g, S_, E); }
    }
    SEAM(3);
    if (IN(4)) { attn_phase(F, args, lds_raw); }
    SEAM(4);
    if (IN(5)) {
        Gemm g{(const bf16_t*)(ws + WS_Y0), (const bf16_t*)(ws + WS_WO), 4096, 4096, 4096}; Order S_; S_.init(NPANEL, 16, F.G, F.bid, 0);
        EpiRes E{args.in[0], args.in[2], mod, args.out, x1c};
        const bool early = STAGGER && F.bid >= 32 && ((F.bid >> 3) & 1);
        if (early) { late_convert(F, args, 32 * NWAVES, (F.G - 32) * NWAVES, 1); __syncthreads(); }
        gemm_phase<EpiRes>(F.lds + LDS_STAGE, g, S_, E);
        if (!early) late_convert(F, args, 32 * NWAVES, (F.G - 32) * NWAVES, 1);
    }
    SEAM(5);
    const float* mod1 = mod + 3 * 12288;
    if (IN(6)) { hnorm_phase(F, args.out, x1c, args.in[4] + D, mod1, (bf16_t*)(ws + WS_H)); }
    SEAM(6);
    if (IN(7)) {
        Gemm g{(const bf16_t*)(ws + WS_H), (const bf16_t*)(ws + WS_W4T), 4096, 4096, 4096}; Order S_; S_.init(NPANEL, 45, F.G, F.bid, 0);
        EpiL1 E{(bf16_t*)(ws + WS_QK1), (bf16_t*)(ws + WS_VT), (bf16_t*)(ws + WS_U1), (bf16_t*)(ws + WS_G1), (float*)(ws + WS_GD), args.var & 1, F.lds + 131072};
        gemm_phase<EpiL1>(F.lds + LDS_STAGE, g, S_, E);
    }
    SEAM(7);
    if (IN(8)) {
        if (!(args.var & 1)) gla_prep_phase(F, args);
        __syncthreads();
        if (!(args.var & 2)) {
        int k8 = 256; asm volatile("" : "+s"(k8));
        Gemm g{(const bf16_t*)(ws + WS_U1), (const bf16_t*)(ws + WS_CS), k8, 256, 256}; Order S_; S_.init(M * 4 / 256, 2, F.G, F.bid, 0);
        EpiPlain E{(bf16_t*)(ws + WS_AB), 512};
        gemm_phase<EpiPlain>(F.lds + LDS_STAGE, g, S_, E); }
    }
    SEAM(8);
    if (IN(9)) {
#ifndef SCAN_NBE
#define SCAN_NBE 1
#endif
        constexpr int NSCAN = 192 / SCAN_NBE;
        const int x = F.bid & 7, j = F.bid >> 3;
        if (j < NSCAN / 8) { if (!(args.var & 1)) { constexpr int SPC = 8 / SCAN_NBE; const int combo = x * 3 + j / SPC, sub = j % SPC;
            gla_scan_wg<SCAN_NBE>(F, args, combo / 12, (combo % 12) / 6, combo % 6, sub / (SPC / 2), sub % (SPC / 2)); } }
        else { const int fw = F.bid - NSCAN;
            if (!(args.var & 2)) { if (fw < 32) f4096_phase(F, (const bf16_t*)(ws + WS_AB), (float*)(ws + WS_F4096), fw, 1.0f / 1448.1546878700494f);
                fold_phase(F, (const bf16_t*)(ws + WS_AB), (bf16_t*)(ws + WS_BF), NSCAN * NWAVES, (256 - NSCAN) * NWAVES); }
            if (!(args.var & 4)) dm_gen(F, (bf16_t*)(ws + WS_DM), fw, 256 - NSCAN);
            wo2_convert(F, args, NSCAN * NWAVES, (256 - NSCAN) * NWAVES); }
    }
    SEAM(9);
    if (IN(10)) {
        Gemm g{(const bf16_t*)(ws + WS_DM), (const bf16_t*)(ws + WS_BF), FKP, FKP, FKP}; OrderFn S_{F.bid};
        EpiPcs E{(bf16_t*)(ws + WS_PCS), 1.0f / 1448.1546878700494f};
        gemm_phase<EpiPcs>(F.lds + LDS_STAGE, g, S_, E);
        gla_finish_phase(F, (const bf16_t*)(ws + WS_O00), (const bf16_t*)(ws + WS_O01), (const bf16_t*)(ws + WS_O10), (const bf16_t*)(ws + WS_O11), (const bf16_t*)(ws + WS_G1), args.in[20], (bf16_t*)(ws + WS_Y1));
    }
    SEAM(10);
    if (IN(11)) { fnet_finish_phase(F, (const bf16_t*)(ws + WS_PCS), (const float*)(ws + WS_F4096), (const bf16_t*)(ws + WS_G1), (bf16_t*)(ws + WS_Y1)); }
    SEAM(11);
    if (IN(12)) {
        Gemm g{(const bf16_t*)(ws + WS_Y1), (const bf16_t*)(ws + WS_WO2), 4096, 4096, 4096}; Order S_; S_.init(64, 16, F.G, F.bid, 1);
#if BF_TAIL
        EpiResB E{args.out, mod1, (bf16_t*)(ws + WS_H)};
        gemm_phase<EpiResB>(F.lds + LDS_STAGE, g, S_, E);
#else
        EpiRes E{args.out, x1c, mod1, args.out, x1c};
        gemm_phase<EpiRes>(F.lds + LDS_STAGE, g, S_, E);
#endif
    }
    SEAM(12);
#if BF_TAIL
    if (IN(13)) { final_norm_b_phase(F, (const bf16_t*)(ws + WS_H), args.out, args.in[22]); }
#else
    if (IN(13)) { final_norm_phase(F, args.out, args.in[22]); }
#endif
#undef IN
#undef SEAM
}

static int g_state = 0;
static bool host_init(int n_in, size_t ws_size) {
    if (g_state == 0) {
        g_state = -1;
        if (n_in != 23 || ws_size < WS_TOTAL) { fprintf(stderr, "kernel_launch: n_in %d ws %zu (need %zu)\n", n_in, ws_size, (size_t)WS_TOTAL); return false; }
        int dev = 0, cus = 0;
        if (hipGetDevice(&dev) != hipSuccess || hipDeviceGetAttribute(&cus, hipDeviceAttributeMultiprocessorCount, dev) != hipSuccess || cus != 256) { fprintf(stderr, "kernel_launch: needs a 256-CU device (got %d)\n", cus); return false; }
        if (hipFuncSetAttribute((const void*)fwd, hipFuncAttributeMaxDynamicSharedMemorySize, LDS_BYTES) != hipSuccess) { fprintf(stderr, "hipFuncSetAttribute(fwd) failed\n"); return false; }
        int per_cu = 0;
        if (hipOccupancyMaxActiveBlocksPerMultiprocessor(&per_cu, (const void*)fwd, NTHR, LDS_BYTES) != hipSuccess || per_cu < 1) fprintf(stderr, "kernel_launch: occupancy query reports %d blocks per CU\n", per_cu);
        (void)hipGetLastError();
#if MODE != 4 && MODE != 3 && MODE != 5
        if (hipFuncSetAttribute((const void*)orc::k_attn, hipFuncAttributeMaxDynamicSharedMemorySize, 160 * 1024 - 256) != hipSuccess) { fprintf(stderr, "hipFuncSetAttribute(k_attn) failed\n"); return false; }
#endif
        g_state = 1;
    }
    return g_state > 0;
}
static void launch_phases(void* const* d_in, void* d_out, void* d_ws, hipStream_t stream, int lo, int hi, bool one_launch, int var = 0) {
    (void)hipMemsetAsync((char*)d_ws + WS_CTL, 0, MiB, stream);
    Args a{};
    for (int i = 0; i < 23; ++i) a.in[i] = (const float*)d_in[i];
    a.out = (float*)d_out; a.ws = (unsigned char*)d_ws; a.var = var;
    if (one_launch) { a.ph_lo = lo; a.ph_hi = hi; hipLaunchKernelGGL(fwd, dim3(256), dim3(NTHR), LDS_BYTES, stream, a); }
    else for (int p = lo; p < hi; ++p) { a.ph_lo = p; a.ph_hi = p + 1; hipLaunchKernelGGL(fwd, dim3(256), dim3(NTHR), LDS_BYTES, stream, a); }
    const hipError_t le = hipPeekAtLastError();
    if (le != hipSuccess) fprintf(stderr, "kernel_launch: launch failed: %s\n", hipGetErrorName(le));
}
}

#ifndef MODE
#define MODE 1
#endif
extern "C" void kernel_launch(void* const* d_in, const int* in_sizes, int n_in, void* d_out, int out_size, void* d_ws, size_t ws_size, hipStream_t stream) {
    if (!fk::host_init(n_in, ws_size)) return;
#if MODE != 4 && MODE != 3 && MODE != 5
    const orc::Ptrs p = orc::ptrs(d_in); (void)p;
#endif
#if MODE == 0
    orc::setup(p, (unsigned char*)d_ws, stream); orc::layer0(p, (float*)d_out, (unsigned char*)d_ws, stream); orc::layer1(p, (float*)d_out, (unsigned char*)d_ws, stream);
#elif MODE == 1
    fk::launch_phases(d_in, d_out, d_ws, stream, 0, 6, false);
    orc::setup(p, (unsigned char*)d_ws, stream); orc::layer1(p, (float*)d_out, (unsigned char*)d_ws, stream);
#elif MODE == 2
    orc::setup(p, (unsigned char*)d_ws, stream); orc::layer0(p, (float*)d_out, (unsigned char*)d_ws, stream);
    fk::launch_phases(d_in, d_out, d_ws, stream, 0, 1, false); fk::launch_phases(d_in, d_out, d_ws, stream, 6, 14, false);
#elif MODE == 3
    fk::launch_phases(d_in, d_out, d_ws, stream, 0, 14, false);
#elif MODE == 5
    { const int lst[] = {PHLIST}; for (unsigned i = 0; i < sizeof(lst) / sizeof(lst[0]); ++i) fk::launch_phases(d_in, d_out, d_ws, stream, lst[i] % 100, lst[i] % 100 + 1, false, lst[i] / 100); }
#elif MODE == 4
    fk::launch_phases(d_in, d_out, d_ws, stream, 0, 14, true);
#endif
}
```

```cpp
#define MODE 4
#define ATT_PP 1
#define ATT_PP_PRIO 3
#define ATT_PP_PRIO_S 0
#include <hip/hip_runtime.h>
#include <cstdio>
#include <cstdint>
namespace fk {
#define LAS __attribute__((address_space(3)))
#define GAS __attribute__((address_space(1)))
typedef unsigned short bf16_t;
typedef short bf16x8 __attribute__((ext_vector_type(8)));
typedef short s16x4 __attribute__((ext_vector_type(4)));
typedef float f32x2 __attribute__((ext_vector_type(2)));
typedef float f32x4 __attribute__((ext_vector_type(4)));
typedef float f32x8 __attribute__((ext_vector_type(8)));
typedef float f32x16 __attribute__((ext_vector_type(16)));
typedef unsigned u32x2 __attribute__((ext_vector_type(2)));
typedef unsigned u32x4 __attribute__((ext_vector_type(4)));

constexpr int NWAVES = 8, NTHR = 512;
constexpr int D = 4096, NB = 2, S = 8192, CTX = 256, SB = S + CTX  , M = NB * SB  , NPANEL = M / 256  , PPB = SB / 256  ;
constexpr float EPS = 1e-6f;

__device__ __forceinline__ unsigned cvt_pk_bf16(float lo, float hi) { unsigned r; asm volatile("v_cvt_pk_bf16_f32 %0, %1, %2" : "=v"(r) : "v"(lo), "v"(hi)); return r; }
__device__ __forceinline__ float bf_lo(unsigned w) { return __uint_as_float(w << 16); }
__device__ __forceinline__ float bf_hi(unsigned w) { return __uint_as_float(w & 0xffff0000u); }
__device__ __forceinline__ float bf2f(bf16_t b) { return __uint_as_float(((unsigned)b) << 16); }
__device__ __forceinline__ float fast_silu(float x) { return x * __builtin_amdgcn_rcpf(1.f + __expf(-x)); }
__device__ __forceinline__ float wave_sum(float v) {
#pragma unroll
    for (int o = 1; o < 64; o <<= 1) v += __shfl_xor(v, o);
    return v;
}
#define LDS_WAIT() asm volatile("s_waitcnt lgkmcnt(0)" ::: "memory")
#define VM_WAIT() asm volatile("s_waitcnt vmcnt(0)" ::: "memory")

#define XB_TMO      128
#define XB_XCNT(j)  (256  + 64 * (j))
#define XB_XSUB(j)  (1280 + 64 * (j))
#define XB_XGEN(j)  (2304 + 64 * (j))
#define XB_TOP      3328
#define XB_TOPGEN   3392
#define XCD_BAR_WORDS 3456
#define XB_SPIN_CAP (1u << 24)
__device__ __forceinline__ unsigned xb_ld(unsigned* p)              { return __hip_atomic_load(p, __ATOMIC_RELAXED, __HIP_MEMORY_SCOPE_AGENT); }
__device__ __forceinline__ unsigned xb_add(unsigned* p, unsigned v) { return __hip_atomic_fetch_add(p, v, __ATOMIC_RELAXED, __HIP_MEMORY_SCOPE_AGENT); }
__device__ __forceinline__ unsigned xb_xcc_id() { return (unsigned)__builtin_amdgcn_s_getreg((3 << 11) | 20) & 0xFu; }
#define XB_SPIN(cond, bar) do { unsigned _sp = 0; while (cond) { __builtin_amdgcn_s_sleep(1); \
    if ((++_sp & 255u) == 0u) { if (xb_ld(&(bar)[XB_TMO])) break; if (_sp > XB_SPIN_CAP) { atomicAdd(&(bar)[XB_TMO], 1u); break; } } } } while (0)
struct XcdBarrier { unsigned* bar; unsigned x; volatile LAS unsigned* st; };
__device__ __forceinline__ XcdBarrier xcd_barrier_post(unsigned* bar, volatile LAS unsigned* st) {
    XcdBarrier b; b.bar = bar; b.x = xb_xcc_id(); b.st = st;
    if (threadIdx.x == 0) (void)xb_add(&bar[XB_XCNT(b.x)], 1u);
    return b;
}
__device__ __forceinline__ void xcd_barrier_complete(unsigned* bar, unsigned x, unsigned& nloc, unsigned& nx) {
    const unsigned G = gridDim.x * gridDim.y * gridDim.z;
    unsigned sum, cnt, mine, sp = 0u;
    for (;;) {
        sum = 0u; cnt = 0u; mine = 0u;
#pragma unroll
        for (unsigned j = 0; j < 16; ++j) { const unsigned c = xb_ld(&bar[XB_XCNT(j)]); sum += c; cnt += (c > 0u) ? 1u : 0u; mine = (j == x) ? c : mine; }
        if (sum == G) break;
        __builtin_amdgcn_s_sleep(1);
        if ((++sp & 255u) == 0u) { if (xb_ld(&bar[XB_TMO])) break; if (sp > XB_SPIN_CAP) { atomicAdd(&bar[XB_TMO], 1u); break; } }
    }
    nloc = mine > 0u ? mine : 1u; nx = cnt > 0u ? cnt : 1u;
}
__device__ __forceinline__ void xcd_barrier(const XcdBarrier& b) {
    asm volatile("s_waitcnt vmcnt(0)" ::: "memory");
    __syncthreads();
    if (threadIdx.x == 0) {
        unsigned* bar = b.bar;
        __builtin_amdgcn_s_waitcnt(0);
        unsigned nloc = b.st[0], nx = b.st[1];
        if (nloc == 0u) { xcd_barrier_complete(bar, b.x, nloc, nx); b.st[0] = nloc; b.st[1] = nx; }
        const unsigned old = xb_add(&bar[XB_XSUB(b.x)], 1u);
        const unsigned gen = old / nloc;
        if (old + 1u == (gen + 1u) * nloc) {
            __builtin_amdgcn_fence(__ATOMIC_RELEASE, "agent");
            asm volatile("s_waitcnt vmcnt(0)" ::: "memory");
            const unsigned og = xb_add(&bar[XB_TOP], 1u);
            const unsigned tg = og / nx;
            if (og + 1u == (tg + 1u) * nx) xb_add(&bar[XB_TOPGEN], 1u);
            else XB_SPIN(xb_ld(&bar[XB_TOPGEN]) == tg, bar);
            __builtin_amdgcn_fence(__ATOMIC_ACQUIRE, "agent");
            xb_add(&bar[XB_XGEN(b.x)], 1u);
            asm volatile("s_waitcnt vmcnt(0)" ::: "memory");
        } else {
            XB_SPIN(xb_ld(&bar[XB_XGEN(b.x)]) == gen, bar);
            __builtin_amdgcn_fence(__ATOMIC_ACQUIRE, "agent");
            asm volatile("s_waitcnt vmcnt(0)" ::: "memory");
        }
    }
    __syncthreads();
}

constexpr int BM = 256, BK = 64, HALF = 128, HTB = HALF * BK * 2, STAGE_BYTES = 8 * HTB, NXCD = 8, WGM = 8;
__host__ __device__ __forceinline__ int lds_byte(int r, int c) { const int st = (r >> 4) * 2 + (c >> 5), rr = r & 15, cc = c & 31, ob = rr * 64 + cc * 2; return st * 1024 + (ob ^ (((ob >> 9) & 1) << 5)); }
__host__ __device__ __forceinline__ void stage_rc(int b, int& R, int& C) { const int st = b / 1024, sb = b % 1024, swz = sb ^ (((sb >> 9) & 1) << 5); R = (st >> 1) * 16 + swz / 64; C = (st & 1) * 32 + (swz % 64) / 2; }
__host__ __device__ __forceinline__ int perm32(int rho) { const int n = rho >> 4, i = rho & 15; return 8 * (i >> 2) + 4 * n + (i & 3); }
struct Unit { int pm, pn, ko; };
struct Gemm { const bf16_t* A; const bf16_t* Bt; int K, lda, ldb; };
struct Order {
    int nM, nN, nwg, G, c, skip;
    __device__ void init(int nM_, int nN_, int G_, int c_, int skip_) { nM = nM_; nN = nN_; nwg = nM * nN; G = G_; c = c_; skip = skip_; }
    __device__ bool next(int i, Unit& u) const {
        const long L = (long)i * G + c; if (L >= nwg) return false;
        int wgid = (int)L; { const int q = nwg / NXCD, r = nwg % NXCD, xcd = wgid % NXCD, off = wgid / NXCD; wgid = (xcd < r ? xcd * (q + 1) : r * (q + 1) + (xcd - r) * q) + off; }
        const int nig = WGM * nN, gid = wgid / nig, fm = gid * WGM, gsz = (nM - fm) < WGM ? (nM - fm) : WGM;
        int pm = fm + ((wgid % nig) % gsz); if (skip && pm >= 32) pm += 1;
        u.pm = pm; u.pn = (wgid % nig) / gsz; u.ko = 0; return true;
    }
};
struct OrderKr {
    int bid;
    __device__ bool next(int i, Unit& u) const {
        int L; if (bid >= 196) { if (i >= 8) return false; L = (bid - 196) * 8 + i; } else { if (i >= 1 || bid >= 48) return false; L = 480 + bid; }
        u.pm = L >> 3; u.pn = 0; u.ko = (L & 7) * 512; return true;
    }
};
struct OrderL0t {
    Order base; int G, c;
    __device__ bool next(int i, Unit& u) const { const int L = i * G + c; if (L < 2244) return base.next(i, u); if (L < 2304) { u.pm = L - 2244; u.pn = 34; u.ko = 0; return true; } return false; }
};
struct OrderKr6 {
    int bid;
    __device__ bool next(int i, Unit& u) const { if (i >= 1 || bid >= 48) return false; u.pm = 60 + (bid >> 3); u.pn = 0; u.ko = (bid & 7) * 512; return true; }
};
struct OrderCtx {
    int bid;
    __device__ bool next(int i, Unit& u) const { if (i >= 1) return false; u.pm = 32 + 33 * (bid >> 7); u.pn = (bid >> 3) & 15; u.ko = (bid & 7) * 512; return true; }
};
template <class Epi, class Sched>
__device__ __forceinline__ void gemm_phase(LAS unsigned char* lds, const Gemm g, const Sched& S, const Epi& E) {
    const int tid = threadIdx.x, wid = __builtin_amdgcn_readfirstlane(tid >> 6), lane = tid & 63, wr = wid >> 2, wc = wid & 3, fr = lane & 15, fq = lane >> 4;
    const int K = g.K, nt = K / BK;
    unsigned voffA[2], voffB[2];
#pragma unroll
    for (int i = 0; i < 2; ++i) { int R, C; stage_rc(tid * 16 + i * 8192, R, C); const int Rb = Epi::PERM ? ((R & ~31) + perm32(R & 31)) : R;
        voffA[i] = (unsigned)(R * g.lda + C) * 2u; voffB[i] = (unsigned)(Rb * g.ldb + C) * 2u; }
    const size_t kstep = (size_t)(BK * 2);
    const size_t hstepA = (size_t)HALF * g.lda * 2, hstepB = (size_t)HALF * g.ldb * 2;
    const size_t tstepA = 2 * hstepA, tstepB = 2 * hstepB;
    const unsigned ldsw = (unsigned)wid * 1024u;
    const int aoff = lds_byte(wr * 64 + fr, fq * 8), boff = lds_byte(wc * 32 + fr, fq * 8);
#define PG8_SA(b, h) (((b) * 2 + (h)) * HTB)
#define PG8_SB(b, h) ((4 + (b) * 2 + (h)) * HTB)
#define PG8_STAGE(bufoff, gbase, voff) do { _Pragma("unroll") for (int _i = 0; _i < 2; ++_i) \
        __builtin_amdgcn_global_load_lds((const unsigned*)((const char*)(gbase) + (voff)[_i]), (LAS unsigned*)(lds + (bufoff) + ldsw + _i * 8192), 16, 0, 0); } while (0)
#define PG8_LDA(dst, b, h) do { _Pragma("unroll") for (int m = 0; m < 4; ++m) _Pragma("unroll") for (int k = 0; k < 2; ++k) dst[m][k] = *(const LAS bf16x8*)(lds + PG8_SA(b, h) + aoff + m * 2048 + k * 1024); } while (0)
#define PG8_LDB(dst, b, h) do { _Pragma("unroll") for (int n = 0; n < 2; ++n) _Pragma("unroll") for (int k = 0; k < 2; ++k) dst[n][k] = *(const LAS bf16x8*)(lds + PG8_SB(b, h) + boff + n * 2048 + k * 1024); } while (0)
#define PG8_MMA(ai, bj, At, Bt) do { __builtin_amdgcn_s_setprio(1); _Pragma("unroll") for (int m = 0; m < 4; ++m) _Pragma("unroll") for (int n = 0; n < 2; ++n) _Pragma("unroll") for (int k = 0; k < 2; ++k) \
        acc[ai][bj][m][n] = __builtin_amdgcn_mfma_f32_16x16x32_bf16(Bt[n][k], At[m][k], acc[ai][bj][m][n], 0, 0, 0); __builtin_amdgcn_s_setprio(0); } while (0)
#define PG8_WAIT_V(n) asm volatile("s_waitcnt vmcnt(" #n ")" ::: "memory")
#define PG8_WAIT_L(n) asm volatile("s_waitcnt lgkmcnt(" #n ")" ::: "memory")
#define PG8_BAR __builtin_amdgcn_s_barrier()
#define PG8_SCHED __builtin_amdgcn_sched_barrier(0)
    Unit cur, nxt; int ui = 0;
    if (!S.next(0, cur)) return;
    f32x4 acc[2][2][4][2];
#pragma unroll
    for (int a = 0; a < 2; ++a)
#pragma unroll
        for (int b = 0; b < 2; ++b)
#pragma unroll
            for (int m = 0; m < 4; ++m)
#pragma unroll
                for (int n = 0; n < 2; ++n) acc[a][b][m][n] = (f32x4){0.f, 0.f, 0.f, 0.f};
    bf16x8 At[4][2], B0[2][2], B1[2][2];
    const char* cA = (const char*)g.A + (size_t)cur.pm * tstepA + (size_t)cur.ko * 2; const char* cB = (const char*)g.Bt + (size_t)cur.pn * tstepB + (size_t)cur.ko * 2;
    PG8_STAGE(PG8_SB(0, 0), cB, voffB); PG8_STAGE(PG8_SB(0, 1), cB + hstepB, voffB); PG8_STAGE(PG8_SA(0, 0), cA, voffA); PG8_STAGE(PG8_SA(0, 1), cA + hstepA, voffA);
    if (wr == 1) PG8_BAR;
    PG8_WAIT_V(2); PG8_BAR;
    PG8_STAGE(PG8_SB(1, 0), cB + kstep, voffB); PG8_STAGE(PG8_SA(1, 0), cA + kstep, voffA); PG8_STAGE(PG8_SB(1, 1), cB + hstepB + kstep, voffB);
    PG8_WAIT_V(6); PG8_BAR;
    for (;;) {
        const bool has_next = S.next(ui + 1, nxt);
        const char* nA = has_next ? (const char*)g.A + (size_t)nxt.pm * tstepA + (size_t)nxt.ko * 2 : cA; const char* nB = has_next ? (const char*)g.Bt + (size_t)nxt.pn * tstepB + (size_t)nxt.ko * 2 : cB;
        for (int t = 0; t < nt; t += 2) {
            const bool last = (t == nt - 2);
            const char* a1 = cA + (size_t)(t + 1) * kstep;
            const char* a2 = last ? nA : cA + (size_t)(t + 2) * kstep; const char* b2 = last ? nB : cB + (size_t)(t + 2) * kstep;
            const char* a3 = a2 + kstep; const char* b3 = b2 + kstep;
            PG8_LDB(B0, 0, 0); PG8_LDB(B1, 0, 1); PG8_SCHED; PG8_LDA(At, 0, 0); PG8_STAGE(PG8_SA(1, 1), a1 + hstepA, voffA);
            PG8_WAIT_V(8); PG8_WAIT_L(0); PG8_BAR; PG8_MMA(0, 0, At, B0); PG8_MMA(0, 1, At, B1); PG8_BAR; PG8_SCHED;
            PG8_LDA(At, 0, 1); PG8_STAGE(PG8_SB(0, 0), b2, voffB); PG8_STAGE(PG8_SB(0, 1), b2 + hstepB, voffB); PG8_STAGE(PG8_SA(0, 0), a2, voffA);
            PG8_WAIT_V(8); PG8_WAIT_L(0); PG8_BAR; PG8_MMA(1, 0, At, B0); PG8_MMA(1, 1, At, B1); PG8_BAR; PG8_SCHED;
            PG8_LDB(B0, 1, 0); PG8_LDB(B1, 1, 1); PG8_SCHED; PG8_LDA(At, 1, 0); PG8_STAGE(PG8_SA(0, 1), a2 + hstepA, voffA);
            PG8_WAIT_V(8); PG8_WAIT_L(0); PG8_BAR; PG8_MMA(0, 0, At, B0); PG8_MMA(0, 1, At, B1); PG8_BAR; PG8_SCHED;
            PG8_LDA(At, 1, 1); PG8_STAGE(PG8_SB(1, 0), b3, voffB); PG8_STAGE(PG8_SB(1, 1), b3 + hstepB, voffB); PG8_STAGE(PG8_SA(1, 0), a3, voffA);
            PG8_WAIT_V(8); PG8_WAIT_L(0); PG8_BAR; PG8_MMA(1, 0, At, B0); PG8_MMA(1, 1, At, B1); PG8_BAR; PG8_SCHED;
        }
        if (wr == 0) PG8_BAR;
        E(acc, cur, wr, wc, fr, fq);
        if (!has_next) break;
#pragma unroll
        for (int a = 0; a < 2; ++a)
#pragma unroll
            for (int b = 0; b < 2; ++b)
#pragma unroll
                for (int m = 0; m < 4; ++m)
#pragma unroll
                    for (int n = 0; n < 2; ++n) acc[a][b][m][n] = (f32x4){0.f, 0.f, 0.f, 0.f};
        cur = nxt; cA = nA; cB = nB; ++ui;
        if (wr == 1) PG8_BAR;
    }
    PG8_WAIT_V(0);
    PG8_BAR;
#undef PG8_SA
#undef PG8_SB
#undef PG8_STAGE
#undef PG8_LDA
#undef PG8_LDB
#undef PG8_MMA
#undef PG8_WAIT_V
#undef PG8_WAIT_L
#undef PG8_BAR
#undef PG8_SCHED
}
}
namespace fk {
constexpr size_t MiB = 1u << 20;
constexpr size_t WS_CTL = 0;
constexpr size_t WS_MOD = 1 * MiB;
constexpr size_t WS_ROPEA = 2 * MiB;
constexpr size_t WS_ROPEB = 2 * MiB + 64 * 1024;
constexpr size_t WS_CS = 2 * MiB + 128 * 1024;
constexpr size_t WS_SSQ = 3 * MiB;
constexpr size_t WS_KR = 4 * MiB;
constexpr size_t WS_GD = 7 * MiB;
constexpr size_t WS_GAM = 1391 * MiB;
constexpr size_t WS_AT = 14 * MiB;
constexpr size_t WS_W1T = 40 * MiB;
constexpr size_t WS_WUQ = 110 * MiB;
constexpr size_t WS_WUKV = 116 * MiB;
constexpr size_t WS_WO = 120 * MiB;
constexpr size_t WS_W4T = 152 * MiB;
constexpr size_t WS_WO2 = 242 * MiB;
constexpr size_t WS_DM = 274 * MiB;
constexpr size_t WS_H = 402 * MiB;
constexpr size_t WS_L = 534 * MiB;
constexpr size_t WS_A1 = WS_L;
constexpr size_t WS_CQKV = WS_L + 99 * MiB;
constexpr size_t WS_G0 = WS_L + 149 * MiB;
constexpr size_t WS_QB = WS_L + 281 * MiB;
constexpr size_t WS_KVB = WS_L + 380 * MiB;
constexpr size_t WS_Y0 = WS_L + 512 * MiB;
constexpr size_t WS_QK1 = WS_L;
constexpr size_t WS_V1 = WS_L + 99 * MiB;
constexpr size_t WS_U1 = WS_L + 198 * MiB;
constexpr size_t WS_G1 = WS_L + 231 * MiB;
constexpr size_t WS_QT = WS_L + 363 * MiB;
constexpr size_t WS_KT = WS_L + 462 * MiB;
constexpr size_t WS_VT = WS_L + 561 * MiB;
constexpr size_t WS_AB = WS_L + 660 * MiB;
constexpr size_t WS_VTF = WS_L + 726 * MiB;
constexpr size_t WS_O00 = WS_QK1, WS_O01 = WS_V1;
constexpr size_t WS_O10 = WS_L + 758 * MiB, WS_O11 = WS_H;
constexpr size_t WS_BF = 1398 * MiB;
constexpr size_t WS_PCS = WS_VTF;
constexpr size_t WS_F4096 = WS_SSQ;
constexpr size_t WS_Y1 = WS_QT;
constexpr size_t WS_LEND = WS_L + 758 * MiB;
constexpr size_t WS_PART = WS_L + 660 * MiB;
constexpr size_t WS_X1C = 1448 * MiB;
constexpr size_t WS_TOTAL = 1456 * MiB;
static_assert(WS_O10 + 99 * MiB <= WS_GAM && WS_GAM + 7 * MiB <= WS_BF && WS_BF + 34 * MiB <= WS_X1C && WS_QT + 132 * MiB <= WS_VT, "ws map");
constexpr int CW_BAR = 4096;

constexpr int LDS_STAGE = 0;
constexpr int LDS_X = 151552;
constexpr int LDS_MISC = 159744;
constexpr int LDS_BYTES = 160256;

struct Args { const float* in[23]; float* out; unsigned char* ws; int ph_lo, ph_hi, var, pad; };

struct Frame { LAS unsigned char* lds; int tid, lane, wave, G, bid; };

__device__ __forceinline__ int map_w1(int n) {
    if (n < 2560) { const int h = n >> 7, p = n & 127; return h * 128 + (p >> 1) + 64 * (p & 1); }
    if (n < 4608) return n;
    if (n < 8704) return 4672 + (n - 4608);
    if (n < 8768) { const int p = n - 8704; return 4608 + (p >> 1) + 32 * (p & 1); }
    return -1;
}
__device__ __forceinline__ int map_uq(int n) { const int h = n / 192, w = n % 192; if (w < 128) return n; const int p = w - 128; return h * 192 + 128 + (p >> 1) + 32 * (p & 1); }
__device__ __forceinline__ int map_w4(int n) {
    if (n < 6144) return n;
    if (n < 7168) return 6176 + (n - 6144);
    if (n < 11264) return 7200 + (n - 7168);
    if (n < 11296) return 6144 + (n - 11264);
    return -1;
}
__device__ __forceinline__ void tr_item(const float* W, int K, int Nsrc, bf16_t* WT, LAS float* scr, int k0, int n0, int lane, int srccol, const float* kscale, float cscale) {
#pragma unroll
    for (int i = 0; i < 32; ++i) { const int kk = 2 * i + (lane >> 5); float v = srccol >= 0 ? W[(size_t)(k0 + kk) * Nsrc + srccol] : 0.f;
        v *= kscale ? cscale * kscale[k0 + kk] : cscale; scr[kk * 33 + (lane & 31)] = v; }
    LDS_WAIT(); asm volatile("" ::: "memory");
    const int c = lane & 7;
#pragma unroll
    for (int j = 0; j < 4; ++j) { const int n = (lane >> 3) + 8 * j; const LAS float* s = scr + (8 * c) * 33 + n;
        u32x4 o; o.x = cvt_pk_bf16(s[0 * 33], s[1 * 33]); o.y = cvt_pk_bf16(s[2 * 33], s[3 * 33]); o.z = cvt_pk_bf16(s[4 * 33], s[5 * 33]); o.w = cvt_pk_bf16(s[6 * 33], s[7 * 33]);
        *(u32x4*)(WT + (size_t)(n0 + n) * K + k0 + 8 * c) = o; }
    LDS_WAIT(); asm volatile("" ::: "memory");
}
__device__ __forceinline__ void mod_gemv(const Frame& F, const Args& a, int l0, int nl, int wg0, int nwg) {
    if (F.bid < wg0) return;
    LAS float* sc = (LAS float*)(F.lds + 72 * 1024);
    LAS float* red = (LAS float*)(F.lds + 120 * 1024);
    __syncthreads();
    for (int i = F.tid; i < 3 * D; i += NTHR) { const float v = i < 2 * D ? a.in[1][i] : a.in[3][i - 2 * D]; sc[i] = v / (1.f + expf(-v)); }
    __syncthreads();
    float* mod = (float*)(a.ws + WS_MOD);
    const int rsub = F.lane >> 3, c4 = (F.lane & 7) * 4;
    for (int u = F.bid - wg0; u < 384 * nl; u += nwg) {
        const int l = l0 + u / 384, n0 = (u % 384) * 32;
        const float* W = a.in[5] + (size_t)l * D * 12288 + n0 + c4;
        f32x4 a0 = {0.f, 0.f, 0.f, 0.f}, a1 = a0, a2 = a0;
        const int kb = F.wave * 512 + rsub;
#pragma unroll 8
        for (int k = kb; k < kb + 512; k += 8) { const f32x4 w = *(const f32x4*)(W + (size_t)k * 12288); a0 += w * sc[k]; a1 += w * sc[D + k]; a2 += w * sc[2 * D + k]; }
#pragma unroll
        for (int o = 8; o < 64; o <<= 1) {
#pragma unroll
            for (int i = 0; i < 4; ++i) { a0[i] += __shfl_xor(a0[i], o); a1[i] += __shfl_xor(a1[i], o); a2[i] += __shfl_xor(a2[i], o); } }
        if (F.lane < 8) { *(LAS f32x4*)(red + (F.wave * 3 + 0) * 32 + c4) = a0; *(LAS f32x4*)(red + (F.wave * 3 + 1) * 32 + c4) = a1; *(LAS f32x4*)(red + (F.wave * 3 + 2) * 32 + c4) = a2; }
        __syncthreads();
        if (F.tid < 96) { const int r = F.tid >> 5, cl = F.tid & 31; float sm = 0.f;
#pragma unroll
            for (int w = 0; w < 8; ++w) sm += red[(w * 3 + r) * 32 + cl];
            mod[(l * 3 + r) * 12288 + n0 + cl] = sm + a.in[6][l * 12288 + n0 + cl]; }
        __syncthreads();
    }
}
__device__ __forceinline__ void p0_prologue(const Frame& F, const Args& a) {
    unsigned char* ws = a.ws;
    mod_gemv(F, a, 0, 2, 0, F.G);
    __syncthreads();
    {
        LAS float* scr = (LAS float*)(F.lds + F.wave * 8448);
        const int gw = F.bid * NWAVES + F.wave, NGW = F.G * NWAVES;
        constexpr int I0 = 64 * 280, I1 = 16 * 96, I2 = 8 * 128;
        constexpr int NIT = I0 + I1 + I2;
        for (int it = gw; it < NIT; it += NGW) {
            int r = it; const int cl = F.lane & 31;
            if (r < I0) { const int nb = r % 280, kb = r / 280; tr_item(a.in[7], 4096, 8768, (bf16_t*)(ws + WS_W1T), scr, kb * 64, nb * 32, F.lane, map_w1(nb * 32 + cl), nullptr, 1.f); continue; } r -= I0;
            if (r < I1) { const int nb = r % 96, kb = r / 96; tr_item(a.in[12], 1024, 3072, (bf16_t*)(ws + WS_WUQ), scr, kb * 64, nb * 32, F.lane, map_uq(nb * 32 + cl), a.in[10], 1.f); continue; } r -= I1;
            { const int nb = r % 128, kb = r / 128; tr_item(a.in[13], 512, 4096, (bf16_t*)(ws + WS_WUKV), scr, kb * 64, nb * 32, F.lane, nb * 32 + cl, a.in[11], 1.f); }
        }
    }
    {
        const int gt = F.bid * NTHR + F.tid, NGT = F.G * NTHR;
        f32x2* ra = (f32x2*)(ws + WS_ROPEA); f32x2* rb = (f32x2*)(ws + WS_ROPEB); bf16_t* cs = (bf16_t*)(ws + WS_CS);
        for (int i = gt; i < 128 * 32; i += NGT) { const int pos = i >> 5, fi = i & 31; const float ang = (float)pos * powf(10000.f, -(float)fi / 32.f); ra[i] = (f32x2){cosf(ang), sinf(ang)}; }
        for (int i = gt; i < 128 * 16; i += NGT) { const int pos = i >> 4, fi = i & 15; const float ang = (float)pos * powf(10000.f, -(float)fi / 16.f); rb[i] = (f32x2){cosf(ang), sinf(ang)}; }
        for (int i = gt; i < 512 * 256; i += NGT) { const int m = i >> 8, c = i & 255, l = m & 255; const float x = (float)((l * c) & 255) * (2.f / 256.f);
            const float v = (m < 256) ? cospif(x) : sinpif(x); cs[i] = (bf16_t)(cvt_pk_bf16(v, 0.f) & 0xffffu); }
    }
}
__device__ __forceinline__ void late_convert(const Frame& F, const Args& a, int w0, int nw, int which) {
    const int gw = F.bid * NWAVES + F.wave - w0; if (gw < 0) return;
    LAS float* scr = (LAS float*)(F.lds + F.wave * 8448);
    constexpr int I3 = 64 * 128, I4 = 64 * 360;
    if (which == 0) { for (int it = gw; it < I3; it += nw) { const int nb = it % 128, kb = it / 128; tr_item(a.in[14], 4096, 4096, (bf16_t*)(a.ws + WS_WO), scr, kb * 64, nb * 32, F.lane, nb * 32 + (F.lane & 31), nullptr, 1.f); } }
    else { for (int it = gw; it < I4; it += nw) { const int nb = it % 360, kb = it / 360; tr_item(a.in[15], 4096, 11296, (bf16_t*)(a.ws + WS_W4T), scr, kb * 64, nb * 32, F.lane, map_w4(nb * 32 + (F.lane & 31)), nullptr, nb * 32 < 1536 ? 0.0625f : 1.f); } }
}
__device__ __forceinline__ void wo2_convert(const Frame& F, const Args& a, int w0, int nw) {
    __syncthreads();
    LAS float* scr = (LAS float*)(F.lds + F.wave * 8448);
    const int gw = F.bid * NWAVES + F.wave - w0;
    for (int it = gw; it < 64 * 128; it += nw) { const int nb = it % 128, kb = it / 128; tr_item(a.in[21], 4096, 4096, (bf16_t*)(a.ws + WS_WO2), scr, kb * 64, nb * 32, F.lane, nb * 32 + (F.lane & 31), nullptr, 1.f); }
}
constexpr int FKP = 4224;
__device__ __forceinline__ void dm_gen(const Frame& F, bf16_t* dm, int w0, int nw) {
    for (int r = w0; r < 8192; r += nw) { const int half = r >> 12, k = r & 4095;
        for (int q = F.tid; q < FKP / 8; q += NTHR) { float v[8];
#pragma unroll
            for (int j = 0; j < 8; ++j) { const int kk = q * 8 + j; const float x = (float)((k * kk) & 8191) * (1.f / 8192.f);
                v[j] = half == 0 ? (kk <= 4096 ? __builtin_amdgcn_cosf(x) : 0.f) : ((kk >= 1 && kk <= 4095) ? __builtin_amdgcn_sinf(x) : 0.f); }
            u32x4 o; o.x = cvt_pk_bf16(v[0], v[1]); o.y = cvt_pk_bf16(v[2], v[3]); o.z = cvt_pk_bf16(v[4], v[5]); o.w = cvt_pk_bf16(v[6], v[7]);
            *(u32x4*)(dm + (size_t)r * FKP + q * 8) = o; }
    }
}
__device__ __forceinline__ void hnorm_phase(const Frame& F, const float* xlat, const float* xctx, const float* g, const float* modl, bf16_t* H) {
    LAS f32x4* MA = (LAS f32x4*)F.lds;
    __syncthreads();
    for (int i = F.tid; i < 3 * 1024; i += NTHR) { const int r = i >> 10, n4 = i & 1023;
        const f32x4 gg = *((const f32x4*)g + n4), scl = *((const f32x4*)(modl + (size_t)r * 12288 + D) + n4), sh = *((const f32x4*)(modl + (size_t)r * 12288) + n4);
        MA[(r * 2 + 0) * 1024 + n4] = gg * (scl + 1.f); MA[(r * 2 + 1) * 1024 + n4] = sh; }
    __syncthreads();
    const int base = F.bid * (M / 256);
    for (int i0 = F.wave; i0 < M / 256; i0 += 16) {
        const int rot = (F.bid * 5) % (M / 256);
        const bool hasB = (i0 + 8) < M / 256;
        const int mA = base + (i0 + rot) % (M / 256), mB = base + (i0 + 8 + rot) % (M / 256);
        const int bA = mA / SB, rA = mA % SB, bB = hasB ? mB / SB : bA, rB = hasB ? mB % SB : rA;
        const float* srcA = rA < S ? xlat + ((size_t)bA * S + rA) * D : xctx + ((size_t)bA * CTX + (rA - S)) * D;
        const float* srcB = rB < S ? xlat + ((size_t)bB * S + rB) * D : xctx + ((size_t)bB * CTX + (rB - S)) * D;
        const LAS f32x4* mA_ = MA + (rA < S ? bA : 2) * 2048 + F.lane; const LAS f32x4* mB_ = MA + (rB < S ? bB : 2) * 2048 + F.lane;
        const f32x4* xa = (const f32x4*)srcA + F.lane; const f32x4* xb = (const f32x4*)srcB + F.lane;
        f32x4 va[16], vb[16]; float sa = 0.f, sb = 0.f;
#pragma unroll
        for (int j = 0; j < 16; ++j) va[j] = __builtin_nontemporal_load(xa + 64 * j);
#pragma unroll
        for (int j = 0; j < 16; ++j) vb[j] = __builtin_nontemporal_load(xb + 64 * j);
#pragma unroll
        for (int j = 0; j < 16; ++j) sa += (va[j].x * va[j].x + va[j].y * va[j].y) + (va[j].z * va[j].z + va[j].w * va[j].w);
#pragma unroll
        for (int j = 0; j < 16; ++j) sb += (vb[j].x * vb[j].x + vb[j].y * vb[j].y) + (vb[j].z * vb[j].z + vb[j].w * vb[j].w);
        const float rsa = 1.0f / sqrtf(wave_sum(sa) * (1.f / D) + EPS), rsb = 1.0f / sqrtf(wave_sum(sb) * (1.f / D) + EPS);
        u32x2* oa = (u32x2*)(H + (size_t)mA * D) + F.lane; u32x2* ob = (u32x2*)(H + (size_t)(hasB ? mB : mA) * D) + F.lane;
#pragma unroll
        for (int j = 0; j < 16; ++j) {
            { const f32x4 h = va[j] * rsa * mA_[64 * j] + mA_[1024 + 64 * j]; u32x2 w; w.x = cvt_pk_bf16(h.x, h.y); w.y = cvt_pk_bf16(h.z, h.w); oa[64 * j] = w; }
            if (hasB) { const f32x4 h = vb[j] * rsb * mB_[64 * j] + mB_[1024 + 64 * j]; u32x2 w; w.x = cvt_pk_bf16(h.x, h.y); w.y = cvt_pk_bf16(h.z, h.w); ob[64 * j] = w; } }
    }
    __syncthreads();
}
__device__ __forceinline__ u32x4 pack8(const f32x4 a, const f32x4 b) { u32x4 w; w.x = cvt_pk_bf16(a[0], a[1]); w.y = cvt_pk_bf16(a[2], a[3]); w.z = cvt_pk_bf16(b[0], b[1]); w.w = cvt_pk_bf16(b[2], b[3]); return w; }
__device__ __forceinline__ f32x4 rope2(const f32x4 v, const f32x4 cs) {
    return (f32x4){v[0] * cs[0] - v[1] * cs[1], v[0] * cs[1] + v[1] * cs[0], v[2] * cs[2] - v[3] * cs[3], v[2] * cs[3] + v[3] * cs[2]};
}
struct EpiL0 {
    static constexpr bool PERM = true;
    bf16_t* A1; bf16_t* CQKV; bf16_t* G0; bf16_t* KRb; float* SSQ; const float* qn_g; const float* kn_g; const float* ropeA; const float* ropeB; LAS float* X;
    __device__ __forceinline__ void operator()(const f32x4 (&acc)[2][2][4][2], const Unit& u, int wr, int wc, int fr, int fq) const {
        const int pn = u.pn, pb = u.pm % PPB; const bool lat = pb < 32;
        const int rowl0 = wr * 64 + fr; const size_t row0 = (size_t)u.pm * 256 + rowl0; const int cl = wc * 32 + 8 * fq;
        if (pn < 10) {
            const float* g = pn < 8 ? qn_g : kn_g; f32x4 gv[2];
#pragma unroll
            for (int n = 0; n < 2; ++n)
#pragma unroll
                for (int i = 0; i < 4; ++i) { const int p = cl + 4 * n + i; gv[n][i] = g[(p >> 1) + 64 * (p & 1)]; }
#pragma unroll
            for (int ai = 0; ai < 2; ++ai)
#pragma unroll
                for (int m = 0; m < 4; ++m)
#pragma unroll
                    for (int bj = 0; bj < 2; ++bj) { const f32x4 x0 = acc[ai][bj][m][0], x1 = acc[ai][bj][m][1];
                        float s = (x0[0] * x0[0] + x0[1] * x0[1]) + (x0[2] * x0[2] + x0[3] * x0[3]) + (x1[0] * x1[0] + x1[1] * x1[1]) + (x1[2] * x1[2] + x1[3] * x1[3]);
                        s += __shfl_xor(s, 16); s += __shfl_xor(s, 32);
                        if (fq == 0) X[((ai * 128 + rowl0 + 16 * m) * 2 + bj) * 4 + wc] = s; }
            LDS_WAIT(); __builtin_amdgcn_s_barrier(); asm volatile("" ::: "memory");
#pragma unroll
            for (int ai = 0; ai < 2; ++ai)
#pragma unroll
                for (int m = 0; m < 4; ++m) { const int rowl = ai * 128 + rowl0 + 16 * m; const int grow = 4 * pb + 2 * ai + wr, gcol = 16 * m + fr;
                    const int pos = wc < 2 ? grow : gcol;
#pragma unroll
                    for (int bj = 0; bj < 2; ++bj) { const f32x4 p4 = *(const LAS f32x4*)&X[(rowl * 2 + bj) * 4];
                        const float rs = 1.0f / sqrtf(((p4[0] + p4[1]) + (p4[2] + p4[3])) * (1.f / 128.f) + EPS);
                        f32x4 v0 = acc[ai][bj][m][0] * rs * gv[0], v1 = acc[ai][bj][m][1] * rs * gv[1];
                        if (lat) { const int fi = (16 * wc + 4 * fq) & 31; const f32x4 c0 = *(const f32x4*)(ropeA + (pos * 32 + fi) * 2), c1 = *(const f32x4*)(ropeA + (pos * 32 + fi + 2) * 2);
                            v0 = rope2(v0, c0); v1 = rope2(v1, c1); }
                        *(u32x4*)(A1 + (row0 + ai * 128 + 16 * m) * 3072 + pn * 256 + bj * 128 + cl) = pack8(v0, v1); } }
        } else if (pn < 12) {
#pragma unroll
            for (int ai = 0; ai < 2; ++ai)
#pragma unroll
                for (int m = 0; m < 4; ++m)
#pragma unroll
                    for (int bj = 0; bj < 2; ++bj) *(u32x4*)(A1 + (row0 + ai * 128 + 16 * m) * 3072 + pn * 256 + bj * 128 + cl) = pack8(acc[ai][bj][m][0], acc[ai][bj][m][1]);
        } else if (pn < 18) {
#pragma unroll
            for (int ai = 0; ai < 2; ++ai)
#pragma unroll
                for (int m = 0; m < 4; ++m) { float s = 0.f;
#pragma unroll
                    for (int bj = 0; bj < 2; ++bj) { const f32x4 x0 = acc[ai][bj][m][0], x1 = acc[ai][bj][m][1];
                        s += (x0[0] * x0[0] + x0[1] * x0[1]) + (x0[2] * x0[2] + x0[3] * x0[3]) + (x1[0] * x1[0] + x1[1] * x1[1]) + (x1[2] * x1[2] + x1[3] * x1[3]);
                        *(u32x4*)(CQKV + (row0 + ai * 128 + 16 * m) * 1536 + (pn - 12) * 256 + bj * 128 + cl) = pack8(x0, x1); }
                    s += __shfl_xor(s, 16); s += __shfl_xor(s, 32);
                    if (fq == 0) X[(ai * 128 + rowl0 + 16 * m) * 4 + wc] = s; }
            LDS_WAIT(); __builtin_amdgcn_s_barrier(); asm volatile("" ::: "memory");
            if (wc == 0 && fq == 0) {
#pragma unroll
                for (int ai = 0; ai < 2; ++ai)
#pragma unroll
                    for (int m = 0; m < 4; ++m) { const f32x4 p4 = *(const LAS f32x4*)&X[(ai * 128 + rowl0 + 16 * m) * 4];
                        SSQ[(row0 + ai * 128 + 16 * m) * 8 + (pn - 12)] = (p4[0] + p4[1]) + (p4[2] + p4[3]); } }
        } else if (pn < 34) {
#pragma unroll
            for (int ai = 0; ai < 2; ++ai)
#pragma unroll
                for (int m = 0; m < 4; ++m)
#pragma unroll
                    for (int bj = 0; bj < 2; ++bj) { f32x4 x0 = acc[ai][bj][m][0], x1 = acc[ai][bj][m][1];
#pragma unroll
                        for (int i = 0; i < 4; ++i) { x0[i] = fast_silu(x0[i]); x1[i] = fast_silu(x1[i]); }
                        *(u32x4*)(G0 + (row0 + ai * 128 + 16 * m) * 4096 + (pn - 18) * 256 + bj * 128 + cl) = pack8(x0, x1); }
        } else {
            if (wc < 2) {
#pragma unroll
                for (int ai = 0; ai < 2; ++ai)
#pragma unroll
                    for (int m = 0; m < 4; ++m) { const int grow = 4 * pb + 2 * ai + wr, gcol = 16 * m + fr; const int pos = wc < 1 ? grow : gcol;
                        f32x4 v0 = acc[ai][0][m][0], v1 = acc[ai][0][m][1];
                        if (lat) { const int fi = (4 * fq) & 15; const f32x4 c0 = *(const f32x4*)(ropeB + (pos * 16 + fi) * 2), c1 = *(const f32x4*)(ropeB + (pos * 16 + fi + 2) * 2);
                            v0 = rope2(v0, c0); v1 = rope2(v1, c1); }
                        *(u32x4*)(KRb + (row0 + ai * 128 + 16 * m) * 64 + cl) = pack8(v0, v1); } }
        }
    }
};
template <int UPM> struct EpiUp {
    static constexpr bool PERM = true;
    bf16_t* O; int ld; const float* SSQ; const float* ropeB;
    __device__ __forceinline__ void operator()(const f32x4 (&acc)[2][2][4][2], const Unit& u, int wr, int wc, int fr, int fq) const {
        const int pb = u.pm % PPB; const bool lat = pb < 32;
        const int rowl0 = wr * 64 + fr; const size_t row0 = (size_t)u.pm * 256 + rowl0;
#pragma unroll
        for (int ai = 0; ai < 2; ++ai)
#pragma unroll
            for (int m = 0; m < 4; ++m) { const size_t row = row0 + ai * 128 + 16 * m; float rs;
                if (UPM == 0) { const f32x4 p4 = *(const f32x4*)(SSQ + row * 8); rs = 1.0f / sqrtf(((p4[0] + p4[1]) + (p4[2] + p4[3])) * (1.f / 1024.f) + EPS); }
                else { const f32x2 p2 = *(const f32x2*)(SSQ + row * 8 + 4); rs = 1.0f / sqrtf((p2[0] + p2[1]) * (1.f / 512.f) + EPS); }
                const int grow = 4 * pb + 2 * ai + wr, gcol = 16 * m + fr;
#pragma unroll
                for (int bj = 0; bj < 2; ++bj) { const int c0 = u.pn * 256 + bj * 128 + wc * 32 + 8 * fq;
                    f32x4 v0 = acc[ai][bj][m][0] * rs, v1 = acc[ai][bj][m][1] * rs;
                    if (UPM == 0) { const int w = c0 % 192;
                        if (lat && w >= 128) { const int p = w - 128; const int pos = p < 32 ? grow : gcol; const int fi = (p >> 1) & 15;
                            const f32x4 c0v = *(const f32x4*)(ropeB + (pos * 16 + fi) * 2), c1v = *(const f32x4*)(ropeB + (pos * 16 + fi + 2) * 2);
                            v0 = rope2(v0, c0v); v1 = rope2(v1, c1v); } }
                    *(u32x4*)(O + row * ld + c0) = pack8(v0, v1); } }
    }
};
struct EpiPartKr {
    static constexpr bool PERM = true;
    float* P;
    __device__ __forceinline__ void operator()(const f32x4 (&acc)[2][2][4][2], const Unit& u, int wr, int wc, int fr, int fq) const {
        if (wc >= 2) return;
        float* base = P + ((size_t)(u.ko >> 9) * M + (size_t)u.pm * 256 + wr * 64 + fr) * 64 + wc * 32 + 8 * fq;
#pragma unroll
        for (int ai = 0; ai < 2; ++ai)
#pragma unroll
            for (int m = 0; m < 4; ++m) { float* p = base + (size_t)(ai * 128 + 16 * m) * 64; *(f32x4*)p = acc[ai][0][m][0]; *(f32x4*)(p + 4) = acc[ai][0][m][1]; }
    }
};
struct EpiPartCtx {
    static constexpr bool PERM = false;
    float* P;
    __device__ __forceinline__ void operator()(const f32x4 (&acc)[2][2][4][2], const Unit& u, int wr, int wc, int fr, int fq) const {
        float* base = P + ((size_t)(u.ko >> 9) * 512 + (size_t)(u.pm / PPB) * 256 + wr * 64 + fr) * D + u.pn * 256 + wc * 32 + 4 * fq;
#pragma unroll
        for (int ai = 0; ai < 2; ++ai)
#pragma unroll
            for (int m = 0; m < 4; ++m)
#pragma unroll
                for (int bj = 0; bj < 2; ++bj)
#pragma unroll
                    for (int n = 0; n < 2; ++n) *(f32x4*)(base + (size_t)(ai * 128 + 16 * m) * D + bj * 128 + n * 16) = acc[ai][bj][m][n];
    }
};
__device__ __forceinline__ void kr_finalize(const Frame& F, const float* P, const float* ropeB, bf16_t* KRb, int m0, int nrows) {
    for (int it = F.bid * NTHR + F.tid; it < nrows * 8; it += F.G * NTHR) {
        const int m = m0 + (it >> 3), c8 = it & 7; f32x4 v0 = {0.f, 0.f, 0.f, 0.f}, v1 = v0;
#pragma unroll
        for (int ks = 0; ks < 8; ++ks) { const float* p = P + ((size_t)ks * M + m) * 64 + c8 * 8; v0 += *(const f32x4*)p; v1 += *(const f32x4*)(p + 4); }
        const int r = m % SB;
        if (r < S) { const int pos = c8 < 4 ? (r >> 6) : (r & 63), fi = (4 * c8) & 15;
            v0 = rope2(v0, *(const f32x4*)(ropeB + (pos * 16 + fi) * 2)); v1 = rope2(v1, *(const f32x4*)(ropeB + (pos * 16 + fi + 2) * 2)); }
        *(u32x4*)(KRb + (size_t)m * 64 + c8 * 8) = pack8(v0, v1);
    }
}
struct EpiRes {
    static constexpr bool PERM = false;
    const float* xlat; const float* xctx; const float* modl; float* olat; float* octx;
    __device__ __forceinline__ void operator()(const f32x4 (&acc)[2][2][4][2], const Unit& u, int wr, int wc, int fr, int fq) const {
        const int b = u.pm / PPB, pb = u.pm % PPB; const bool lat = pb < 32;
        const size_t r0 = lat ? ((size_t)b * S + 256 * pb) : ((size_t)b * CTX);
        const float* src = (lat ? xlat : xctx) + r0 * D; float* dst = (lat ? olat : octx) + r0 * D;
        const float* gt = modl + (size_t)(lat ? b : 2) * 12288 + 2 * D;
        const int rowl0 = wr * 64 + fr, col0 = u.pn * 256 + wc * 32 + 4 * fq;
        f32x4 gv[2][2];
#pragma unroll
        for (int bj = 0; bj < 2; ++bj)
#pragma unroll
            for (int n = 0; n < 2; ++n) gv[bj][n] = *(const f32x4*)(gt + col0 + bj * 128 + n * 16);
#pragma unroll
        for (int ai = 0; ai < 2; ++ai)
#pragma unroll
            for (int m = 0; m < 4; ++m) { const size_t off = (size_t)(ai * 128 + rowl0 + 16 * m) * D + col0;
#pragma unroll
                for (int bj = 0; bj < 2; ++bj)
#pragma unroll
                    for (int n = 0; n < 2; ++n) { const f32x4 xs = *(const f32x4*)(src + off + bj * 128 + n * 16);
                        *(f32x4*)(dst + off + bj * 128 + n * 16) = xs + gv[bj][n] * acc[ai][bj][m][n]; }
                if (m & 1) asm volatile("" ::: "memory"); }
    }
};

struct EpiResB {
    static constexpr bool PERM = false;
    const float* xlat; const float* modl; bf16_t* o;
    __device__ __forceinline__ void operator()(const f32x4 (&acc)[2][2][4][2], const Unit& u, int wr, int wc, int fr, int fq) const {
        const int b = u.pm / PPB, pb = u.pm % PPB;
        const size_t r0 = (size_t)b * S + 256 * pb;
        const float* src = xlat + r0 * D; bf16_t* dst = o + r0 * D;
        const float* gt = modl + (size_t)b * 12288 + 2 * D;
        const int rowl0 = wr * 64 + fr, col0 = u.pn * 256 + wc * 32 + 4 * fq;
        f32x4 gv[2][2];
#pragma unroll
        for (int bj = 0; bj < 2; ++bj)
#pragma unroll
            for (int n = 0; n < 2; ++n) gv[bj][n] = *(const f32x4*)(gt + col0 + bj * 128 + n * 16);
#pragma unroll
        for (int ai = 0; ai < 2; ++ai)
#pragma unroll
            for (int m = 0; m < 4; ++m) { const size_t off = (size_t)(ai * 128 + rowl0 + 16 * m) * D + col0;
#pragma unroll
                for (int bj = 0; bj < 2; ++bj)
#pragma unroll
                    for (int n = 0; n < 2; ++n) { const f32x4 xs = *(const f32x4*)(src + off + bj * 128 + n * 16); const f32x4 h = xs + gv[bj][n] * acc[ai][bj][m][n];
                        u32x2 w; w.x = cvt_pk_bf16(h.x, h.y); w.y = cvt_pk_bf16(h.z, h.w); *(u32x2*)(dst + off + bj * 128 + n * 16) = w; }
                if (m & 1) asm volatile("" ::: "memory"); }
    }
};

#ifndef ATT_PP_PRIO
#define ATT_PP_PRIO 1
#endif
#ifndef ATT_PP_PRIO_S
#define ATT_PP_PRIO_S 0
#endif
#ifndef ATT_PVSM_A
#define ATT_PVSM_A 0
#endif
#ifndef ATT_PVSM_B
#define ATT_PVSM_B 0
#endif
#ifndef ATT_PRIO
#define ATT_PRIO 0
#endif
namespace att {
using bf16 = unsigned short;
constexpr int   D = 128, NW = 8, QBLK = 32, KVBLK = 64;
constexpr float THR = 8.f;
constexpr size_t SHM_V = KVBLK * D * 2;
#define KSWZ(row, colB) ((row) * 256 + ((colB) ^ (((row) & 7) << 4)))
#define SBAR() __builtin_amdgcn_sched_barrier(0)
#define PIN(x) asm volatile("" : "+v"(x))
__device__ __forceinline__ int crow(int r, int hi) { return (r & 3) + 8 * (r >> 2) + 4 * hi; }
__device__ __forceinline__ unsigned cvtpk(float lo, float hi) {
  unsigned r; asm volatile("v_cvt_pk_bf16_f32 %0, %1, %2" : "=v"(r) : "v"(lo), "v"(hi)); return r;
}
template <typename TIn> struct Stage;
template <> struct Stage<bf16>  { using T = bf16x8;
  __device__ static __forceinline__ T ld8(const bf16* p) { return *reinterpret_cast<const bf16x8*>(p); }
  __device__ static __forceinline__ bf16x8 tobf(T x) { return x; } };
template <> struct Stage<float> { using T = f32x8;
  __device__ static __forceinline__ T ld8(const float* p) { return *reinterpret_cast<const f32x8*>(p); }
  __device__ static __forceinline__ bf16x8 tobf(T x) {
    u32x4 w = {cvtpk(x[0], x[1]), cvtpk(x[2], x[3]), cvtpk(x[4], x[5]), cvtpk(x[6], x[7])}; return *reinterpret_cast<bf16x8*>(&w); } };

template <int DQK> __device__ __forceinline__ void partialSM(f32x16& p0, f32x16& p1, float& m_reg, float& mn, float& alpha) {
  constexpr float SCALE = DQK == 128 ? 0.088388347648318440f : 0.072168783648703220f;
  constexpr float C = SCALE * 1.4426950408889634f;
  float pmax = p0[0]; for (int r = 1; r < 16; ++r) pmax = fmaxf(pmax, p0[r]); for (int r = 0; r < 16; ++r) pmax = fmaxf(pmax, p1[r]);
  { auto rr = __builtin_amdgcn_permlane32_swap(__float_as_uint(pmax), __float_as_uint(pmax), false, false);
    pmax = fmaxf(__uint_as_float(rr[0]), __uint_as_float(rr[1])); }
  if (__builtin_expect(__all(pmax - m_reg <= THR / SCALE), 1)) { mn = m_reg; alpha = 1.f; }
  else { mn = fmaxf(m_reg, pmax); alpha = __builtin_amdgcn_exp2f((m_reg - mn) * C); m_reg = mn; }
  float mnC = -mn * C;
  for (int r = 0; r < 16; ++r) p0[r] = fmaf(p0[r], C, mnC); for (int r = 0; r < 16; ++r) p1[r] = fmaf(p1[r], C, mnC);
  for (int r = 0; r < 16; ++r) p0[r] = __builtin_amdgcn_exp2f(p0[r]);
}
__device__ __forceinline__ void finishSM(f32x16& p0, f32x16& p1, float alpha, float& l_reg, bf16x8& pa0, bf16x8& pa1, bf16x8& pa2, bf16x8& pa3) {
  for (int r = 0; r < 16; ++r) p1[r] = __builtin_amdgcn_exp2f(p1[r]);
  float ps = 0; for (int r = 0; r < 16; ++r) ps += p0[r]; for (int r = 0; r < 16; ++r) ps += p1[r];
  { auto rr = __builtin_amdgcn_permlane32_swap(__float_as_uint(ps), __float_as_uint(ps), false, false);
    ps = __uint_as_float(rr[0]) + __uint_as_float(rr[1]); }
  l_reg = l_reg * alpha + ps;
#define PK4(P, BASE, OUT) do { unsigned a0 = cvtpk(P[BASE + 0], P[BASE + 1]), a1 = cvtpk(P[BASE + 2], P[BASE + 3]);   \
    unsigned b0 = cvtpk(P[BASE + 4], P[BASE + 5]), b1 = cvtpk(P[BASE + 6], P[BASE + 7]);                              \
    auto r0 = __builtin_amdgcn_permlane32_swap(a0, b0, false, false); auto r1 = __builtin_amdgcn_permlane32_swap(a1, b1, false, false); \
    u32x4 w = {r0[0], r1[0], r0[1], r1[1]}; OUT = *reinterpret_cast<bf16x8*>(&w); } while (0)
  PK4(p0, 0, pa0); PK4(p0, 8, pa1); PK4(p1, 0, pa2); PK4(p1, 8, pa3);
#undef PK4
}
__device__ __forceinline__ void fin_nop(f32x16& p0, f32x16& p1, bf16x8& pa0, bf16x8& pa1, bf16x8& pa2, bf16x8& pa3) {
#define PK4(P, BASE, OUT) do { unsigned a0 = cvtpk(P[BASE + 0], P[BASE + 1]), a1 = cvtpk(P[BASE + 2], P[BASE + 3]);   \
    unsigned b0 = cvtpk(P[BASE + 4], P[BASE + 5]), b1 = cvtpk(P[BASE + 6], P[BASE + 7]);                              \
    auto r0 = __builtin_amdgcn_permlane32_swap(a0, b0, false, false); auto r1 = __builtin_amdgcn_permlane32_swap(a1, b1, false, false); \
    u32x4 w = {r0[0], r1[0], r0[1], r1[1]}; OUT = *reinterpret_cast<bf16x8*>(&w); } while (0)
  PK4(p0, 0, pa0); PK4(p0, 8, pa1); PK4(p1, 0, pa2); PK4(p1, 8, pa3);
#undef PK4
}
#ifndef ATT_KSW15
#define ATT_KSW15 1
#endif
#define KSWZK(row, KP) (ATT_KSW15 ? ((KP) == 256 ? ((row) & 15) : (((row) >> 1) & 7)) : ((row) & 7))
#define KSWZP(row, colB, KP) ((row) * (KP) + ((colB) ^ (KSWZK(row, KP) << 4)))
template <int DQK, int NQR, int NL = 0> __device__ __forceinline__ void qkt(f32x16& p0, f32x16& p1, const bf16* Ks, const bf16x8* qr, int r32, int hi, const char* qx) {
  if constexpr (NL != 0) { p0 = f32x16{}; p1 = f32x16{};
    for (int d0 = 0; d0 < DQK / 16; ++d0) { const bf16x8 kv = qr[d0 % (NQR > 1 ? NQR : 1)], qv = qr[(d0 + 1) % (NQR > 1 ? NQR : 1)];
      p0 = __builtin_amdgcn_mfma_f32_32x32x16_bf16(kv, qv, p0, 0, 0, 0); p1 = __builtin_amdgcn_mfma_f32_32x32x16_bf16(qv, kv, p1, 0, 0, 0); } return; }
  p0 = f32x16{}; p1 = f32x16{};
  for (int d0 = NQR; d0 < DQK / 16; ++d0) { int cb = (d0 * 16 + hi * 8) * 2;
    bf16x8 qv = *reinterpret_cast<const bf16x8*>(qx + (d0 - NQR) * 1024);
    bf16x8 b0 = *reinterpret_cast<const bf16x8*>((const char*)Ks + KSWZP(r32, cb, DQK * 2));
    bf16x8 b1 = *reinterpret_cast<const bf16x8*>((const char*)Ks + KSWZP(32 + r32, cb, DQK * 2));
    p0 = __builtin_amdgcn_mfma_f32_32x32x16_bf16(b0, qv, p0, 0, 0, 0);
    p1 = __builtin_amdgcn_mfma_f32_32x32x16_bf16(b1, qv, p1, 0, 0, 0); }
  for (int d0 = 0; d0 < NQR; ++d0) { int cb = (d0 * 16 + hi * 8) * 2;
    bf16x8 b0 = *reinterpret_cast<const bf16x8*>((const char*)Ks + KSWZP(r32, cb, DQK * 2));
    bf16x8 b1 = *reinterpret_cast<const bf16x8*>((const char*)Ks + KSWZP(32 + r32, cb, DQK * 2));
    p0 = __builtin_amdgcn_mfma_f32_32x32x16_bf16(b0, qr[d0], p0, 0, 0, 0);
    p1 = __builtin_amdgcn_mfma_f32_32x32x16_bf16(b1, qr[d0], p1, 0, 0, 0); }
}
__device__ __forceinline__ int v_st(int k, int c) { const int kk = (k & ~0xC) | ((k & 4) << 1) | ((k & 8) >> 1); return ((kk >> 3) * 4 + (c >> 5)) * 512 + ((kk & 7) * 32 + (c & 31)) * 2; }
__device__ __forceinline__ int v_rd_base(int lane) { return ((lane & 3) << 3) | (((lane >> 2) & 3) << 6) | (((lane >> 4) & 1) << 5) | (((lane >> 5) & 1) << 8); }
constexpr int v_rd_off(int d0, int ks, int half) { return d0 * 512 + ks * 4096 + half * 2048; }
template <int OFF> __device__ __forceinline__ s16x4 tr_read(int vb) {
  s16x4 r; asm volatile("ds_read_b64_tr_b16 %0, %1 offset:%2" : "=&v"(r) : "v"(vb), "i"(OFF) : "memory"); return r;
}
template <int D0> __device__ __forceinline__ void pv_one(f32x16& od, int vb, bf16x8 pa0, bf16x8 pa1, bf16x8 pa2, bf16x8 pa3) {
  const s16x4 l0 = tr_read<v_rd_off(D0, 0, 0)>(vb), h0 = tr_read<v_rd_off(D0, 0, 1)>(vb), l1 = tr_read<v_rd_off(D0, 1, 0)>(vb), h1 = tr_read<v_rd_off(D0, 1, 1)>(vb);
  const s16x4 l2 = tr_read<v_rd_off(D0, 2, 0)>(vb), h2 = tr_read<v_rd_off(D0, 2, 1)>(vb), l3 = tr_read<v_rd_off(D0, 3, 0)>(vb), h3 = tr_read<v_rd_off(D0, 3, 1)>(vb);
  asm volatile("s_waitcnt lgkmcnt(0)" ::: "memory"); SBAR();
#define PK(L, H) (bf16x8){L[0], L[1], L[2], L[3], H[0], H[1], H[2], H[3]}
#if ATT_PRIO
  __builtin_amdgcn_s_setprio(1);
#endif
  od = __builtin_amdgcn_mfma_f32_32x32x16_bf16(pa0, PK(l0, h0), od, 0, 0, 0);
  od = __builtin_amdgcn_mfma_f32_32x32x16_bf16(pa1, PK(l1, h1), od, 0, 0, 0);
  od = __builtin_amdgcn_mfma_f32_32x32x16_bf16(pa2, PK(l2, h2), od, 0, 0, 0);
  od = __builtin_amdgcn_mfma_f32_32x32x16_bf16(pa3, PK(l3, h3), od, 0, 0, 0);
#if ATT_PRIO
  __builtin_amdgcn_s_setprio(0);
#endif
#undef PK
}
__device__ __forceinline__ void pv_d0_nl(f32x16* o, bf16x8 pa0, bf16x8 pa1, bf16x8 pa2, bf16x8 pa3) {
  for (int d = 0; d < 4; ++d) { o[d] = __builtin_amdgcn_mfma_f32_32x32x16_bf16(pa0, pa1, o[d], 0, 0, 0); o[d] = __builtin_amdgcn_mfma_f32_32x32x16_bf16(pa1, pa2, o[d], 0, 0, 0);
    o[d] = __builtin_amdgcn_mfma_f32_32x32x16_bf16(pa2, pa3, o[d], 0, 0, 0); o[d] = __builtin_amdgcn_mfma_f32_32x32x16_bf16(pa3, pa0, o[d], 0, 0, 0); } }
__device__ __forceinline__ void pv_d0(f32x16* o, int vb, bf16x8 pa0, bf16x8 pa1, bf16x8 pa2, bf16x8 pa3) {
  pv_one<0>(o[0], vb, pa0, pa1, pa2, pa3); pv_one<1>(o[1], vb, pa0, pa1, pa2, pa3); pv_one<2>(o[2], vb, pa0, pa1, pa2, pa3); pv_one<3>(o[3], vb, pa0, pa1, pa2, pa3);
}

struct VFrag { s16x4 l0, h0, l1, h1, l2, h2, l3, h3; };
template <int D0> __device__ __forceinline__ void pv_rd(VFrag& f, int vb) {
  f.l0 = tr_read<v_rd_off(D0, 0, 0)>(vb); f.h0 = tr_read<v_rd_off(D0, 0, 1)>(vb); f.l1 = tr_read<v_rd_off(D0, 1, 0)>(vb); f.h1 = tr_read<v_rd_off(D0, 1, 1)>(vb);
  f.l2 = tr_read<v_rd_off(D0, 2, 0)>(vb); f.h2 = tr_read<v_rd_off(D0, 2, 1)>(vb); f.l3 = tr_read<v_rd_off(D0, 3, 0)>(vb); f.h3 = tr_read<v_rd_off(D0, 3, 1)>(vb);
}
__device__ __forceinline__ void pv_mm(f32x16& od, const VFrag& f, bf16x8 pa0, bf16x8 pa1, bf16x8 pa2, bf16x8 pa3) {
#define PK(L, H) (bf16x8){L[0], L[1], L[2], L[3], H[0], H[1], H[2], H[3]}
  od = __builtin_amdgcn_mfma_f32_32x32x16_bf16(pa0, PK(f.l0, f.h0), od, 0, 0, 0);
  od = __builtin_amdgcn_mfma_f32_32x32x16_bf16(pa1, PK(f.l1, f.h1), od, 0, 0, 0);
  od = __builtin_amdgcn_mfma_f32_32x32x16_bf16(pa2, PK(f.l2, f.h2), od, 0, 0, 0);
  od = __builtin_amdgcn_mfma_f32_32x32x16_bf16(pa3, PK(f.l3, f.h3), od, 0, 0, 0);
#undef PK
}
#define PVWAIT() do { asm volatile("s_waitcnt lgkmcnt(0)" ::: "memory"); SBAR(); } while (0)
template <int DQK> __device__ __forceinline__ void pv_sm(f32x16* o, int vb, bf16x8 pa0, bf16x8 pa1, bf16x8 pa2, bf16x8 pa3, f32x16& p0, f32x16& p1, float& m_reg, float& mn, float& alpha) {
  constexpr float SCALE = DQK == 128 ? 0.088388347648318440f : 0.072168783648703220f;
  constexpr float C = SCALE * 1.4426950408889634f;
  VFrag f;
  pv_rd<0>(f, vb); PVWAIT();
  pv_mm(o[0], f, pa0, pa1, pa2, pa3); pv_rd<1>(f, vb);
  float pmax = p0[0]; for (int r = 1; r < 16; ++r) pmax = fmaxf(pmax, p0[r]); for (int r = 0; r < 16; ++r) pmax = fmaxf(pmax, p1[r]);
  { auto rr = __builtin_amdgcn_permlane32_swap(__float_as_uint(pmax), __float_as_uint(pmax), false, false);
    pmax = fmaxf(__uint_as_float(rr[0]), __uint_as_float(rr[1])); }
  if (__builtin_expect(__all(pmax - m_reg <= THR / SCALE), 1)) { mn = m_reg; alpha = 1.f; }
  else { mn = fmaxf(m_reg, pmax); alpha = __builtin_amdgcn_exp2f((m_reg - mn) * C); m_reg = mn; }
  float mnC = -mn * C; PIN(mnC); PIN(alpha);
  PVWAIT();
  pv_mm(o[1], f, pa0, pa1, pa2, pa3); pv_rd<2>(f, vb);
  { const f32x2 CC = {C, C}, MM = {mnC, mnC};
    for (int r = 0; r < 8; ++r) { f32x2 t = {p0[2 * r], p0[2 * r + 1]}; t = t * CC + MM; PIN(t); p0[2 * r] = t[0]; p0[2 * r + 1] = t[1]; }
    for (int r = 0; r < 8; ++r) { f32x2 t = {p1[2 * r], p1[2 * r + 1]}; t = t * CC + MM; PIN(t); p1[2 * r] = t[0]; p1[2 * r + 1] = t[1]; } }
  PVWAIT();
  pv_mm(o[2], f, pa0, pa1, pa2, pa3); pv_rd<3>(f, vb);
  for (int r = 0; r < 8; ++r) { float t = __builtin_amdgcn_exp2f(p0[r]); PIN(t); p0[r] = t; }
  PVWAIT();
  pv_mm(o[3], f, pa0, pa1, pa2, pa3);
  for (int r = 8; r < 16; ++r) { float t = __builtin_amdgcn_exp2f(p0[r]); PIN(t); p0[r] = t; }
  SBAR();
}

template <typename TQ, int LDQ, int LDK, int LDO, int DQK, int LDK2, int SDEPTH, int NQR, int PRB = 0>
__device__ __forceinline__ void attn_dense_body(const TQ* __restrict__ Qb, const bf16* __restrict__ Kh, const bf16* __restrict__ K2h, const bf16* __restrict__ Vh,
                                                bf16* __restrict__ Ob, const bf16* __restrict__ Gb, int seq, char* lds) {
  constexpr size_t SHM_K = 64 * DQK * 2; constexpr bool X = DQK == 192; constexpr bool PVSM = X ? (ATT_PVSM_B != 0) : (ATT_PVSM_A != 0);
  using St = Stage<bf16>; using SQ = Stage<TQ>;
  int tid_o = threadIdx.x; asm volatile("" : "+v"(tid_o));
  const int tid = tid_o, wid = __builtin_amdgcn_readfirstlane(tid >> 6), lane = tid & 63, r32 = lane & 31, hi = lane >> 5;
  bf16* V_lds = (bf16*)lds; bf16* K_lds = (bf16*)(lds + 2 * SHM_V);
  float* ws = (float*)(lds + 2 * SHM_V + 2 * SHM_K) + wid * 64; float* li_l = ws; float* al_l = ws + 32;
  float m_reg = -1e30f, l_reg = 0; f32x16 o[4] = {}; bf16x8 qr[NQR]; char* qx = lds + 2 * SHM_V + 2 * SHM_K + 2048 + wid * ((DQK / 16 - NQR) * 1024) + lane * 16;
  const TQ* Qw = Qb + (long)(wid * QBLK + r32) * LDQ + hi * 8;
#pragma unroll
  for (int d0 = 0; d0 < NQR; ++d0) qr[d0] = SQ::tobf(SQ::ld8(Qw + d0 * 16));
#pragma unroll
  for (int d0 = NQR; d0 < DQK / 16; ++d0) *reinterpret_cast<bf16x8*>(qx + (d0 - NQR) * 1024) = SQ::tobf(SQ::ld8(Qw + d0 * 16));
  const int sr = tid >> 4, sc = (tid & 15) * 8, vst0 = v_st(sr, sc), vst1 = v_st(32 + sr, sc);
  const int vb0 = (int)(uintptr_t)V_lds + v_rd_base(lane);
  const int sr2 = tid >> 3, sc2 = (tid & 7) * 8;
  struct { typename St::T vs0, vs1, ks0, ks1, ks2; } sr_[SDEPTH];
  constexpr int LDKP = (PRB & 32) ? 128 : LDK;
  const unsigned voff = (unsigned)(sr * LDKP + sc) * 2u, k2off = (unsigned)(sr2 * LDK2 + sc2) * 2u;
#define SLOAD(i, k0) do { const char* vb_ = (const char*)Vh + (size_t)(k0) * (LDKP * 2) + ((PRB & 32) ? (size_t)(k0) * 256 : 0); const char* kb_ = (const char*)Kh + (size_t)(k0) * (LDKP * 2); \
    sr_[i].vs0 = *(const bf16x8*)(vb_ + voff); sr_[i].vs1 = *(const bf16x8*)(vb_ + 32 * LDKP * 2 + voff); \
    sr_[i].ks0 = *(const bf16x8*)(kb_ + voff); sr_[i].ks1 = *(const bf16x8*)(kb_ + 32 * LDKP * 2 + voff); \
    if constexpr (X) sr_[i].ks2 = *(const bf16x8*)((const char*)K2h + (size_t)(k0) * (LDK2 * 2) + k2off); } while (0)
#define SWRITE(b, i) do { *(bf16x8*)((char*)V_lds + (b) * SHM_V + vst0) = St::tobf(sr_[i].vs0);          \
    *(bf16x8*)((char*)V_lds + (b) * SHM_V + vst1) = St::tobf(sr_[i].vs1); int kc = sc * 2;               \
    *(bf16x8*)((char*)K_lds + (b) * SHM_K + KSWZP(sr, kc, DQK * 2)) = St::tobf(sr_[i].ks0);                       \
    *(bf16x8*)((char*)K_lds + (b) * SHM_K + KSWZP(32 + sr, kc, DQK * 2)) = St::tobf(sr_[i].ks1); \
    if constexpr (X) *(bf16x8*)((char*)K_lds + (b) * SHM_K + KSWZP(sr2, 256 + sc2 * 2, DQK * 2)) = St::tobf(sr_[i].ks2); } while (0)
#define SWAIT() do { if constexpr (SDEPTH == 2) { if constexpr (X) asm volatile("s_waitcnt vmcnt(5)" ::: "memory"); else asm volatile("s_waitcnt vmcnt(4)" ::: "memory"); } else asm volatile("s_waitcnt vmcnt(0)" ::: "memory"); } while (0)
#define RESC(a) do { if (__any((a) < 1.f)) { if (hi == 0) al_l[r32] = (a); asm volatile("s_waitcnt lgkmcnt(0)" ::: "memory"); \
    for (int d = 0; d < 4; ++d) for (int r = 0; r < 16; ++r) o[d][r] *= al_l[crow(r, hi)]; } } while (0)
#define QKT_(P0, P1, KS) do { if constexpr ((PRB & 8) != 0) { P0 = f32x16{}; P1 = f32x16{}; for (int r_ = 0; r_ < 16; ++r_) { float t0_ = P0[r_], t1_ = P1[r_]; PIN(t0_); PIN(t1_); P0[r_] = t0_; P1[r_] = t1_; } } \
    else qkt<DQK, NQR, (PRB & 64)>(P0, P1, KS, qr, r32, hi, qx); } while (0)
#define FIN_(P0, P1, AL) do { if constexpr ((PRB & 1) != 0) fin_nop(P0, P1, pa0, pa1, pa2, pa3); else finishSM(P0, P1, AL, l_reg, pa0, pa1, pa2, pa3); } while (0)
#define PVS_(VB, P0, P1, MN, AL) do { \
    if constexpr ((PRB & 4) != 0) { if constexpr ((PRB & 1) != 0) { MN = 0.f; AL = 1.f; } else partialSM<DQK>(P0, P1, m_reg, MN, AL); } \
    else if constexpr ((PRB & 64) != 0) { pv_d0_nl(o, pa0, pa1, pa2, pa3); partialSM<DQK>(P0, P1, m_reg, MN, AL); } \
    else if constexpr ((PRB & 1) != 0) { pv_d0(o, VB, pa0, pa1, pa2, pa3); MN = 0.f; AL = 1.f; } \
    else if constexpr (PVSM) pv_sm<DQK>(o, VB, pa0, pa1, pa2, pa3, P0, P1, m_reg, MN, AL); \
    else { pv_d0(o, VB, pa0, pa1, pa2, pa3); partialSM<DQK>(P0, P1, m_reg, MN, AL); } } while (0)
#define WGB_() do { if constexpr ((PRB & 2) == 0) __syncthreads(); } while (0)
#define SLD_(i, k0) do { if constexpr ((PRB & 16) == 0) SLOAD(i, k0); } while (0)
#define SWR_(bb, i) do { if constexpr ((PRB & 16) == 0) { SWAIT(); SWRITE(bb, i); } } while (0)
  f32x16 pA0, pA1, pB0, pB1; float mnA, mnB, alA, alB; bf16x8 pa0, pa1, pa2, pa3; const int NT = seq / KVBLK;
  constexpr int SE = 0, SO = SDEPTH - 1;
  SLOAD(SE, 0); asm volatile("s_waitcnt vmcnt(0)" ::: "memory"); SWRITE(0, SE); __syncthreads();
  qkt<DQK, NQR>(pA0, pA1, K_lds, qr, r32, hi, qx); partialSM<DQK>(pA0, pA1, m_reg, mnA, alA);
  SLOAD(SO, KVBLK); if constexpr (SDEPTH == 2) { if (2 < NT) SLOAD(SE, 2 * KVBLK); }
  SWAIT(); SWRITE(1, SO); __syncthreads();
  for (int j = 1; j + 1 < NT; j += 2) {
    SBAR(); QKT_(pB0, pB1, (bf16*)((char*)K_lds + SHM_K));
    FIN_(pA0, pA1, alA); SBAR();
    SLD_(SO, (j + SDEPTH) * KVBLK); SBAR();
    PVS_(vb0, pB0, pB1, mnB, alB);
    WGB_(); SWR_(0, SE);
    RESC(alB); WGB_();
    SBAR(); QKT_(pA0, pA1, K_lds);
    FIN_(pB0, pB1, alB); SBAR();
    if (SDEPTH == 1 || j + 3 < NT) SLD_(SE, (j + 1 + SDEPTH) * KVBLK); SBAR();
    PVS_(vb0 + (int)SHM_V, pA0, pA1, mnA, alA);
    WGB_(); SWR_(1, SO);
    RESC(alA); WGB_();
  }
  SBAR(); qkt<DQK, NQR>(pB0, pB1, (bf16*)((char*)K_lds + SHM_K), qr, r32, hi, qx);
  finishSM(pA0, pA1, alA, l_reg, pa0, pa1, pa2, pa3); SBAR();
  if constexpr (PVSM) pv_sm<DQK>(o, vb0, pa0, pa1, pa2, pa3, pB0, pB1, m_reg, mnB, alB); else { pv_d0(o, vb0, pa0, pa1, pa2, pa3); partialSM<DQK>(pB0, pB1, m_reg, mnB, alB); }
  __syncthreads(); RESC(alB);
  finishSM(pB0, pB1, alB, l_reg, pa0, pa1, pa2, pa3); SBAR();
  pv_d0(o, vb0 + (int)SHM_V, pa0, pa1, pa2, pa3);
  if (hi == 0) li_l[r32] = l_reg; asm volatile("s_waitcnt lgkmcnt(0)" ::: "memory");
  float rli[16];
#pragma unroll
  for (int r = 0; r < 16; ++r) rli[r] = __builtin_amdgcn_rcpf(li_l[crow(r, hi)]);
  __syncthreads();
  {
    char* ep = lds + wid * 8704;
    int lane_e = hi * 4 * 272 + r32 * 2; asm volatile("" : "+v"(lane_e));
#pragma unroll
    for (int r = 0; r < 16; ++r) { const int ro = ((r & 3) + 8 * (r >> 2)) * 272;
#pragma unroll
      for (int d0 = 0; d0 < 4; ++d0) *(unsigned short*)(ep + lane_e + ro + d0 * 64) = (unsigned short)(cvtpk(o[d0][r] * rli[r], 0.f) & 0xffffu); }
    asm volatile("s_waitcnt lgkmcnt(0)" ::: "memory");
    int lane_q = lane; asm volatile("" : "+v"(lane_q));
    const int row0 = lane_q >> 4, ch = lane_q & 15;
    unsigned short* Yw = Ob + (long)(wid * QBLK + row0) * LDO + ch * 8; const unsigned short* Gw = Gb + (long)(wid * QBLK + row0) * LDO + ch * 8;
#pragma unroll
    for (int hf = 0; hf < 2; ++hf) { u32x4 gv[4], ov[4];
#pragma unroll
      for (int i = 0; i < 4; ++i) gv[i] = *(const u32x4*)(Gw + (long)(4 * (4 * hf + i)) * LDO);
#pragma unroll
      for (int i = 0; i < 4; ++i) ov[i] = *(const u32x4*)(ep + (row0 + 4 * (4 * hf + i)) * 272 + ch * 16);
#pragma unroll
      for (int i = 0; i < 4; ++i) { u32x4 w;
#pragma unroll
        for (int j = 0; j < 4; ++j) { const float lo = __uint_as_float(ov[i][j] << 16) * __uint_as_float(gv[i][j] << 16), hi2 = __uint_as_float(ov[i][j] & 0xffff0000u) * __uint_as_float(gv[i][j] & 0xffff0000u); w[j] = cvtpk(lo, hi2); }
        *(u32x4*)(Yw + (long)(4 * (4 * hf + i)) * LDO) = w; }
      asm volatile("" ::: "memory"); }
  }
  __syncthreads();
#undef SLOAD
#undef SWRITE
#undef SWAIT
#undef RESC
#undef QKT_
#undef FIN_
#undef PVS_
#undef WGB_
#undef SLD_
#undef SWR_
}

template <typename TQ, int LDQ, int LDK, int LDO, int DQK, int LDK2, int SDEPTH, int NQR>
__device__ __forceinline__ void attn_dense_body3(const TQ* __restrict__ Qb, const bf16* __restrict__ Kh, const bf16* __restrict__ K2h, const bf16* __restrict__ Vh,
                                                bf16* __restrict__ Ob, const bf16* __restrict__ Gb, int seq, char* lds) {
  constexpr size_t SHM_K = 64 * DQK * 2; constexpr bool X = DQK == 192;
  using St = Stage<bf16>; using SQ = Stage<TQ>;
  int tid_o = threadIdx.x; asm volatile("" : "+v"(tid_o));
  const int tid = tid_o, wid = __builtin_amdgcn_readfirstlane(tid >> 6), lane = tid & 63, r32 = lane & 31, hi = lane >> 5;
  bf16* V_lds = (bf16*)lds; bf16* K_lds = (bf16*)(lds + 3 * SHM_V);
  float* ws = (float*)(lds + 3 * SHM_V + 3 * SHM_K) + wid * 64; float* li_l = ws; float* al_l = ws + 32;
  float m_reg = -1e30f, l_reg = 0; f32x16 o[4] = {}; bf16x8 qr[NQR]; char* qx = lds + 3 * SHM_V + 3 * SHM_K + 2048 + wid * ((DQK / 16 - NQR) * 1024) + lane * 16;
  const TQ* Qw = Qb + (long)(wid * QBLK + r32) * LDQ + hi * 8;
#pragma unroll
  for (int d0 = 0; d0 < NQR; ++d0) qr[d0] = SQ::tobf(SQ::ld8(Qw + d0 * 16));
#pragma unroll
  for (int d0 = NQR; d0 < DQK / 16; ++d0) *reinterpret_cast<bf16x8*>(qx + (d0 - NQR) * 1024) = SQ::tobf(SQ::ld8(Qw + d0 * 16));
  const int sr = tid >> 4, sc = (tid & 15) * 8, vst0 = v_st(sr, sc), vst1 = v_st(32 + sr, sc);
  const int vb0 = (int)(uintptr_t)V_lds + v_rd_base(lane);
  const int sr2 = tid >> 3, sc2 = (tid & 7) * 8;
  struct { typename St::T vs0, vs1, ks0, ks1, ks2; } sr_[SDEPTH];
  const unsigned voff = (unsigned)(sr * LDK + sc) * 2u, k2off = (unsigned)(sr2 * LDK2 + sc2) * 2u;
#define SLOAD(i, k0) do { const char* vb_ = (const char*)Vh + (size_t)(k0) * (LDK * 2); const char* kb_ = (const char*)Kh + (size_t)(k0) * (LDK * 2); \
    sr_[i].vs0 = *(const bf16x8*)(vb_ + voff); sr_[i].vs1 = *(const bf16x8*)(vb_ + 32 * LDK * 2 + voff); \
    sr_[i].ks0 = *(const bf16x8*)(kb_ + voff); sr_[i].ks1 = *(const bf16x8*)(kb_ + 32 * LDK * 2 + voff); \
    if constexpr (X) sr_[i].ks2 = *(const bf16x8*)((const char*)K2h + (size_t)(k0) * (LDK2 * 2) + k2off); } while (0)
#define SWRITE(b, i) do { *(bf16x8*)((char*)V_lds + (b) * SHM_V + vst0) = St::tobf(sr_[i].vs0);          \
    *(bf16x8*)((char*)V_lds + (b) * SHM_V + vst1) = St::tobf(sr_[i].vs1); int kc = sc * 2;               \
    *(bf16x8*)((char*)K_lds + (b) * SHM_K + KSWZP(sr, kc, DQK * 2)) = St::tobf(sr_[i].ks0);                       \
    *(bf16x8*)((char*)K_lds + (b) * SHM_K + KSWZP(32 + sr, kc, DQK * 2)) = St::tobf(sr_[i].ks1); \
    if constexpr (X) *(bf16x8*)((char*)K_lds + (b) * SHM_K + KSWZP(sr2, 256 + sc2 * 2, DQK * 2)) = St::tobf(sr_[i].ks2); } while (0)
#define SWAIT() do { if constexpr (SDEPTH == 2) { if constexpr (X) asm volatile("s_waitcnt vmcnt(5)" ::: "memory"); else asm volatile("s_waitcnt vmcnt(4)" ::: "memory"); } else asm volatile("s_waitcnt vmcnt(0)" ::: "memory"); } while (0)
#define RESC(a) do { if (__any((a) < 1.f)) { if (hi == 0) al_l[r32] = (a); asm volatile("s_waitcnt lgkmcnt(0)" ::: "memory"); \
    for (int d = 0; d < 4; ++d) for (int r = 0; r < 16; ++r) o[d][r] *= al_l[crow(r, hi)]; } } while (0)
  f32x16 pA0, pA1, pB0, pB1; float mnA, mnB, alA, alB; bf16x8 pa0, pa1, pa2, pa3; const int NT = seq / KVBLK;
  SLOAD(0, 0); asm volatile("s_waitcnt vmcnt(0)" ::: "memory"); SWRITE(0, 0);
  SLOAD(0, KVBLK); asm volatile("s_waitcnt vmcnt(0)" ::: "memory"); SWRITE(1, 0); __syncthreads();
  qkt<DQK, NQR>(pA0, pA1, K_lds, qr, r32, hi, qx); partialSM<DQK>(pA0, pA1, m_reg, mnA, alA);
  if (2 < NT) SLOAD(0, 2 * KVBLK);
  if constexpr (SDEPTH == 2) { if (3 < NT) SLOAD(1, 3 * KVBLK); }
  int cur = 0, nxt = 1, wr = 2;
#define HALF(t, SL, PC0, PC1, ALC, PN0, PN1, MNN, ALN) do { \
    if ((t) + 2 < NT) { if (SDEPTH == 2 && (t) + 3 < NT) SWAIT(); else asm volatile("s_waitcnt vmcnt(0)" ::: "memory"); SWRITE(wr, SL); if ((t) + 2 + SDEPTH < NT) SLOAD(SL, ((t) + 2 + SDEPTH) * KVBLK); } \
    SBAR(); if ((t) + 1 < NT) qkt<DQK, NQR>(PN0, PN1, (bf16*)((char*)K_lds + nxt * SHM_K), qr, r32, hi, qx); \
    finishSM(PC0, PC1, ALC, l_reg, pa0, pa1, pa2, pa3); SBAR(); \
    pv_d0(o, vb0 + cur * (int)SHM_V, pa0, pa1, pa2, pa3); \
    if ((t) + 1 < NT) { partialSM<DQK>(PN0, PN1, m_reg, MNN, ALN); RESC(ALN); } \
    __syncthreads(); { const int c_ = cur; cur = nxt; nxt = wr; wr = c_; } } while (0)
  for (int t = 0; t < NT; t += 2) {
    HALF(t, 0, pA0, pA1, alA, pB0, pB1, mnB, alB);
    HALF(t + 1, (SDEPTH - 1), pB0, pB1, alB, pA0, pA1, mnA, alA);
  }
#undef HALF
  if (hi == 0) li_l[r32] = l_reg; asm volatile("s_waitcnt lgkmcnt(0)" ::: "memory");
  float rli[16];
#pragma unroll
  for (int r = 0; r < 16; ++r) rli[r] = __builtin_amdgcn_rcpf(li_l[crow(r, hi)]);
  __syncthreads();
  {
    char* ep = lds + wid * 8704;
    int lane_e = hi * 4 * 272 + r32 * 2; asm volatile("" : "+v"(lane_e));
#pragma unroll
    for (int r = 0; r < 16; ++r) { const int ro = ((r & 3) + 8 * (r >> 2)) * 272;
#pragma unroll
      for (int d0 = 0; d0 < 4; ++d0) *(unsigned short*)(ep + lane_e + ro + d0 * 64) = (unsigned short)(cvtpk(o[d0][r] * rli[r], 0.f) & 0xffffu); }
    asm volatile("s_waitcnt lgkmcnt(0)" ::: "memory");
    int lane_q = lane; asm volatile("" : "+v"(lane_q));
    const int row0 = lane_q >> 4, ch = lane_q & 15;
    unsigned short* Yw = Ob + (long)(wid * QBLK + row0) * LDO + ch * 8; const unsigned short* Gw = Gb + (long)(wid * QBLK + row0) * LDO + ch * 8;
#pragma unroll
    for (int hf = 0; hf < 2; ++hf) { u32x4 gv[4], ov[4];
#pragma unroll
      for (int i = 0; i < 4; ++i) gv[i] = *(const u32x4*)(Gw + (long)(4 * (4 * hf + i)) * LDO);
#pragma unroll
      for (int i = 0; i < 4; ++i) ov[i] = *(const u32x4*)(ep + (row0 + 4 * (4 * hf + i)) * 272 + ch * 16);
#pragma unroll
      for (int i = 0; i < 4; ++i) { u32x4 w;
#pragma unroll
        for (int j = 0; j < 4; ++j) { const float lo = __uint_as_float(ov[i][j] << 16) * __uint_as_float(gv[i][j] << 16), hi2 = __uint_as_float(ov[i][j] & 0xffff0000u) * __uint_as_float(gv[i][j] & 0xffff0000u); w[j] = cvtpk(lo, hi2); }
        *(u32x4*)(Yw + (long)(4 * (4 * hf + i)) * LDO) = w; }
      asm volatile("" ::: "memory"); }
  }
  __syncthreads();
#undef SLOAD
#undef SWRITE
#undef SWAIT
#undef RESC
}

template <typename TQ, int LDQ, int LDK, int LDO, int DQK, int LDK2, int SDEPTH, int NQR>
__device__ __forceinline__ void attn_dense_body_dma(const TQ* __restrict__ Qb, const bf16* __restrict__ Kh, const bf16* __restrict__ K2h, const bf16* __restrict__ Vh,
                                                bf16* __restrict__ Ob, const bf16* __restrict__ Gb, int seq, char* lds) {
  constexpr size_t SHM_K = 64 * DQK * 2; constexpr bool X = DQK == 192; constexpr bool PVSM = X ? (ATT_PVSM_B != 0) : (ATT_PVSM_A != 0);
  using St = Stage<bf16>; using SQ = Stage<TQ>;
  int tid_o = threadIdx.x; asm volatile("" : "+v"(tid_o));
  const int tid = tid_o, wid = __builtin_amdgcn_readfirstlane(tid >> 6), lane = tid & 63, r32 = lane & 31, hi = lane >> 5;
  bf16* V_lds = (bf16*)lds; bf16* K_lds = (bf16*)(lds + 3 * SHM_V);
  float* ws = (float*)(lds + 3 * SHM_V + 4 * SHM_K) + wid * 64; float* li_l = ws; float* al_l = ws + 32;
  float m_reg = -1e30f, l_reg = 0; f32x16 o[4] = {}; bf16x8 qr[NQR]; char* qx = lds + 3 * SHM_V + 4 * SHM_K + 2048 + wid * ((DQK / 16 - NQR) * 1024) + lane * 16;
  const TQ* Qw = Qb + (long)(wid * QBLK + r32) * LDQ + hi * 8;
#pragma unroll
  for (int d0 = 0; d0 < NQR; ++d0) qr[d0] = SQ::tobf(SQ::ld8(Qw + d0 * 16));
#pragma unroll
  for (int d0 = NQR; d0 < DQK / 16; ++d0) *reinterpret_cast<bf16x8*>(qx + (d0 - NQR) * 1024) = SQ::tobf(SQ::ld8(Qw + d0 * 16));
  const int vb0 = (int)(uintptr_t)V_lds + v_rd_base(lane);
  const unsigned ldsK = (unsigned)(uintptr_t)K_lds + wid * 1024u, ldsV = (unsigned)(uintptr_t)V_lds + wid * 1024u;
  const char* kg = (const char*)Kh; const char* vg = (const char*)Vh;
  unsigned koff = 0; const char* kp[3] = {nullptr, nullptr, nullptr}; unsigned kst[3] = {0, 0, 0};
  if constexpr (!X) { const int krow = 4 * wid + (lane >> 4); koff = (unsigned)(krow * (LDK * 2) + (((lane & 15) ^ KSWZK(krow, 256)) << 4)); }
  else {
#pragma unroll
    for (int i = 0; i < 3; ++i) { const int P = (wid + 8 * i) * 64 + lane, row = P / 24, slot = P - row * 24, cb = slot ^ KSWZK(row, 384);
      if (cb < 16) { kp[i] = (const char*)Kh + (size_t)row * (LDK * 2) + cb * 16; kst[i] = 64 * LDK * 2; }
      else { kp[i] = (const char*)K2h + (size_t)row * (LDK2 * 2) + (cb - 16) * 16; kst[i] = 64 * LDK2 * 2; } } }
  unsigned voff; { const int st = 2 * wid + (lane >> 5), kk = (st >> 2) * 8 + ((lane & 31) >> 2), k = (kk & ~0xC) | ((kk & 4) << 1) | ((kk & 8) >> 1), c = (st & 3) * 32 + (lane & 3) * 8;
    voff = (unsigned)(k * (LDK * 2) + c * 2); }
#define GLDS(g, l) __builtin_amdgcn_global_load_lds((const unsigned*)(g), (LAS unsigned*)(l), 16, 0, 0)
#define DMAK(bi) do { const unsigned kd_ = ldsK + (bi) * (unsigned)SHM_K; \
    if constexpr (!X) { GLDS(kg + koff, kd_); GLDS(kg + 32 * LDK * 2 + koff, kd_ + 8192); kg += 64 * LDK * 2; } \
    else { _Pragma("unroll") for (int i_ = 0; i_ < 3; ++i_) { GLDS(kp[i_], kd_ + i_ * 8192); kp[i_] += kst[i_]; } } } while (0)
#define DMAV(bi) do { const unsigned vd_ = ldsV + (bi) * (unsigned)SHM_V; GLDS(vg + voff, vd_); GLDS(vg + 32 * LDK * 2 + voff, vd_ + 8192); vg += 64 * LDK * 2; } while (0)
#define RESC(a) do { if (__any((a) < 1.f)) { if (hi == 0) al_l[r32] = (a); asm volatile("s_waitcnt lgkmcnt(0)" ::: "memory"); \
    for (int d = 0; d < 4; ++d) for (int r = 0; r < 16; ++r) o[d][r] *= al_l[crow(r, hi)]; } } while (0)
  f32x16 pA0, pA1, pB0, pB1; float mnA, mnB, alA, alB; bf16x8 pa0, pa1, pa2, pa3; const int NT = seq / KVBLK;
  DMAK(0); DMAV(0); DMAK(1); DMAV(1); DMAK(2); asm volatile("s_waitcnt vmcnt(0)" ::: "memory"); __syncthreads();
  qkt<DQK, NQR>(pA0, pA1, K_lds, qr, r32, hi, qx); partialSM<DQK>(pA0, pA1, m_reg, mnA, alA);
  int vcur = 0, vnxt = 1, vwr = 2;
#define HALF(t, FULL, PC0, PC1, ALC, PN0, PN1, MNN, ALN) do { \
    if (FULL || (t) + 3 < NT) DMAK(((t) + 3) & 3); if (FULL || (t) + 2 < NT) DMAV(vwr); \
    SBAR(); if (FULL || (t) + 1 < NT) qkt<DQK, NQR>(PN0, PN1, (bf16*)((char*)K_lds + (((t) + 1) & 3) * SHM_K), qr, r32, hi, qx); \
    finishSM(PC0, PC1, ALC, l_reg, pa0, pa1, pa2, pa3); SBAR(); \
    pv_d0(o, vb0 + vcur * (int)SHM_V, pa0, pa1, pa2, pa3); \
    if (FULL || (t) + 1 < NT) { partialSM<DQK>(PN0, PN1, m_reg, MNN, ALN); RESC(ALN); } \
    if (FULL || (t) + 3 < NT) { if constexpr (X) asm volatile("s_waitcnt vmcnt(5)" ::: "memory"); else asm volatile("s_waitcnt vmcnt(4)" ::: "memory"); } \
    else if ((t) + 2 < NT) asm volatile("s_waitcnt vmcnt(2)" ::: "memory"); else asm volatile("s_waitcnt vmcnt(0)" ::: "memory"); \
    __syncthreads(); { const int c_ = vcur; vcur = vnxt; vnxt = vwr; vwr = c_; } } while (0)
  int t = 0;
  for (; t + 5 < NT; t += 2) {
    HALF(t, 1, pA0, pA1, alA, pB0, pB1, mnB, alB);
    HALF(t + 1, 1, pB0, pB1, alB, pA0, pA1, mnA, alA);
  }
  for (; t < NT; t += 2) {
    HALF(t, 0, pA0, pA1, alA, pB0, pB1, mnB, alB);
    HALF(t + 1, 0, pB0, pB1, alB, pA0, pA1, mnA, alA);
  }
#undef HALF
  if (hi == 0) li_l[r32] = l_reg; asm volatile("s_waitcnt lgkmcnt(0)" ::: "memory");
  float rli[16];
#pragma unroll
  for (int r = 0; r < 16; ++r) rli[r] = __builtin_amdgcn_rcpf(li_l[crow(r, hi)]);
  __syncthreads();
  {
    char* ep = lds + wid * 8704;
    int lane_e = hi * 4 * 272 + r32 * 2; asm volatile("" : "+v"(lane_e));
#pragma unroll
    for (int r = 0; r < 16; ++r) { const int ro = ((r & 3) + 8 * (r >> 2)) * 272;
#pragma unroll
      for (int d0 = 0; d0 < 4; ++d0) *(unsigned short*)(ep + lane_e + ro + d0 * 64) = (unsigned short)(cvtpk(o[d0][r] * rli[r], 0.f) & 0xffffu); }
    asm volatile("s_waitcnt lgkmcnt(0)" ::: "memory");
    int lane_q = lane; asm volatile("" : "+v"(lane_q));
    const int row0 = lane_q >> 4, ch = lane_q & 15;
    unsigned short* Yw = Ob + (long)(wid * QBLK + row0) * LDO + ch * 8; const unsigned short* Gw = Gb + (long)(wid * QBLK + row0) * LDO + ch * 8;
#pragma unroll
    for (int hf = 0; hf < 2; ++hf) { u32x4 gv[4], ov[4];
#pragma unroll
      for (int i = 0; i < 4; ++i) gv[i] = *(const u32x4*)(Gw + (long)(4 * (4 * hf + i)) * LDO);
#pragma unroll
      for (int i = 0; i < 4; ++i) ov[i] = *(const u32x4*)(ep + (row0 + 4 * (4 * hf + i)) * 272 + ch * 16);
#pragma unroll
      for (int i = 0; i < 4; ++i) { u32x4 w;
#pragma unroll
        for (int j = 0; j < 4; ++j) { const float lo = __uint_as_float(ov[i][j] << 16) * __uint_as_float(gv[i][j] << 16), hi2 = __uint_as_float(ov[i][j] & 0xffff0000u) * __uint_as_float(gv[i][j] & 0xffff0000u); w[j] = cvtpk(lo, hi2); }
        *(u32x4*)(Yw + (long)(4 * (4 * hf + i)) * LDO) = w; }
      asm volatile("" ::: "memory"); }
  }
  __syncthreads();
#undef DMAK
#undef DMAV
#undef GLDS
#undef RESC
}

template <typename TQ, int LDQ, int LDK, int LDO, int DQK, int LDK2, int SDEPTH, int NQR>
__device__ __forceinline__ void attn_dense_body_pp(const TQ* __restrict__ Qb, const bf16* __restrict__ Kh, const bf16* __restrict__ K2h, const bf16* __restrict__ Vh,
                                                bf16* __restrict__ Ob, const bf16* __restrict__ Gb, int seq, char* lds) {
  constexpr size_t SHM_K = 64 * DQK * 2; constexpr bool X = DQK == 192; constexpr bool PVSM = X ? (ATT_PVSM_B != 0) : (ATT_PVSM_A != 0);
  using St = Stage<bf16>; using SQ = Stage<TQ>;
  int tid_o = threadIdx.x; asm volatile("" : "+v"(tid_o));
  const int tid = tid_o, wid = __builtin_amdgcn_readfirstlane(tid >> 6), lane = tid & 63, r32 = lane & 31, hi = lane >> 5;
  bf16* V_lds = (bf16*)lds; bf16* K_lds = (bf16*)(lds + 3 * SHM_V);
  float* ws = (float*)(lds + 3 * SHM_V + 4 * SHM_K) + wid * 64; float* li_l = ws; float* al_l = ws + 32;
  float m_reg = -1e30f, l_reg = 0; f32x16 o[4] = {}; bf16x8 qr[NQR]; char* qx = lds + 3 * SHM_V + 4 * SHM_K + 2048 + wid * ((DQK / 16 - NQR) * 1024) + lane * 16;
  const TQ* Qw = Qb + (long)(wid * QBLK + r32) * LDQ + hi * 8;
#pragma unroll
  for (int d0 = 0; d0 < NQR; ++d0) qr[d0] = SQ::tobf(SQ::ld8(Qw + d0 * 16));
#pragma unroll
  for (int d0 = NQR; d0 < DQK / 16; ++d0) *reinterpret_cast<bf16x8*>(qx + (d0 - NQR) * 1024) = SQ::tobf(SQ::ld8(Qw + d0 * 16));
  const int vb0 = (int)(uintptr_t)V_lds + v_rd_base(lane);
  const unsigned ldsK = (unsigned)(uintptr_t)K_lds + wid * 1024u, ldsV = (unsigned)(uintptr_t)V_lds + wid * 1024u;
  const char* kg = (const char*)Kh; const char* vg = (const char*)Vh;
  unsigned koff = 0; const char* kp[3] = {nullptr, nullptr, nullptr}; unsigned kst[3] = {0, 0, 0};
  if constexpr (!X) { const int krow = 4 * wid + (lane >> 4); koff = (unsigned)(krow * (LDK * 2) + (((lane & 15) ^ KSWZK(krow, 256)) << 4)); }
  else {
#pragma unroll
    for (int i = 0; i < 3; ++i) { const int P = (wid + 8 * i) * 64 + lane, row = P / 24, slot = P - row * 24, cb = slot ^ KSWZK(row, 384);
      if (cb < 16) { kp[i] = (const char*)Kh + (size_t)row * (LDK * 2) + cb * 16; kst[i] = 64 * LDK * 2; }
      else { kp[i] = (const char*)K2h + (size_t)row * (LDK2 * 2) + (cb - 16) * 16; kst[i] = 64 * LDK2 * 2; } } }
  unsigned voff; { const int st = 2 * wid + (lane >> 5), kk = (st >> 2) * 8 + ((lane & 31) >> 2), k = (kk & ~0xC) | ((kk & 4) << 1) | ((kk & 8) >> 1), c = (st & 3) * 32 + (lane & 3) * 8;
    voff = (unsigned)(k * (LDK * 2) + c * 2); }
#define GLDS(g, l) __builtin_amdgcn_global_load_lds((const unsigned*)(g), (LAS unsigned*)(l), 16, 0, 0)
#define DMAK(bi) do { const unsigned kd_ = ldsK + (bi) * (unsigned)SHM_K; \
    if constexpr (!X) { GLDS(kg + koff, kd_); GLDS(kg + 32 * LDK * 2 + koff, kd_ + 8192); kg += 64 * LDK * 2; } \
    else { _Pragma("unroll") for (int i_ = 0; i_ < 3; ++i_) { GLDS(kp[i_], kd_ + i_ * 8192); kp[i_] += kst[i_]; } } } while (0)
#define DMAV(bi) do { const unsigned vd_ = ldsV + (bi) * (unsigned)SHM_V; GLDS(vg + voff, vd_); GLDS(vg + 32 * LDK * 2 + voff, vd_ + 8192); vg += 64 * LDK * 2; } while (0)
#define RESC(a) do { if (__any((a) < 1.f)) { if (hi == 0) al_l[r32] = (a); asm volatile("s_waitcnt lgkmcnt(0)" ::: "memory"); \
    for (int d = 0; d < 4; ++d) for (int r = 0; r < 16; ++r) o[d][r] *= al_l[crow(r, hi)]; } } while (0)
  f32x16 p0, p1; float mn, al; bf16x8 pa0, pa1, pa2, pa3; const int NT = seq / KVBLK; const int grp = wid >> 2;
  DMAK(0); DMAV(0); DMAK(1); DMAV(1); DMAK(2); asm volatile("s_waitcnt vmcnt(0)" ::: "memory"); __syncthreads();
  qkt<DQK, NQR>(p0, p1, K_lds, qr, r32, hi, qx);
  partialSM<DQK>(p0, p1, m_reg, mn, al); finishSM(p0, p1, al, l_reg, pa0, pa1, pa2, pa3);
  if (grp) __syncthreads();
  int vcur = 0, vnxt = 1, vwr = 2;
#define MSEG(t, FULL) do { __builtin_amdgcn_s_setprio(ATT_PP_PRIO); \
    if (FULL || (t) + 3 < NT) DMAK(((t) + 3) & 3); if (FULL || (t) + 2 < NT) DMAV(vwr); \
    SBAR(); if (FULL || (t) + 1 < NT) qkt<DQK, NQR>(p0, p1, (bf16*)((char*)K_lds + (((t) + 1) & 3) * SHM_K), qr, r32, hi, qx); \
    pv_d0(o, vb0 + vcur * (int)SHM_V, pa0, pa1, pa2, pa3); \
    if (FULL || (t) + 3 < NT) { if constexpr (X) asm volatile("s_waitcnt vmcnt(5)" ::: "memory"); else asm volatile("s_waitcnt vmcnt(4)" ::: "memory"); } \
    else if ((t) + 2 < NT) asm volatile("s_waitcnt vmcnt(2)" ::: "memory"); else asm volatile("s_waitcnt vmcnt(0)" ::: "memory"); \
    __syncthreads(); { const int c_ = vcur; vcur = vnxt; vnxt = vwr; vwr = c_; } } while (0)
#define SSEG(t, FULL) do { __builtin_amdgcn_s_setprio(ATT_PP_PRIO_S); \
    if (FULL || (t) + 1 < NT) { partialSM<DQK>(p0, p1, m_reg, mn, al); RESC(al); finishSM(p0, p1, al, l_reg, pa0, pa1, pa2, pa3); } \
    __syncthreads(); } while (0)
  int t = 0;
  for (; t + 3 < NT; ++t) { MSEG(t, 1); SSEG(t, 1); }
  for (; t < NT; ++t) { MSEG(t, 0); SSEG(t, 0); }
  if (!grp) __syncthreads();
#undef MSEG
#undef SSEG
  if (hi == 0) li_l[r32] = l_reg; asm volatile("s_waitcnt lgkmcnt(0)" ::: "memory");
  float rli[16];
#pragma unroll
  for (int r = 0; r < 16; ++r) rli[r] = __builtin_amdgcn_rcpf(li_l[crow(r, hi)]);
  __syncthreads();
  {
    char* ep = lds + wid * 8704;
    int lane_e = hi * 4 * 272 + r32 * 2; asm volatile("" : "+v"(lane_e));
#pragma unroll
    for (int r = 0; r < 16; ++r) { const int ro = ((r & 3) + 8 * (r >> 2)) * 272;
#pragma unroll
      for (int d0 = 0; d0 < 4; ++d0) *(unsigned short*)(ep + lane_e + ro + d0 * 64) = (unsigned short)(cvtpk(o[d0][r] * rli[r], 0.f) & 0xffffu); }
    asm volatile("s_waitcnt lgkmcnt(0)" ::: "memory");
    int lane_q = lane; asm volatile("" : "+v"(lane_q));
    const int row0 = lane_q >> 4, ch = lane_q & 15;
    unsigned short* Yw = Ob + (long)(wid * QBLK + row0) * LDO + ch * 8; const unsigned short* Gw = Gb + (long)(wid * QBLK + row0) * LDO + ch * 8;
#pragma unroll
    for (int hf = 0; hf < 2; ++hf) { u32x4 gv[4], ov[4];
#pragma unroll
      for (int i = 0; i < 4; ++i) gv[i] = *(const u32x4*)(Gw + (long)(4 * (4 * hf + i)) * LDO);
#pragma unroll
      for (int i = 0; i < 4; ++i) ov[i] = *(const u32x4*)(ep + (row0 + 4 * (4 * hf + i)) * 272 + ch * 16);
#pragma unroll
      for (int i = 0; i < 4; ++i) { u32x4 w;
#pragma unroll
        for (int j = 0; j < 4; ++j) { const float lo = __uint_as_float(ov[i][j] << 16) * __uint_as_float(gv[i][j] << 16), hi2 = __uint_as_float(ov[i][j] & 0xffff0000u) * __uint_as_float(gv[i][j] & 0xffff0000u); w[j] = cvtpk(lo, hi2); }
        *(u32x4*)(Yw + (long)(4 * (4 * hf + i)) * LDO) = w; }
      asm volatile("" ::: "memory"); }
  }
  __syncthreads();
#undef DMAK
#undef DMAV
#undef GLDS
#undef RESC
}

}

#ifndef ATT_DMA_A
#define ATT_DMA_A 0
#endif
#ifndef ATT_DMA_B
#define ATT_DMA_B 0
#endif
#ifndef ATT_PP
#define ATT_PP 0
#endif
#if ATT_PP
#define ATT_BODY attn_dense_body_pp
#ifndef ATT_NQR_A
#define ATT_NQR_A 8
#endif
#elif ATT_DMA_A
#define ATT_BODY attn_dense_body_dma
#ifndef ATT_NQR_A
#define ATT_NQR_A 8
#endif
#else
#define ATT_BODY attn_dense_body
#endif
#ifndef ATT_PP_B
#define ATT_PP_B 1
#endif
#if ATT_PP_B
#define ATT_BODY_B attn_dense_body_pp
#ifndef ATT_NQR_B
#define ATT_NQR_B 12
#endif
#elif ATT_DMA_B
#define ATT_BODY_B attn_dense_body_dma
#ifndef ATT_NQR_B
#define ATT_NQR_B 11
#endif
#else
#define ATT_BODY_B attn_dense_body
#endif
#ifndef ATT_NQR_A
#define ATT_NQR_A 6
#endif
#ifndef ATT_NQR_B
#define ATT_NQR_B 10
#endif
#ifndef ATT_SD_A
#define ATT_SD_A 2
#endif
#ifndef ATT_SD_B
#define ATT_SD_B 1
#endif
__device__ __forceinline__ void attn_phase(const Frame& F, const Args& a, unsigned char* lds_generic) {
    unsigned char* ws = a.ws;
    const bf16_t* A1 = (const bf16_t*)(ws + WS_A1); const bf16_t* QB = (const bf16_t*)(ws + WS_QB); const bf16_t* KVB = (const bf16_t*)(ws + WS_KVB);
    const bf16_t* KRb = (const bf16_t*)(ws + WS_KR); const bf16_t* G0 = (const bf16_t*)(ws + WS_G0); bf16_t* Y0 = (bf16_t*)(ws + WS_Y0);
    char* lds = (char*)lds_generic;
    const int x = F.bid & 7, slot = F.bid >> 3;
    for (int ii = 0; ii < ((a.var & 1) ? 0 : 5); ++ii) {
        int b, hd, q0, kb, seq;
        if (ii < 4) { const int i = (ii & 1) + 4 * (ii >> 1); const int p = i * 8 + x; b = p >> 5; hd = p & 31; q0 = b * SB + slot * 256; kb = b * SB; seq = SB; }
        else { if (F.bid >= 32) break; b = F.bid >> 4; hd = F.bid & 15; q0 = b * SB + S; kb = q0; seq = CTX; }
        att::ATT_BODY<att::bf16, 3072, 3072, 4096, 128, 64, ATT_SD_A, ATT_NQR_A>(A1 + (size_t)q0 * 3072 + hd * 128, A1 + (size_t)kb * 3072 + 2048 + (hd >> 2) * 128, nullptr,
                            A1 + (size_t)kb * 3072 + 2560 + (hd >> 2) * 128, Y0 + (size_t)q0 * 4096 + hd * 128, G0 + (size_t)q0 * 4096 + hd * 128, seq, lds);
        __syncthreads();
    }
#ifdef ATT_PRB
    if (a.var & 4) for (int ii = 0; ii < 4; ++ii) {
        const int i = (ii & 1) + 4 * (ii >> 1); const int p = i * 8 + x; const int b = p >> 5, hd = p & 31, q0 = b * SB + slot * 256, kb = b * SB;
        att::attn_dense_body<att::bf16, 3072, 3072, 4096, 128, 64, ATT_SD_A, ATT_NQR_A, ATT_PRB>(A1 + (size_t)q0 * 3072 + hd * 128, A1 + (size_t)kb * 3072 + 2048 + (hd >> 2) * 128, nullptr,
                            A1 + (size_t)kb * 3072 + 2560 + (hd >> 2) * 128, Y0 + (size_t)q0 * 4096 + hd * 128, G0 + (size_t)q0 * 4096 + hd * 128, SB, lds);
        __syncthreads();
    }
#endif
    for (int ii = 0; ii < ((a.var & 2) ? 0 : 5); ++ii) {
        int b, h, q0, kb, seq;
        if (ii < 4) { const int i = 2 + (ii & 1) + 4 * (ii >> 1); const int p = i * 8 + x; b = p >> 5; h = (p & 31) - 16; q0 = b * SB + slot * 256; kb = b * SB; seq = SB; }
        else { if (F.bid >= 32) break; b = F.bid >> 4; h = F.bid & 15; q0 = b * SB + S; kb = q0; seq = CTX; }
        att::ATT_BODY_B<att::bf16, 3072, 4096, 4096, 192, 64, ATT_SD_B, ATT_NQR_B>(QB + (size_t)q0 * 3072 + h * 192, KVB + (size_t)kb * 4096 + h * 256, KRb + (size_t)kb * 64,
                            KVB + (size_t)kb * 4096 + h * 256 + 128, Y0 + (size_t)q0 * 4096 + 2048 + h * 128, G0 + (size_t)q0 * 4096 + 2048 + h * 128, seq, lds);
        __syncthreads();
    }
}
}
namespace fk {
constexpr int NCH = SB / 64;
constexpr int NC2_ = SB / 32;
struct EpiL1 {
    static constexpr bool PERM = true;
    bf16_t* QK1; bf16_t* VT; bf16_t* U1; bf16_t* G1; float* GD; int skip; LAS unsigned char* vx;
    __device__ __forceinline__ void operator()(const f32x4 (&acc)[2][2][4][2], const Unit& u, int wr, int wc, int fr, int fq) const {
        if (skip) return;
        const int pn = u.pn; const int rowl0 = wr * 64 + fr; const size_t row0 = (size_t)u.pm * 256 + rowl0; const int cl = wc * 32 + 8 * fq;
        if (pn >= 12 && pn < 24) {
            const int b = u.pm / PPB, pb = u.pm % PPB; const int cv = (pn - 12) * 256, h = cv >> 9; const int lane = fq * 16 + fr;
            LAS bf16_t* w = (LAS bf16_t*)(vx + (wr * 4 + wc) * 2048);
#pragma unroll
            for (int ai = 0; ai < 2; ++ai)
#pragma unroll
                for (int bj = 0; bj < 2; ++bj)
#pragma unroll
                    for (int mh = 0; mh < 2; ++mh) {
#pragma unroll
                        for (int mm = 0; mm < 2; ++mm) { const int m = 2 * mh + mm; const f32x4 x0 = acc[ai][bj][m][0], x1 = acc[ai][bj][m][1]; const int tl = 16 * mm + fr;
#pragma unroll
                            for (int j = 0; j < 4; ++j) { w[(8 * fq + j) * 32 + tl] = (bf16_t)(cvt_pk_bf16(x0[j], 0.f) & 0xffffu); w[(8 * fq + 4 + j) * 32 + tl] = (bf16_t)(cvt_pk_bf16(x1[j], 0.f) & 0xffffu); } }
                        LDS_WAIT(); asm volatile("" ::: "memory");
                        const int c32 = pb * 8 + 4 * ai + 2 * wr + mh; const int e0 = (cv & 511) + bj * 128 + wc * 32;
                        bf16_t* dst = VT + ((size_t)((b * 6 + h) * NC2_ + c32) * 512 + e0) * 32;
#pragma unroll
                        for (int i = 0; i < 2; ++i) { const int q = lane + 64 * i, el = q >> 2, tc = q & 3; *(u32x4*)(dst + el * 32 + tc * 8) = *(const LAS u32x4*)(w + el * 32 + tc * 8); }
                        LDS_WAIT(); asm volatile("" ::: "memory");
                    }
        } else if (pn < 28) {
            bf16_t* base; int ld, c0;
            if (pn < 12) { base = QK1; ld = 3072; c0 = pn * 256; } else { base = U1; ld = 1024; c0 = (pn - 24) * 256; }
#pragma unroll
            for (int ai = 0; ai < 2; ++ai)
#pragma unroll
                for (int m = 0; m < 4; ++m)
#pragma unroll
                    for (int bj = 0; bj < 2; ++bj) *(u32x4*)(base + (row0 + ai * 128 + 16 * m) * ld + c0 + bj * 128 + cl) = pack8(acc[ai][bj][m][0], acc[ai][bj][m][1]);
        } else if (pn < 44) {
#pragma unroll
            for (int ai = 0; ai < 2; ++ai)
#pragma unroll
                for (int m = 0; m < 4; ++m)
#pragma unroll
                    for (int bj = 0; bj < 2; ++bj) { f32x4 x0 = acc[ai][bj][m][0], x1 = acc[ai][bj][m][1];
#pragma unroll
                        for (int i = 0; i < 4; ++i) { x0[i] = fast_silu(x0[i]); x1[i] = fast_silu(x1[i]); }
                        *(u32x4*)(G1 + (row0 + ai * 128 + 16 * m) * 4096 + (pn - 28) * 256 + bj * 128 + cl) = pack8(x0, x1); }
        } else {
            if (wc == 0) {
#pragma unroll
                for (int ai = 0; ai < 2; ++ai)
#pragma unroll
                    for (int m = 0; m < 4; ++m) { float* g = GD + (row0 + ai * 128 + 16 * m) * 32 + 8 * fq; *(f32x4*)g = acc[ai][0][m][0]; *(f32x4*)(g + 4) = acc[ai][0][m][1]; } }
        }
    }
};
struct EpiPlain {
    static constexpr bool PERM = true;
    bf16_t* O; int ld;
    __device__ __forceinline__ void operator()(const f32x4 (&acc)[2][2][4][2], const Unit& u, int wr, int wc, int fr, int fq) const {
        const size_t row0 = (size_t)u.pm * 256 + wr * 64 + fr; const int c0 = u.pn * 256 + wc * 32 + 8 * fq;
#pragma unroll
        for (int ai = 0; ai < 2; ++ai)
#pragma unroll
            for (int m = 0; m < 4; ++m)
#pragma unroll
                for (int bj = 0; bj < 2; ++bj) *(u32x4*)(O + (row0 + ai * 128 + 16 * m) * ld + c0 + bj * 128) = pack8(acc[ai][bj][m][0], acc[ai][bj][m][1]);
    }
};
struct OrderFn {
    int bid;
    __device__ bool next(int i, Unit& u) const { if (i >= 1) return false; const int half = bid >> 7, t = bid & 127; u.pm = (t >> 3) + 16 * half; u.pn = (t & 7) + 8 * half; u.ko = 0; return true; }
};
struct EpiPcs {
    static constexpr bool PERM = true;
    bf16_t* P; float scale;
    __device__ __forceinline__ void operator()(const f32x4 (&acc)[2][2][4][2], const Unit& u, int wr, int wc, int fr, int fq) const {
        const size_t row0 = (size_t)(u.pm >> 4) * 4096 + (size_t)(u.pm & 15) * 256 + wr * 64 + fr; const int c0 = (u.pn & 7) * 256 + wc * 32 + 8 * fq;
#pragma unroll
        for (int ai = 0; ai < 2; ++ai)
#pragma unroll
            for (int m = 0; m < 4; ++m)
#pragma unroll
                for (int bj = 0; bj < 2; ++bj) *(u32x4*)(P + (row0 + ai * 128 + 16 * m) * 2048 + c0 + bj * 128) = pack8(acc[ai][bj][m][0] * scale, acc[ai][bj][m][1] * scale);
    }
};
__device__ __forceinline__ void fold_phase(const Frame& F, const bf16_t* AB, bf16_t* BF, int w0, int nw) {
    const int gw = F.bid * NWAVES + F.wave - w0; if (gw < 0 || gw >= nw) return;
    LAS float* scr = (LAS float*)(F.lds + 4096 + F.wave * (64 * 65 * 4));
    const int lane = F.lane, rr = lane >> 3, c8 = (lane & 7) * 8;
    for (int it = gw; it < 2 * 2 * 66 * 16; it += nw) {
        const int half = it / 2112, r0 = it % 2112, b = r0 / 1056, r = r0 % 1056, kb = r / 16, cb = r % 16;
        const int ch = cb * 64 + c8, g = ch >> 8, l = ch & 255;
        const bf16_t* base = AB + (size_t)b * SB * 2048 + g * 512 + half * 256 + l;
        u32x4 p0[8], p1[8];
#pragma unroll
        for (int jj = 0; jj < 8; ++jj) { const int kk = kb * 64 + jj * 8 + rr; const u32x4 z = {0u, 0u, 0u, 0u};
            const bool v0 = half == 0 ? (kk <= 4096) : (kk >= 1 && kk <= 4095), v1 = (kk >= 1 && kk <= 4095);
            p0[jj] = v0 ? *(const u32x4*)(base + (size_t)kk * 2048) : z; p1[jj] = v1 ? *(const u32x4*)(base + (size_t)(8192 - kk) * 2048) : z; }
        const float sg = half == 0 ? 1.f : -1.f;
#pragma unroll
        for (int jj = 0; jj < 8; ++jj) { const int j = jj * 8 + rr; LAS float* dst = scr + j * 65 + c8;
            const unsigned a[4] = {p0[jj].x, p0[jj].y, p0[jj].z, p0[jj].w}, m[4] = {p1[jj].x, p1[jj].y, p1[jj].z, p1[jj].w};
#pragma unroll
            for (int i = 0; i < 4; ++i) { dst[2 * i] = bf_lo(a[i]) + sg * bf_lo(m[i]); dst[2 * i + 1] = bf_hi(a[i]) + sg * bf_hi(m[i]); } }
        LDS_WAIT(); asm volatile("" ::: "memory");
#pragma unroll
        for (int t = 0; t < 8; ++t) { const int cr = (lane >> 3) + 8 * t, k8 = (lane & 7) * 8; float v[8];
#pragma unroll
            for (int i = 0; i < 8; ++i) v[i] = scr[(k8 + i) * 65 + cr];
            u32x4 o; o.x = cvt_pk_bf16(v[0], v[1]); o.y = cvt_pk_bf16(v[2], v[3]); o.z = cvt_pk_bf16(v[4], v[5]); o.w = cvt_pk_bf16(v[6], v[7]);
            *(u32x4*)(BF + ((size_t)half * 2048 + b * 1024 + cb * 64 + cr) * FKP + kb * 64 + k8) = o; }
        LDS_WAIT(); asm volatile("" ::: "memory");
    }
}
__device__ __forceinline__ void f4096_phase(const Frame& F, const bf16_t* AB, float* F4, int item, float scale) {
    const int b = item >> 4, cb = item & 15, lane = F.lane, rr = lane >> 3, c8 = (lane & 7) * 8;
    const int ch = cb * 64 + c8, g = ch >> 8, l = ch & 255;
    const bf16_t* base = AB + ((size_t)b * SB + F.wave * 1024 + rr) * 2048 + g * 512 + l;
    float acc[8] = {0.f, 0.f, 0.f, 0.f, 0.f, 0.f, 0.f, 0.f};
#pragma unroll 8
    for (int i = 0; i < 128; ++i) { const u32x4 v = *(const u32x4*)(base + (size_t)(8 * i) * 2048);
        acc[0] += bf_lo(v.x); acc[1] += bf_hi(v.x); acc[2] += bf_lo(v.y); acc[3] += bf_hi(v.y); acc[4] += bf_lo(v.z); acc[5] += bf_hi(v.z); acc[6] += bf_lo(v.w); acc[7] += bf_hi(v.w); }
    const float sg = (rr & 1) ? -1.f : 1.f;
#pragma unroll
    for (int i = 0; i < 8; ++i) { float v = acc[i] * sg; v += __shfl_xor(v, 8); v += __shfl_xor(v, 16); v += __shfl_xor(v, 32); acc[i] = v; }
    LAS float* red = (LAS float*)F.lds;
    __syncthreads();
    if (lane < 8) {
#pragma unroll
        for (int i = 0; i < 8; ++i) red[F.wave * 64 + lane * 8 + i] = acc[i]; }
    __syncthreads();
    if (F.tid < 64) { float s = 0.f;
#pragma unroll
        for (int w = 0; w < 8; ++w) s += red[w * 64 + F.tid];
        F4[b * 1024 + cb * 64 + F.tid] = s * scale; }
    __syncthreads();
}
__device__ __forceinline__ void fnet_finish_phase(const Frame& F, const bf16_t* PCS, const float* F4, const bf16_t* G1, bf16_t* Y1) {
    const int gw = F.bid * NWAVES + F.wave, NGW = F.G * NWAVES; const int ch = F.lane * 16;
    for (int it = gw; it < 2 * 1024; it += NGW) { const int b = it >> 10, k0 = (it & 1023) * 4;
        u32x4 pc[4][2], ps[4][2], ga[4][2], gb[4][2];
#pragma unroll
        for (int i = 0; i < 4; ++i) { const int k = k0 + i; const int km = k ? 8192 - k : 0;
#pragma unroll
            for (int hh = 0; hh < 2; ++hh) { pc[i][hh] = *(const u32x4*)(PCS + (size_t)k * 2048 + b * 1024 + ch + hh * 8); ps[i][hh] = *(const u32x4*)(PCS + (size_t)(4096 + k) * 2048 + b * 1024 + ch + hh * 8);
                ga[i][hh] = *(const u32x4*)(G1 + ((size_t)b * SB + k) * 4096 + 3072 + ch + hh * 8); gb[i][hh] = *(const u32x4*)(G1 + ((size_t)b * SB + km) * 4096 + 3072 + ch + hh * 8); } }
#pragma unroll
        for (int i = 0; i < 4; ++i) { const int k = k0 + i; const size_t ya = ((size_t)b * SB + k) * 4096 + 3072 + ch, yb = ((size_t)b * SB + (8192 - k)) * 4096 + 3072 + ch;
#pragma unroll
            for (int hh = 0; hh < 2; ++hh) { u32x4 oa, ob;
#pragma unroll
                for (int j = 0; j < 4; ++j) { const float cl = bf_lo(pc[i][hh][j]), chh = bf_hi(pc[i][hh][j]), sl = bf_lo(ps[i][hh][j]), sh = bf_hi(ps[i][hh][j]);
                    oa[j] = cvt_pk_bf16((cl - sl) * bf_lo(ga[i][hh][j]), (chh - sh) * bf_hi(ga[i][hh][j])); ob[j] = cvt_pk_bf16((cl + sl) * bf_lo(gb[i][hh][j]), (chh + sh) * bf_hi(gb[i][hh][j])); }
                *(u32x4*)(Y1 + ya + hh * 8) = oa; if (k) *(u32x4*)(Y1 + yb + hh * 8) = ob; } }
    }
    if (gw < 2) { const int b = gw; const size_t ya = ((size_t)b * SB + 4096) * 4096 + 3072 + ch;
#pragma unroll
        for (int hh = 0; hh < 2; ++hh) { const u32x4 g = *(const u32x4*)(G1 + ya + hh * 8); const f32x4 f0 = *(const f32x4*)(F4 + b * 1024 + ch + hh * 8), f1 = *(const f32x4*)(F4 + b * 1024 + ch + hh * 8 + 4);
            f32x4 x0 = f0, x1 = f1; x0[0] *= bf_lo(g.x); x0[1] *= bf_hi(g.x); x0[2] *= bf_lo(g.y); x0[3] *= bf_hi(g.y); x1[0] *= bf_lo(g.z); x1[1] *= bf_hi(g.z); x1[2] *= bf_lo(g.w); x1[3] *= bf_hi(g.w);
            *(u32x4*)(Y1 + ya + hh * 8) = pack8(x0, x1); } }
}
__device__ __forceinline__ void gla_finish_phase(const Frame& F, const bf16_t* O0, const bf16_t* O1, const bf16_t* O2, const bf16_t* O3, const bf16_t* G1, const float* on_g, bf16_t* Y1) {
    const int base = F.bid * (NB * S / 256);
    const f32x4 o0 = *(const f32x4*)(on_g + F.lane * 8), o1 = *(const f32x4*)(on_g + F.lane * 8 + 4);
    for (int i0 = F.wave; i0 < NB * S / 256; i0 += 8) {
        const int ml = base + i0; const size_t row = (size_t)(ml / S) * SB + (ml % S);
        u32x4 pa[6], pb[6], pc[6], pd[6], gg[6];
#pragma unroll
        for (int h = 0; h < 6; ++h) { const size_t ix = row * 3072 + h * 512 + F.lane * 8;
            pa[h] = *(const u32x4*)(O0 + ix); pb[h] = *(const u32x4*)(O1 + ix); pc[h] = *(const u32x4*)(O2 + ix); pd[h] = *(const u32x4*)(O3 + ix);
            gg[h] = *(const u32x4*)(G1 + row * 4096 + h * 512 + F.lane * 8); }
#pragma unroll
        for (int h = 0; h < 6; ++h) { float v[8];
#pragma unroll
            for (int j = 0; j < 4; ++j) { v[2 * j] = (bf_lo(pa[h][j]) + bf_lo(pb[h][j])) + (bf_lo(pc[h][j]) + bf_lo(pd[h][j])); v[2 * j + 1] = (bf_hi(pa[h][j]) + bf_hi(pb[h][j])) + (bf_hi(pc[h][j]) + bf_hi(pd[h][j])); }
            float ss = 0.f;
#pragma unroll
            for (int i = 0; i < 8; ++i) ss += v[i] * v[i];
            const float rs = 1.0f / sqrtf(wave_sum(ss) * (1.f / 512.f) + EPS);
            f32x4 x0 = (f32x4){v[0], v[1], v[2], v[3]} * rs * o0, x1 = (f32x4){v[4], v[5], v[6], v[7]} * rs * o1; const u32x4 g = gg[h];
            x0[0] *= bf_lo(g.x); x0[1] *= bf_hi(g.x); x0[2] *= bf_lo(g.y); x0[3] *= bf_hi(g.y); x1[0] *= bf_lo(g.z); x1[1] *= bf_hi(g.z); x1[2] *= bf_lo(g.w); x1[3] *= bf_hi(g.w);
            *(u32x4*)(Y1 + row * 4096 + h * 512 + F.lane * 8) = pack8(x0, x1); }
    }
}
__device__ __forceinline__ void final_norm_b_phase(const Frame& F, const bf16_t* src, float* out, const float* fg) {
    const int base = F.bid * (NB * S / 256);
    for (int i0 = F.wave; i0 < NB * S / 256; i0 += 16) {
        const int rot = (F.bid * 5) & 63;
        const size_t ra = (size_t)(base + ((i0 + rot) & 63)) * D, rb = (size_t)(base + ((i0 + 8 + rot) & 63)) * D;
        const u32x2* xa = (const u32x2*)(src + ra) + F.lane; const u32x2* xb = (const u32x2*)(src + rb) + F.lane;
        u32x2 wa[16], wb[16]; float sa = 0.f, sb = 0.f;
#pragma unroll
        for (int j = 0; j < 16; ++j) wa[j] = __builtin_nontemporal_load(xa + 64 * j);
#pragma unroll
        for (int j = 0; j < 16; ++j) wb[j] = __builtin_nontemporal_load(xb + 64 * j);
#pragma unroll
        for (int j = 0; j < 16; ++j) { const float a0 = bf_lo(wa[j].x), a1 = bf_hi(wa[j].x), a2 = bf_lo(wa[j].y), a3 = bf_hi(wa[j].y); sa += (a0 * a0 + a1 * a1) + (a2 * a2 + a3 * a3); }
#pragma unroll
        for (int j = 0; j < 16; ++j) { const float a0 = bf_lo(wb[j].x), a1 = bf_hi(wb[j].x), a2 = bf_lo(wb[j].y), a3 = bf_hi(wb[j].y); sb += (a0 * a0 + a1 * a1) + (a2 * a2 + a3 * a3); }
        const float rsa = 1.0f / sqrtf(wave_sum(sa) * (1.f / D) + EPS), rsb = 1.0f / sqrtf(wave_sum(sb) * (1.f / D) + EPS);
        f32x4* oa = (f32x4*)(out + ra) + F.lane; f32x4* ob = (f32x4*)(out + rb) + F.lane;
#pragma unroll
        for (int j = 0; j < 16; ++j) { const f32x4 gg = *(const f32x4*)(fg + 4 * (F.lane + 64 * j));
            const f32x4 va = {bf_lo(wa[j].x), bf_hi(wa[j].x), bf_lo(wa[j].y), bf_hi(wa[j].y)}, vb = {bf_lo(wb[j].x), bf_hi(wb[j].x), bf_lo(wb[j].y), bf_hi(wb[j].y)};
            __builtin_nontemporal_store(va * rsa * gg, oa + 64 * j); __builtin_nontemporal_store(vb * rsb * gg, ob + 64 * j); }
    }
}
__device__ __forceinline__ void final_norm_phase(const Frame& F, float* out, const float* fg) {
    const int base = F.bid * (NB * S / 256);
    for (int i0 = F.wave; i0 < NB * S / 256; i0 += 16) {
        const int rot = (F.bid * 5) & 63;
        f32x4* xa = (f32x4*)(out + (size_t)(base + ((i0 + rot) & 63)) * D) + F.lane; f32x4* xb = (f32x4*)(out + (size_t)(base + ((i0 + 8 + rot) & 63)) * D) + F.lane;
        f32x4 va[16], vb[16]; float sa = 0.f, sb = 0.f;
#pragma unroll
        for (int j = 0; j < 16; ++j) va[j] = __builtin_nontemporal_load(xa + 64 * j);
#pragma unroll
        for (int j = 0; j < 16; ++j) vb[j] = __builtin_nontemporal_load(xb + 64 * j);
#pragma unroll
        for (int j = 0; j < 16; ++j) sa += (va[j].x * va[j].x + va[j].y * va[j].y) + (va[j].z * va[j].z + va[j].w * va[j].w);
#pragma unroll
        for (int j = 0; j < 16; ++j) sb += (vb[j].x * vb[j].x + vb[j].y * vb[j].y) + (vb[j].z * vb[j].z + vb[j].w * vb[j].w);
        const float rsa = 1.0f / sqrtf(wave_sum(sa) * (1.f / D) + EPS), rsb = 1.0f / sqrtf(wave_sum(sb) * (1.f / D) + EPS);
#pragma unroll
        for (int j = 0; j < 16; ++j) { const f32x4 gg = *(const f32x4*)(fg + 4 * (F.lane + 64 * j)); __builtin_nontemporal_store(va[j] * rsa * gg, xa + 64 * j); __builtin_nontemporal_store(vb[j] * rsb * gg, xb + 64 * j); }
    }
}
}
namespace fk {
constexpr int NC2 = SB / 32;
__device__ __forceinline__ size_t gla_idx2(int dir, int b, int h, int c) { return (size_t)(((dir * 2 + b) * 6 + h) * NC2 + c); }
__device__ __forceinline__ int swz4(int x) { return (0x1320 >> (4 * x)) & 3; }
__device__ __forceinline__ void gla_prep_unit(const Frame& F, const Args& a, int b, int h, int ci) {
    unsigned char* ws = a.ws;
    const bf16_t* QK1 = (const bf16_t*)(ws + WS_QK1); const float* GD = (const float*)(ws + WS_GD);
    bf16_t* QT = (bf16_t*)(ws + WS_QT); bf16_t* KT = (bf16_t*)(ws + WS_KT); bf16_t* AT = (bf16_t*)(ws + WS_AT); float* GAM = (float*)(ws + WS_GAM);
    const int tid = F.tid, lane = F.lane, wid = F.wave;
    const size_t r0 = (size_t)b * SB + 64 * ci;
    LAS float* gds = (LAS float*)(F.lds);
    LAS bf16_t* qs = (LAS bf16_t*)(F.lds + 8192);
    LAS bf16_t* ks = (LAS bf16_t*)(F.lds + 8192 + 33792);
    LAS bf16_t* ktl = (LAS bf16_t*)(F.lds + 8192 + 2 * 33792);
    __syncthreads();
    *(LAS f32x4*)(gds + tid * 4) = *(const f32x4*)(GD + (r0 + (tid >> 3)) * 32 + (tid & 7) * 4);
    __syncthreads();
    if (a.var & 8) return;
    const int r32 = lane & 31, hi = lane >> 5, d = 32 * wid + r32;
    u32x4 rq[4], rk[4];
#pragma unroll
    for (int i = 0; i < 4; ++i) { const int q = tid + 512 * i, tok = q >> 5, dc = q & 31; const bf16_t* src = QK1 + (r0 + tok) * 3072 + h * 256 + dc * 8;
        rq[i] = *(const u32x4*)src; rk[i] = *(const u32x4*)(src + 1536); }
#pragma unroll
    for (int dir = 0; dir < 2; ++dir) {
        constexpr float L2E = 1.4426950408889634f;
        const float* wg = a.in[dir ? 18 : 16] + h * 256 + d; const float bias = a.in[dir ? 19 : 17][h * 256 + d] * L2E;
        float wgv[8];
#pragma unroll
        for (int kk = 0; kk < 8; ++kk) wgv[kk] = wg[(2 * kk + hi) * 1536] * L2E;
        float cum[2][16], last[2];
#pragma unroll
        for (int tt = 0; tt < 2; ++tt) {
            f32x16 z;
#pragma unroll
            for (int r = 0; r < 16; ++r) z[r] = bias;
            const LAS float* gp = gds + (tt * 32 + r32) * 32 + 16 * dir + hi;
#pragma unroll
            for (int kk = 0; kk < 8; ++kk) z = __builtin_amdgcn_mfma_f32_32x32x2f32(gp[2 * kk], wgv[kk], z, 0, 0, 0);
            float lg[16];
#pragma unroll
            for (int r = 0; r < 16; ++r) lg[r] = (fminf(z[r], 0.f) - __builtin_amdgcn_logf(1.f + __builtin_amdgcn_exp2f(-fabsf(z[r])))) * 0.0625f;
            float T[4], PT[4];
#pragma unroll
            for (int q = 0; q < 4; ++q) {
                if (dir == 0) { lg[4 * q + 1] += lg[4 * q]; lg[4 * q + 2] += lg[4 * q + 1]; lg[4 * q + 3] += lg[4 * q + 2]; T[q] = lg[4 * q + 3]; }
                else { lg[4 * q + 2] += lg[4 * q + 3]; lg[4 * q + 1] += lg[4 * q + 2]; lg[4 * q] += lg[4 * q + 1]; T[q] = lg[4 * q]; }
                PT[q] = __shfl_xor(T[q], 32); }
            float offs[4];
            if (dir == 0) { float run = 0.f;
#pragma unroll
                for (int q = 0; q < 4; ++q) { const float t0 = hi ? PT[q] : T[q], t1 = hi ? T[q] : PT[q]; offs[q] = run + (hi ? t0 : 0.f); run += t0 + t1; }
                last[tt] = run; }
            else { float run = 0.f;
#pragma unroll
                for (int q = 3; q >= 0; --q) { const float t0 = hi ? PT[q] : T[q], t1 = hi ? T[q] : PT[q]; offs[q] = run + (hi ? 0.f : t1); run += t0 + t1; }
                last[tt] = run; }
#pragma unroll
            for (int r = 0; r < 16; ++r) cum[tt][r] = lg[r] + offs[r >> 2];
        }
#pragma unroll
        for (int i = 0; i < 4; ++i) { const int q = tid + 512 * i, tok = q >> 5, dc = q & 31; *(LAS u32x4*)(qs + tok * 264 + dc * 8) = rq[i]; *(LAS u32x4*)(ks + tok * 264 + dc * 8) = rk[i]; }
        float el[2];
#pragma unroll
        for (int tt = 0; tt < 2; ++tt) { el[tt] = __builtin_amdgcn_exp2f(last[tt]); if (hi == 0) GAM[gla_idx2(dir, b, h, 2 * ci + tt) * 256 + d] = el[tt]; }
        __syncthreads();
#pragma unroll
        for (int tt = 0; tt < 2; ++tt)
#pragma unroll
            for (int j = 0; j < 8; ++j) { float kh2[2]; const int tl0 = ((2 * j) & 3) + 8 * ((2 * j) >> 2) + 4 * hi;
#pragma unroll
                for (int u = 0; u < 2; ++u) { const int t = 32 * tt + tl0 + u; const float e1 = __builtin_amdgcn_exp2f(cum[tt][2 * j + u]), e2 = __builtin_amdgcn_rcpf(e1);
                    const float qv = bf2f(qs[t * 264 + d]), kv = bf2f(ks[t * 264 + d]); const float kt = kv * e2;
                    qs[t * 264 + d] = (bf16_t)(cvt_pk_bf16(qv * e1, 0.f) & 0xffffu); ks[t * 264 + d] = (bf16_t)(cvt_pk_bf16(kt, 0.f) & 0xffffu); kh2[u] = kt * el[tt]; }
                *(LAS unsigned*)(ktl + (tt * 256 + d) * 34 + tl0) = cvt_pk_bf16(kh2[0], kh2[1]); }
        __syncthreads();
#pragma unroll
        for (int i = 0; i < 4; ++i) { const int q = tid + 512 * i, t2 = q >> 10, rem = q & 1023, dd = rem >> 2, c4 = rem & 3; const LAS unsigned* src = (const LAS unsigned*)(ktl + (t2 * 256 + dd) * 34 + c4 * 8);
            *(u32x4*)(KT + gla_idx2(dir, b, h, 2 * ci + t2) * 8192 + dd * 32 + c4 * 8) = (u32x4){src[0], src[1], src[2], src[3]}; }
#pragma unroll
        for (int i = 0; i < 4; ++i) { const int q = tid + 512 * i, t2 = q >> 10, rem = q & 1023, tl = rem >> 5, pc = rem & 31, blk = pc >> 2, gg = pc & 3;
            const LAS u32x2* s0 = (const LAS u32x2*)(qs + (32 * t2 + tl) * 264 + blk * 32 + 4 * gg); const LAS u32x2* s1 = (const LAS u32x2*)(qs + (32 * t2 + tl) * 264 + blk * 32 + 16 + 4 * gg);
            const u32x2 lo = *s0, hi2 = *s1;
            *(u32x4*)(QT + gla_idx2(dir, b, h, 2 * ci + t2) * 8192 + (blk >> 2) * 4096 + tl * 128 + (pc & 15) * 8) = (u32x4){lo.x, lo.y, hi2.x, hi2.y}; }
        if (wid < 2) { f32x16 acc = {};
#pragma unroll
            for (int kk = 0; kk < 16; ++kk) { const bf16x8 A = *(const LAS bf16x8*)(qs + (wid * 32 + r32) * 264 + kk * 16 + hi * 8), Bv = *(const LAS bf16x8*)(ks + (wid * 32 + r32) * 264 + kk * 16 + hi * 8);
                acc = __builtin_amdgcn_mfma_f32_32x32x16_bf16(A, Bv, acc, 0, 0, 0); }
            bf16_t* at = AT + gla_idx2(dir, b, h, 2 * ci + wid) * 1024;
#pragma unroll
            for (int r = 0; r < 16; ++r) { const int itok = (r & 3) + 8 * (r >> 2) + 4 * hi; const bool keep = dir ? (r32 >= itok) : (r32 <= itok);
                at[itok * 32 + r32] = (bf16_t)(cvt_pk_bf16(keep ? acc[r] : 0.f, 0.f) & 0xffffu); } }
        __syncthreads();
    }
}
__device__ __forceinline__ void gla_prep_phase(const Frame& F, const Args& a) {
    for (int u = F.bid; u < NB * 6 * NCH; u += F.G) { const int ci = u % NCH, bh = u / NCH; gla_prep_unit(F, a, bh / 6, bh % 6, ci); }
}
#ifndef SC_SYNC
#define SC_SYNC 0
#endif
#ifndef SCAN_OSTAGE
#define SCAN_OSTAGE 0
#endif
template <int NBE>
__device__ __forceinline__ void gla_scan_wg(const Frame& F, const Args& a, int dir, int b, int h, int dhalf, int esl) {
    constexpr int SC_OST = 136192;
    constexpr int SC_QT = 0, SC_KT = 8192, SC_VT = 16384, SC_AT = SC_VT + 8192 * NBE, SC_GAM = SC_AT + 2048, SC_STAGE = SC_GAM + 512, SC_NS = NBE == 2 ? 4 : 5, EW = 128 * NBE;
    unsigned char* ws = a.ws;
    const bf16_t* QT = (const bf16_t*)(ws + WS_QT); const bf16_t* KT = (const bf16_t*)(ws + WS_KT); const bf16_t* AT = (const bf16_t*)(ws + WS_AT); const float* GAM = (const float*)(ws + WS_GAM);
    const bf16_t* VT = (const bf16_t*)(ws + WS_VT);
    bf16_t* O = (bf16_t*)(ws + (dir ? (dhalf ? WS_O11 : WS_O10) : (dhalf ? WS_O01 : WS_O00)));
    const int lane = F.lane, wid = F.wave, c = lane & 15, g = lane >> 4;
    LAS unsigned char* lds = F.lds;
    unsigned qsrc, ksrc, vsrc[NBE], asrc;
    { const int P = wid * 64 + lane;
      { const int r = P >> 4, sp = P & 15; qsrc = (unsigned)(dhalf * 4096 + r * 128 + (sp ^ (r & 15)) * 8); }
      { const int dd = P >> 2, sp = P & 3; ksrc = (unsigned)(dhalf * 4096 + dd * 32 + (sp ^ swz4((dd >> 2) & 3)) * 8); }
#pragma unroll
      for (int be = 0; be < NBE; ++be) { const int Pv = (wid + 8 * be) * 64 + lane; const int e = Pv >> 2, sp = Pv & 3; vsrc[be] = (unsigned)((esl * EW + e) * 32 + (sp ^ swz4((e >> 2) & 3)) * 8); }
      { const int i = (P >> 2) & 31, sp = P & 3; asrc = (unsigned)(i * 32 + (sp ^ swz4((i >> 2) & 3)) * 8); } }
    const int sw = swz4(c >> 2);
    const int q_rd = c * 256;
    const int k_rd = SC_KT + c * 64 + ((g ^ sw) * 16);
    const int v_rd = SC_VT + (16 * wid + c) * 64 + ((g ^ sw) * 16);
    const int a_rd = SC_AT + c * 64 + ((g ^ sw) * 16);
    const int g_rd = SC_GAM + 16 * g;
    f32x4 St[NBE][8];
#pragma unroll
    for (int be = 0; be < NBE; ++be)
#pragma unroll
        for (int t = 0; t < 8; ++t) St[be][t] = (f32x4){0.f, 0.f, 0.f, 0.f};
#define SC_CI(s) (dir ? (NC2 - 1 - (s)) : (((s) + 256) % NC2))
#define SC_DMA(slot, ci_) do { const size_t x_ = gla_idx2(dir, b, h, (ci_)); const int so_ = (slot) * SC_STAGE; \
        __builtin_amdgcn_global_load_lds((const unsigned*)(QT + x_ * 8192 + qsrc), (LAS unsigned*)(lds + so_ + SC_QT + wid * 1024), 16, 0, 0); \
        __builtin_amdgcn_global_load_lds((const unsigned*)(KT + x_ * 8192 + ksrc), (LAS unsigned*)(lds + so_ + SC_KT + wid * 1024), 16, 0, 0); \
        _Pragma("unroll") for (int be = 0; be < NBE; ++be) \
            __builtin_amdgcn_global_load_lds((const unsigned*)(VT + ((size_t)((b * 6 + h) * NC2 + (ci_))) * 16384 + vsrc[be]), (LAS unsigned*)(lds + so_ + SC_VT + (wid + 8 * be) * 1024), 16, 0, 0); \
        if (wid < 2) __builtin_amdgcn_global_load_lds((const unsigned*)(AT + x_ * 1024 + asrc), (LAS unsigned*)(lds + so_ + SC_AT + wid * 1024), 16, 0, 0); \
        if (wid == 2) { if (lane < 32) __builtin_amdgcn_global_load_lds((const unsigned*)(GAM + x_ * 256 + dhalf * 128 + lane * 4), (LAS unsigned*)(lds + so_ + SC_GAM), 16, 0, 0); } } while (0)
    __syncthreads();
#pragma unroll
    for (int p = 0; p < SC_NS - 1; ++p) SC_DMA(p, SC_CI(p));
    for (int s = 0; s < NC2; ++s) {
        const int ci = SC_CI(s); const int so = (s % SC_NS) * SC_STAGE;
        if (s < SC_NS || SC_SYNC || (a.var & 56)) __builtin_amdgcn_s_waitcnt(0x0F70);
        else if (a.var & 64) { if (wid < 3) __builtin_amdgcn_s_waitcnt(0x0F7C); else __builtin_amdgcn_s_waitcnt(0x0F79); }
        else if (NBE == 1 && SCAN_OSTAGE) { if (wid < 3) __builtin_amdgcn_s_waitcnt(0x4F70); else __builtin_amdgcn_s_waitcnt(0x0F7D); }
        else if (NBE == 1) { if (wid < 3) __builtin_amdgcn_s_waitcnt(0x4F74); else __builtin_amdgcn_s_waitcnt(0x4F71); }
        else { if (wid < 3) __builtin_amdgcn_s_waitcnt(0x4F76); else __builtin_amdgcn_s_waitcnt(0x4F74); }
        __builtin_amdgcn_s_barrier(); asm volatile("" ::: "memory");
        if (!(a.var & 8)) { const int sn = s + SC_NS - 1; const int cn = SC_CI(sn < NC2 ? sn : NC2 - 1); SC_DMA(sn % SC_NS, cn); }
        if (a.var & 16) continue;
        if constexpr (NBE == 1 && SCAN_OSTAGE) { if (s > 0) {
            const int cp = SC_CI(s - 1); const int row = F.tid >> 4, ch = F.tid & 15;
            const u32x4 w = *(const LAS u32x4*)(lds + SC_OST + ((s - 1) & 1) * 8704 + row * 272 + ch * 16);
            *(u32x4*)(O + ((size_t)b * SB + 32 * cp + row) * 3072 + h * 512 + esl * EW + ch * 8) = w; } }
        bf16x8 vf[NBE], qf[4][2], af[2], kf[8]; f32x4 gmv[8];
#pragma unroll
        for (int be = 0; be < NBE; ++be) vf[be] = *(const LAS bf16x8*)(lds + so + v_rd + be * 8192);
#pragma unroll
        for (int ks = 0; ks < 4; ++ks) { const int chk = ((4 * ks + g) ^ c) * 16;
#pragma unroll
            for (int tt = 0; tt < 2; ++tt) qf[ks][tt] = *(const LAS bf16x8*)(lds + so + SC_QT + q_rd + tt * 4096 + chk); }
        if (dhalf == 0) {
#pragma unroll
            for (int tt = 0; tt < 2; ++tt) af[tt] = *(const LAS bf16x8*)(lds + so + a_rd + tt * 1024); }
#pragma unroll
        for (int t = 0; t < 8; ++t) { kf[t] = *(const LAS bf16x8*)(lds + so + k_rd + t * 1024); gmv[t] = *(const LAS f32x4*)(lds + so + g_rd + t * 64); }
        __builtin_amdgcn_sched_barrier(0);
#pragma unroll
        for (int be = 0; be < NBE; ++be) {
            f32x4 oT[2] = {(f32x4){0.f, 0.f, 0.f, 0.f}, (f32x4){0.f, 0.f, 0.f, 0.f}};
#pragma unroll
            for (int ks = 0; ks < 4; ++ks) {
                u32x4 aw; aw.x = cvt_pk_bf16(St[be][2 * ks][0], St[be][2 * ks][1]); aw.y = cvt_pk_bf16(St[be][2 * ks][2], St[be][2 * ks][3]);
                aw.z = cvt_pk_bf16(St[be][2 * ks + 1][0], St[be][2 * ks + 1][1]); aw.w = cvt_pk_bf16(St[be][2 * ks + 1][2], St[be][2 * ks + 1][3]);
                const bf16x8 Af = *reinterpret_cast<bf16x8*>(&aw);
#pragma unroll
                for (int tt = 0; tt < 2; ++tt) oT[tt] = __builtin_amdgcn_mfma_f32_16x16x32_bf16(Af, qf[ks][tt], oT[tt], 0, 0, 0); }
            if (dhalf == 0) {
#pragma unroll
                for (int tt = 0; tt < 2; ++tt) oT[tt] = __builtin_amdgcn_mfma_f32_16x16x32_bf16(vf[be], af[tt], oT[tt], 0, 0, 0); }
            if constexpr (NBE == 1 && SCAN_OSTAGE) {
#pragma unroll
              for (int tt = 0; tt < 2; ++tt) { u32x2 w; w.x = cvt_pk_bf16(oT[tt][0], oT[tt][1]); w.y = cvt_pk_bf16(oT[tt][2], oT[tt][3]);
                *(LAS u32x2*)(lds + SC_OST + (s & 1) * 8704 + (16 * tt + c) * 272 + wid * 32 + g * 8) = w; } }
            else if (!(a.var & 96)) { bf16_t* orow = O + ((size_t)b * SB + 32 * ci + c) * 3072 + h * 512 + esl * EW + be * 128 + 16 * wid + 4 * g;
#pragma unroll
              for (int tt = 0; tt < 2; ++tt) { u32x2 w; w.x = cvt_pk_bf16(oT[tt][0], oT[tt][1]); w.y = cvt_pk_bf16(oT[tt][2], oT[tt][3]); *(u32x2*)(orow + (size_t)(16 * tt) * 3072) = w; } }
#pragma unroll
            for (int t = 0; t < 8; ++t) St[be][t] = __builtin_amdgcn_mfma_f32_16x16x32_bf16(kf[t], vf[be], St[be][t] * gmv[t], 0, 0, 0);
        }
    }
    __builtin_amdgcn_s_waitcnt(0x0F70); __syncthreads();
    if constexpr (NBE == 1 && SCAN_OSTAGE) { const int cp = SC_CI(NC2 - 1); const int row = F.tid >> 4, ch = F.tid & 15;
        const u32x4 w = *(const LAS u32x4*)(lds + SC_OST + ((NC2 - 1) & 1) * 8704 + row * 272 + ch * 16);
        *(u32x4*)(O + ((size_t)b * SB + 32 * cp + row) * 3072 + h * 512 + esl * EW + ch * 8) = w; __syncthreads(); }
#undef SC_CI
#undef SC_DMA
}
template <int NBE>
__device__ __forceinline__ void gla_scan_wg_pp(const Frame& F, const Args& a, int dir, int b, int h, int dhalf, int esl) {
    constexpr int SC_OST = 136192;
    constexpr int SC_QT = 0, SC_KT = 8192, SC_VT = 16384, SC_AT = SC_VT + 8192 * NBE, SC_GAM = SC_AT + 2048, SC_STAGE = SC_GAM + 512, SC_NS = NBE == 2 ? 4 : 5, EW = 128 * NBE;
    unsigned char* ws = a.ws;
    const bf16_t* QT = (const bf16_t*)(ws + WS_QT); const bf16_t* KT = (const bf16_t*)(ws + WS_KT); const bf16_t* AT = (const bf16_t*)(ws + WS_AT); const float* GAM = (const float*)(ws + WS_GAM);
    const bf16_t* VT = (const bf16_t*)(ws + WS_VT);
    bf16_t* O = (bf16_t*)(ws + (dir ? (dhalf ? WS_O11 : WS_O10) : (dhalf ? WS_O01 : WS_O00)));
    const int lane = F.lane, wid = F.wave, c = lane & 15, g = lane >> 4;
    LAS unsigned char* lds = F.lds;
    unsigned qsrc, ksrc, vsrc[NBE], asrc;
    { const int P = wid * 64 + lane;
      { const int r = P >> 4, sp = P & 15; qsrc = (unsigned)(dhalf * 4096 + r * 128 + (sp ^ (r & 15)) * 8); }
      { const int dd = P >> 2, sp = P & 3; ksrc = (unsigned)(dhalf * 4096 + dd * 32 + (sp ^ swz4((dd >> 2) & 3)) * 8); }
#pragma unroll
      for (int be = 0; be < NBE; ++be) { const int Pv = (wid + 8 * be) * 64 + lane; const int e = Pv >> 2, sp = Pv & 3; vsrc[be] = (unsigned)((esl * EW + e) * 32 + (sp ^ swz4((e >> 2) & 3)) * 8); }
      { const int i = (P >> 2) & 31, sp = P & 3; asrc = (unsigned)(i * 32 + (sp ^ swz4((i >> 2) & 3)) * 8); } }
    const int sw = swz4(c >> 2);
    const int q_rd = c * 256;
    const int k_rd = SC_KT + c * 64 + ((g ^ sw) * 16);
    const int v_rd = SC_VT + (16 * wid + c) * 64 + ((g ^ sw) * 16);
    const int a_rd = SC_AT + c * 64 + ((g ^ sw) * 16);
    const int g_rd = SC_GAM + 16 * g;
    f32x4 St[NBE][8];
#pragma unroll
    for (int be = 0; be < NBE; ++be)
#pragma unroll
        for (int t = 0; t < 8; ++t) St[be][t] = (f32x4){0.f, 0.f, 0.f, 0.f};
#define SC_CI(s) (dir ? (NC2 - 1 - (s)) : (((s) + 256) % NC2))
#define SC_DMA(slot, ci_) do { const size_t x_ = gla_idx2(dir, b, h, (ci_)); const int so_ = (slot) * SC_STAGE; \
        __builtin_amdgcn_global_load_lds((const unsigned*)(QT + x_ * 8192 + qsrc), (LAS unsigned*)(lds + so_ + SC_QT + wid * 1024), 16, 0, 0); \
        __builtin_amdgcn_global_load_lds((const unsigned*)(KT + x_ * 8192 + ksrc), (LAS unsigned*)(lds + so_ + SC_KT + wid * 1024), 16, 0, 0); \
        _Pragma("unroll") for (int be = 0; be < NBE; ++be) \
            __builtin_amdgcn_global_load_lds((const unsigned*)(VT + ((size_t)((b * 6 + h) * NC2 + (ci_))) * 16384 + vsrc[be]), (LAS unsigned*)(lds + so_ + SC_VT + (wid + 8 * be) * 1024), 16, 0, 0); \
        if (wid < 2) __builtin_amdgcn_global_load_lds((const unsigned*)(AT + x_ * 1024 + asrc), (LAS unsigned*)(lds + so_ + SC_AT + wid * 1024), 16, 0, 0); \
        if (wid == 2) { if (lane < 32) __builtin_amdgcn_global_load_lds((const unsigned*)(GAM + x_ * 256 + dhalf * 128 + lane * 4), (LAS unsigned*)(lds + so_ + SC_GAM), 16, 0, 0); } } while (0)
    const int grp = wid >> 2, fl = grp ? 1 : 2;
    const int frow = F.tid >> 4, fch = F.tid & 15;
    __syncthreads();
#pragma unroll
    for (int p = 0; p < SC_NS - 1; ++p) SC_DMA(p, SC_CI(p));
    __builtin_amdgcn_s_waitcnt(0x0F70); __syncthreads();
    if (grp) __builtin_amdgcn_s_barrier();
#define SC_WAIT(s_) do { if ((s_) < SC_NS) __builtin_amdgcn_s_waitcnt(0x0F70); else if (wid < 3) __builtin_amdgcn_s_waitcnt(0x4F70); else __builtin_amdgcn_s_waitcnt(0x0F7D); } while (0)
#define SC_FLUSH(st_) do { const int cp_ = SC_CI(st_); \
        const u32x4 w_ = *(const LAS u32x4*)(lds + SC_OST + ((st_) & 1) * 8704 + frow * 272 + fch * 16); \
        *(u32x4*)(O + ((size_t)b * SB + 32 * cp_ + frow) * 3072 + h * 512 + esl * EW + fch * 8) = w_; } while (0)
    for (int s = 0; s < NC2; ++s) {
        const int ci = SC_CI(s); const int so = (s % SC_NS) * SC_STAGE;
        { const int sn = s + SC_NS - 1; const int cn = SC_CI(sn < NC2 ? sn : NC2 - 1); SC_DMA(sn % SC_NS, cn); }
        if (s >= fl) SC_FLUSH(s - fl);
        bf16x8 vf, qf[4][2], af[2], kf[8]; f32x4 gmv[8];
        vf = *(const LAS bf16x8*)(lds + so + v_rd);
#pragma unroll
        for (int ks = 0; ks < 4; ++ks) { const int chk = ((4 * ks + g) ^ c) * 16;
#pragma unroll
            for (int tt = 0; tt < 2; ++tt) qf[ks][tt] = *(const LAS bf16x8*)(lds + so + SC_QT + q_rd + tt * 4096 + chk); }
        if (dhalf == 0) {
#pragma unroll
            for (int tt = 0; tt < 2; ++tt) af[tt] = *(const LAS bf16x8*)(lds + so + a_rd + tt * 1024); }
#pragma unroll
        for (int t = 0; t < 8; ++t) { kf[t] = *(const LAS bf16x8*)(lds + so + k_rd + t * 1024); gmv[t] = *(const LAS f32x4*)(lds + so + g_rd + t * 64); }
        if (grp) SC_WAIT(s);
        LDS_WAIT();
        __builtin_amdgcn_s_barrier(); asm volatile("" ::: "memory");
        __builtin_amdgcn_sched_barrier(0);
        {
            f32x4 oT[2] = {(f32x4){0.f, 0.f, 0.f, 0.f}, (f32x4){0.f, 0.f, 0.f, 0.f}};
#pragma unroll
            for (int ks = 0; ks < 4; ++ks) {
                u32x4 aw; aw.x = cvt_pk_bf16(St[0][2 * ks][0], St[0][2 * ks][1]); aw.y = cvt_pk_bf16(St[0][2 * ks][2], St[0][2 * ks][3]);
                aw.z = cvt_pk_bf16(St[0][2 * ks + 1][0], St[0][2 * ks + 1][1]); aw.w = cvt_pk_bf16(St[0][2 * ks + 1][2], St[0][2 * ks + 1][3]);
                const bf16x8 Af = *reinterpret_cast<bf16x8*>(&aw);
#pragma unroll
                for (int tt = 0; tt < 2; ++tt) oT[tt] = __builtin_amdgcn_mfma_f32_16x16x32_bf16(Af, qf[ks][tt], oT[tt], 0, 0, 0); }
            if (dhalf == 0) {
#pragma unroll
                for (int tt = 0; tt < 2; ++tt) oT[tt] = __builtin_amdgcn_mfma_f32_16x16x32_bf16(vf, af[tt], oT[tt], 0, 0, 0); }
#pragma unroll
            for (int tt = 0; tt < 2; ++tt) { u32x2 w; w.x = cvt_pk_bf16(oT[tt][0], oT[tt][1]); w.y = cvt_pk_bf16(oT[tt][2], oT[tt][3]);
                *(LAS u32x2*)(lds + SC_OST + (s & 1) * 8704 + (16 * tt + c) * 272 + wid * 32 + g * 8) = w; }
#pragma unroll
            for (int t = 0; t < 8; ++t) St[0][t] = __builtin_amdgcn_mfma_f32_16x16x32_bf16(kf[t], vf, St[0][t] * gmv[t], 0, 0, 0);
        }
        if (!grp) SC_WAIT(s);
        LDS_WAIT();
        __builtin_amdgcn_s_barrier(); asm volatile("" ::: "memory");
    }
    if (!grp) __builtin_amdgcn_s_barrier();
    __builtin_amdgcn_s_waitcnt(0x0F70); __syncthreads();
    if (!grp) SC_FLUSH(NC2 - 2);
    SC_FLUSH(NC2 - 1);
    __builtin_amdgcn_s_waitcnt(0x0F70); __syncthreads();
#undef SC_WAIT
#undef SC_FLUSH
#undef SC_CI
#undef SC_DMA
}
}
namespace fk {
constexpr int NPHASE = 14;
#ifndef SCAN_PP
#define SCAN_PP 0
#endif
#ifndef BF_TAIL
#define BF_TAIL 0
#endif
#ifndef STAGGER
#define STAGGER 0
#endif
__global__ void __launch_bounds__(NTHR, 2) fwd(Args args) {
    extern __shared__ __attribute__((aligned(16))) unsigned char lds_raw[];
    Frame F; F.lds = (LAS unsigned char*)lds_raw; F.tid = threadIdx.x; F.lane = F.tid & 63; F.wave = __builtin_amdgcn_readfirstlane(F.tid >> 6); F.G = gridDim.x; F.bid = blockIdx.x;
    unsigned char* ws = args.ws;
    volatile LAS unsigned* MISC = (volatile LAS unsigned*)(F.lds + LDS_MISC);
    if (F.tid < 64) MISC[F.tid] = 0u;
    __syncthreads();
    const int lo = args.ph_lo, hi = args.ph_hi;
    XcdBarrier bar; bar.bar = (unsigned*)(ws + WS_CTL) + CW_BAR; bar.x = 0; bar.st = MISC + 8;
    if (hi - lo > 1) bar = xcd_barrier_post((unsigned*)(ws + WS_CTL) + CW_BAR, MISC + 8);
#ifndef PHMASK
#define PHMASK 0xFFFF
#endif
#define IN(k) (((PHMASK >> (k)) & 1) && lo <= (k) && (k) < hi)
#define SEAM(k) do { if (IN(k) && IN((k) + 1)) xcd_barrier(bar); } while (0)
    float* mod = (float*)(ws + WS_MOD);
    float* x1c = (float*)(ws + WS_X1C);
    LAS float* XCH = (LAS float*)(F.lds + LDS_X);
    if (IN(0)) { p0_prologue(F, args); }
    SEAM(0);
    if (IN(1)) { hnorm_phase(F, args.in[0], args.in[2], args.in[4], mod, (bf16_t*)(ws + WS_H)); }
    SEAM(1);
    if (IN(2)) {
        Gemm g{(const bf16_t*)(ws + WS_H), (const bf16_t*)(ws + WS_W1T), 4096, 4096, 4096}; Order S_; S_.init(NPANEL, 35, F.G, F.bid, 0);
        EpiL0 E{(bf16_t*)(ws + WS_A1), (bf16_t*)(ws + WS_CQKV), (bf16_t*)(ws + WS_G0), (bf16_t*)(ws + WS_KR), (float*)(ws + WS_SSQ), args.in[8], args.in[9],
                (const float*)(ws + WS_ROPEA), (const float*)(ws + WS_ROPEB), XCH};
        const bool early = STAGGER && F.bid >= 6 && ((F.bid >> 3) & 1);
        if (early) { late_convert(F, args, 6 * NWAVES, (F.G - 6) * NWAVES, 0); __syncthreads(); }
        gemm_phase<EpiL0>(F.lds + LDS_STAGE, g, S_, E);
        if (!early) late_convert(F, args, 6 * NWAVES, (F.G - 6) * NWAVES, 0);
    }
    SEAM(2);
    if (IN(3)) {
        { Gemm g{(const bf16_t*)(ws + WS_CQKV), (const bf16_t*)(ws + WS_WUQ), 1024, 1536, 1024}; Order S_; S_.init(NPANEL, 12, F.G, F.bid, 0);
          EpiUp<0> E{(bf16_t*)(ws + WS_QB), 3072, (const float*)(ws + WS_SSQ), (const float*)(ws + WS_ROPEB)};
          gemm_phase<EpiUp<0>>(F.lds + LDS_STAGE, g, S_, E); }
        { Gemm g{(const bf16_t*)(ws + WS_CQKV) + 1024, (const bf16_t*)(ws + WS_WUKV), 512, 1536, 512}; Order S_; S_.init(NPANEL, 16, F.G, (F.bid + 128) & 255, 0);
          EpiUp<1> E{(bf16_t*)(ws + WS_KVB), 4096, (const float*)(ws + WS_SSQ), (const float*)(ws + WS_ROPEB)};
          gemm_phase<EpiUp<1>>(F.lds + LDS_STAGE, g, S_, E); }
    }
    SEAM(3);
    if (IN(4)) { attn_phase(F, args, lds_raw); }
    SEAM(4);
    if (IN(5)) {
        Gemm g{(const bf16_t*)(ws + WS_Y0), (const bf16_t*)(ws + WS_WO), 4096, 4096, 4096}; Order S_; S_.init(NPANEL, 16, F.G, F.bid, 0);
        EpiRes E{args.in[0], args.in[2], mod, args.out, x1c};
        const bool early = STAGGER && F.bid >= 32 && ((F.bid >> 3) & 1);
        if (early) { late_convert(F, args, 32 * NWAVES, (F.G - 32) * NWAVES, 1); __syncthreads(); }
        gemm_phase<EpiRes>(F.lds + LDS_STAGE, g, S_, E);
        if (!early) late_convert(F, args, 32 * NWAVES, (F.G - 32) * NWAVES, 1);
    }
    SEAM(5);
    const float* mod1 = mod + 3 * 12288;
    if (IN(6)) { hnorm_phase(F, args.out, x1c, args.in[4] + D, mod1, (bf16_t*)(ws + WS_H)); }
    SEAM(6);
    if (IN(7)) {
        Gemm g{(const bf16_t*)(ws + WS_H), (const bf16_t*)(ws + WS_W4T), 4096, 4096, 4096}; Order S_; S_.init(NPANEL, 45, F.G, F.bid, 0);
        EpiL1 E{(bf16_t*)(ws + WS_QK1), (bf16_t*)(ws + WS_VT), (bf16_t*)(ws + WS_U1), (bf16_t*)(ws + WS_G1), (float*)(ws + WS_GD), args.var & 1, F.lds + 131072};
        gemm_phase<EpiL1>(F.lds + LDS_STAGE, g, S_, E);
    }
    SEAM(7);
    if (IN(8)) {
        if (!(args.var & 1)) gla_prep_phase(F, args);
        __syncthreads();
        if (!(args.var & 2)) {
        int k8 = 256; asm volatile("" : "+s"(k8));
        Gemm g{(const bf16_t*)(ws + WS_U1), (const bf16_t*)(ws + WS_CS), k8, 256, 256}; Order S_; S_.init(M * 4 / 256, 2, F.G, (F.bid + 128) & 255, 0);
        EpiPlain E{(bf16_t*)(ws + WS_AB), 512};
        gemm_phase<EpiPlain>(F.lds + LDS_STAGE, g, S_, E); }
    }
    SEAM(8);
    if (IN(9)) {
#ifndef SCAN_NBE
#define SCAN_NBE 1
#endif
        constexpr int NSCAN = 192 / SCAN_NBE;
        const int x = F.bid & 7, j = F.bid >> 3;
        if (j < NSCAN / 8) { if (!(args.var & 1)) { constexpr int SPC = 8 / SCAN_NBE; const int combo = x * 3 + j / SPC, sub = j % SPC;
#if SCAN_PP
            gla_scan_wg_pp<1>(F, args, combo / 12, (combo % 12) / 6, combo % 6, sub / (SPC / 2), sub % (SPC / 2)); } }
#else
            gla_scan_wg<SCAN_NBE>(F, args, combo / 12, (combo % 12) / 6, combo % 6, sub / (SPC / 2), sub % (SPC / 2)); } }
#endif
        else { const int fw = F.bid - NSCAN;
            if (!(args.var & 2)) { if (fw < 32) f4096_phase(F, (const bf16_t*)(ws + WS_AB), (float*)(ws + WS_F4096), fw, 1.0f / 1448.1546878700494f);
                fold_phase(F, (const bf16_t*)(ws + WS_AB), (bf16_t*)(ws + WS_BF), NSCAN * NWAVES, (256 - NSCAN) * NWAVES); }
            if (!(args.var & 4)) dm_gen(F, (bf16_t*)(ws + WS_DM), fw, 256 - NSCAN);
            wo2_convert(F, args, NSCAN * NWAVES, (256 - NSCAN) * NWAVES); }
    }
    SEAM(9);
    if (IN(10)) {
        Gemm g{(const bf16_t*)(ws + WS_DM), (const bf16_t*)(ws + WS_BF), FKP, FKP, FKP}; OrderFn S_{F.bid};
        EpiPcs E{(bf16_t*)(ws + WS_PCS), 1.0f / 1448.1546878700494f};
        gemm_phase<EpiPcs>(F.lds + LDS_STAGE, g, S_, E);
        gla_finish_phase(F, (const bf16_t*)(ws + WS_O00), (const bf16_t*)(ws + WS_O01), (const bf16_t*)(ws + WS_O10), (const bf16_t*)(ws + WS_O11), (const bf16_t*)(ws + WS_G1), args.in[20], (bf16_t*)(ws + WS_Y1));
    }
    SEAM(10);
    if (IN(11)) { fnet_finish_phase(F, (const bf16_t*)(ws + WS_PCS), (const float*)(ws + WS_F4096), (const bf16_t*)(ws + WS_G1), (bf16_t*)(ws + WS_Y1)); }
    SEAM(11);
    if (IN(12)) {
        Gemm g{(const bf16_t*)(ws + WS_Y1), (const bf16_t*)(ws + WS_WO2), 4096, 4096, 4096}; Order S_; S_.init(64, 16, F.G, F.bid, 1);
#if BF_TAIL
        EpiResB E{args.out, mod1, (bf16_t*)(ws + WS_H)};
        gemm_phase<EpiResB>(F.lds + LDS_STAGE, g, S_, E);
#else
        EpiRes E{args.out, x1c, mod1, args.out, x1c};
        gemm_phase<EpiRes>(F.lds + LDS_STAGE, g, S_, E);
#endif
    }
    SEAM(12);
#if BF_TAIL
    if (IN(13)) { final_norm_b_phase(F, (const bf16_t*)(ws + WS_H), args.out, args.in[22]); }
#else
    if (IN(13)) { final_norm_phase(F, args.out, args.in[22]); }
#endif
#undef IN
#undef SEAM
}

static int g_state = 0;
static bool host_init(int n_in, size_t ws_size) {
    if (g_state == 0) {
        g_state = -1;
        if (n_in != 23 || ws_size < WS_TOTAL) { fprintf(stderr, "kernel_launch: n_in %d ws %zu (need %zu)\n", n_in, ws_size, (size_t)WS_TOTAL); return false; }
        int dev = 0, cus = 0;
        if (hipGetDevice(&dev) != hipSuccess || hipDeviceGetAttribute(&cus, hipDeviceAttributeMultiprocessorCount, dev) != hipSuccess || cus != 256) { fprintf(stderr, "kernel_launch: needs a 256-CU device (got %d)\n", cus); return false; }
        if (hipFuncSetAttribute((const void*)fwd, hipFuncAttributeMaxDynamicSharedMemorySize, LDS_BYTES) != hipSuccess) { fprintf(stderr, "hipFuncSetAttribute(fwd) failed\n"); return false; }
        int per_cu = 0;
        if (hipOccupancyMaxActiveBlocksPerMultiprocessor(&per_cu, (const void*)fwd, NTHR, LDS_BYTES) != hipSuccess || per_cu < 1) fprintf(stderr, "kernel_launch: occupancy query reports %d blocks per CU\n", per_cu);
        (void)hipGetLastError();
#if MODE != 4 && MODE != 3 && MODE != 5
        if (hipFuncSetAttribute((const void*)orc::k_attn, hipFuncAttributeMaxDynamicSharedMemorySize, 160 * 1024 - 256) != hipSuccess) { fprintf(stderr, "hipFuncSetAttribute(k_attn) failed\n"); return false; }
#endif
        g_state = 1;
    }
    return g_state > 0;
}
static void launch_phases(void* const* d_in, void* d_out, void* d_ws, hipStream_t stream, int lo, int hi, bool one_launch, int var = 0) {
    (void)hipMemsetAsync((char*)d_ws + WS_CTL, 0, MiB, stream);
    Args a{};
    for (int i = 0; i < 23; ++i) a.in[i] = (const float*)d_in[i];
    a.out = (float*)d_out; a.ws = (unsigned char*)d_ws; a.var = var;
    if (one_launch) { a.ph_lo = lo; a.ph_hi = hi; hipLaunchKernelGGL(fwd, dim3(256), dim3(NTHR), LDS_BYTES, stream, a); }
    else for (int p = lo; p < hi; ++p) { a.ph_lo = p; a.ph_hi = p + 1; hipLaunchKernelGGL(fwd, dim3(256), dim3(NTHR), LDS_BYTES, stream, a); }
    const hipError_t le = hipPeekAtLastError();
    if (le != hipSuccess) fprintf(stderr, "kernel_launch: launch failed: %s\n", hipGetErrorName(le));
}
}

#ifndef MODE
#define MODE 1
#endif
extern "C" void kernel_launch(void* const* d_in, const int* in_sizes, int n_in, void* d_out, int out_size, void* d_ws, size_t ws_size, hipStream_t stream) {
    if (!fk::host_init(n_in, ws_size)) return;
#if MODE != 4 && MODE != 3 && MODE != 5
    const orc::Ptrs p = orc::ptrs(d_in); (void)p;
#endif
#if MODE == 0
    orc::setup(p, (unsigned char*)d_ws, stream); orc::layer0(p, (float*)d_out, (unsigned char*)d_ws, stream); orc::layer1(p, (float*)d_out, (unsigned char*)d_ws, stream);
#elif MODE == 1
    fk::launch_phases(d_in, d_out, d_ws, stream, 0, 6, false);
    orc::setup(p, (unsigned char*)d_ws, stream); orc::layer1(p, (float*)d_out, (unsigned char*)d_ws, stream);
#elif MODE == 2
    orc::setup(p, (unsigned char*)d_ws, stream); orc::layer0(p, (float*)d_out, (unsigned char*)d_ws, stream);
    fk::launch_phases(d_in, d_out, d_ws, stream, 0, 1, false); fk::launch_phases(d_in, d_out, d_ws, stream, 6, 14, false);
#elif MODE == 3
    fk::launch_phases(d_in, d_out, d_ws, stream, 0, 14, false);
#elif MODE == 5
    { const int lst[] = {PHLIST}; for (unsigned i = 0; i < sizeof(lst) / sizeof(lst[0]); ++i) fk::launch_phases(d_in, d_out, d_ws, stream, lst[i] % 100, lst[i] % 100 + 1, false, lst[i] / 100); }
#elif MODE == 4
    fk::launch_phases(d_in, d_out, d_ws, stream, 0, 14, true);
#endif
}
```

```cpp
#define MODE 4
#define ATT_PP 1
#include <hip/hip_runtime.h>
#include <cstdio>
#include <cstdint>
namespace fk {
#define LAS __attribute__((address_space(3)))
#define GAS __attribute__((address_space(1)))
typedef unsigned short bf16_t;
typedef short bf16x8 __attribute__((ext_vector_type(8)));
typedef short s16x4 __attribute__((ext_vector_type(4)));
typedef float f32x2 __attribute__((ext_vector_type(2)));
typedef float f32x4 __attribute__((ext_vector_type(4)));
typedef float f32x8 __attribute__((ext_vector_type(8)));
typedef float f32x16 __attribute__((ext_vector_type(16)));
typedef unsigned u32x2 __attribute__((ext_vector_type(2)));
typedef unsigned u32x4 __attribute__((ext_vector_type(4)));

constexpr int NWAVES = 8, NTHR = 512;
constexpr int D = 4096, NB = 2, S = 8192, CTX = 256, SB = S + CTX  , M = NB * SB  , NPANEL = M / 256  , PPB = SB / 256  ;
constexpr float EPS = 1e-6f;

__device__ __forceinline__ unsigned cvt_pk_bf16(float lo, float hi) { unsigned r; asm volatile("v_cvt_pk_bf16_f32 %0, %1, %2" : "=v"(r) : "v"(lo), "v"(hi)); return r; }
__device__ __forceinline__ float bf_lo(unsigned w) { return __uint_as_float(w << 16); }
__device__ __forceinline__ float bf_hi(unsigned w) { return __uint_as_float(w & 0xffff0000u); }
__device__ __forceinline__ float bf2f(bf16_t b) { return __uint_as_float(((unsigned)b) << 16); }
__device__ __forceinline__ float fast_silu(float x) { return x * __builtin_amdgcn_rcpf(1.f + __expf(-x)); }
__device__ __forceinline__ float wave_sum(float v) {
#pragma unroll
    for (int o = 1; o < 64; o <<= 1) v += __shfl_xor(v, o);
    return v;
}
#define LDS_WAIT() asm volatile("s_waitcnt lgkmcnt(0)" ::: "memory")
#define VM_WAIT() asm volatile("s_waitcnt vmcnt(0)" ::: "memory")

#define XB_TMO      128
#define XB_XCNT(j)  (256  + 64 * (j))
#define XB_XSUB(j)  (1280 + 64 * (j))
#define XB_XGEN(j)  (2304 + 64 * (j))
#define XB_TOP      3328
#define XB_TOPGEN   3392
#define XCD_BAR_WORDS 3456
#define XB_SPIN_CAP (1u << 24)
__device__ __forceinline__ unsigned xb_ld(unsigned* p)              { return __hip_atomic_load(p, __ATOMIC_RELAXED, __HIP_MEMORY_SCOPE_AGENT); }
__device__ __forceinline__ unsigned xb_add(unsigned* p, unsigned v) { return __hip_atomic_fetch_add(p, v, __ATOMIC_RELAXED, __HIP_MEMORY_SCOPE_AGENT); }
__device__ __forceinline__ unsigned xb_xcc_id() { return (unsigned)__builtin_amdgcn_s_getreg((3 << 11) | 20) & 0xFu; }
#define XB_SPIN(cond, bar) do { unsigned _sp = 0; while (cond) { __builtin_amdgcn_s_sleep(1); \
    if ((++_sp & 255u) == 0u) { if (xb_ld(&(bar)[XB_TMO])) break; if (_sp > XB_SPIN_CAP) { atomicAdd(&(bar)[XB_TMO], 1u); break; } } } } while (0)
struct XcdBarrier { unsigned* bar; unsigned x; volatile LAS unsigned* st; };
__device__ __forceinline__ XcdBarrier xcd_barrier_post(unsigned* bar, volatile LAS unsigned* st) {
    XcdBarrier b; b.bar = bar; b.x = xb_xcc_id(); b.st = st;
    if (threadIdx.x == 0) (void)xb_add(&bar[XB_XCNT(b.x)], 1u);
    return b;
}
__device__ __forceinline__ void xcd_barrier_complete(unsigned* bar, unsigned x, unsigned& nloc, unsigned& nx) {
    const unsigned G = gridDim.x * gridDim.y * gridDim.z;
    unsigned sum, cnt, mine, sp = 0u;
    for (;;) {
        sum = 0u; cnt = 0u; mine = 0u;
#pragma unroll
        for (unsigned j = 0; j < 16; ++j) { const unsigned c = xb_ld(&bar[XB_XCNT(j)]); sum += c; cnt += (c > 0u) ? 1u : 0u; mine = (j == x) ? c : mine; }
        if (sum == G) break;
        __builtin_amdgcn_s_sleep(1);
        if ((++sp & 255u) == 0u) { if (xb_ld(&bar[XB_TMO])) break; if (sp > XB_SPIN_CAP) { atomicAdd(&bar[XB_TMO], 1u); break; } }
    }
    nloc = mine > 0u ? mine : 1u; nx = cnt > 0u ? cnt : 1u;
}
__device__ __forceinline__ void xcd_barrier(const XcdBarrier& b) {
    asm volatile("s_waitcnt vmcnt(0)" ::: "memory");
    __syncthreads();
    if (threadIdx.x == 0) {
        unsigned* bar = b.bar;
        __builtin_amdgcn_s_waitcnt(0);
        unsigned nloc = b.st[0], nx = b.st[1];
        if (nloc == 0u) { xcd_barrier_complete(bar, b.x, nloc, nx); b.st[0] = nloc; b.st[1] = nx; }
        const unsigned old = xb_add(&bar[XB_XSUB(b.x)], 1u);
        const unsigned gen = old / nloc;
        if (old + 1u == (gen + 1u) * nloc) {
            __builtin_amdgcn_fence(__ATOMIC_RELEASE, "agent");
            asm volatile("s_waitcnt vmcnt(0)" ::: "memory");
            const unsigned og = xb_add(&bar[XB_TOP], 1u);
            const unsigned tg = og / nx;
            if (og + 1u == (tg + 1u) * nx) xb_add(&bar[XB_TOPGEN], 1u);
            else XB_SPIN(xb_ld(&bar[XB_TOPGEN]) == tg, bar);
            __builtin_amdgcn_fence(__ATOMIC_ACQUIRE, "agent");
            xb_add(&bar[XB_XGEN(b.x)], 1u);
            asm volatile("s_waitcnt vmcnt(0)" ::: "memory");
        } else {
            XB_SPIN(xb_ld(&bar[XB_XGEN(b.x)]) == gen, bar);
            __builtin_amdgcn_fence(__ATOMIC_ACQUIRE, "agent");
            asm volatile("s_waitcnt vmcnt(0)" ::: "memory");
        }
    }
    __syncthreads();
}

constexpr int BM = 256, BK = 64, HALF = 128, HTB = HALF * BK * 2, STAGE_BYTES = 8 * HTB, NXCD = 8, WGM = 8;
__host__ __device__ __forceinline__ int lds_byte(int r, int c) { const int st = (r >> 4) * 2 + (c >> 5), rr = r & 15, cc = c & 31, ob = rr * 64 + cc * 2; return st * 1024 + (ob ^ (((ob >> 9) & 1) << 5)); }
__host__ __device__ __forceinline__ void stage_rc(int b, int& R, int& C) { const int st = b / 1024, sb = b % 1024, swz = sb ^ (((sb >> 9) & 1) << 5); R = (st >> 1) * 16 + swz / 64; C = (st & 1) * 32 + (swz % 64) / 2; }
__host__ __device__ __forceinline__ int perm32(int rho) { const int n = rho >> 4, i = rho & 15; return 8 * (i >> 2) + 4 * n + (i & 3); }
struct Unit { int pm, pn, ko; };
struct Gemm { const bf16_t* A; const bf16_t* Bt; int K, lda, ldb; };
struct Order {
    int nM, nN, nwg, G, c, skip;
    __device__ void init(int nM_, int nN_, int G_, int c_, int skip_) { nM = nM_; nN = nN_; nwg = nM * nN; G = G_; c = c_; skip = skip_; }
    __device__ bool next(int i, Unit& u) const {
        const long L = (long)i * G + c; if (L >= nwg) return false;
        int wgid = (int)L; { const int q = nwg / NXCD, r = nwg % NXCD, xcd = wgid % NXCD, off = wgid / NXCD; wgid = (xcd < r ? xcd * (q + 1) : r * (q + 1) + (xcd - r) * q) + off; }
        const int nig = WGM * nN, gid = wgid / nig, fm = gid * WGM, gsz = (nM - fm) < WGM ? (nM - fm) : WGM;
        int pm = fm + ((wgid % nig) % gsz); if (skip && pm >= 32) pm += 1;
        u.pm = pm; u.pn = (wgid % nig) / gsz; u.ko = 0; return true;
    }
};
struct OrderKr {
    int bid;
    __device__ bool next(int i, Unit& u) const {
        int L; if (bid >= 196) { if (i >= 8) return false; L = (bid - 196) * 8 + i; } else { if (i >= 1 || bid >= 48) return false; L = 480 + bid; }
        u.pm = L >> 3; u.pn = 0; u.ko = (L & 7) * 512; return true;
    }
};
struct OrderL0t {
    Order base; int G, c;
    __device__ bool next(int i, Unit& u) const { const int L = i * G + c; if (L < 2244) return base.next(i, u); if (L < 2304) { u.pm = L - 2244; u.pn = 34; u.ko = 0; return true; } return false; }
};
struct OrderKr6 {
    int bid;
    __device__ bool next(int i, Unit& u) const { if (i >= 1 || bid >= 48) return false; u.pm = 60 + (bid >> 3); u.pn = 0; u.ko = (bid & 7) * 512; return true; }
};
struct OrderCtx {
    int bid;
    __device__ bool next(int i, Unit& u) const { if (i >= 1) return false; u.pm = 32 + 33 * (bid >> 7); u.pn = (bid >> 3) & 15; u.ko = (bid & 7) * 512; return true; }
};
template <class Epi, class Sched>
__device__ __forceinline__ void gemm_phase(LAS unsigned char* lds, const Gemm g, const Sched& S, const Epi& E) {
    const int tid = threadIdx.x, wid = __builtin_amdgcn_readfirstlane(tid >> 6), lane = tid & 63, wr = wid >> 2, wc = wid & 3, fr = lane & 15, fq = lane >> 4;
    const int K = g.K, nt = K / BK;
    unsigned voffA[2], voffB[2];
#pragma unroll
    for (int i = 0; i < 2; ++i) { int R, C; stage_rc(tid * 16 + i * 8192, R, C); const int Rb = Epi::PERM ? ((R & ~31) + perm32(R & 31)) : R;
        voffA[i] = (unsigned)(R * g.lda + C) * 2u; voffB[i] = (unsigned)(Rb * g.ldb + C) * 2u; }
    const size_t kstep = (size_t)(BK * 2);
    const size_t hstepA = (size_t)HALF * g.lda * 2, hstepB = (size_t)HALF * g.ldb * 2;
    const size_t tstepA = 2 * hstepA, tstepB = 2 * hstepB;
    const unsigned ldsw = (unsigned)wid * 1024u;
    const int aoff = lds_byte(wr * 64 + fr, fq * 8), boff = lds_byte(wc * 32 + fr, fq * 8);
#define PG8_SA(b, h) (((b) * 2 + (h)) * HTB)
#define PG8_SB(b, h) ((4 + (b) * 2 + (h)) * HTB)
#define PG8_STAGE(bufoff, gbase, voff) do { _Pragma("unroll") for (int _i = 0; _i < 2; ++_i) \
        __builtin_amdgcn_global_load_lds((const unsigned*)((const char*)(gbase) + (voff)[_i]), (LAS unsigned*)(lds + (bufoff) + ldsw + _i * 8192), 16, 0, 0); } while (0)
#define PG8_LDA(dst, b, h) do { _Pragma("unroll") for (int m = 0; m < 4; ++m) _Pragma("unroll") for (int k = 0; k < 2; ++k) dst[m][k] = *(const LAS bf16x8*)(lds + PG8_SA(b, h) + aoff + m * 2048 + k * 1024); } while (0)
#define PG8_LDB(dst, b, h) do { _Pragma("unroll") for (int n = 0; n < 2; ++n) _Pragma("unroll") for (int k = 0; k < 2; ++k) dst[n][k] = *(const LAS bf16x8*)(lds + PG8_SB(b, h) + boff + n * 2048 + k * 1024); } while (0)
#ifndef GEMM_PRIO
#define GEMM_PRIO 1
#endif
#define PG8_MMA(ai, bj, At, Bt) do { __builtin_amdgcn_s_setprio(GEMM_PRIO); _Pragma("unroll") for (int m = 0; m < 4; ++m) _Pragma("unroll") for (int n = 0; n < 2; ++n) _Pragma("unroll") for (int k = 0; k < 2; ++k) \
        acc[ai][bj][m][n] = __builtin_amdgcn_mfma_f32_16x16x32_bf16(Bt[n][k], At[m][k], acc[ai][bj][m][n], 0, 0, 0); __builtin_amdgcn_s_setprio(0); } while (0)
#define PG8_WAIT_V(n) asm volatile("s_waitcnt vmcnt(" #n ")" ::: "memory")
#define PG8_WAIT_L(n) asm volatile("s_waitcnt lgkmcnt(" #n ")" ::: "memory")
#define PG8_BAR __builtin_amdgcn_s_barrier()
#define PG8_SCHED __builtin_amdgcn_sched_barrier(0)
    Unit cur, nxt; int ui = 0;
    if (!S.next(0, cur)) return;
    f32x4 acc[2][2][4][2];
#pragma unroll
    for (int a = 0; a < 2; ++a)
#pragma unroll
        for (int b = 0; b < 2; ++b)
#pragma unroll
            for (int m = 0; m < 4; ++m)
#pragma unroll
                for (int n = 0; n < 2; ++n) acc[a][b][m][n] = (f32x4){0.f, 0.f, 0.f, 0.f};
    bf16x8 At[4][2], B0[2][2], B1[2][2];
    const char* cA = (const char*)g.A + (size_t)cur.pm * tstepA + (size_t)cur.ko * 2; const char* cB = (const char*)g.Bt + (size_t)cur.pn * tstepB + (size_t)cur.ko * 2;
    PG8_STAGE(PG8_SB(0, 0), cB, voffB); PG8_STAGE(PG8_SB(0, 1), cB + hstepB, voffB); PG8_STAGE(PG8_SA(0, 0), cA, voffA); PG8_STAGE(PG8_SA(0, 1), cA + hstepA, voffA);
    if (wr == 1) PG8_BAR;
    PG8_WAIT_V(2); PG8_BAR;
    PG8_STAGE(PG8_SB(1, 0), cB + kstep, voffB); PG8_STAGE(PG8_SA(1, 0), cA + kstep, voffA); PG8_STAGE(PG8_SB(1, 1), cB + hstepB + kstep, voffB);
    PG8_WAIT_V(6); PG8_BAR;
    for (;;) {
        const bool has_next = S.next(ui + 1, nxt);
        const char* nA = has_next ? (const char*)g.A + (size_t)nxt.pm * tstepA + (size_t)nxt.ko * 2 : cA; const char* nB = has_next ? (const char*)g.Bt + (size_t)nxt.pn * tstepB + (size_t)nxt.ko * 2 : cB;
        for (int t = 0; t < nt; t += 2) {
            const bool last = (t == nt - 2);
            const char* a1 = cA + (size_t)(t + 1) * kstep;
            const char* a2 = last ? nA : cA + (size_t)(t + 2) * kstep; const char* b2 = last ? nB : cB + (size_t)(t + 2) * kstep;
            const char* a3 = a2 + kstep; const char* b3 = b2 + kstep;
            PG8_LDB(B0, 0, 0); PG8_LDB(B1, 0, 1); PG8_SCHED; PG8_LDA(At, 0, 0); PG8_STAGE(PG8_SA(1, 1), a1 + hstepA, voffA);
            PG8_WAIT_V(8); PG8_WAIT_L(0); PG8_BAR; PG8_MMA(0, 0, At, B0); PG8_MMA(0, 1, At, B1); PG8_BAR; PG8_SCHED;
            PG8_LDA(At, 0, 1); PG8_STAGE(PG8_SB(0, 0), b2, voffB); PG8_STAGE(PG8_SB(0, 1), b2 + hstepB, voffB); PG8_STAGE(PG8_SA(0, 0), a2, voffA);
            PG8_WAIT_V(8); PG8_WAIT_L(0); PG8_BAR; PG8_MMA(1, 0, At, B0); PG8_MMA(1, 1, At, B1); PG8_BAR; PG8_SCHED;
            PG8_LDB(B0, 1, 0); PG8_LDB(B1, 1, 1); PG8_SCHED; PG8_LDA(At, 1, 0); PG8_STAGE(PG8_SA(0, 1), a2 + hstepA, voffA);
            PG8_WAIT_V(8); PG8_WAIT_L(0); PG8_BAR; PG8_MMA(0, 0, At, B0); PG8_MMA(0, 1, At, B1); PG8_BAR; PG8_SCHED;
            PG8_LDA(At, 1, 1); PG8_STAGE(PG8_SB(1, 0), b3, voffB); PG8_STAGE(PG8_SB(1, 1), b3 + hstepB, voffB); PG8_STAGE(PG8_SA(1, 0), a3, voffA);
            PG8_WAIT_V(8); PG8_WAIT_L(0); PG8_BAR; PG8_MMA(1, 0, At, B0); PG8_MMA(1, 1, At, B1); PG8_BAR; PG8_SCHED;
        }
        if (wr == 0) PG8_BAR;
        E(acc, cur, wr, wc, fr, fq);
        if (!has_next) break;
#pragma unroll
        for (int a = 0; a < 2; ++a)
#pragma unroll
            for (int b = 0; b < 2; ++b)
#pragma unroll
                for (int m = 0; m < 4; ++m)
#pragma unroll
                    for (int n = 0; n < 2; ++n) acc[a][b][m][n] = (f32x4){0.f, 0.f, 0.f, 0.f};
        cur = nxt; cA = nA; cB = nB; ++ui;
        if (wr == 1) PG8_BAR;
    }
    PG8_WAIT_V(0);
    PG8_BAR;
#undef PG8_SA
#undef PG8_SB
#undef PG8_STAGE
#undef PG8_LDA
#undef PG8_LDB
#undef PG8_MMA
#undef PG8_WAIT_V
#undef PG8_WAIT_L
#undef PG8_BAR
#undef PG8_SCHED
}
}
namespace fk {
constexpr size_t MiB = 1u << 20;
constexpr size_t WS_CTL = 0;
constexpr size_t WS_MOD = 1 * MiB;
constexpr size_t WS_ROPEA = 2 * MiB;
constexpr size_t WS_ROPEB = 2 * MiB + 64 * 1024;
constexpr size_t WS_CS = 2 * MiB + 128 * 1024;
constexpr size_t WS_SSQ = 3 * MiB;
constexpr size_t WS_KR = 4 * MiB;
constexpr size_t WS_GD = 7 * MiB;
constexpr size_t WS_GAM = 1391 * MiB;
constexpr size_t WS_AT = 14 * MiB;
constexpr size_t WS_W1T = 40 * MiB;
constexpr size_t WS_WUQ = 110 * MiB;
constexpr size_t WS_WUKV = 116 * MiB;
constexpr size_t WS_WO = 120 * MiB;
constexpr size_t WS_W4T = 152 * MiB;
constexpr size_t WS_WO2 = 242 * MiB;
constexpr size_t WS_DM = 274 * MiB;
constexpr size_t WS_H = 402 * MiB;
constexpr size_t WS_L = 534 * MiB;
constexpr size_t WS_A1 = WS_L;
constexpr size_t WS_CQKV = WS_L + 99 * MiB;
constexpr size_t WS_G0 = WS_L + 149 * MiB;
constexpr size_t WS_QB = WS_L + 281 * MiB;
constexpr size_t WS_KVB = WS_L + 380 * MiB;
constexpr size_t WS_Y0 = WS_L + 512 * MiB;
constexpr size_t WS_QK1 = WS_L;
constexpr size_t WS_V1 = WS_L + 99 * MiB;
constexpr size_t WS_U1 = WS_L + 198 * MiB;
constexpr size_t WS_G1 = WS_L + 231 * MiB;
constexpr size_t WS_QT = WS_L + 363 * MiB;
constexpr size_t WS_KT = WS_L + 462 * MiB;
constexpr size_t WS_VT = WS_L + 561 * MiB;
constexpr size_t WS_AB = WS_L + 660 * MiB;
constexpr size_t WS_VTF = WS_L + 726 * MiB;
constexpr size_t WS_O00 = WS_QK1, WS_O01 = WS_V1;
constexpr size_t WS_O10 = WS_L + 758 * MiB, WS_O11 = WS_H;
constexpr size_t WS_BF = 1398 * MiB;
constexpr size_t WS_PCS = WS_VTF;
constexpr size_t WS_F4096 = WS_SSQ;
constexpr size_t WS_Y1 = WS_QT;
constexpr size_t WS_LEND = WS_L + 758 * MiB;
constexpr size_t WS_PART = WS_L + 660 * MiB;
constexpr size_t WS_X1C = 1448 * MiB;
constexpr size_t WS_TOTAL = 1456 * MiB;
static_assert(WS_O10 + 99 * MiB <= WS_GAM && WS_GAM + 7 * MiB <= WS_BF && WS_BF + 34 * MiB <= WS_X1C && WS_QT + 132 * MiB <= WS_VT, "ws map");
constexpr int CW_BAR = 4096;

constexpr int LDS_STAGE = 0;
constexpr int LDS_X = 151552;
constexpr int LDS_MISC = 159744;
constexpr int LDS_BYTES = 160256;

struct Args { const float* in[23]; float* out; unsigned char* ws; int ph_lo, ph_hi, var, pad; };

struct Frame { LAS unsigned char* lds; int tid, lane, wave, G, bid; };

__device__ __forceinline__ int map_w1(int n) {
    if (n < 2560) { const int h = n >> 7, p = n & 127; return h * 128 + (p >> 1) + 64 * (p & 1); }
    if (n < 4608) return n;
    if (n < 8704) return 4672 + (n - 4608);
    if (n < 8768) { const int p = n - 8704; return 4608 + (p >> 1) + 32 * (p & 1); }
    return -1;
}
__device__ __forceinline__ int map_uq(int n) { const int h = n / 192, w = n % 192; if (w < 128) return n; const int p = w - 128; return h * 192 + 128 + (p >> 1) + 32 * (p & 1); }
__device__ __forceinline__ int map_w4(int n) {
    if (n < 6144) return n;
    if (n < 7168) return 6176 + (n - 6144);
    if (n < 11264) return 7200 + (n - 7168);
    if (n < 11296) return 6144 + (n - 11264);
    return -1;
}
__device__ __forceinline__ void tr_item(const float* W, int K, int Nsrc, bf16_t* WT, LAS float* scr, int k0, int n0, int lane, int srccol, const float* kscale, float cscale) {
#pragma unroll
    for (int i = 0; i < 32; ++i) { const int kk = 2 * i + (lane >> 5); float v = srccol >= 0 ? W[(size_t)(k0 + kk) * Nsrc + srccol] : 0.f;
        v *= kscale ? cscale * kscale[k0 + kk] : cscale; scr[kk * 33 + (lane & 31)] = v; }
    LDS_WAIT(); asm volatile("" ::: "memory");
    const int c = lane & 7;
#pragma unroll
    for (int j = 0; j < 4; ++j) { const int n = (lane >> 3) + 8 * j; const LAS float* s = scr + (8 * c) * 33 + n;
        u32x4 o; o.x = cvt_pk_bf16(s[0 * 33], s[1 * 33]); o.y = cvt_pk_bf16(s[2 * 33], s[3 * 33]); o.z = cvt_pk_bf16(s[4 * 33], s[5 * 33]); o.w = cvt_pk_bf16(s[6 * 33], s[7 * 33]);
        *(u32x4*)(WT + (size_t)(n0 + n) * K + k0 + 8 * c) = o; }
    LDS_WAIT(); asm volatile("" ::: "memory");
}
__device__ __forceinline__ void mod_gemv(const Frame& F, const Args& a, int l0, int nl, int wg0, int nwg) {
    if (F.bid < wg0) return;
    LAS float* sc = (LAS float*)(F.lds + 72 * 1024);
    LAS float* red = (LAS float*)(F.lds + 120 * 1024);
    __syncthreads();
    for (int i = F.tid; i < 3 * D; i += NTHR) { const float v = i < 2 * D ? a.in[1][i] : a.in[3][i - 2 * D]; sc[i] = v / (1.f + expf(-v)); }
    __syncthreads();
    float* mod = (float*)(a.ws + WS_MOD);
    const int rsub = F.lane >> 3, c4 = (F.lane & 7) * 4;
    for (int u = F.bid - wg0; u < 384 * nl; u += nwg) {
        const int l = l0 + u / 384, n0 = (u % 384) * 32;
        const float* W = a.in[5] + (size_t)l * D * 12288 + n0 + c4;
        f32x4 a0 = {0.f, 0.f, 0.f, 0.f}, a1 = a0, a2 = a0;
        const int kb = F.wave * 512 + rsub;
#pragma unroll 8
        for (int k = kb; k < kb + 512; k += 8) { const f32x4 w = *(const f32x4*)(W + (size_t)k * 12288); a0 += w * sc[k]; a1 += w * sc[D + k]; a2 += w * sc[2 * D + k]; }
#pragma unroll
        for (int o = 8; o < 64; o <<= 1) {
#pragma unroll
            for (int i = 0; i < 4; ++i) { a0[i] += __shfl_xor(a0[i], o); a1[i] += __shfl_xor(a1[i], o); a2[i] += __shfl_xor(a2[i], o); } }
        if (F.lane < 8) { *(LAS f32x4*)(red + (F.wave * 3 + 0) * 32 + c4) = a0; *(LAS f32x4*)(red + (F.wave * 3 + 1) * 32 + c4) = a1; *(LAS f32x4*)(red + (F.wave * 3 + 2) * 32 + c4) = a2; }
        __syncthreads();
        if (F.tid < 96) { const int r = F.tid >> 5, cl = F.tid & 31; float sm = 0.f;
#pragma unroll
            for (int w = 0; w < 8; ++w) sm += red[(w * 3 + r) * 32 + cl];
            mod[(l * 3 + r) * 12288 + n0 + cl] = sm + a.in[6][l * 12288 + n0 + cl]; }
        __syncthreads();
    }
}
__device__ __forceinline__ void p0_prologue(const Frame& F, const Args& a) {
    unsigned char* ws = a.ws;
    mod_gemv(F, a, 0, 2, 0, F.G);
    __syncthreads();
    {
        LAS float* scr = (LAS float*)(F.lds + F.wave * 8448);
        const int gw = F.bid * NWAVES + F.wave, NGW = F.G * NWAVES;
        constexpr int I0 = 64 * 280, I1 = 16 * 96, I2 = 8 * 128;
        constexpr int NIT = I0 + I1 + I2;
        for (int it = gw; it < NIT; it += NGW) {
            int r = it; const int cl = F.lane & 31;
            if (r < I0) { const int nb = r % 280, kb = r / 280; tr_item(a.in[7], 4096, 8768, (bf16_t*)(ws + WS_W1T), scr, kb * 64, nb * 32, F.lane, map_w1(nb * 32 + cl), nullptr, 1.f); continue; } r -= I0;
            if (r < I1) { const int nb = r % 96, kb = r / 96; tr_item(a.in[12], 1024, 3072, (bf16_t*)(ws + WS_WUQ), scr, kb * 64, nb * 32, F.lane, map_uq(nb * 32 + cl), a.in[10], 1.f); continue; } r -= I1;
            { const int nb = r % 128, kb = r / 128; tr_item(a.in[13], 512, 4096, (bf16_t*)(ws + WS_WUKV), scr, kb * 64, nb * 32, F.lane, nb * 32 + cl, a.in[11], 1.f); }
        }
    }
    {
        const int gt = F.bid * NTHR + F.tid, NGT = F.G * NTHR;
        f32x2* ra = (f32x2*)(ws + WS_ROPEA); f32x2* rb = (f32x2*)(ws + WS_ROPEB); bf16_t* cs = (bf16_t*)(ws + WS_CS);
        for (int i = gt; i < 128 * 32; i += NGT) { const int pos = i >> 5, fi = i & 31; const float ang = (float)pos * powf(10000.f, -(float)fi / 32.f); ra[i] = (f32x2){cosf(ang), sinf(ang)}; }
        for (int i = gt; i < 128 * 16; i += NGT) { const int pos = i >> 4, fi = i & 15; const float ang = (float)pos * powf(10000.f, -(float)fi / 16.f); rb[i] = (f32x2){cosf(ang), sinf(ang)}; }
        for (int i = gt; i < 512 * 256; i += NGT) { const int m = i >> 8, c = i & 255, l = m & 255; const float x = (float)((l * c) & 255) * (2.f / 256.f);
            const float v = (m < 256) ? cospif(x) : sinpif(x); cs[i] = (bf16_t)(cvt_pk_bf16(v, 0.f) & 0xffffu); }
    }
}
__device__ __forceinline__ void late_convert(const Frame& F, const Args& a, int w0, int nw, int which) {
    const int gw = F.bid * NWAVES + F.wave - w0; if (gw < 0) return;
    LAS float* scr = (LAS float*)(F.lds + F.wave * 8448);
    constexpr int I3 = 64 * 128, I4 = 64 * 360;
    if (which == 0) { for (int it = gw; it < I3; it += nw) { const int nb = it % 128, kb = it / 128; tr_item(a.in[14], 4096, 4096, (bf16_t*)(a.ws + WS_WO), scr, kb * 64, nb * 32, F.lane, nb * 32 + (F.lane & 31), nullptr, 1.f); } }
    else { for (int it = gw; it < I4; it += nw) { const int nb = it % 360, kb = it / 360; tr_item(a.in[15], 4096, 11296, (bf16_t*)(a.ws + WS_W4T), scr, kb * 64, nb * 32, F.lane, map_w4(nb * 32 + (F.lane & 31)), nullptr, nb * 32 < 1536 ? 0.0625f : 1.f); } }
}
__device__ __forceinline__ void wo2_convert(const Frame& F, const Args& a, int w0, int nw) {
    __syncthreads();
    LAS float* scr = (LAS float*)(F.lds + F.wave * 8448);
    const int gw = F.bid * NWAVES + F.wave - w0;
    for (int it = gw; it < 64 * 128; it += nw) { const int nb = it % 128, kb = it / 128; tr_item(a.in[21], 4096, 4096, (bf16_t*)(a.ws + WS_WO2), scr, kb * 64, nb * 32, F.lane, nb * 32 + (F.lane & 31), nullptr, 1.f); }
}
constexpr int FKP = 4224;
__device__ __forceinline__ void dm_gen(const Frame& F, bf16_t* dm, int w0, int nw) {
    for (int r = w0; r < 8192; r += nw) { const int half = r >> 12, k = r & 4095;
        for (int q = F.tid; q < FKP / 8; q += NTHR) { float v[8];
#pragma unroll
            for (int j = 0; j < 8; ++j) { const int kk = q * 8 + j; const float x = (float)((k * kk) & 8191) * (1.f / 8192.f);
                v[j] = half == 0 ? (kk <= 4096 ? __builtin_amdgcn_cosf(x) : 0.f) : ((kk >= 1 && kk <= 4095) ? __builtin_amdgcn_sinf(x) : 0.f); }
            u32x4 o; o.x = cvt_pk_bf16(v[0], v[1]); o.y = cvt_pk_bf16(v[2], v[3]); o.z = cvt_pk_bf16(v[4], v[5]); o.w = cvt_pk_bf16(v[6], v[7]);
            *(u32x4*)(dm + (size_t)r * FKP + q * 8) = o; }
    }
}
#ifndef HNORM_PIPE
#define HNORM_PIPE 1
#endif
__device__ __forceinline__ void hnorm_phase(const Frame& F, const float* xlat, const float* xctx, const float* g, const float* modl, bf16_t* H) {
    LAS f32x4* MA = (LAS f32x4*)F.lds;
    __syncthreads();
    for (int i = F.tid; i < 3 * 1024; i += NTHR) { const int r = i >> 10, n4 = i & 1023;
        const f32x4 gg = *((const f32x4*)g + n4), scl = *((const f32x4*)(modl + (size_t)r * 12288 + D) + n4), sh = *((const f32x4*)(modl + (size_t)r * 12288) + n4);
        MA[(r * 2 + 0) * 1024 + n4] = gg * (scl + 1.f); MA[(r * 2 + 1) * 1024 + n4] = sh; }
    __syncthreads();
#if HNORM_PIPE
    const int base = F.bid * (M / 256);
    const int rot = (F.bid * 5) % (M / 256);
    const int nrows = (M / 256 - F.wave + 7) >> 3;
#define HN_ROW(k_) (base + (F.wave + 8 * (k_) + rot) % (M / 256))
#define HN_LOAD(V, k_) do { const int m_ = HN_ROW(k_); const int b_ = m_ / SB, r_ = m_ % SB; \
        const float* s_ = r_ < S ? xlat + ((size_t)b_ * S + r_) * D : xctx + ((size_t)b_ * CTX + (r_ - S)) * D; const f32x4* x_ = (const f32x4*)s_ + F.lane; \
        _Pragma("unroll") for (int j = 0; j < 16; ++j) V[j] = __builtin_nontemporal_load(x_ + 64 * j); } while (0)
#define HN_PROC(V, k_) do { const int m_ = HN_ROW(k_); const int b_ = m_ / SB, r_ = m_ % SB; const LAS f32x4* mm_ = MA + (r_ < S ? b_ : 2) * 2048 + F.lane; float s_ = 0.f; \
        _Pragma("unroll") for (int j = 0; j < 16; ++j) s_ += (V[j].x * V[j].x + V[j].y * V[j].y) + (V[j].z * V[j].z + V[j].w * V[j].w); \
        const float rs_ = 1.0f / sqrtf(wave_sum(s_) * (1.f / D) + EPS); u32x2* o_ = (u32x2*)(H + (size_t)m_ * D) + F.lane; \
        _Pragma("unroll") for (int j = 0; j < 16; ++j) { const f32x4 h = V[j] * rs_ * mm_[64 * j] + mm_[1024 + 64 * j]; u32x2 w; w.x = cvt_pk_bf16(h.x, h.y); w.y = cvt_pk_bf16(h.z, h.w); o_[64 * j] = w; } } while (0)
    {
        f32x4 va[16], vb[16];
        HN_LOAD(va, 0);
        for (int k = 0; k < nrows; k += 2) {
            if (k + 1 < nrows) HN_LOAD(vb, k + 1);
            HN_PROC(va, k);
            if (k + 2 < nrows) HN_LOAD(va, k + 2);
            if (k + 1 < nrows) HN_PROC(vb, k + 1);
        }
    }
#undef HN_ROW
#undef HN_LOAD
#undef HN_PROC
#else
    const int base = F.bid * (M / 256);
    for (int i0 = F.wave; i0 < M / 256; i0 += 16) {
        const int rot = (F.bid * 5) % (M / 256);
        const bool hasB = (i0 + 8) < M / 256;
        const int mA = base + (i0 + rot) % (M / 256), mB = base + (i0 + 8 + rot) % (M / 256);
        const int bA = mA / SB, rA = mA % SB, bB = hasB ? mB / SB : bA, rB = hasB ? mB % SB : rA;
        const float* srcA = rA < S ? xlat + ((size_t)bA * S + rA) * D : xctx + ((size_t)bA * CTX + (rA - S)) * D;
        const float* srcB = rB < S ? xlat + ((size_t)bB * S + rB) * D : xctx + ((size_t)bB * CTX + (rB - S)) * D;
        const LAS f32x4* mA_ = MA + (rA < S ? bA : 2) * 2048 + F.lane; const LAS f32x4* mB_ = MA + (rB < S ? bB : 2) * 2048 + F.lane;
        const f32x4* xa = (const f32x4*)srcA + F.lane; const f32x4* xb = (const f32x4*)srcB + F.lane;
        f32x4 va[16], vb[16]; float sa = 0.f, sb = 0.f;
#pragma unroll
        for (int j = 0; j < 16; ++j) va[j] = __builtin_nontemporal_load(xa + 64 * j);
#pragma unroll
        for (int j = 0; j < 16; ++j) vb[j] = __builtin_nontemporal_load(xb + 64 * j);
#pragma unroll
        for (int j = 0; j < 16; ++j) sa += (va[j].x * va[j].x + va[j].y * va[j].y) + (va[j].z * va[j].z + va[j].w * va[j].w);
#pragma unroll
        for (int j = 0; j < 16; ++j) sb += (vb[j].x * vb[j].x + vb[j].y * vb[j].y) + (vb[j].z * vb[j].z + vb[j].w * vb[j].w);
        const float rsa = 1.0f / sqrtf(wave_sum(sa) * (1.f / D) + EPS), rsb = 1.0f / sqrtf(wave_sum(sb) * (1.f / D) + EPS);
        u32x2* oa = (u32x2*)(H + (size_t)mA * D) + F.lane; u32x2* ob = (u32x2*)(H + (size_t)(hasB ? mB : mA) * D) + F.lane;
#pragma unroll
        for (int j = 0; j < 16; ++j) {
            { const f32x4 h = va[j] * rsa * mA_[64 * j] + mA_[1024 + 64 * j]; u32x2 w; w.x = cvt_pk_bf16(h.x, h.y); w.y = cvt_pk_bf16(h.z, h.w); oa[64 * j] = w; }
            if (hasB) { const f32x4 h = vb[j] * rsb * mB_[64 * j] + mB_[1024 + 64 * j]; u32x2 w; w.x = cvt_pk_bf16(h.x, h.y); w.y = cvt_pk_bf16(h.z, h.w); ob[64 * j] = w; } }
    }
#endif
    __syncthreads();
}
__device__ __forceinline__ u32x4 pack8(const f32x4 a, const f32x4 b) { u32x4 w; w.x = cvt_pk_bf16(a[0], a[1]); w.y = cvt_pk_bf16(a[2], a[3]); w.z = cvt_pk_bf16(b[0], b[1]); w.w = cvt_pk_bf16(b[2], b[3]); return w; }
__device__ __forceinline__ f32x4 rope2(const f32x4 v, const f32x4 cs) {
    return (f32x4){v[0] * cs[0] - v[1] * cs[1], v[0] * cs[1] + v[1] * cs[0], v[2] * cs[2] - v[3] * cs[3], v[2] * cs[3] + v[3] * cs[2]};
}
struct EpiL0 {
    static constexpr bool PERM = true;
    bf16_t* A1; bf16_t* CQKV; bf16_t* G0; bf16_t* KRb; float* SSQ; const float* qn_g; const float* kn_g; const float* ropeA; const float* ropeB; LAS float* X;
    __device__ __forceinline__ void operator()(const f32x4 (&acc)[2][2][4][2], const Unit& u, int wr, int wc, int fr, int fq) const {
        const int pn = u.pn, pb = u.pm % PPB; const bool lat = pb < 32;
        const int rowl0 = wr * 64 + fr; const size_t row0 = (size_t)u.pm * 256 + rowl0; const int cl = wc * 32 + 8 * fq;
        if (pn < 10) {
            const float* g = pn < 8 ? qn_g : kn_g; f32x4 gv[2];
#pragma unroll
            for (int n = 0; n < 2; ++n)
#pragma unroll
                for (int i = 0; i < 4; ++i) { const int p = cl + 4 * n + i; gv[n][i] = g[(p >> 1) + 64 * (p & 1)]; }
#pragma unroll
            for (int ai = 0; ai < 2; ++ai)
#pragma unroll
                for (int m = 0; m < 4; ++m)
#pragma unroll
                    for (int bj = 0; bj < 2; ++bj) { const f32x4 x0 = acc[ai][bj][m][0], x1 = acc[ai][bj][m][1];
                        float s = (x0[0] * x0[0] + x0[1] * x0[1]) + (x0[2] * x0[2] + x0[3] * x0[3]) + (x1[0] * x1[0] + x1[1] * x1[1]) + (x1[2] * x1[2] + x1[3] * x1[3]);
                        s += __shfl_xor(s, 16); s += __shfl_xor(s, 32);
                        if (fq == 0) X[((ai * 128 + rowl0 + 16 * m) * 2 + bj) * 4 + wc] = s; }
            LDS_WAIT(); __builtin_amdgcn_s_barrier(); asm volatile("" ::: "memory");
#pragma unroll
            for (int ai = 0; ai < 2; ++ai)
#pragma unroll
                for (int m = 0; m < 4; ++m) { const int rowl = ai * 128 + rowl0 + 16 * m; const int grow = 4 * pb + 2 * ai + wr, gcol = 16 * m + fr;
                    const int pos = wc < 2 ? grow : gcol;
#pragma unroll
                    for (int bj = 0; bj < 2; ++bj) { const f32x4 p4 = *(const LAS f32x4*)&X[(rowl * 2 + bj) * 4];
                        const float rs = 1.0f / sqrtf(((p4[0] + p4[1]) + (p4[2] + p4[3])) * (1.f / 128.f) + EPS);
                        f32x4 v0 = acc[ai][bj][m][0] * rs * gv[0], v1 = acc[ai][bj][m][1] * rs * gv[1];
                        if (lat) { const int fi = (16 * wc + 4 * fq) & 31; const f32x4 c0 = *(const f32x4*)(ropeA + (pos * 32 + fi) * 2), c1 = *(const f32x4*)(ropeA + (pos * 32 + fi + 2) * 2);
                            v0 = rope2(v0, c0); v1 = rope2(v1, c1); }
                        *(u32x4*)(A1 + (row0 + ai * 128 + 16 * m) * 3072 + pn * 256 + bj * 128 + cl) = pack8(v0, v1); } }
        } else if (pn < 12) {
#pragma unroll
            for (int ai = 0; ai < 2; ++ai)
#pragma unroll
                for (int m = 0; m < 4; ++m)
#pragma unroll
                    for (int bj = 0; bj < 2; ++bj) *(u32x4*)(A1 + (row0 + ai * 128 + 16 * m) * 3072 + pn * 256 + bj * 128 + cl) = pack8(acc[ai][bj][m][0], acc[ai][bj][m][1]);
        } else if (pn < 18) {
#pragma unroll
            for (int ai = 0; ai < 2; ++ai)
#pragma unroll
                for (int m = 0; m < 4; ++m) { float s = 0.f;
#pragma unroll
                    for (int bj = 0; bj < 2; ++bj) { const f32x4 x0 = acc[ai][bj][m][0], x1 = acc[ai][bj][m][1];
                        s += (x0[0] * x0[0] + x0[1] * x0[1]) + (x0[2] * x0[2] + x0[3] * x0[3]) + (x1[0] * x1[0] + x1[1] * x1[1]) + (x1[2] * x1[2] + x1[3] * x1[3]);
                        *(u32x4*)(CQKV + (row0 + ai * 128 + 16 * m) * 1536 + (pn - 12) * 256 + bj * 128 + cl) = pack8(x0, x1); }
                    s += __shfl_xor(s, 16); s += __shfl_xor(s, 32);
                    if (fq == 0) X[(ai * 128 + rowl0 + 16 * m) * 4 + wc] = s; }
            LDS_WAIT(); __builtin_amdgcn_s_barrier(); asm volatile("" ::: "memory");
            if (wc == 0 && fq == 0) {
#pragma unroll
                for (int ai = 0; ai < 2; ++ai)
#pragma unroll
                    for (int m = 0; m < 4; ++m) { const f32x4 p4 = *(const LAS f32x4*)&X[(ai * 128 + rowl0 + 16 * m) * 4];
                        SSQ[(row0 + ai * 128 + 16 * m) * 8 + (pn - 12)] = (p4[0] + p4[1]) + (p4[2] + p4[3]); } }
        } else if (pn < 34) {
#pragma unroll
            for (int ai = 0; ai < 2; ++ai)
#pragma unroll
                for (int m = 0; m < 4; ++m)
#pragma unroll
                    for (int bj = 0; bj < 2; ++bj) { f32x4 x0 = acc[ai][bj][m][0], x1 = acc[ai][bj][m][1];
#pragma unroll
                        for (int i = 0; i < 4; ++i) { x0[i] = fast_silu(x0[i]); x1[i] = fast_silu(x1[i]); }
                        *(u32x4*)(G0 + (row0 + ai * 128 + 16 * m) * 4096 + (pn - 18) * 256 + bj * 128 + cl) = pack8(x0, x1); }
        } else {
            if (wc < 2) {
#pragma unroll
                for (int ai = 0; ai < 2; ++ai)
#pragma unroll
                    for (int m = 0; m < 4; ++m) { const int grow = 4 * pb + 2 * ai + wr, gcol = 16 * m + fr; const int pos = wc < 1 ? grow : gcol;
                        f32x4 v0 = acc[ai][0][m][0], v1 = acc[ai][0][m][1];
                        if (lat) { const int fi = (4 * fq) & 15; const f32x4 c0 = *(const f32x4*)(ropeB + (pos * 16 + fi) * 2), c1 = *(const f32x4*)(ropeB + (pos * 16 + fi + 2) * 2);
                            v0 = rope2(v0, c0); v1 = rope2(v1, c1); }
                        *(u32x4*)(KRb + (row0 + ai * 128 + 16 * m) * 64 + cl) = pack8(v0, v1); } }
        }
    }
};
template <int UPM> struct EpiUp {
    static constexpr bool PERM = true;
    bf16_t* O; int ld; const float* SSQ; const float* ropeB;
    __device__ __forceinline__ void operator()(const f32x4 (&acc)[2][2][4][2], const Unit& u, int wr, int wc, int fr, int fq) const {
        const int pb = u.pm % PPB; const bool lat = pb < 32;
        const int rowl0 = wr * 64 + fr; const size_t row0 = (size_t)u.pm * 256 + rowl0;
#pragma unroll
        for (int ai = 0; ai < 2; ++ai)
#pragma unroll
            for (int m = 0; m < 4; ++m) { const size_t row = row0 + ai * 128 + 16 * m; float rs;
                if (UPM == 0) { const f32x4 p4 = *(const f32x4*)(SSQ + row * 8); rs = 1.0f / sqrtf(((p4[0] + p4[1]) + (p4[2] + p4[3])) * (1.f / 1024.f) + EPS); }
                else { const f32x2 p2 = *(const f32x2*)(SSQ + row * 8 + 4); rs = 1.0f / sqrtf((p2[0] + p2[1]) * (1.f / 512.f) + EPS); }
                const int grow = 4 * pb + 2 * ai + wr, gcol = 16 * m + fr;
#pragma unroll
                for (int bj = 0; bj < 2; ++bj) { const int c0 = u.pn * 256 + bj * 128 + wc * 32 + 8 * fq;
                    f32x4 v0 = acc[ai][bj][m][0] * rs, v1 = acc[ai][bj][m][1] * rs;
                    if (UPM == 0) { const int w = c0 % 192;
                        if (lat && w >= 128) { const int p = w - 128; const int pos = p < 32 ? grow : gcol; const int fi = (p >> 1) & 15;
                            const f32x4 c0v = *(const f32x4*)(ropeB + (pos * 16 + fi) * 2), c1v = *(const f32x4*)(ropeB + (pos * 16 + fi + 2) * 2);
                            v0 = rope2(v0, c0v); v1 = rope2(v1, c1v); } }
                    *(u32x4*)(O + row * ld + c0) = pack8(v0, v1); } }
    }
};
struct EpiPartKr {
    static constexpr bool PERM = true;
    float* P;
    __device__ __forceinline__ void operator()(const f32x4 (&acc)[2][2][4][2], const Unit& u, int wr, int wc, int fr, int fq) const {
        if (wc >= 2) return;
        float* base = P + ((size_t)(u.ko >> 9) * M + (size_t)u.pm * 256 + wr * 64 + fr) * 64 + wc * 32 + 8 * fq;
#pragma unroll
        for (int ai = 0; ai < 2; ++ai)
#pragma unroll
            for (int m = 0; m < 4; ++m) { float* p = base + (size_t)(ai * 128 + 16 * m) * 64; *(f32x4*)p = acc[ai][0][m][0]; *(f32x4*)(p + 4) = acc[ai][0][m][1]; }
    }
};
struct EpiPartCtx {
    static constexpr bool PERM = false;
    float* P;
    __device__ __forceinline__ void operator()(const f32x4 (&acc)[2][2][4][2], const Unit& u, int wr, int wc, int fr, int fq) const {
        float* base = P + ((size_t)(u.ko >> 9) * 512 + (size_t)(u.pm / PPB) * 256 + wr * 64 + fr) * D + u.pn * 256 + wc * 32 + 4 * fq;
#pragma unroll
        for (int ai = 0; ai < 2; ++ai)
#pragma unroll
            for (int m = 0; m < 4; ++m)
#pragma unroll
                for (int bj = 0; bj < 2; ++bj)
#pragma unroll
                    for (int n = 0; n < 2; ++n) *(f32x4*)(base + (size_t)(ai * 128 + 16 * m) * D + bj * 128 + n * 16) = acc[ai][bj][m][n];
    }
};
__device__ __forceinline__ void kr_finalize(const Frame& F, const float* P, const float* ropeB, bf16_t* KRb, int m0, int nrows) {
    for (int it = F.bid * NTHR + F.tid; it < nrows * 8; it += F.G * NTHR) {
        const int m = m0 + (it >> 3), c8 = it & 7; f32x4 v0 = {0.f, 0.f, 0.f, 0.f}, v1 = v0;
#pragma unroll
        for (int ks = 0; ks < 8; ++ks) { const float* p = P + ((size_t)ks * M + m) * 64 + c8 * 8; v0 += *(const f32x4*)p; v1 += *(const f32x4*)(p + 4); }
        const int r = m % SB;
        if (r < S) { const int pos = c8 < 4 ? (r >> 6) : (r & 63), fi = (4 * c8) & 15;
            v0 = rope2(v0, *(const f32x4*)(ropeB + (pos * 16 + fi) * 2)); v1 = rope2(v1, *(const f32x4*)(ropeB + (pos * 16 + fi + 2) * 2)); }
        *(u32x4*)(KRb + (size_t)m * 64 + c8 * 8) = pack8(v0, v1);
    }
}
struct EpiRes {
    static constexpr bool PERM = false;
    const float* xlat; const float* xctx; const float* modl; float* olat; float* octx;
    __device__ __forceinline__ void operator()(const f32x4 (&acc)[2][2][4][2], const Unit& u, int wr, int wc, int fr, int fq) const {
        const int b = u.pm / PPB, pb = u.pm % PPB; const bool lat = pb < 32;
        const size_t r0 = lat ? ((size_t)b * S + 256 * pb) : ((size_t)b * CTX);
        const float* src = (lat ? xlat : xctx) + r0 * D; float* dst = (lat ? olat : octx) + r0 * D;
        const float* gt = modl + (size_t)(lat ? b : 2) * 12288 + 2 * D;
        const int rowl0 = wr * 64 + fr, col0 = u.pn * 256 + wc * 32 + 4 * fq;
        f32x4 gv[2][2];
#pragma unroll
        for (int bj = 0; bj < 2; ++bj)
#pragma unroll
            for (int n = 0; n < 2; ++n) gv[bj][n] = *(const f32x4*)(gt + col0 + bj * 128 + n * 16);
#pragma unroll
        for (int ai = 0; ai < 2; ++ai)
#pragma unroll
            for (int m = 0; m < 4; ++m) { const size_t off = (size_t)(ai * 128 + rowl0 + 16 * m) * D + col0;
#pragma unroll
                for (int bj = 0; bj < 2; ++bj)
#pragma unroll
                    for (int n = 0; n < 2; ++n) { const f32x4 xs = *(const f32x4*)(src + off + bj * 128 + n * 16);
                        *(f32x4*)(dst + off + bj * 128 + n * 16) = xs + gv[bj][n] * acc[ai][bj][m][n]; }
                if (m & 1) asm volatile("" ::: "memory"); }
    }
};

struct EpiResB {
    static constexpr bool PERM = false;
    const float* xlat; const float* modl; bf16_t* o;
    __device__ __forceinline__ void operator()(const f32x4 (&acc)[2][2][4][2], const Unit& u, int wr, int wc, int fr, int fq) const {
        const int b = u.pm / PPB, pb = u.pm % PPB;
        const size_t r0 = (size_t)b * S + 256 * pb;
        const float* src = xlat + r0 * D; bf16_t* dst = o + r0 * D;
        const float* gt = modl + (size_t)b * 12288 + 2 * D;
        const int rowl0 = wr * 64 + fr, col0 = u.pn * 256 + wc * 32 + 4 * fq;
        f32x4 gv[2][2];
#pragma unroll
        for (int bj = 0; bj < 2; ++bj)
#pragma unroll
            for (int n = 0; n < 2; ++n) gv[bj][n] = *(const f32x4*)(gt + col0 + bj * 128 + n * 16);
#pragma unroll
        for (int ai = 0; ai < 2; ++ai)
#pragma unroll
            for (int m = 0; m < 4; ++m) { const size_t off = (size_t)(ai * 128 + rowl0 + 16 * m) * D + col0;
#pragma unroll
                for (int bj = 0; bj < 2; ++bj)
#pragma unroll
                    for (int n = 0; n < 2; ++n) { const f32x4 xs = *(const f32x4*)(src + off + bj * 128 + n * 16); const f32x4 h = xs + gv[bj][n] * acc[ai][bj][m][n];
                        u32x2 w; w.x = cvt_pk_bf16(h.x, h.y); w.y = cvt_pk_bf16(h.z, h.w); *(u32x2*)(dst + off + bj * 128 + n * 16) = w; }
                if (m & 1) asm volatile("" ::: "memory"); }
    }
};

#ifndef ATT_PP_PRIO
#define ATT_PP_PRIO 3
#endif
#ifndef ATT_PP_PVPIPE
#define ATT_PP_PVPIPE 0
#endif
#ifndef ATT_PP_PVFIRST
#define ATT_PP_PVFIRST 0
#endif
#ifndef ATT_PP_SPLITSM
#define ATT_PP_SPLITSM 0
#endif
#ifndef ATT_PP_DMAS_A
#define ATT_PP_DMAS_A 1
#endif
#ifndef ATT_PP_DMAS_B
#define ATT_PP_DMAS_B 0
#endif
#ifndef ATT_PP_KPIPE
#define ATT_PP_KPIPE 1
#endif
#ifndef ATT_PP_VPIPE
#define ATT_PP_VPIPE 0
#endif
#ifndef ATT_PP_PVS
#define ATT_PP_PVS 0
#endif
#ifndef ATT_PP_DMAHI
#define ATT_PP_DMAHI 1
#endif
#ifndef ATT_PP_DMAMID
#define ATT_PP_DMAMID 0
#endif
#ifndef ATT_PP_DMAHOOK
#define ATT_PP_DMAHOOK 0
#endif
#ifndef ATT_PP_KDEPTH_B
#define ATT_PP_KDEPTH_B 4
#endif
#ifndef ATT_PP_KDEPTH
#define ATT_PP_KDEPTH 4
#endif
#ifndef ATT_PP_RAWBAR
#define ATT_PP_RAWBAR 0
#endif
#ifndef ATT_PP_PRIO_S
#define ATT_PP_PRIO_S 0
#endif
#ifndef ATT_PVSM_A
#define ATT_PVSM_A 0
#endif
#ifndef ATT_PVSM_B
#define ATT_PVSM_B 0
#endif
#ifndef ATT_PRIO
#define ATT_PRIO 0
#endif
namespace att {
using bf16 = unsigned short;
constexpr int   D = 128, NW = 8, QBLK = 32, KVBLK = 64;
constexpr float THR = 8.f;
constexpr size_t SHM_V = KVBLK * D * 2;
#define KSWZ(row, colB) ((row) * 256 + ((colB) ^ (((row) & 7) << 4)))
#define SBAR() __builtin_amdgcn_sched_barrier(0)
#define PIN(x) asm volatile("" : "+v"(x))
__device__ __forceinline__ int crow(int r, int hi) { return (r & 3) + 8 * (r >> 2) + 4 * hi; }
__device__ __forceinline__ unsigned cvtpk(float lo, float hi) {
  unsigned r; asm volatile("v_cvt_pk_bf16_f32 %0, %1, %2" : "=v"(r) : "v"(lo), "v"(hi)); return r;
}
template <typename TIn> struct Stage;
template <> struct Stage<bf16>  { using T = bf16x8;
  __device__ static __forceinline__ T ld8(const bf16* p) { return *reinterpret_cast<const bf16x8*>(p); }
  __device__ static __forceinline__ bf16x8 tobf(T x) { return x; } };
template <> struct Stage<float> { using T = f32x8;
  __device__ static __forceinline__ T ld8(const float* p) { return *reinterpret_cast<const f32x8*>(p); }
  __device__ static __forceinline__ bf16x8 tobf(T x) {
    u32x4 w = {cvtpk(x[0], x[1]), cvtpk(x[2], x[3]), cvtpk(x[4], x[5]), cvtpk(x[6], x[7])}; return *reinterpret_cast<bf16x8*>(&w); } };

template <int DQK> __device__ __forceinline__ void partialSM(f32x16& p0, f32x16& p1, float& m_reg, float& mn, float& alpha) {
  constexpr float SCALE = DQK == 128 ? 0.088388347648318440f : 0.072168783648703220f;
  constexpr float C = SCALE * 1.4426950408889634f;
  float pmax = p0[0]; for (int r = 1; r < 16; ++r) pmax = fmaxf(pmax, p0[r]); for (int r = 0; r < 16; ++r) pmax = fmaxf(pmax, p1[r]);
  { auto rr = __builtin_amdgcn_permlane32_swap(__float_as_uint(pmax), __float_as_uint(pmax), false, false);
    pmax = fmaxf(__uint_as_float(rr[0]), __uint_as_float(rr[1])); }
  if (__builtin_expect(__all(pmax - m_reg <= THR / SCALE), 1)) { mn = m_reg; alpha = 1.f; }
  else { mn = fmaxf(m_reg, pmax); alpha = __builtin_amdgcn_exp2f((m_reg - mn) * C); m_reg = mn; }
  float mnC = -mn * C;
  for (int r = 0; r < 16; ++r) p0[r] = fmaf(p0[r], C, mnC); for (int r = 0; r < 16; ++r) p1[r] = fmaf(p1[r], C, mnC);
  for (int r = 0; r < 16; ++r) p0[r] = __builtin_amdgcn_exp2f(p0[r]);
}
__device__ __forceinline__ void finishSM(f32x16& p0, f32x16& p1, float alpha, float& l_reg, bf16x8& pa0, bf16x8& pa1, bf16x8& pa2, bf16x8& pa3) {
  for (int r = 0; r < 16; ++r) p1[r] = __builtin_amdgcn_exp2f(p1[r]);
  float ps = 0; for (int r = 0; r < 16; ++r) ps += p0[r]; for (int r = 0; r < 16; ++r) ps += p1[r];
  { auto rr = __builtin_amdgcn_permlane32_swap(__float_as_uint(ps), __float_as_uint(ps), false, false);
    ps = __uint_as_float(rr[0]) + __uint_as_float(rr[1]); }
  l_reg = l_reg * alpha + ps;
#define PK4(P, BASE, OUT) do { unsigned a0 = cvtpk(P[BASE + 0], P[BASE + 1]), a1 = cvtpk(P[BASE + 2], P[BASE + 3]);   \
    unsigned b0 = cvtpk(P[BASE + 4], P[BASE + 5]), b1 = cvtpk(P[BASE + 6], P[BASE + 7]);                              \
    auto r0 = __builtin_amdgcn_permlane32_swap(a0, b0, false, false); auto r1 = __builtin_amdgcn_permlane32_swap(a1, b1, false, false); \
    u32x4 w = {r0[0], r1[0], r0[1], r1[1]}; OUT = *reinterpret_cast<bf16x8*>(&w); } while (0)
  PK4(p0, 0, pa0); PK4(p0, 8, pa1); PK4(p1, 0, pa2); PK4(p1, 8, pa3);
#undef PK4
}
__device__ __forceinline__ void fin_nop(f32x16& p0, f32x16& p1, bf16x8& pa0, bf16x8& pa1, bf16x8& pa2, bf16x8& pa3) {
#define PK4(P, BASE, OUT) do { unsigned a0 = cvtpk(P[BASE + 0], P[BASE + 1]), a1 = cvtpk(P[BASE + 2], P[BASE + 3]);   \
    unsigned b0 = cvtpk(P[BASE + 4], P[BASE + 5]), b1 = cvtpk(P[BASE + 6], P[BASE + 7]);                              \
    auto r0 = __builtin_amdgcn_permlane32_swap(a0, b0, false, false); auto r1 = __builtin_amdgcn_permlane32_swap(a1, b1, false, false); \
    u32x4 w = {r0[0], r1[0], r0[1], r1[1]}; OUT = *reinterpret_cast<bf16x8*>(&w); } while (0)
  PK4(p0, 0, pa0); PK4(p0, 8, pa1); PK4(p1, 0, pa2); PK4(p1, 8, pa3);
#undef PK4
}
#ifndef ATT_KSW15
#define ATT_KSW15 1
#endif
#define KSWZK(row, KP) (ATT_KSW15 ? ((KP) == 256 ? ((row) & 15) : (((row) >> 1) & 7)) : ((row) & 7))
#define KSWZP(row, colB, KP) ((row) * (KP) + ((colB) ^ (KSWZK(row, KP) << 4)))
template <int DQK, int NQR, int NL = 0> __device__ __forceinline__ void qkt(f32x16& p0, f32x16& p1, const bf16* Ks, const bf16x8* qr, int r32, int hi, const char* qx) {
  if constexpr (NL != 0) { p0 = f32x16{}; p1 = f32x16{};
    for (int d0 = 0; d0 < DQK / 16; ++d0) { const bf16x8 kv = qr[d0 % (NQR > 1 ? NQR : 1)], qv = qr[(d0 + 1) % (NQR > 1 ? NQR : 1)];
      p0 = __builtin_amdgcn_mfma_f32_32x32x16_bf16(kv, qv, p0, 0, 0, 0); p1 = __builtin_amdgcn_mfma_f32_32x32x16_bf16(qv, kv, p1, 0, 0, 0); } return; }
  p0 = f32x16{}; p1 = f32x16{};
  for (int d0 = NQR; d0 < DQK / 16; ++d0) { int cb = (d0 * 16 + hi * 8) * 2;
    bf16x8 qv = *reinterpret_cast<const bf16x8*>(qx + (d0 - NQR) * 1024);
    bf16x8 b0 = *reinterpret_cast<const bf16x8*>((const char*)Ks + KSWZP(r32, cb, DQK * 2));
    bf16x8 b1 = *reinterpret_cast<const bf16x8*>((const char*)Ks + KSWZP(32 + r32, cb, DQK * 2));
    p0 = __builtin_amdgcn_mfma_f32_32x32x16_bf16(b0, qv, p0, 0, 0, 0);
    p1 = __builtin_amdgcn_mfma_f32_32x32x16_bf16(b1, qv, p1, 0, 0, 0); }
  for (int d0 = 0; d0 < NQR; ++d0) { int cb = (d0 * 16 + hi * 8) * 2;
    bf16x8 b0 = *reinterpret_cast<const bf16x8*>((const char*)Ks + KSWZP(r32, cb, DQK * 2));
    bf16x8 b1 = *reinterpret_cast<const bf16x8*>((const char*)Ks + KSWZP(32 + r32, cb, DQK * 2));
    p0 = __builtin_amdgcn_mfma_f32_32x32x16_bf16(b0, qr[d0], p0, 0, 0, 0);
    p1 = __builtin_amdgcn_mfma_f32_32x32x16_bf16(b1, qr[d0], p1, 0, 0, 0); }
}
__device__ __forceinline__ int v_st(int k, int c) { const int kk = (k & ~0xC) | ((k & 4) << 1) | ((k & 8) >> 1); return ((kk >> 3) * 4 + (c >> 5)) * 512 + ((kk & 7) * 32 + (c & 31)) * 2; }
__device__ __forceinline__ int v_rd_base(int lane) { return ((lane & 3) << 3) | (((lane >> 2) & 3) << 6) | (((lane >> 4) & 1) << 5) | (((lane >> 5) & 1) << 8); }
constexpr int v_rd_off(int d0, int ks, int half) { return d0 * 512 + ks * 4096 + half * 2048; }
template <int OFF> __device__ __forceinline__ s16x4 tr_read(int vb) {
  s16x4 r; asm volatile("ds_read_b64_tr_b16 %0, %1 offset:%2" : "=&v"(r) : "v"(vb), "i"(OFF) : "memory"); return r;
}
template <int D0> __device__ __forceinline__ void pv_one(f32x16& od, int vb, bf16x8 pa0, bf16x8 pa1, bf16x8 pa2, bf16x8 pa3) {
  const s16x4 l0 = tr_read<v_rd_off(D0, 0, 0)>(vb), h0 = tr_read<v_rd_off(D0, 0, 1)>(vb), l1 = tr_read<v_rd_off(D0, 1, 0)>(vb), h1 = tr_read<v_rd_off(D0, 1, 1)>(vb);
  const s16x4 l2 = tr_read<v_rd_off(D0, 2, 0)>(vb), h2 = tr_read<v_rd_off(D0, 2, 1)>(vb), l3 = tr_read<v_rd_off(D0, 3, 0)>(vb), h3 = tr_read<v_rd_off(D0, 3, 1)>(vb);
  asm volatile("s_waitcnt lgkmcnt(0)" ::: "memory"); SBAR();
#define PK(L, H) (bf16x8){L[0], L[1], L[2], L[3], H[0], H[1], H[2], H[3]}
#if ATT_PRIO
  __builtin_amdgcn_s_setprio(1);
#endif
  od = __builtin_amdgcn_mfma_f32_32x32x16_bf16(pa0, PK(l0, h0), od, 0, 0, 0);
  od = __builtin_amdgcn_mfma_f32_32x32x16_bf16(pa1, PK(l1, h1), od, 0, 0, 0);
  od = __builtin_amdgcn_mfma_f32_32x32x16_bf16(pa2, PK(l2, h2), od, 0, 0, 0);
  od = __builtin_amdgcn_mfma_f32_32x32x16_bf16(pa3, PK(l3, h3), od, 0, 0, 0);
#if ATT_PRIO
  __builtin_amdgcn_s_setprio(0);
#endif
#undef PK
}
__device__ __forceinline__ void pv_d0_nl(f32x16* o, bf16x8 pa0, bf16x8 pa1, bf16x8 pa2, bf16x8 pa3) {
  for (int d = 0; d < 4; ++d) { o[d] = __builtin_amdgcn_mfma_f32_32x32x16_bf16(pa0, pa1, o[d], 0, 0, 0); o[d] = __builtin_amdgcn_mfma_f32_32x32x16_bf16(pa1, pa2, o[d], 0, 0, 0);
    o[d] = __builtin_amdgcn_mfma_f32_32x32x16_bf16(pa2, pa3, o[d], 0, 0, 0); o[d] = __builtin_amdgcn_mfma_f32_32x32x16_bf16(pa3, pa0, o[d], 0, 0, 0); } }
__device__ __forceinline__ void pv_d0(f32x16* o, int vb, bf16x8 pa0, bf16x8 pa1, bf16x8 pa2, bf16x8 pa3) {
  pv_one<0>(o[0], vb, pa0, pa1, pa2, pa3); pv_one<1>(o[1], vb, pa0, pa1, pa2, pa3); pv_one<2>(o[2], vb, pa0, pa1, pa2, pa3); pv_one<3>(o[3], vb, pa0, pa1, pa2, pa3);
}

struct VFrag { s16x4 l0, h0, l1, h1, l2, h2, l3, h3; };
template <int D0> __device__ __forceinline__ void pv_rd(VFrag& f, int vb) {
  f.l0 = tr_read<v_rd_off(D0, 0, 0)>(vb); f.h0 = tr_read<v_rd_off(D0, 0, 1)>(vb); f.l1 = tr_read<v_rd_off(D0, 1, 0)>(vb); f.h1 = tr_read<v_rd_off(D0, 1, 1)>(vb);
  f.l2 = tr_read<v_rd_off(D0, 2, 0)>(vb); f.h2 = tr_read<v_rd_off(D0, 2, 1)>(vb); f.l3 = tr_read<v_rd_off(D0, 3, 0)>(vb); f.h3 = tr_read<v_rd_off(D0, 3, 1)>(vb);
}
__device__ __forceinline__ void pv_mm(f32x16& od, const VFrag& f, bf16x8 pa0, bf16x8 pa1, bf16x8 pa2, bf16x8 pa3) {
#define PK(L, H) (bf16x8){L[0], L[1], L[2], L[3], H[0], H[1], H[2], H[3]}
  od = __builtin_amdgcn_mfma_f32_32x32x16_bf16(pa0, PK(f.l0, f.h0), od, 0, 0, 0);
  od = __builtin_amdgcn_mfma_f32_32x32x16_bf16(pa1, PK(f.l1, f.h1), od, 0, 0, 0);
  od = __builtin_amdgcn_mfma_f32_32x32x16_bf16(pa2, PK(f.l2, f.h2), od, 0, 0, 0);
  od = __builtin_amdgcn_mfma_f32_32x32x16_bf16(pa3, PK(f.l3, f.h3), od, 0, 0, 0);
#undef PK
}
template <int N> __device__ __forceinline__ void lgk_wait() { asm volatile("s_waitcnt lgkmcnt(%0)" :: "i"(N) : "memory"); }
struct NoHook { __device__ __forceinline__ void operator()() const {} };
template <int DQK, int VPRE = 0, typename HOOK = NoHook> __device__ __forceinline__ void qkt_pipe(f32x16& p0, f32x16& p1, int kb, int y, int hi, const bf16x8* qr, VFrag* vf0 = nullptr, int vb = 0, HOOK hook = HOOK()) {
  constexpr int ND = DQK / 16, KP = DQK * 2, DEPTH = DQK == 192 ? ATT_PP_KDEPTH_B : ATT_PP_KDEPTH;
  bf16x8 b0[ND], b1[ND];
  p0 = f32x16{}; p1 = f32x16{};
#define KRD_(d) do { const int ad_ = kb + ((((d) * 32) + hi * 16) ^ y); asm volatile("ds_read_b128 %0, %1" : "=v"(b0[d]) : "v"(ad_) : "memory"); \
    asm volatile("ds_read_b128 %0, %1 offset:%2" : "=v"(b1[d]) : "v"(ad_), "i"(32 * KP) : "memory"); } while (0)
#pragma unroll
  for (int d = 0; d < DEPTH; ++d) KRD_(d);
  hook();
#pragma unroll
  for (int d = 0; d < ND; ++d) {
    constexpr int dummy = 0; (void)dummy;
    const int young = (d + DEPTH - 1 < ND - 1 ? d + DEPTH - 1 : ND - 1) - d;
    const bool vfly = VPRE != 0 && d + DEPTH > ND;
    if (!vfly) { if (young >= 7) lgk_wait<14>(); else if (young == 6) lgk_wait<12>(); else if (young == 5) lgk_wait<10>(); else if (young == 4) lgk_wait<8>(); else if (young == 3) lgk_wait<6>(); else if (young == 2) lgk_wait<4>(); else if (young == 1) lgk_wait<2>(); else lgk_wait<0>(); }
    else { if (young >= 3) lgk_wait<14>(); else if (young == 2) lgk_wait<12>(); else if (young == 1) lgk_wait<10>(); else lgk_wait<8>(); }
    SBAR();
    p0 = __builtin_amdgcn_mfma_f32_32x32x16_bf16(b0[d], qr[d], p0, 0, 0, 0);
    p1 = __builtin_amdgcn_mfma_f32_32x32x16_bf16(b1[d], qr[d], p1, 0, 0, 0);
    if (d + DEPTH < ND) KRD_(d + DEPTH);
    if (VPRE != 0 && d + DEPTH == ND) pv_rd<0>(*vf0, vb);
  }
#undef KRD_
}
#define PVWAIT() do { asm volatile("s_waitcnt lgkmcnt(0)" ::: "memory"); SBAR(); } while (0)
__device__ __forceinline__ void pv_cont(f32x16* o, int vb, VFrag& fa, bf16x8 pa0, bf16x8 pa1, bf16x8 pa2, bf16x8 pa3) {
  VFrag fb;
  pv_rd<1>(fb, vb); lgk_wait<8>(); SBAR(); pv_mm(o[0], fa, pa0, pa1, pa2, pa3);
  pv_rd<2>(fa, vb); lgk_wait<8>(); SBAR(); pv_mm(o[1], fb, pa0, pa1, pa2, pa3);
  pv_rd<3>(fb, vb); lgk_wait<8>(); SBAR(); pv_mm(o[2], fa, pa0, pa1, pa2, pa3);
  lgk_wait<0>(); SBAR(); pv_mm(o[3], fb, pa0, pa1, pa2, pa3); SBAR();
}
template <int DQK> __device__ __forceinline__ void pv_sm(f32x16* o, int vb, bf16x8 pa0, bf16x8 pa1, bf16x8 pa2, bf16x8 pa3, f32x16& p0, f32x16& p1, float& m_reg, float& mn, float& alpha) {
  constexpr float SCALE = DQK == 128 ? 0.088388347648318440f : 0.072168783648703220f;
  constexpr float C = SCALE * 1.4426950408889634f;
  VFrag f;
  pv_rd<0>(f, vb); PVWAIT();
  pv_mm(o[0], f, pa0, pa1, pa2, pa3); pv_rd<1>(f, vb);
  float pmax = p0[0]; for (int r = 1; r < 16; ++r) pmax = fmaxf(pmax, p0[r]); for (int r = 0; r < 16; ++r) pmax = fmaxf(pmax, p1[r]);
  { auto rr = __builtin_amdgcn_permlane32_swap(__float_as_uint(pmax), __float_as_uint(pmax), false, false);
    pmax = fmaxf(__uint_as_float(rr[0]), __uint_as_float(rr[1])); }
  if (__builtin_expect(__all(pmax - m_reg <= THR / SCALE), 1)) { mn = m_reg; alpha = 1.f; }
  else { mn = fmaxf(m_reg, pmax); alpha = __builtin_amdgcn_exp2f((m_reg - mn) * C); m_reg = mn; }
  float mnC = -mn * C; PIN(mnC); PIN(alpha);
  PVWAIT();
  pv_mm(o[1], f, pa0, pa1, pa2, pa3); pv_rd<2>(f, vb);
  { const f32x2 CC = {C, C}, MM = {mnC, mnC};
    for (int r = 0; r < 8; ++r) { f32x2 t = {p0[2 * r], p0[2 * r + 1]}; t = t * CC + MM; PIN(t); p0[2 * r] = t[0]; p0[2 * r + 1] = t[1]; }
    for (int r = 0; r < 8; ++r) { f32x2 t = {p1[2 * r], p1[2 * r + 1]}; t = t * CC + MM; PIN(t); p1[2 * r] = t[0]; p1[2 * r + 1] = t[1]; } }
  PVWAIT();
  pv_mm(o[2], f, pa0, pa1, pa2, pa3); pv_rd<3>(f, vb);
  for (int r = 0; r < 8; ++r) { float t = __builtin_amdgcn_exp2f(p0[r]); PIN(t); p0[r] = t; }
  PVWAIT();
  pv_mm(o[3], f, pa0, pa1, pa2, pa3);
  for (int r = 8; r < 16; ++r) { float t = __builtin_amdgcn_exp2f(p0[r]); PIN(t); p0[r] = t; }
  SBAR();
}

template <typename TQ, int LDQ, int LDK, int LDO, int DQK, int LDK2, int SDEPTH, int NQR, int PRB = 0>
__device__ __forceinline__ void attn_dense_body(const TQ* __restrict__ Qb, const bf16* __restrict__ Kh, const bf16* __restrict__ K2h, const bf16* __restrict__ Vh,
                                                bf16* __restrict__ Ob, const bf16* __restrict__ Gb, int seq, char* lds) {
  constexpr size_t SHM_K = 64 * DQK * 2; constexpr bool X = DQK == 192; constexpr bool PVSM = X ? (ATT_PVSM_B != 0) : (ATT_PVSM_A != 0);
  using St = Stage<bf16>; using SQ = Stage<TQ>;
  int tid_o = threadIdx.x; asm volatile("" : "+v"(tid_o));
  const int tid = tid_o, wid = __builtin_amdgcn_readfirstlane(tid >> 6), lane = tid & 63, r32 = lane & 31, hi = lane >> 5;
  bf16* V_lds = (bf16*)lds; bf16* K_lds = (bf16*)(lds + 2 * SHM_V);
  float* ws = (float*)(lds + 2 * SHM_V + 2 * SHM_K) + wid * 64; float* li_l = ws; float* al_l = ws + 32;
  float m_reg = -1e30f, l_reg = 0; f32x16 o[4] = {}; bf16x8 qr[NQR]; char* qx = lds + 2 * SHM_V + 2 * SHM_K + 2048 + wid * ((DQK / 16 - NQR) * 1024) + lane * 16;
  const TQ* Qw = Qb + (long)(wid * QBLK + r32) * LDQ + hi * 8;
#pragma unroll
  for (int d0 = 0; d0 < NQR; ++d0) qr[d0] = SQ::tobf(SQ::ld8(Qw + d0 * 16));
#pragma unroll
  for (int d0 = NQR; d0 < DQK / 16; ++d0) *reinterpret_cast<bf16x8*>(qx + (d0 - NQR) * 1024) = SQ::tobf(SQ::ld8(Qw + d0 * 16));
  const int sr = tid >> 4, sc = (tid & 15) * 8, vst0 = v_st(sr, sc), vst1 = v_st(32 + sr, sc);
  const int vb0 = (int)(uintptr_t)V_lds + v_rd_base(lane);
  const int sr2 = tid >> 3, sc2 = (tid & 7) * 8;
  struct { typename St::T vs0, vs1, ks0, ks1, ks2; } sr_[SDEPTH];
  constexpr int LDKP = (PRB & 32) ? 128 : LDK;
  const unsigned voff = (unsigned)(sr * LDKP + sc) * 2u, k2off = (unsigned)(sr2 * LDK2 + sc2) * 2u;
#define SLOAD(i, k0) do { const char* vb_ = (const char*)Vh + (size_t)(k0) * (LDKP * 2) + ((PRB & 32) ? (size_t)(k0) * 256 : 0); const char* kb_ = (const char*)Kh + (size_t)(k0) * (LDKP * 2); \
    sr_[i].vs0 = *(const bf16x8*)(vb_ + voff); sr_[i].vs1 = *(const bf16x8*)(vb_ + 32 * LDKP * 2 + voff); \
    sr_[i].ks0 = *(const bf16x8*)(kb_ + voff); sr_[i].ks1 = *(const bf16x8*)(kb_ + 32 * LDKP * 2 + voff); \
    if constexpr (X) sr_[i].ks2 = *(const bf16x8*)((const char*)K2h + (size_t)(k0) * (LDK2 * 2) + k2off); } while (0)
#define SWRITE(b, i) do { *(bf16x8*)((char*)V_lds + (b) * SHM_V + vst0) = St::tobf(sr_[i].vs0);          \
    *(bf16x8*)((char*)V_lds + (b) * SHM_V + vst1) = St::tobf(sr_[i].vs1); int kc = sc * 2;               \
    *(bf16x8*)((char*)K_lds + (b) * SHM_K + KSWZP(sr, kc, DQK * 2)) = St::tobf(sr_[i].ks0);                       \
    *(bf16x8*)((char*)K_lds + (b) * SHM_K + KSWZP(32 + sr, kc, DQK * 2)) = St::tobf(sr_[i].ks1); \
    if constexpr (X) *(bf16x8*)((char*)K_lds + (b) * SHM_K + KSWZP(sr2, 256 + sc2 * 2, DQK * 2)) = St::tobf(sr_[i].ks2); } while (0)
#define SWAIT() do { if constexpr (SDEPTH == 2) { if constexpr (X) asm volatile("s_waitcnt vmcnt(5)" ::: "memory"); else asm volatile("s_waitcnt vmcnt(4)" ::: "memory"); } else asm volatile("s_waitcnt vmcnt(0)" ::: "memory"); } while (0)
#define RESC(a) do { if (__any((a) < 1.f)) { if (hi == 0) al_l[r32] = (a); asm volatile("s_waitcnt lgkmcnt(0)" ::: "memory"); \
    for (int d = 0; d < 4; ++d) for (int r = 0; r < 16; ++r) o[d][r] *= al_l[crow(r, hi)]; } } while (0)
#define QKT_(P0, P1, KS) do { if constexpr ((PRB & 8) != 0) { P0 = f32x16{}; P1 = f32x16{}; for (int r_ = 0; r_ < 16; ++r_) { float t0_ = P0[r_], t1_ = P1[r_]; PIN(t0_); PIN(t1_); P0[r_] = t0_; P1[r_] = t1_; } } \
    else qkt<DQK, NQR, (PRB & 64)>(P0, P1, KS, qr, r32, hi, qx); } while (0)
#define FIN_(P0, P1, AL) do { if constexpr ((PRB & 1) != 0) fin_nop(P0, P1, pa0, pa1, pa2, pa3); else finishSM(P0, P1, AL, l_reg, pa0, pa1, pa2, pa3); } while (0)
#define PVS_(VB, P0, P1, MN, AL) do { \
    if constexpr ((PRB & 4) != 0) { if constexpr ((PRB & 1) != 0) { MN = 0.f; AL = 1.f; } else partialSM<DQK>(P0, P1, m_reg, MN, AL); } \
    else if constexpr ((PRB & 64) != 0) { pv_d0_nl(o, pa0, pa1, pa2, pa3); partialSM<DQK>(P0, P1, m_reg, MN, AL); } \
    else if constexpr ((PRB & 1) != 0) { pv_d0(o, VB, pa0, pa1, pa2, pa3); MN = 0.f; AL = 1.f; } \
    else if constexpr (PVSM) pv_sm<DQK>(o, VB, pa0, pa1, pa2, pa3, P0, P1, m_reg, MN, AL); \
    else { pv_d0(o, VB, pa0, pa1, pa2, pa3); partialSM<DQK>(P0, P1, m_reg, MN, AL); } } while (0)
#define WGB_() do { if constexpr ((PRB & 2) == 0) __syncthreads(); } while (0)
#define SLD_(i, k0) do { if constexpr ((PRB & 16) == 0) SLOAD(i, k0); } while (0)
#define SWR_(bb, i) do { if constexpr ((PRB & 16) == 0) { SWAIT(); SWRITE(bb, i); } } while (0)
  f32x16 pA0, pA1, pB0, pB1; float mnA, mnB, alA, alB; bf16x8 pa0, pa1, pa2, pa3; const int NT = seq / KVBLK;
  constexpr int SE = 0, SO = SDEPTH - 1;
  SLOAD(SE, 0); asm volatile("s_waitcnt vmcnt(0)" ::: "memory"); SWRITE(0, SE); __syncthreads();
  qkt<DQK, NQR>(pA0, pA1, K_lds, qr, r32, hi, qx); partialSM<DQK>(pA0, pA1, m_reg, mnA, alA);
  SLOAD(SO, KVBLK); if constexpr (SDEPTH == 2) { if (2 < NT) SLOAD(SE, 2 * KVBLK); }
  SWAIT(); SWRITE(1, SO); __syncthreads();
  for (int j = 1; j + 1 < NT; j += 2) {
    SBAR(); QKT_(pB0, pB1, (bf16*)((char*)K_lds + SHM_K));
    FIN_(pA0, pA1, alA); SBAR();
    SLD_(SO, (j + SDEPTH) * KVBLK); SBAR();
    PVS_(vb0, pB0, pB1, mnB, alB);
    WGB_(); SWR_(0, SE);
    RESC(alB); WGB_();
    SBAR(); QKT_(pA0, pA1, K_lds);
    FIN_(pB0, pB1, alB); SBAR();
    if (SDEPTH == 1 || j + 3 < NT) SLD_(SE, (j + 1 + SDEPTH) * KVBLK); SBAR();
    PVS_(vb0 + (int)SHM_V, pA0, pA1, mnA, alA);
    WGB_(); SWR_(1, SO);
    RESC(alA); WGB_();
  }
  SBAR(); qkt<DQK, NQR>(pB0, pB1, (bf16*)((char*)K_lds + SHM_K), qr, r32, hi, qx);
  finishSM(pA0, pA1, alA, l_reg, pa0, pa1, pa2, pa3); SBAR();
  if constexpr (PVSM) pv_sm<DQK>(o, vb0, pa0, pa1, pa2, pa3, pB0, pB1, m_reg, mnB, alB); else { pv_d0(o, vb0, pa0, pa1, pa2, pa3); partialSM<DQK>(pB0, pB1, m_reg, mnB, alB); }
  __syncthreads(); RESC(alB);
  finishSM(pB0, pB1, alB, l_reg, pa0, pa1, pa2, pa3); SBAR();
  pv_d0(o, vb0 + (int)SHM_V, pa0, pa1, pa2, pa3);
  if (hi == 0) li_l[r32] = l_reg; asm volatile("s_waitcnt lgkmcnt(0)" ::: "memory");
  float rli[16];
#pragma unroll
  for (int r = 0; r < 16; ++r) rli[r] = __builtin_amdgcn_rcpf(li_l[crow(r, hi)]);
  __syncthreads();
  {
    char* ep = lds + wid * 8704;
    int lane_e = hi * 4 * 272 + r32 * 2; asm volatile("" : "+v"(lane_e));
#pragma unroll
    for (int r = 0; r < 16; ++r) { const int ro = ((r & 3) + 8 * (r >> 2)) * 272;
#pragma unroll
      for (int d0 = 0; d0 < 4; ++d0) *(unsigned short*)(ep + lane_e + ro + d0 * 64) = (unsigned short)(cvtpk(o[d0][r] * rli[r], 0.f) & 0xffffu); }
    asm volatile("s_waitcnt lgkmcnt(0)" ::: "memory");
    int lane_q = lane; asm volatile("" : "+v"(lane_q));
    const int row0 = lane_q >> 4, ch = lane_q & 15;
    unsigned short* Yw = Ob + (long)(wid * QBLK + row0) * LDO + ch * 8; const unsigned short* Gw = Gb + (long)(wid * QBLK + row0) * LDO + ch * 8;
#pragma unroll
    for (int hf = 0; hf < 2; ++hf) { u32x4 gv[4], ov[4];
#pragma unroll
      for (int i = 0; i < 4; ++i) gv[i] = *(const u32x4*)(Gw + (long)(4 * (4 * hf + i)) * LDO);
#pragma unroll
      for (int i = 0; i < 4; ++i) ov[i] = *(const u32x4*)(ep + (row0 + 4 * (4 * hf + i)) * 272 + ch * 16);
#pragma unroll
      for (int i = 0; i < 4; ++i) { u32x4 w;
#pragma unroll
        for (int j = 0; j < 4; ++j) { const float lo = __uint_as_float(ov[i][j] << 16) * __uint_as_float(gv[i][j] << 16), hi2 = __uint_as_float(ov[i][j] & 0xffff0000u) * __uint_as_float(gv[i][j] & 0xffff0000u); w[j] = cvtpk(lo, hi2); }
        *(u32x4*)(Yw + (long)(4 * (4 * hf + i)) * LDO) = w; }
      asm volatile("" ::: "memory"); }
  }
  __syncthreads();
#undef SLOAD
#undef SWRITE
#undef SWAIT
#undef RESC
#undef QKT_
#undef FIN_
#undef PVS_
#undef WGB_
#undef SLD_
#undef SWR_
}

template <typename TQ, int LDQ, int LDK, int LDO, int DQK, int LDK2, int SDEPTH, int NQR>
__device__ __forceinline__ void attn_dense_body3(const TQ* __restrict__ Qb, const bf16* __restrict__ Kh, const bf16* __restrict__ K2h, const bf16* __restrict__ Vh,
                                                bf16* __restrict__ Ob, const bf16* __restrict__ Gb, int seq, char* lds) {
  constexpr size_t SHM_K = 64 * DQK * 2; constexpr bool X = DQK == 192;
  using St = Stage<bf16>; using SQ = Stage<TQ>;
  int tid_o = threadIdx.x; asm volatile("" : "+v"(tid_o));
  const int tid = tid_o, wid = __builtin_amdgcn_readfirstlane(tid >> 6), lane = tid & 63, r32 = lane & 31, hi = lane >> 5;
  bf16* V_lds = (bf16*)lds; bf16* K_lds = (bf16*)(lds + 3 * SHM_V);
  float* ws = (float*)(lds + 3 * SHM_V + 3 * SHM_K) + wid * 64; float* li_l = ws; float* al_l = ws + 32;
  float m_reg = -1e30f, l_reg = 0; f32x16 o[4] = {}; bf16x8 qr[NQR]; char* qx = lds + 3 * SHM_V + 3 * SHM_K + 2048 + wid * ((DQK / 16 - NQR) * 1024) + lane * 16;
  const TQ* Qw = Qb + (long)(wid * QBLK + r32) * LDQ + hi * 8;
#pragma unroll
  for (int d0 = 0; d0 < NQR; ++d0) qr[d0] = SQ::tobf(SQ::ld8(Qw + d0 * 16));
#pragma unroll
  for (int d0 = NQR; d0 < DQK / 16; ++d0) *reinterpret_cast<bf16x8*>(qx + (d0 - NQR) * 1024) = SQ::tobf(SQ::ld8(Qw + d0 * 16));
  const int sr = tid >> 4, sc = (tid & 15) * 8, vst0 = v_st(sr, sc), vst1 = v_st(32 + sr, sc);
  const int vb0 = (int)(uintptr_t)V_lds + v_rd_base(lane);
  const int sr2 = tid >> 3, sc2 = (tid & 7) * 8;
  struct { typename St::T vs0, vs1, ks0, ks1, ks2; } sr_[SDEPTH];
  const unsigned voff = (unsigned)(sr * LDK + sc) * 2u, k2off = (unsigned)(sr2 * LDK2 + sc2) * 2u;
#define SLOAD(i, k0) do { const char* vb_ = (const char*)Vh + (size_t)(k0) * (LDK * 2); const char* kb_ = (const char*)Kh + (size_t)(k0) * (LDK * 2); \
    sr_[i].vs0 = *(const bf16x8*)(vb_ + voff); sr_[i].vs1 = *(const bf16x8*)(vb_ + 32 * LDK * 2 + voff); \
    sr_[i].ks0 = *(const bf16x8*)(kb_ + voff); sr_[i].ks1 = *(const bf16x8*)(kb_ + 32 * LDK * 2 + voff); \
    if constexpr (X) sr_[i].ks2 = *(const bf16x8*)((const char*)K2h + (size_t)(k0) * (LDK2 * 2) + k2off); } while (0)
#define SWRITE(b, i) do { *(bf16x8*)((char*)V_lds + (b) * SHM_V + vst0) = St::tobf(sr_[i].vs0);          \
    *(bf16x8*)((char*)V_lds + (b) * SHM_V + vst1) = St::tobf(sr_[i].vs1); int kc = sc * 2;               \
    *(bf16x8*)((char*)K_lds + (b) * SHM_K + KSWZP(sr, kc, DQK * 2)) = St::tobf(sr_[i].ks0);                       \
    *(bf16x8*)((char*)K_lds + (b) * SHM_K + KSWZP(32 + sr, kc, DQK * 2)) = St::tobf(sr_[i].ks1); \
    if constexpr (X) *(bf16x8*)((char*)K_lds + (b) * SHM_K + KSWZP(sr2, 256 + sc2 * 2, DQK * 2)) = St::tobf(sr_[i].ks2); } while (0)
#define SWAIT() do { if constexpr (SDEPTH == 2) { if constexpr (X) asm volatile("s_waitcnt vmcnt(5)" ::: "memory"); else asm volatile("s_waitcnt vmcnt(4)" ::: "memory"); } else asm volatile("s_waitcnt vmcnt(0)" ::: "memory"); } while (0)
#define RESC(a) do { if (__any((a) < 1.f)) { if (hi == 0) al_l[r32] = (a); asm volatile("s_waitcnt lgkmcnt(0)" ::: "memory"); \
    for (int d = 0; d < 4; ++d) for (int r = 0; r < 16; ++r) o[d][r] *= al_l[crow(r, hi)]; } } while (0)
  f32x16 pA0, pA1, pB0, pB1; float mnA, mnB, alA, alB; bf16x8 pa0, pa1, pa2, pa3; const int NT = seq / KVBLK;
  SLOAD(0, 0); asm volatile("s_waitcnt vmcnt(0)" ::: "memory"); SWRITE(0, 0);
  SLOAD(0, KVBLK); asm volatile("s_waitcnt vmcnt(0)" ::: "memory"); SWRITE(1, 0); __syncthreads();
  qkt<DQK, NQR>(pA0, pA1, K_lds, qr, r32, hi, qx); partialSM<DQK>(pA0, pA1, m_reg, mnA, alA);
  if (2 < NT) SLOAD(0, 2 * KVBLK);
  if constexpr (SDEPTH == 2) { if (3 < NT) SLOAD(1, 3 * KVBLK); }
  int cur = 0, nxt = 1, wr = 2;
#define HALF(t, SL, PC0, PC1, ALC, PN0, PN1, MNN, ALN) do { \
    if ((t) + 2 < NT) { if (SDEPTH == 2 && (t) + 3 < NT) SWAIT(); else asm volatile("s_waitcnt vmcnt(0)" ::: "memory"); SWRITE(wr, SL); if ((t) + 2 + SDEPTH < NT) SLOAD(SL, ((t) + 2 + SDEPTH) * KVBLK); } \
    SBAR(); if ((t) + 1 < NT) qkt<DQK, NQR>(PN0, PN1, (bf16*)((char*)K_lds + nxt * SHM_K), qr, r32, hi, qx); \
    finishSM(PC0, PC1, ALC, l_reg, pa0, pa1, pa2, pa3); SBAR(); \
    pv_d0(o, vb0 + cur * (int)SHM_V, pa0, pa1, pa2, pa3); \
    if ((t) + 1 < NT) { partialSM<DQK>(PN0, PN1, m_reg, MNN, ALN); RESC(ALN); } \
    __syncthreads(); { const int c_ = cur; cur = nxt; nxt = wr; wr = c_; } } while (0)
  for (int t = 0; t < NT; t += 2) {
    HALF(t, 0, pA0, pA1, alA, pB0, pB1, mnB, alB);
    HALF(t + 1, (SDEPTH - 1), pB0, pB1, alB, pA0, pA1, mnA, alA);
  }
#undef HALF
  if (hi == 0) li_l[r32] = l_reg; asm volatile("s_waitcnt lgkmcnt(0)" ::: "memory");
  float rli[16];
#pragma unroll
  for (int r = 0; r < 16; ++r) rli[r] = __builtin_amdgcn_rcpf(li_l[crow(r, hi)]);
  __syncthreads();
  {
    char* ep = lds + wid * 8704;
    int lane_e = hi * 4 * 272 + r32 * 2; asm volatile("" : "+v"(lane_e));
#pragma unroll
    for (int r = 0; r < 16; ++r) { const int ro = ((r & 3) + 8 * (r >> 2)) * 272;
#pragma unroll
      for (int d0 = 0; d0 < 4; ++d0) *(unsigned short*)(ep + lane_e + ro + d0 * 64) = (unsigned short)(cvtpk(o[d0][r] * rli[r], 0.f) & 0xffffu); }
    asm volatile("s_waitcnt lgkmcnt(0)" ::: "memory");
    int lane_q = lane; asm volatile("" : "+v"(lane_q));
    const int row0 = lane_q >> 4, ch = lane_q & 15;
    unsigned short* Yw = Ob + (long)(wid * QBLK + row0) * LDO + ch * 8; const unsigned short* Gw = Gb + (long)(wid * QBLK + row0) * LDO + ch * 8;
#pragma unroll
    for (int hf = 0; hf < 2; ++hf) { u32x4 gv[4], ov[4];
#pragma unroll
      for (int i = 0; i < 4; ++i) gv[i] = *(const u32x4*)(Gw + (long)(4 * (4 * hf + i)) * LDO);
#pragma unroll
      for (int i = 0; i < 4; ++i) ov[i] = *(const u32x4*)(ep + (row0 + 4 * (4 * hf + i)) * 272 + ch * 16);
#pragma unroll
      for (int i = 0; i < 4; ++i) { u32x4 w;
#pragma unroll
        for (int j = 0; j < 4; ++j) { const float lo = __uint_as_float(ov[i][j] << 16) * __uint_as_float(gv[i][j] << 16), hi2 = __uint_as_float(ov[i][j] & 0xffff0000u) * __uint_as_float(gv[i][j] & 0xffff0000u); w[j] = cvtpk(lo, hi2); }
        *(u32x4*)(Yw + (long)(4 * (4 * hf + i)) * LDO) = w; }
      asm volatile("" ::: "memory"); }
  }
  __syncthreads();
#undef SLOAD
#undef SWRITE
#undef SWAIT
#undef RESC
}

template <typename TQ, int LDQ, int LDK, int LDO, int DQK, int LDK2, int SDEPTH, int NQR>
__device__ __forceinline__ void attn_dense_body_dma(const TQ* __restrict__ Qb, const bf16* __restrict__ Kh, const bf16* __restrict__ K2h, const bf16* __restrict__ Vh,
                                                bf16* __restrict__ Ob, const bf16* __restrict__ Gb, int seq, char* lds) {
  constexpr size_t SHM_K = 64 * DQK * 2; constexpr bool X = DQK == 192; constexpr bool PVSM = X ? (ATT_PVSM_B != 0) : (ATT_PVSM_A != 0);
  using St = Stage<bf16>; using SQ = Stage<TQ>;
  int tid_o = threadIdx.x; asm volatile("" : "+v"(tid_o));
  const int tid = tid_o, wid = __builtin_amdgcn_readfirstlane(tid >> 6), lane = tid & 63, r32 = lane & 31, hi = lane >> 5;
  bf16* V_lds = (bf16*)lds; bf16* K_lds = (bf16*)(lds + 3 * SHM_V);
  float* ws = (float*)(lds + 3 * SHM_V + 4 * SHM_K) + wid * 64; float* li_l = ws; float* al_l = ws + 32;
  float m_reg = -1e30f, l_reg = 0; f32x16 o[4] = {}; bf16x8 qr[NQR]; char* qx = lds + 3 * SHM_V + 4 * SHM_K + 2048 + wid * ((DQK / 16 - NQR) * 1024) + lane * 16;
  const TQ* Qw = Qb + (long)(wid * QBLK + r32) * LDQ + hi * 8;
#pragma unroll
  for (int d0 = 0; d0 < NQR; ++d0) qr[d0] = SQ::tobf(SQ::ld8(Qw + d0 * 16));
#pragma unroll
  for (int d0 = NQR; d0 < DQK / 16; ++d0) *reinterpret_cast<bf16x8*>(qx + (d0 - NQR) * 1024) = SQ::tobf(SQ::ld8(Qw + d0 * 16));
  const int vb0 = (int)(uintptr_t)V_lds + v_rd_base(lane);
  const unsigned ldsK = (unsigned)(uintptr_t)K_lds + wid * 1024u, ldsV = (unsigned)(uintptr_t)V_lds + wid * 1024u;
  const char* kg = (const char*)Kh; const char* vg = (const char*)Vh;
  unsigned koff = 0; const char* kp[3] = {nullptr, nullptr, nullptr}; unsigned kst[3] = {0, 0, 0};
  if constexpr (!X) { const int krow = 4 * wid + (lane >> 4); koff = (unsigned)(krow * (LDK * 2) + (((lane & 15) ^ KSWZK(krow, 256)) << 4)); }
  else {
#pragma unroll
    for (int i = 0; i < 3; ++i) { const int P = (wid + 8 * i) * 64 + lane, row = P / 24, slot = P - row * 24, cb = slot ^ KSWZK(row, 384);
      if (cb < 16) { kp[i] = (const char*)Kh + (size_t)row * (LDK * 2) + cb * 16; kst[i] = 64 * LDK * 2; }
      else { kp[i] = (const char*)K2h + (size_t)row * (LDK2 * 2) + (cb - 16) * 16; kst[i] = 64 * LDK2 * 2; } } }
  unsigned voff; { const int st = 2 * wid + (lane >> 5), kk = (st >> 2) * 8 + ((lane & 31) >> 2), k = (kk & ~0xC) | ((kk & 4) << 1) | ((kk & 8) >> 1), c = (st & 3) * 32 + (lane & 3) * 8;
    voff = (unsigned)(k * (LDK * 2) + c * 2); }
#define GLDS(g, l) __builtin_amdgcn_global_load_lds((const unsigned*)(g), (LAS unsigned*)(l), 16, 0, 0)
#define DMAK(bi) do { const unsigned kd_ = ldsK + (bi) * (unsigned)SHM_K; \
    if constexpr (!X) { GLDS(kg + koff, kd_); GLDS(kg + 32 * LDK * 2 + koff, kd_ + 8192); kg += 64 * LDK * 2; } \
    else { _Pragma("unroll") for (int i_ = 0; i_ < 3; ++i_) { GLDS(kp[i_], kd_ + i_ * 8192); kp[i_] += kst[i_]; } } } while (0)
#define DMAV(bi) do { const unsigned vd_ = ldsV + (bi) * (unsigned)SHM_V; GLDS(vg + voff, vd_); GLDS(vg + 32 * LDK * 2 + voff, vd_ + 8192); vg += 64 * LDK * 2; } while (0)
#define RESC(a) do { if (__any((a) < 1.f)) { if (hi == 0) al_l[r32] = (a); asm volatile("s_waitcnt lgkmcnt(0)" ::: "memory"); \
    for (int d = 0; d < 4; ++d) for (int r = 0; r < 16; ++r) o[d][r] *= al_l[crow(r, hi)]; } } while (0)
  f32x16 pA0, pA1, pB0, pB1; float mnA, mnB, alA, alB; bf16x8 pa0, pa1, pa2, pa3; const int NT = seq / KVBLK;
  DMAK(0); DMAV(0); DMAK(1); DMAV(1); DMAK(2); asm volatile("s_waitcnt vmcnt(0)" ::: "memory"); __syncthreads();
  qkt<DQK, NQR>(pA0, pA1, K_lds, qr, r32, hi, qx); partialSM<DQK>(pA0, pA1, m_reg, mnA, alA);
  int vcur = 0, vnxt = 1, vwr = 2;
#define HALF(t, FULL, PC0, PC1, ALC, PN0, PN1, MNN, ALN) do { \
    if (FULL || (t) + 3 < NT) DMAK(((t) + 3) & 3); if (FULL || (t) + 2 < NT) DMAV(vwr); \
    SBAR(); if (FULL || (t) + 1 < NT) qkt<DQK, NQR>(PN0, PN1, (bf16*)((char*)K_lds + (((t) + 1) & 3) * SHM_K), qr, r32, hi, qx); \
    finishSM(PC0, PC1, ALC, l_reg, pa0, pa1, pa2, pa3); SBAR(); \
    pv_d0(o, vb0 + vcur * (int)SHM_V, pa0, pa1, pa2, pa3); \
    if (FULL || (t) + 1 < NT) { partialSM<DQK>(PN0, PN1, m_reg, MNN, ALN); RESC(ALN); } \
    if (FULL || (t) + 3 < NT) { if constexpr (X) asm volatile("s_waitcnt vmcnt(5)" ::: "memory"); else asm volatile("s_waitcnt vmcnt(4)" ::: "memory"); } \
    else if ((t) + 2 < NT) asm volatile("s_waitcnt vmcnt(2)" ::: "memory"); else asm volatile("s_waitcnt vmcnt(0)" ::: "memory"); \
    __syncthreads(); { const int c_ = vcur; vcur = vnxt; vnxt = vwr; vwr = c_; } } while (0)
  int t = 0;
  for (; t + 5 < NT; t += 2) {
    HALF(t, 1, pA0, pA1, alA, pB0, pB1, mnB, alB);
    HALF(t + 1, 1, pB0, pB1, alB, pA0, pA1, mnA, alA);
  }
  for (; t < NT; t += 2) {
    HALF(t, 0, pA0, pA1, alA, pB0, pB1, mnB, alB);
    HALF(t + 1, 0, pB0, pB1, alB, pA0, pA1, mnA, alA);
  }
#undef HALF
  if (hi == 0) li_l[r32] = l_reg; asm volatile("s_waitcnt lgkmcnt(0)" ::: "memory");
  float rli[16];
#pragma unroll
  for (int r = 0; r < 16; ++r) rli[r] = __builtin_amdgcn_rcpf(li_l[crow(r, hi)]);
  __syncthreads();
  {
    char* ep = lds + wid * 8704;
    int lane_e = hi * 4 * 272 + r32 * 2; asm volatile("" : "+v"(lane_e));
#pragma unroll
    for (int r = 0; r < 16; ++r) { const int ro = ((r & 3) + 8 * (r >> 2)) * 272;
#pragma unroll
      for (int d0 = 0; d0 < 4; ++d0) *(unsigned short*)(ep + lane_e + ro + d0 * 64) = (unsigned short)(cvtpk(o[d0][r] * rli[r], 0.f) & 0xffffu); }
    asm volatile("s_waitcnt lgkmcnt(0)" ::: "memory");
    int lane_q = lane; asm volatile("" : "+v"(lane_q));
    const int row0 = lane_q >> 4, ch = lane_q & 15;
    unsigned short* Yw = Ob + (long)(wid * QBLK + row0) * LDO + ch * 8; const unsigned short* Gw = Gb + (long)(wid * QBLK + row0) * LDO + ch * 8;
#pragma unroll
    for (int hf = 0; hf < 2; ++hf) { u32x4 gv[4], ov[4];
#pragma unroll
      for (int i = 0; i < 4; ++i) gv[i] = *(const u32x4*)(Gw + (long)(4 * (4 * hf + i)) * LDO);
#pragma unroll
      for (int i = 0; i < 4; ++i) ov[i] = *(const u32x4*)(ep + (row0 + 4 * (4 * hf + i)) * 272 + ch * 16);
#pragma unroll
      for (int i = 0; i < 4; ++i) { u32x4 w;
#pragma unroll
        for (int j = 0; j < 4; ++j) { const float lo = __uint_as_float(ov[i][j] << 16) * __uint_as_float(gv[i][j] << 16), hi2 = __uint_as_float(ov[i][j] & 0xffff0000u) * __uint_as_float(gv[i][j] & 0xffff0000u); w[j] = cvtpk(lo, hi2); }
        *(u32x4*)(Yw + (long)(4 * (4 * hf + i)) * LDO) = w; }
      asm volatile("" ::: "memory"); }
  }
  __syncthreads();
#undef DMAK
#undef DMAV
#undef GLDS
#undef RESC
}

template <typename TQ, int LDQ, int LDK, int LDO, int DQK, int LDK2, int SDEPTH, int NQR>
__device__ __forceinline__ void attn_dense_body_pp(const TQ* __restrict__ Qb, const bf16* __restrict__ Kh, const bf16* __restrict__ K2h, const bf16* __restrict__ Vh,
                                                bf16* __restrict__ Ob, const bf16* __restrict__ Gb, int seq, char* lds) {
  constexpr size_t SHM_K = 64 * DQK * 2; constexpr bool X = DQK == 192; constexpr bool DMAS = X ? (ATT_PP_DMAS_B != 0) : (ATT_PP_DMAS_A != 0); constexpr bool PVS = DMAS && (ATT_PP_PVS != 0);
  using St = Stage<bf16>; using SQ = Stage<TQ>;
  int tid_o = threadIdx.x; asm volatile("" : "+v"(tid_o));
  const int tid = tid_o, wid = __builtin_amdgcn_readfirstlane(tid >> 6), lane = tid & 63, r32 = lane & 31, hi = lane >> 5;
  bf16* V_lds = (bf16*)lds; bf16* K_lds = (bf16*)(lds + 3 * SHM_V);
  float* ws = (float*)(lds + 3 * SHM_V + 4 * SHM_K) + wid * 64; float* li_l = ws; float* al_l = ws + 32;
  float m_reg = -1e30f, l_reg = 0; f32x16 o[4] = {}; bf16x8 qr[NQR]; char* qx = lds + 3 * SHM_V + 4 * SHM_K + 2048 + wid * ((DQK / 16 - NQR) * 1024) + lane * 16;
  const TQ* Qw = Qb + (long)(wid * QBLK + r32) * LDQ + hi * 8;
#pragma unroll
  for (int d0 = 0; d0 < NQR; ++d0) qr[d0] = SQ::tobf(SQ::ld8(Qw + d0 * 16));
#pragma unroll
  for (int d0 = NQR; d0 < DQK / 16; ++d0) *reinterpret_cast<bf16x8*>(qx + (d0 - NQR) * 1024) = SQ::tobf(SQ::ld8(Qw + d0 * 16));
  const int vb0 = (int)(uintptr_t)V_lds + v_rd_base(lane);
  const int kb0 = (int)(uintptr_t)K_lds + r32 * (DQK * 2), ky = KSWZK(r32, DQK * 2) << 4;
  const unsigned ldsK = (unsigned)(uintptr_t)K_lds + wid * 1024u, ldsV = (unsigned)(uintptr_t)V_lds + wid * 1024u;
  const char* kg = (const char*)Kh; const char* vg = (const char*)Vh;
  unsigned koff = 0; const char* kp[3] = {nullptr, nullptr, nullptr}; unsigned kst[3] = {0, 0, 0};
  if constexpr (!X) { const int krow = 4 * wid + (lane >> 4); koff = (unsigned)(krow * (LDK * 2) + (((lane & 15) ^ KSWZK(krow, 256)) << 4)); }
  else {
#pragma unroll
    for (int i = 0; i < 3; ++i) { const int P = (wid + 8 * i) * 64 + lane, row = P / 24, slot = P - row * 24, cb = slot ^ KSWZK(row, 384);
      if (cb < 16) { kp[i] = (const char*)Kh + (size_t)row * (LDK * 2) + cb * 16; kst[i] = 64 * LDK * 2; }
      else { kp[i] = (const char*)K2h + (size_t)row * (LDK2 * 2) + (cb - 16) * 16; kst[i] = 64 * LDK2 * 2; } } }
  unsigned voff; { const int st = 2 * wid + (lane >> 5), kk = (st >> 2) * 8 + ((lane & 31) >> 2), k = (kk & ~0xC) | ((kk & 4) << 1) | ((kk & 8) >> 1), c = (st & 3) * 32 + (lane & 3) * 8;
    voff = (unsigned)(k * (LDK * 2) + c * 2); }
#define GLDS(g, l) __builtin_amdgcn_global_load_lds((const unsigned*)(g), (LAS unsigned*)(l), 16, 0, 0)
#define DMAK(bi) do { const unsigned kd_ = ldsK + (bi) * (unsigned)SHM_K; \
    if constexpr (!X) { GLDS(kg + koff, kd_); GLDS(kg + 32 * LDK * 2 + koff, kd_ + 8192); kg += 64 * LDK * 2; } \
    else { _Pragma("unroll") for (int i_ = 0; i_ < 3; ++i_) { GLDS(kp[i_], kd_ + i_ * 8192); kp[i_] += kst[i_]; } } } while (0)
#define DMAV(bi) do { const unsigned vd_ = ldsV + (bi) * (unsigned)SHM_V; GLDS(vg + voff, vd_); GLDS(vg + 32 * LDK * 2 + voff, vd_ + 8192); vg += 64 * LDK * 2; } while (0)
#define RESC(a) do { if (__any((a) < 1.f)) { if (hi == 0) al_l[r32] = (a); asm volatile("s_waitcnt lgkmcnt(0)" ::: "memory"); \
    for (int d = 0; d < 4; ++d) for (int r = 0; r < 16; ++r) o[d][r] *= al_l[crow(r, hi)]; } } while (0)
  f32x16 p0, p1; float mn, al; bf16x8 pa0, pa1, pa2, pa3; const int NT = seq / KVBLK; const int grp = wid >> 2;
  DMAK(0); DMAV(0); DMAK(1); DMAV(1); DMAK(2); asm volatile("s_waitcnt vmcnt(0)" ::: "memory"); __syncthreads();
  qkt<DQK, NQR>(p0, p1, K_lds, qr, r32, hi, qx);
  partialSM<DQK>(p0, p1, m_reg, mn, al); finishSM(p0, p1, al, l_reg, pa0, pa1, pa2, pa3);
#if ATT_PP_RAWBAR
#define PPBAR() do { asm volatile("" ::: "memory"); __builtin_amdgcn_s_barrier(); asm volatile("" ::: "memory"); } while (0)
#else
#define PPBAR() __syncthreads()
#endif
  if (grp) PPBAR();
  int vcur = 0, vnxt = 1, vwr = 2, vlast = 0;
#define MSEG(t, FULL) do { __builtin_amdgcn_s_setprio(ATT_PP_PRIO); \
    if constexpr (!DMAS && ATT_PP_DMAMID == 0 && ATT_PP_DMAHOOK == 0) { if (FULL || (t) + 3 < NT) DMAK(((t) + 3) & 3); if (FULL || (t) + 2 < NT) DMAV(vwr); } \
    SBAR(); \
    if constexpr (ATT_PP_PVPIPE != 0) { const int vb_ = vb0 + vcur * (int)SHM_V; VFrag fa_, fb_; \
      pv_rd<0>(fa_, vb_); pv_rd<1>(fb_, vb_);                     \
      if (FULL || (t) + 1 < NT) qkt<DQK, NQR>(p0, p1, (bf16*)((char*)K_lds + (((t) + 1) & 3) * SHM_K), qr, r32, hi, qx); \
      asm volatile("s_waitcnt lgkmcnt(8)" ::: "memory"); SBAR(); pv_mm(o[0], fa_, pa0, pa1, pa2, pa3); pv_rd<2>(fa_, vb_); \
      asm volatile("s_waitcnt lgkmcnt(8)" ::: "memory"); SBAR(); pv_mm(o[1], fb_, pa0, pa1, pa2, pa3); pv_rd<3>(fb_, vb_); \
      asm volatile("s_waitcnt lgkmcnt(8)" ::: "memory"); SBAR(); pv_mm(o[2], fa_, pa0, pa1, pa2, pa3); \
      asm volatile("s_waitcnt lgkmcnt(0)" ::: "memory"); SBAR(); pv_mm(o[3], fb_, pa0, pa1, pa2, pa3); SBAR(); } \
    else if constexpr (ATT_PP_PVFIRST != 0) { pv_d0(o, vb0 + vcur * (int)SHM_V, pa0, pa1, pa2, pa3); \
      if (FULL || (t) + 1 < NT) qkt<DQK, NQR>(p0, p1, (bf16*)((char*)K_lds + (((t) + 1) & 3) * SHM_K), qr, r32, hi, qx); SBAR(); } \
    else if constexpr (ATT_PP_SPLITSM != 0) { if (FULL || (t) + 1 < NT) { qkt<DQK, NQR>(p0, p1, (bf16*)((char*)K_lds + (((t) + 1) & 3) * SHM_K), qr, r32, hi, qx); \
        pv_sm<DQK>(o, vb0 + vcur * (int)SHM_V, pa0, pa1, pa2, pa3, p0, p1, m_reg, mn, al); }        \
      else pv_d0(o, vb0 + vcur * (int)SHM_V, pa0, pa1, pa2, pa3); } \
    else if constexpr (ATT_PP_KPIPE != 0 && ATT_PP_VPIPE != 0 && NQR == DQK / 16) { const int vb_ = vb0 + vcur * (int)SHM_V; \
      if (FULL || (t) + 1 < NT) { VFrag fa_; qkt_pipe<DQK, 1>(p0, p1, kb0 + (((t) + 1) & 3) * (int)SHM_K, ky, hi, qr, &fa_, vb_); pv_cont(o, vb_, fa_, pa0, pa1, pa2, pa3); } \
      else pv_d0(o, vb_, pa0, pa1, pa2, pa3); } \
    else if constexpr (ATT_PP_KPIPE != 0 && PVS && NQR == DQK / 16) { if (FULL || (t) + 1 < NT) qkt_pipe<DQK>(p0, p1, kb0 + (((t) + 1) & 3) * (int)SHM_K, ky, hi, qr); \
      { const int vb_ = vb0 + vcur * (int)SHM_V; pv_one<0>(o[0], vb_, pa0, pa1, pa2, pa3); pv_one<1>(o[1], vb_, pa0, pa1, pa2, pa3); pv_one<2>(o[2], vb_, pa0, pa1, pa2, pa3); vlast = vb_; } } \
    else if constexpr (ATT_PP_KPIPE != 0 && !DMAS && ATT_PP_DMAHOOK != 0 && NQR == DQK / 16) { \
      auto hook_ = [&]() { if (FULL || (t) + 3 < NT) DMAK(((t) + 3) & 3); if (FULL || (t) + 2 < NT) DMAV(vwr); }; \
      if (FULL || (t) + 1 < NT) qkt_pipe<DQK, 0>(p0, p1, kb0 + (((t) + 1) & 3) * (int)SHM_K, ky, hi, qr, nullptr, 0, hook_); else hook_(); \
      pv_d0(o, vb0 + vcur * (int)SHM_V, pa0, pa1, pa2, pa3); } \
    else if constexpr (ATT_PP_KPIPE != 0 && NQR == DQK / 16) { if (FULL || (t) + 1 < NT) qkt_pipe<DQK>(p0, p1, kb0 + (((t) + 1) & 3) * (int)SHM_K, ky, hi, qr); \
      if constexpr (!DMAS && ATT_PP_DMAMID != 0) { if (FULL || (t) + 3 < NT) DMAK(((t) + 3) & 3); if (FULL || (t) + 2 < NT) DMAV(vwr); SBAR(); }     \
      pv_d0(o, vb0 + vcur * (int)SHM_V, pa0, pa1, pa2, pa3); } \
    else { if (FULL || (t) + 1 < NT) qkt<DQK, NQR>(p0, p1, (bf16*)((char*)K_lds + (((t) + 1) & 3) * SHM_K), qr, r32, hi, qx); \
      pv_d0(o, vb0 + vcur * (int)SHM_V, pa0, pa1, pa2, pa3); } \
    if constexpr (!DMAS) { if (FULL || (t) + 3 < NT) { if constexpr (X) asm volatile("s_waitcnt vmcnt(5)" ::: "memory"); else asm volatile("s_waitcnt vmcnt(4)" ::: "memory"); } \
    else if ((t) + 2 < NT) asm volatile("s_waitcnt vmcnt(2)" ::: "memory"); else asm volatile("s_waitcnt vmcnt(0)" ::: "memory"); } \
    PPBAR(); { const int c_ = vcur; vcur = vnxt; vnxt = vwr; vwr = c_; } } while (0)
#define SSEG(t, FULL) do { if constexpr (!DMAS || ATT_PP_DMAHI == 0) __builtin_amdgcn_s_setprio(ATT_PP_PRIO_S); \
    if constexpr (ATT_PP_KPIPE != 0 && PVS && NQR == DQK / 16) { pv_one<3>(o[3], vlast, pa0, pa1, pa2, pa3); SBAR(); } \
    if constexpr (DMAS) { if (FULL || (t) + 3 < NT) DMAK(((t) + 3) & 3); if (FULL || (t) + 2 < NT) DMAV(vnxt); if constexpr (ATT_PP_DMAHI != 0) { SBAR(); __builtin_amdgcn_s_setprio(ATT_PP_PRIO_S); } }     \
    if (FULL || (t) + 1 < NT) { if constexpr (ATT_PP_SPLITSM == 0) partialSM<DQK>(p0, p1, m_reg, mn, al); RESC(al); finishSM(p0, p1, al, l_reg, pa0, pa1, pa2, pa3); } \
    if constexpr (DMAS) asm volatile("s_waitcnt vmcnt(0)" ::: "memory"); \
    PPBAR(); } while (0)
  int t = 0;
  for (; t + 3 < NT; ++t) { MSEG(t, 1); SSEG(t, 1); }
  for (; t < NT; ++t) { MSEG(t, 0); SSEG(t, 0); }
  if (!grp) PPBAR();
  __builtin_amdgcn_s_setprio(0);
#undef PPBAR
#undef MSEG
#undef SSEG
  if (hi == 0) li_l[r32] = l_reg; asm volatile("s_waitcnt lgkmcnt(0)" ::: "memory");
  float rli[16];
#pragma unroll
  for (int r = 0; r < 16; ++r) rli[r] = __builtin_amdgcn_rcpf(li_l[crow(r, hi)]);
  __syncthreads();
  {
    char* ep = lds + wid * 8704;
    int lane_e = hi * 4 * 272 + r32 * 2; asm volatile("" : "+v"(lane_e));
#pragma unroll
    for (int r = 0; r < 16; ++r) { const int ro = ((r & 3) + 8 * (r >> 2)) * 272;
#pragma unroll
      for (int d0 = 0; d0 < 4; ++d0) *(unsigned short*)(ep + lane_e + ro + d0 * 64) = (unsigned short)(cvtpk(o[d0][r] * rli[r], 0.f) & 0xffffu); }
    asm volatile("s_waitcnt lgkmcnt(0)" ::: "memory");
    int lane_q = lane; asm volatile("" : "+v"(lane_q));
    const int row0 = lane_q >> 4, ch = lane_q & 15;
    unsigned short* Yw = Ob + (long)(wid * QBLK + row0) * LDO + ch * 8; const unsigned short* Gw = Gb + (long)(wid * QBLK + row0) * LDO + ch * 8;
#pragma unroll
    for (int hf = 0; hf < 2; ++hf) { u32x4 gv[4], ov[4];
#pragma unroll
      for (int i = 0; i < 4; ++i) gv[i] = *(const u32x4*)(Gw + (long)(4 * (4 * hf + i)) * LDO);
#pragma unroll
      for (int i = 0; i < 4; ++i) ov[i] = *(const u32x4*)(ep + (row0 + 4 * (4 * hf + i)) * 272 + ch * 16);
#pragma unroll
      for (int i = 0; i < 4; ++i) { u32x4 w;
#pragma unroll
        for (int j = 0; j < 4; ++j) { const float lo = __uint_as_float(ov[i][j] << 16) * __uint_as_float(gv[i][j] << 16), hi2 = __uint_as_float(ov[i][j] & 0xffff0000u) * __uint_as_float(gv[i][j] & 0xffff0000u); w[j] = cvtpk(lo, hi2); }
        *(u32x4*)(Yw + (long)(4 * (4 * hf + i)) * LDO) = w; }
      asm volatile("" ::: "memory"); }
  }
  __syncthreads();
#undef DMAK
#undef DMAV
#undef GLDS
#undef RESC
}

}

#ifndef ATT_DMA_A
#define ATT_DMA_A 0
#endif
#ifndef ATT_DMA_B
#define ATT_DMA_B 0
#endif
#ifndef ATT_PP
#define ATT_PP 0
#endif
#if ATT_PP
#define ATT_BODY attn_dense_body_pp
#ifndef ATT_NQR_A
#define ATT_NQR_A 8
#endif
#elif ATT_DMA_A
#define ATT_BODY attn_dense_body_dma
#ifndef ATT_NQR_A
#define ATT_NQR_A 8
#endif
#else
#define ATT_BODY attn_dense_body
#endif
#ifndef ATT_PP_B
#define ATT_PP_B 1
#endif
#if ATT_PP_B
#define ATT_BODY_B attn_dense_body_pp
#ifndef ATT_NQR_B
#define ATT_NQR_B 12
#endif
#elif ATT_DMA_B
#define ATT_BODY_B attn_dense_body_dma
#ifndef ATT_NQR_B
#define ATT_NQR_B 11
#endif
#else
#define ATT_BODY_B attn_dense_body
#endif
#ifndef ATT_NQR_A
#define ATT_NQR_A 6
#endif
#ifndef ATT_NQR_B
#define ATT_NQR_B 10
#endif
#ifndef ATT_SD_A
#define ATT_SD_A 2
#endif
#ifndef ATT_SD_B
#define ATT_SD_B 1
#endif
__device__ __forceinline__ void attn_phase(const Frame& F, const Args& a, unsigned char* lds_generic) {
    unsigned char* ws = a.ws;
    const bf16_t* A1 = (const bf16_t*)(ws + WS_A1); const bf16_t* QB = (const bf16_t*)(ws + WS_QB); const bf16_t* KVB = (const bf16_t*)(ws + WS_KVB);
    const bf16_t* KRb = (const bf16_t*)(ws + WS_KR); const bf16_t* G0 = (const bf16_t*)(ws + WS_G0); bf16_t* Y0 = (bf16_t*)(ws + WS_Y0);
    char* lds = (char*)lds_generic;
    const int x = F.bid & 7, slot = F.bid >> 3;
    for (int ii = 0; ii < ((a.var & 1) ? 0 : 5); ++ii) {
        int b, hd, q0, kb, seq;
        if (ii < 4) { const int i = (ii & 1) + 4 * (ii >> 1); const int p = i * 8 + x; b = p >> 5; hd = p & 31; q0 = b * SB + slot * 256; kb = b * SB; seq = SB; }
        else { if (F.bid >= 32) break; b = F.bid >> 4; hd = F.bid & 15; q0 = b * SB + S; kb = q0; seq = CTX; }
        att::ATT_BODY<att::bf16, 3072, 3072, 4096, 128, 64, ATT_SD_A, ATT_NQR_A>(A1 + (size_t)q0 * 3072 + hd * 128, A1 + (size_t)kb * 3072 + 2048 + (hd >> 2) * 128, nullptr,
                            A1 + (size_t)kb * 3072 + 2560 + (hd >> 2) * 128, Y0 + (size_t)q0 * 4096 + hd * 128, G0 + (size_t)q0 * 4096 + hd * 128, seq, lds);
        __syncthreads();
    }
#ifdef ATT_PRB
    if (a.var & 4) for (int ii = 0; ii < 4; ++ii) {
        const int i = (ii & 1) + 4 * (ii >> 1); const int p = i * 8 + x; const int b = p >> 5, hd = p & 31, q0 = b * SB + slot * 256, kb = b * SB;
        att::attn_dense_body<att::bf16, 3072, 3072, 4096, 128, 64, ATT_SD_A, ATT_NQR_A, ATT_PRB>(A1 + (size_t)q0 * 3072 + hd * 128, A1 + (size_t)kb * 3072 + 2048 + (hd >> 2) * 128, nullptr,
                            A1 + (size_t)kb * 3072 + 2560 + (hd >> 2) * 128, Y0 + (size_t)q0 * 4096 + hd * 128, G0 + (size_t)q0 * 4096 + hd * 128, SB, lds);
        __syncthreads();
    }
#endif
    for (int ii = 0; ii < ((a.var & 2) ? 0 : 5); ++ii) {
        int b, h, q0, kb, seq;
        if (ii < 4) { const int i = 2 + (ii & 1) + 4 * (ii >> 1); const int p = i * 8 + x; b = p >> 5; h = (p & 31) - 16; q0 = b * SB + slot * 256; kb = b * SB; seq = SB; }
        else { if (F.bid >= 32) break; b = F.bid >> 4; h = F.bid & 15; q0 = b * SB + S; kb = q0; seq = CTX; }
        att::ATT_BODY_B<att::bf16, 3072, 4096, 4096, 192, 64, ATT_SD_B, ATT_NQR_B>(QB + (size_t)q0 * 3072 + h * 192, KVB + (size_t)kb * 4096 + h * 256, KRb + (size_t)kb * 64,
                            KVB + (size_t)kb * 4096 + h * 256 + 128, Y0 + (size_t)q0 * 4096 + 2048 + h * 128, G0 + (size_t)q0 * 4096 + 2048 + h * 128, seq, lds);
        __syncthreads();
    }
}
}
namespace fk {
constexpr int NCH = SB / 64;
constexpr int NC2_ = SB / 32;
struct EpiL1 {
    static constexpr bool PERM = true;
    bf16_t* QK1; bf16_t* VT; bf16_t* U1; bf16_t* G1; float* GD; int skip; LAS unsigned char* vx;
    __device__ __forceinline__ void operator()(const f32x4 (&acc)[2][2][4][2], const Unit& u, int wr, int wc, int fr, int fq) const {
        if (skip) return;
        const int pn = u.pn; const int rowl0 = wr * 64 + fr; const size_t row0 = (size_t)u.pm * 256 + rowl0; const int cl = wc * 32 + 8 * fq;
        if (pn >= 12 && pn < 24) {
            const int b = u.pm / PPB, pb = u.pm % PPB; const int cv = (pn - 12) * 256, h = cv >> 9; const int lane = fq * 16 + fr;
            LAS bf16_t* w = (LAS bf16_t*)(vx + (wr * 4 + wc) * 2048);
#pragma unroll
            for (int ai = 0; ai < 2; ++ai)
#pragma unroll
                for (int bj = 0; bj < 2; ++bj)
#pragma unroll
                    for (int mh = 0; mh < 2; ++mh) {
#pragma unroll
                        for (int mm = 0; mm < 2; ++mm) { const int m = 2 * mh + mm; const f32x4 x0 = acc[ai][bj][m][0], x1 = acc[ai][bj][m][1]; const int tl = 16 * mm + fr;
#pragma unroll
                            for (int j = 0; j < 4; ++j) { w[(8 * fq + j) * 32 + tl] = (bf16_t)(cvt_pk_bf16(x0[j], 0.f) & 0xffffu); w[(8 * fq + 4 + j) * 32 + tl] = (bf16_t)(cvt_pk_bf16(x1[j], 0.f) & 0xffffu); } }
                        LDS_WAIT(); asm volatile("" ::: "memory");
                        const int c32 = pb * 8 + 4 * ai + 2 * wr + mh; const int e0 = (cv & 511) + bj * 128 + wc * 32;
                        bf16_t* dst = VT + ((size_t)((b * 6 + h) * NC2_ + c32) * 512 + e0) * 32;
#pragma unroll
                        for (int i = 0; i < 2; ++i) { const int q = lane + 64 * i, el = q >> 2, tc = q & 3; *(u32x4*)(dst + el * 32 + tc * 8) = *(const LAS u32x4*)(w + el * 32 + tc * 8); }
                        LDS_WAIT(); asm volatile("" ::: "memory");
                    }
        } else if (pn < 28) {
            bf16_t* base; int ld, c0;
            if (pn < 12) { base = QK1; ld = 3072; c0 = pn * 256; } else { base = U1; ld = 1024; c0 = (pn - 24) * 256; }
#pragma unroll
            for (int ai = 0; ai < 2; ++ai)
#pragma unroll
                for (int m = 0; m < 4; ++m)
#pragma unroll
                    for (int bj = 0; bj < 2; ++bj) *(u32x4*)(base + (row0 + ai * 128 + 16 * m) * ld + c0 + bj * 128 + cl) = pack8(acc[ai][bj][m][0], acc[ai][bj][m][1]);
        } else if (pn < 44) {
#pragma unroll
            for (int ai = 0; ai < 2; ++ai)
#pragma unroll
                for (int m = 0; m < 4; ++m)
#pragma unroll
                    for (int bj = 0; bj < 2; ++bj) { f32x4 x0 = acc[ai][bj][m][0], x1 = acc[ai][bj][m][1];
#pragma unroll
                        for (int i = 0; i < 4; ++i) { x0[i] = fast_silu(x0[i]); x1[i] = fast_silu(x1[i]); }
                        *(u32x4*)(G1 + (row0 + ai * 128 + 16 * m) * 4096 + (pn - 28) * 256 + bj * 128 + cl) = pack8(x0, x1); }
        } else {
            if (wc == 0) {
#pragma unroll
                for (int ai = 0; ai < 2; ++ai)
#pragma unroll
                    for (int m = 0; m < 4; ++m) { float* g = GD + (row0 + ai * 128 + 16 * m) * 32 + 8 * fq; *(f32x4*)g = acc[ai][0][m][0]; *(f32x4*)(g + 4) = acc[ai][0][m][1]; } }
        }
    }
};
struct EpiPlain {
    static constexpr bool PERM = true;
    bf16_t* O; int ld;
    __device__ __forceinline__ void operator()(const f32x4 (&acc)[2][2][4][2], const Unit& u, int wr, int wc, int fr, int fq) const {
        const size_t row0 = (size_t)u.pm * 256 + wr * 64 + fr; const int c0 = u.pn * 256 + wc * 32 + 8 * fq;
#pragma unroll
        for (int ai = 0; ai < 2; ++ai)
#pragma unroll
            for (int m = 0; m < 4; ++m)
#pragma unroll
                for (int bj = 0; bj < 2; ++bj) *(u32x4*)(O + (row0 + ai * 128 + 16 * m) * ld + c0 + bj * 128) = pack8(acc[ai][bj][m][0], acc[ai][bj][m][1]);
    }
};
struct OrderFn {
    int bid;
    __device__ bool next(int i, Unit& u) const { if (i >= 1) return false; const int half = bid >> 7, t = bid & 127; u.pm = (t >> 3) + 16 * half; u.pn = (t & 7) + 8 * half; u.ko = 0; return true; }
};
struct EpiPcs {
    static constexpr bool PERM = true;
    bf16_t* P; float scale;
    __device__ __forceinline__ void operator()(const f32x4 (&acc)[2][2][4][2], const Unit& u, int wr, int wc, int fr, int fq) const {
        const size_t row0 = (size_t)(u.pm >> 4) * 4096 + (size_t)(u.pm & 15) * 256 + wr * 64 + fr; const int c0 = (u.pn & 7) * 256 + wc * 32 + 8 * fq;
#pragma unroll
        for (int ai = 0; ai < 2; ++ai)
#pragma unroll
            for (int m = 0; m < 4; ++m)
#pragma unroll
                for (int bj = 0; bj < 2; ++bj) *(u32x4*)(P + (row0 + ai * 128 + 16 * m) * 2048 + c0 + bj * 128) = pack8(acc[ai][bj][m][0] * scale, acc[ai][bj][m][1] * scale);
    }
};
__device__ __forceinline__ void fold_phase(const Frame& F, const bf16_t* AB, bf16_t* BF, int w0, int nw) {
    const int gw = F.bid * NWAVES + F.wave - w0; if (gw < 0 || gw >= nw) return;
    LAS float* scr = (LAS float*)(F.lds + 4096 + F.wave * (64 * 65 * 4));
    const int lane = F.lane, rr = lane >> 3, c8 = (lane & 7) * 8;
    for (int it = gw; it < 2 * 2 * 66 * 16; it += nw) {
        const int half = it / 2112, r0 = it % 2112, b = r0 / 1056, r = r0 % 1056, kb = r / 16, cb = r % 16;
        const int ch = cb * 64 + c8, g = ch >> 8, l = ch & 255;
        const bf16_t* base = AB + (size_t)b * SB * 2048 + g * 512 + half * 256 + l;
        u32x4 p0[8], p1[8];
#pragma unroll
        for (int jj = 0; jj < 8; ++jj) { const int kk = kb * 64 + jj * 8 + rr; const u32x4 z = {0u, 0u, 0u, 0u};
            const bool v0 = half == 0 ? (kk <= 4096) : (kk >= 1 && kk <= 4095), v1 = (kk >= 1 && kk <= 4095);
            p0[jj] = v0 ? *(const u32x4*)(base + (size_t)kk * 2048) : z; p1[jj] = v1 ? *(const u32x4*)(base + (size_t)(8192 - kk) * 2048) : z; }
        const float sg = half == 0 ? 1.f : -1.f;
#pragma unroll
        for (int jj = 0; jj < 8; ++jj) { const int j = jj * 8 + rr; LAS float* dst = scr + j * 65 + c8;
            const unsigned a[4] = {p0[jj].x, p0[jj].y, p0[jj].z, p0[jj].w}, m[4] = {p1[jj].x, p1[jj].y, p1[jj].z, p1[jj].w};
#pragma unroll
            for (int i = 0; i < 4; ++i) { dst[2 * i] = bf_lo(a[i]) + sg * bf_lo(m[i]); dst[2 * i + 1] = bf_hi(a[i]) + sg * bf_hi(m[i]); } }
        LDS_WAIT(); asm volatile("" ::: "memory");
#pragma unroll
        for (int t = 0; t < 8; ++t) { const int cr = (lane >> 3) + 8 * t, k8 = (lane & 7) * 8; float v[8];
#pragma unroll
            for (int i = 0; i < 8; ++i) v[i] = scr[(k8 + i) * 65 + cr];
            u32x4 o; o.x = cvt_pk_bf16(v[0], v[1]); o.y = cvt_pk_bf16(v[2], v[3]); o.z = cvt_pk_bf16(v[4], v[5]); o.w = cvt_pk_bf16(v[6], v[7]);
            *(u32x4*)(BF + ((size_t)half * 2048 + b * 1024 + cb * 64 + cr) * FKP + kb * 64 + k8) = o; }
        LDS_WAIT(); asm volatile("" ::: "memory");
    }
}
__device__ __forceinline__ void f4096_phase(const Frame& F, const bf16_t* AB, float* F4, int item, float scale) {
    const int b = item >> 4, cb = item & 15, lane = F.lane, rr = lane >> 3, c8 = (lane & 7) * 8;
    const int ch = cb * 64 + c8, g = ch >> 8, l = ch & 255;
    const bf16_t* base = AB + ((size_t)b * SB + F.wave * 1024 + rr) * 2048 + g * 512 + l;
    float acc[8] = {0.f, 0.f, 0.f, 0.f, 0.f, 0.f, 0.f, 0.f};
#pragma unroll 8
    for (int i = 0; i < 128; ++i) { const u32x4 v = *(const u32x4*)(base + (size_t)(8 * i) * 2048);
        acc[0] += bf_lo(v.x); acc[1] += bf_hi(v.x); acc[2] += bf_lo(v.y); acc[3] += bf_hi(v.y); acc[4] += bf_lo(v.z); acc[5] += bf_hi(v.z); acc[6] += bf_lo(v.w); acc[7] += bf_hi(v.w); }
    const float sg = (rr & 1) ? -1.f : 1.f;
#pragma unroll
    for (int i = 0; i < 8; ++i) { float v = acc[i] * sg; v += __shfl_xor(v, 8); v += __shfl_xor(v, 16); v += __shfl_xor(v, 32); acc[i] = v; }
    LAS float* red = (LAS float*)F.lds;
    __syncthreads();
    if (lane < 8) {
#pragma unroll
        for (int i = 0; i < 8; ++i) red[F.wave * 64 + lane * 8 + i] = acc[i]; }
    __syncthreads();
    if (F.tid < 64) { float s = 0.f;
#pragma unroll
        for (int w = 0; w < 8; ++w) s += red[w * 64 + F.tid];
        F4[b * 1024 + cb * 64 + F.tid] = s * scale; }
    __syncthreads();
}
__device__ __forceinline__ void fnet_finish_phase(const Frame& F, const bf16_t* PCS, const float* F4, const bf16_t* G1, bf16_t* Y1) {
    const int gw = F.bid * NWAVES + F.wave, NGW = F.G * NWAVES; const int ch = F.lane * 16;
    for (int it = gw; it < 2 * 1024; it += NGW) { const int b = it >> 10, k0 = (it & 1023) * 4;
        u32x4 pc[4][2], ps[4][2], ga[4][2], gb[4][2];
#pragma unroll
        for (int i = 0; i < 4; ++i) { const int k = k0 + i; const int km = k ? 8192 - k : 0;
#pragma unroll
            for (int hh = 0; hh < 2; ++hh) { pc[i][hh] = *(const u32x4*)(PCS + (size_t)k * 2048 + b * 1024 + ch + hh * 8); ps[i][hh] = *(const u32x4*)(PCS + (size_t)(4096 + k) * 2048 + b * 1024 + ch + hh * 8);
                ga[i][hh] = *(const u32x4*)(G1 + ((size_t)b * SB + k) * 4096 + 3072 + ch + hh * 8); gb[i][hh] = *(const u32x4*)(G1 + ((size_t)b * SB + km) * 4096 + 3072 + ch + hh * 8); } }
#pragma unroll
        for (int i = 0; i < 4; ++i) { const int k = k0 + i; const size_t ya = ((size_t)b * SB + k) * 4096 + 3072 + ch, yb = ((size_t)b * SB + (8192 - k)) * 4096 + 3072 + ch;
#pragma unroll
            for (int hh = 0; hh < 2; ++hh) { u32x4 oa, ob;
#pragma unroll
                for (int j = 0; j < 4; ++j) { const float cl = bf_lo(pc[i][hh][j]), chh = bf_hi(pc[i][hh][j]), sl = bf_lo(ps[i][hh][j]), sh = bf_hi(ps[i][hh][j]);
                    oa[j] = cvt_pk_bf16((cl - sl) * bf_lo(ga[i][hh][j]), (chh - sh) * bf_hi(ga[i][hh][j])); ob[j] = cvt_pk_bf16((cl + sl) * bf_lo(gb[i][hh][j]), (chh + sh) * bf_hi(gb[i][hh][j])); }
                *(u32x4*)(Y1 + ya + hh * 8) = oa; if (k) *(u32x4*)(Y1 + yb + hh * 8) = ob; } }
    }
    if (gw < 2) { const int b = gw; const size_t ya = ((size_t)b * SB + 4096) * 4096 + 3072 + ch;
#pragma unroll
        for (int hh = 0; hh < 2; ++hh) { const u32x4 g = *(const u32x4*)(G1 + ya + hh * 8); const f32x4 f0 = *(const f32x4*)(F4 + b * 1024 + ch + hh * 8), f1 = *(const f32x4*)(F4 + b * 1024 + ch + hh * 8 + 4);
            f32x4 x0 = f0, x1 = f1; x0[0] *= bf_lo(g.x); x0[1] *= bf_hi(g.x); x0[2] *= bf_lo(g.y); x0[3] *= bf_hi(g.y); x1[0] *= bf_lo(g.z); x1[1] *= bf_hi(g.z); x1[2] *= bf_lo(g.w); x1[3] *= bf_hi(g.w);
            *(u32x4*)(Y1 + ya + hh * 8) = pack8(x0, x1); } }
}
__device__ __forceinline__ void gla_finish_phase(const Frame& F, const bf16_t* O0, const bf16_t* O1, const bf16_t* O2, const bf16_t* O3, const bf16_t* G1, const float* on_g, bf16_t* Y1) {
    const int base = F.bid * (NB * S / 256);
    const f32x4 o0 = *(const f32x4*)(on_g + F.lane * 8), o1 = *(const f32x4*)(on_g + F.lane * 8 + 4);
    for (int i0 = F.wave; i0 < NB * S / 256; i0 += 8) {
        const int ml = base + i0; const size_t row = (size_t)(ml / S) * SB + (ml % S);
        u32x4 pa[6], pb[6], pc[6], pd[6], gg[6];
#pragma unroll
        for (int h = 0; h < 6; ++h) { const size_t ix = row * 3072 + h * 512 + F.lane * 8;
            pa[h] = *(const u32x4*)(O0 + ix); pb[h] = *(const u32x4*)(O1 + ix); pc[h] = *(const u32x4*)(O2 + ix); pd[h] = *(const u32x4*)(O3 + ix);
            gg[h] = *(const u32x4*)(G1 + row * 4096 + h * 512 + F.lane * 8); }
#pragma unroll
        for (int h = 0; h < 6; ++h) { float v[8];
#pragma unroll
            for (int j = 0; j < 4; ++j) { v[2 * j] = (bf_lo(pa[h][j]) + bf_lo(pb[h][j])) + (bf_lo(pc[h][j]) + bf_lo(pd[h][j])); v[2 * j + 1] = (bf_hi(pa[h][j]) + bf_hi(pb[h][j])) + (bf_hi(pc[h][j]) + bf_hi(pd[h][j])); }
            float ss = 0.f;
#pragma unroll
            for (int i = 0; i < 8; ++i) ss += v[i] * v[i];
            const float rs = 1.0f / sqrtf(wave_sum(ss) * (1.f / 512.f) + EPS);
            f32x4 x0 = (f32x4){v[0], v[1], v[2], v[3]} * rs * o0, x1 = (f32x4){v[4], v[5], v[6], v[7]} * rs * o1; const u32x4 g = gg[h];
            x0[0] *= bf_lo(g.x); x0[1] *= bf_hi(g.x); x0[2] *= bf_lo(g.y); x0[3] *= bf_hi(g.y); x1[0] *= bf_lo(g.z); x1[1] *= bf_hi(g.z); x1[2] *= bf_lo(g.w); x1[3] *= bf_hi(g.w);
            *(u32x4*)(Y1 + row * 4096 + h * 512 + F.lane * 8) = pack8(x0, x1); }
    }
}
__device__ __forceinline__ void final_norm_b_phase(const Frame& F, const bf16_t* src, float* out, const float* fg) {
    const int base = F.bid * (NB * S / 256);
    for (int i0 = F.wave; i0 < NB * S / 256; i0 += 16) {
        const int rot = (F.bid * 5) & 63;
        const size_t ra = (size_t)(base + ((i0 + rot) & 63)) * D, rb = (size_t)(base + ((i0 + 8 + rot) & 63)) * D;
        const u32x2* xa = (const u32x2*)(src + ra) + F.lane; const u32x2* xb = (const u32x2*)(src + rb) + F.lane;
        u32x2 wa[16], wb[16]; float sa = 0.f, sb = 0.f;
#pragma unroll
        for (int j = 0; j < 16; ++j) wa[j] = __builtin_nontemporal_load(xa + 64 * j);
#pragma unroll
        for (int j = 0; j < 16; ++j) wb[j] = __builtin_nontemporal_load(xb + 64 * j);
#pragma unroll
        for (int j = 0; j < 16; ++j) { const float a0 = bf_lo(wa[j].x), a1 = bf_hi(wa[j].x), a2 = bf_lo(wa[j].y), a3 = bf_hi(wa[j].y); sa += (a0 * a0 + a1 * a1) + (a2 * a2 + a3 * a3); }
#pragma unroll
        for (int j = 0; j < 16; ++j) { const float a0 = bf_lo(wb[j].x), a1 = bf_hi(wb[j].x), a2 = bf_lo(wb[j].y), a3 = bf_hi(wb[j].y); sb += (a0 * a0 + a1 * a1) + (a2 * a2 + a3 * a3); }
        const float rsa = 1.0f / sqrtf(wave_sum(sa) * (1.f / D) + EPS), rsb = 1.0f / sqrtf(wave_sum(sb) * (1.f / D) + EPS);
        f32x4* oa = (f32x4*)(out + ra) + F.lane; f32x4* ob = (f32x4*)(out + rb) + F.lane;
#pragma unroll
        for (int j = 0; j < 16; ++j) { const f32x4 gg = *(const f32x4*)(fg + 4 * (F.lane + 64 * j));
            const f32x4 va = {bf_lo(wa[j].x), bf_hi(wa[j].x), bf_lo(wa[j].y), bf_hi(wa[j].y)}, vb = {bf_lo(wb[j].x), bf_hi(wb[j].x), bf_lo(wb[j].y), bf_hi(wb[j].y)};
            __builtin_nontemporal_store(va * rsa * gg, oa + 64 * j); __builtin_nontemporal_store(vb * rsb * gg, ob + 64 * j); }
    }
}
__device__ __forceinline__ void final_norm_phase(const Frame& F, float* out, const float* fg) {
    const int base = F.bid * (NB * S / 256);
    for (int i0 = F.wave; i0 < NB * S / 256; i0 += 16) {
        const int rot = (F.bid * 5) & 63;
        f32x4* xa = (f32x4*)(out + (size_t)(base + ((i0 + rot) & 63)) * D) + F.lane; f32x4* xb = (f32x4*)(out + (size_t)(base + ((i0 + 8 + rot) & 63)) * D) + F.lane;
        f32x4 va[16], vb[16]; float sa = 0.f, sb = 0.f;
#pragma unroll
        for (int j = 0; j < 16; ++j) va[j] = __builtin_nontemporal_load(xa + 64 * j);
#pragma unroll
        for (int j = 0; j < 16; ++j) vb[j] = __builtin_nontemporal_load(xb + 64 * j);
#pragma unroll
        for (int j = 0; j < 16; ++j) sa += (va[j].x * va[j].x + va[j].y * va[j].y) + (va[j].z * va[j].z + va[j].w * va[j].w);
#pragma unroll
        for (int j = 0; j < 16; ++j) sb += (vb[j].x * vb[j].x + vb[j].y * vb[j].y) + (vb[j].z * vb[j].z + vb[j].w * vb[j].w);
        const float rsa = 1.0f / sqrtf(wave_sum(sa) * (1.f / D) + EPS), rsb = 1.0f / sqrtf(wave_sum(sb) * (1.f / D) + EPS);
#pragma unroll
        for (int j = 0; j < 16; ++j) { const f32x4 gg = *(const f32x4*)(fg + 4 * (F.lane + 64 * j)); __builtin_nontemporal_store(va[j] * rsa * gg, xa + 64 * j); __builtin_nontemporal_store(vb[j] * rsb * gg, xb + 64 * j); }
    }
}
}
namespace fk {
constexpr int NC2 = SB / 32;
__device__ __forceinline__ size_t gla_idx2(int dir, int b, int h, int c) { return (size_t)(((dir * 2 + b) * 6 + h) * NC2 + c); }
__device__ __forceinline__ int swz4(int x) { return (0x1320 >> (4 * x)) & 3; }
__device__ __forceinline__ void gla_prep_unit(const Frame& F, const Args& a, int b, int h, int ci) {
    unsigned char* ws = a.ws;
    const bf16_t* QK1 = (const bf16_t*)(ws + WS_QK1); const float* GD = (const float*)(ws + WS_GD);
    bf16_t* QT = (bf16_t*)(ws + WS_QT); bf16_t* KT = (bf16_t*)(ws + WS_KT); bf16_t* AT = (bf16_t*)(ws + WS_AT); float* GAM = (float*)(ws + WS_GAM);
    const int tid = F.tid, lane = F.lane, wid = F.wave;
    const size_t r0 = (size_t)b * SB + 64 * ci;
    LAS float* gds = (LAS float*)(F.lds);
    LAS bf16_t* qs = (LAS bf16_t*)(F.lds + 8192);
    LAS bf16_t* ks = (LAS bf16_t*)(F.lds + 8192 + 33792);
    LAS bf16_t* ktl = (LAS bf16_t*)(F.lds + 8192 + 2 * 33792);
    __syncthreads();
    *(LAS f32x4*)(gds + tid * 4) = *(const f32x4*)(GD + (r0 + (tid >> 3)) * 32 + (tid & 7) * 4);
    __syncthreads();
    if (a.var & 8) return;
    const int r32 = lane & 31, hi = lane >> 5, d = 32 * wid + r32;
    u32x4 rq[4], rk[4];
#pragma unroll
    for (int i = 0; i < 4; ++i) { const int q = tid + 512 * i, tok = q >> 5, dc = q & 31; const bf16_t* src = QK1 + (r0 + tok) * 3072 + h * 256 + dc * 8;
        rq[i] = *(const u32x4*)src; rk[i] = *(const u32x4*)(src + 1536); }
#pragma unroll
    for (int dir = 0; dir < 2; ++dir) {
        constexpr float L2E = 1.4426950408889634f;
        const float* wg = a.in[dir ? 18 : 16] + h * 256 + d; const float bias = a.in[dir ? 19 : 17][h * 256 + d] * L2E;
        float wgv[8];
#pragma unroll
        for (int kk = 0; kk < 8; ++kk) wgv[kk] = wg[(2 * kk + hi) * 1536] * L2E;
        float cum[2][16], last[2];
#pragma unroll
        for (int tt = 0; tt < 2; ++tt) {
            f32x16 z;
#pragma unroll
            for (int r = 0; r < 16; ++r) z[r] = bias;
            const LAS float* gp = gds + (tt * 32 + r32) * 32 + 16 * dir + hi;
#pragma unroll
            for (int kk = 0; kk < 8; ++kk) z = __builtin_amdgcn_mfma_f32_32x32x2f32(gp[2 * kk], wgv[kk], z, 0, 0, 0);
            float lg[16];
#pragma unroll
            for (int r = 0; r < 16; ++r) lg[r] = (fminf(z[r], 0.f) - __builtin_amdgcn_logf(1.f + __builtin_amdgcn_exp2f(-fabsf(z[r])))) * 0.0625f;
            float T[4], PT[4];
#pragma unroll
            for (int q = 0; q < 4; ++q) {
                if (dir == 0) { lg[4 * q + 1] += lg[4 * q]; lg[4 * q + 2] += lg[4 * q + 1]; lg[4 * q + 3] += lg[4 * q + 2]; T[q] = lg[4 * q + 3]; }
                else { lg[4 * q + 2] += lg[4 * q + 3]; lg[4 * q + 1] += lg[4 * q + 2]; lg[4 * q] += lg[4 * q + 1]; T[q] = lg[4 * q]; }
                PT[q] = __shfl_xor(T[q], 32); }
            float offs[4];
            if (dir == 0) { float run = 0.f;
#pragma unroll
                for (int q = 0; q < 4; ++q) { const float t0 = hi ? PT[q] : T[q], t1 = hi ? T[q] : PT[q]; offs[q] = run + (hi ? t0 : 0.f); run += t0 + t1; }
                last[tt] = run; }
            else { float run = 0.f;
#pragma unroll
                for (int q = 3; q >= 0; --q) { const float t0 = hi ? PT[q] : T[q], t1 = hi ? T[q] : PT[q]; offs[q] = run + (hi ? 0.f : t1); run += t0 + t1; }
                last[tt] = run; }
#pragma unroll
            for (int r = 0; r < 16; ++r) cum[tt][r] = lg[r] + offs[r >> 2];
        }
#pragma unroll
        for (int i = 0; i < 4; ++i) { const int q = tid + 512 * i, tok = q >> 5, dc = q & 31; *(LAS u32x4*)(qs + tok * 264 + dc * 8) = rq[i]; *(LAS u32x4*)(ks + tok * 264 + dc * 8) = rk[i]; }
        float el[2];
#pragma unroll
        for (int tt = 0; tt < 2; ++tt) { el[tt] = __builtin_amdgcn_exp2f(last[tt]); if (hi == 0) GAM[gla_idx2(dir, b, h, 2 * ci + tt) * 256 + d] = el[tt]; }
        __syncthreads();
#pragma unroll
        for (int tt = 0; tt < 2; ++tt)
#pragma unroll
            for (int j = 0; j < 8; ++j) { float kh2[2]; const int tl0 = ((2 * j) & 3) + 8 * ((2 * j) >> 2) + 4 * hi;
#pragma unroll
                for (int u = 0; u < 2; ++u) { const int t = 32 * tt + tl0 + u; const float e1 = __builtin_amdgcn_exp2f(cum[tt][2 * j + u]), e2 = __builtin_amdgcn_rcpf(e1);
                    const float qv = bf2f(qs[t * 264 + d]), kv = bf2f(ks[t * 264 + d]); const float kt = kv * e2;
                    qs[t * 264 + d] = (bf16_t)(cvt_pk_bf16(qv * e1, 0.f) & 0xffffu); ks[t * 264 + d] = (bf16_t)(cvt_pk_bf16(kt, 0.f) & 0xffffu); kh2[u] = kt * el[tt]; }
                *(LAS unsigned*)(ktl + (tt * 256 + d) * 34 + tl0) = cvt_pk_bf16(kh2[0], kh2[1]); }
        __syncthreads();
#pragma unroll
        for (int i = 0; i < 4; ++i) { const int q = tid + 512 * i, t2 = q >> 10, rem = q & 1023, dd = rem >> 2, c4 = rem & 3; const LAS unsigned* src = (const LAS unsigned*)(ktl + (t2 * 256 + dd) * 34 + c4 * 8);
            *(u32x4*)(KT + gla_idx2(dir, b, h, 2 * ci + t2) * 8192 + dd * 32 + c4 * 8) = (u32x4){src[0], src[1], src[2], src[3]}; }
#pragma unroll
        for (int i = 0; i < 4; ++i) { const int q = tid + 512 * i, t2 = q >> 10, rem = q & 1023, tl = rem >> 5, pc = rem & 31, blk = pc >> 2, gg = pc & 3;
            const LAS u32x2* s0 = (const LAS u32x2*)(qs + (32 * t2 + tl) * 264 + blk * 32 + 4 * gg); const LAS u32x2* s1 = (const LAS u32x2*)(qs + (32 * t2 + tl) * 264 + blk * 32 + 16 + 4 * gg);
            const u32x2 lo = *s0, hi2 = *s1;
            *(u32x4*)(QT + gla_idx2(dir, b, h, 2 * ci + t2) * 8192 + (blk >> 2) * 4096 + tl * 128 + (pc & 15) * 8) = (u32x4){lo.x, lo.y, hi2.x, hi2.y}; }
        if (wid < 2) { f32x16 acc = {};
#pragma unroll
            for (int kk = 0; kk < 16; ++kk) { const bf16x8 A = *(const LAS bf16x8*)(qs + (wid * 32 + r32) * 264 + kk * 16 + hi * 8), Bv = *(const LAS bf16x8*)(ks + (wid * 32 + r32) * 264 + kk * 16 + hi * 8);
                acc = __builtin_amdgcn_mfma_f32_32x32x16_bf16(A, Bv, acc, 0, 0, 0); }
            bf16_t* at = AT + gla_idx2(dir, b, h, 2 * ci + wid) * 1024;
#pragma unroll
            for (int r = 0; r < 16; ++r) { const int itok = (r & 3) + 8 * (r >> 2) + 4 * hi; const bool keep = dir ? (r32 >= itok) : (r32 <= itok);
                at[itok * 32 + r32] = (bf16_t)(cvt_pk_bf16(keep ? acc[r] : 0.f, 0.f) & 0xffffu); } }
        __syncthreads();
    }
}
__device__ __forceinline__ void gla_prep_phase(const Frame& F, const Args& a) {
    for (int u = F.bid; u < NB * 6 * NCH; u += F.G) { const int ci = u % NCH, bh = u / NCH; gla_prep_unit(F, a, bh / 6, bh % 6, ci); }
}
#ifndef SC_SYNC
#define SC_SYNC 0
#endif
#ifndef SCAN_OSTAGE
#define SCAN_OSTAGE 0
#endif
template <int NBE>
__device__ __forceinline__ void gla_scan_wg(const Frame& F, const Args& a, int dir, int b, int h, int dhalf, int esl) {
    constexpr int SC_OST = 136192;
    constexpr int SC_QT = 0, SC_KT = 8192, SC_VT = 16384, SC_AT = SC_VT + 8192 * NBE, SC_GAM = SC_AT + 2048, SC_STAGE = SC_GAM + 512, SC_NS = NBE == 2 ? 4 : 5, EW = 128 * NBE;
    unsigned char* ws = a.ws;
    const bf16_t* QT = (const bf16_t*)(ws + WS_QT); const bf16_t* KT = (const bf16_t*)(ws + WS_KT); const bf16_t* AT = (const bf16_t*)(ws + WS_AT); const float* GAM = (const float*)(ws + WS_GAM);
    const bf16_t* VT = (const bf16_t*)(ws + WS_VT);
    bf16_t* O = (bf16_t*)(ws + (dir ? (dhalf ? WS_O11 : WS_O10) : (dhalf ? WS_O01 : WS_O00)));
    const int lane = F.lane, wid = F.wave, c = lane & 15, g = lane >> 4;
    LAS unsigned char* lds = F.lds;
    unsigned qsrc, ksrc, vsrc[NBE], asrc;
    { const int P = wid * 64 + lane;
      { const int r = P >> 4, sp = P & 15; qsrc = (unsigned)(dhalf * 4096 + r * 128 + (sp ^ (r & 15)) * 8); }
      { const int dd = P >> 2, sp = P & 3; ksrc = (unsigned)(dhalf * 4096 + dd * 32 + (sp ^ swz4((dd >> 2) & 3)) * 8); }
#pragma unroll
      for (int be = 0; be < NBE; ++be) { const int Pv = (wid + 8 * be) * 64 + lane; const int e = Pv >> 2, sp = Pv & 3; vsrc[be] = (unsigned)((esl * EW + e) * 32 + (sp ^ swz4((e >> 2) & 3)) * 8); }
      { const int i = (P >> 2) & 31, sp = P & 3; asrc = (unsigned)(i * 32 + (sp ^ swz4((i >> 2) & 3)) * 8); } }
    const int sw = swz4(c >> 2);
    const int q_rd = c * 256;
    const int k_rd = SC_KT + c * 64 + ((g ^ sw) * 16);
    const int v_rd = SC_VT + (16 * wid + c) * 64 + ((g ^ sw) * 16);
    const int a_rd = SC_AT + c * 64 + ((g ^ sw) * 16);
    const int g_rd = SC_GAM + 16 * g;
    f32x4 St[NBE][8];
#pragma unroll
    for (int be = 0; be < NBE; ++be)
#pragma unroll
        for (int t = 0; t < 8; ++t) St[be][t] = (f32x4){0.f, 0.f, 0.f, 0.f};
#define SC_CI(s) (dir ? (NC2 - 1 - (s)) : (((s) + 256) % NC2))
#define SC_DMA(slot, ci_) do { const size_t x_ = gla_idx2(dir, b, h, (ci_)); const int so_ = (slot) * SC_STAGE; \
        __builtin_amdgcn_global_load_lds((const unsigned*)(QT + x_ * 8192 + qsrc), (LAS unsigned*)(lds + so_ + SC_QT + wid * 1024), 16, 0, 0); \
        __builtin_amdgcn_global_load_lds((const unsigned*)(KT + x_ * 8192 + ksrc), (LAS unsigned*)(lds + so_ + SC_KT + wid * 1024), 16, 0, 0); \
        _Pragma("unroll") for (int be = 0; be < NBE; ++be) \
            __builtin_amdgcn_global_load_lds((const unsigned*)(VT + ((size_t)((b * 6 + h) * NC2 + (ci_))) * 16384 + vsrc[be]), (LAS unsigned*)(lds + so_ + SC_VT + (wid + 8 * be) * 1024), 16, 0, 0); \
        if (wid < 2) __builtin_amdgcn_global_load_lds((const unsigned*)(AT + x_ * 1024 + asrc), (LAS unsigned*)(lds + so_ + SC_AT + wid * 1024), 16, 0, 0); \
        if (wid == 2) { if (lane < 32) __builtin_amdgcn_global_load_lds((const unsigned*)(GAM + x_ * 256 + dhalf * 128 + lane * 4), (LAS unsigned*)(lds + so_ + SC_GAM), 16, 0, 0); } } while (0)
    __syncthreads();
#pragma unroll
    for (int p = 0; p < SC_NS - 1; ++p) SC_DMA(p, SC_CI(p));
    for (int s = 0; s < NC2; ++s) {
        const int ci = SC_CI(s); const int so = (s % SC_NS) * SC_STAGE;
        if (s < SC_NS || SC_SYNC || (a.var & 56)) __builtin_amdgcn_s_waitcnt(0x0F70);
        else if (a.var & 64) { if (wid < 3) __builtin_amdgcn_s_waitcnt(0x0F7C); else __builtin_amdgcn_s_waitcnt(0x0F79); }
        else if (NBE == 1 && SCAN_OSTAGE) { if (wid < 3) __builtin_amdgcn_s_waitcnt(0x4F70); else __builtin_amdgcn_s_waitcnt(0x0F7D); }
        else if (NBE == 1) { if (wid < 3) __builtin_amdgcn_s_waitcnt(0x4F74); else __builtin_amdgcn_s_waitcnt(0x4F71); }
        else { if (wid < 3) __builtin_amdgcn_s_waitcnt(0x4F76); else __builtin_amdgcn_s_waitcnt(0x4F74); }
        __builtin_amdgcn_s_barrier(); asm volatile("" ::: "memory");
        if (!(a.var & 8)) { const int sn = s + SC_NS - 1; const int cn = SC_CI(sn < NC2 ? sn : NC2 - 1); SC_DMA(sn % SC_NS, cn); }
        if (a.var & 16) continue;
        if constexpr (NBE == 1 && SCAN_OSTAGE) { if (s > 0) {
            const int cp = SC_CI(s - 1); const int row = F.tid >> 4, ch = F.tid & 15;
            const u32x4 w = *(const LAS u32x4*)(lds + SC_OST + ((s - 1) & 1) * 8704 + row * 272 + ch * 16);
            *(u32x4*)(O + ((size_t)b * SB + 32 * cp + row) * 3072 + h * 512 + esl * EW + ch * 8) = w; } }
        bf16x8 vf[NBE], qf[4][2], af[2], kf[8]; f32x4 gmv[8];
#pragma unroll
        for (int be = 0; be < NBE; ++be) vf[be] = *(const LAS bf16x8*)(lds + so + v_rd + be * 8192);
#pragma unroll
        for (int ks = 0; ks < 4; ++ks) { const int chk = ((4 * ks + g) ^ c) * 16;
#pragma unroll
            for (int tt = 0; tt < 2; ++tt) qf[ks][tt] = *(const LAS bf16x8*)(lds + so + SC_QT + q_rd + tt * 4096 + chk); }
        if (dhalf == 0) {
#pragma unroll
            for (int tt = 0; tt < 2; ++tt) af[tt] = *(const LAS bf16x8*)(lds + so + a_rd + tt * 1024); }
#pragma unroll
        for (int t = 0; t < 8; ++t) { kf[t] = *(const LAS bf16x8*)(lds + so + k_rd + t * 1024); gmv[t] = *(const LAS f32x4*)(lds + so + g_rd + t * 64); }
        __builtin_amdgcn_sched_barrier(0);
#pragma unroll
        for (int be = 0; be < NBE; ++be) {
            f32x4 oT[2] = {(f32x4){0.f, 0.f, 0.f, 0.f}, (f32x4){0.f, 0.f, 0.f, 0.f}};
#pragma unroll
            for (int ks = 0; ks < 4; ++ks) {
                u32x4 aw; aw.x = cvt_pk_bf16(St[be][2 * ks][0], St[be][2 * ks][1]); aw.y = cvt_pk_bf16(St[be][2 * ks][2], St[be][2 * ks][3]);
                aw.z = cvt_pk_bf16(St[be][2 * ks + 1][0], St[be][2 * ks + 1][1]); aw.w = cvt_pk_bf16(St[be][2 * ks + 1][2], St[be][2 * ks + 1][3]);
                const bf16x8 Af = *reinterpret_cast<bf16x8*>(&aw);
#pragma unroll
                for (int tt = 0; tt < 2; ++tt) oT[tt] = __builtin_amdgcn_mfma_f32_16x16x32_bf16(Af, qf[ks][tt], oT[tt], 0, 0, 0); }
            if (dhalf == 0) {
#pragma unroll
                for (int tt = 0; tt < 2; ++tt) oT[tt] = __builtin_amdgcn_mfma_f32_16x16x32_bf16(vf[be], af[tt], oT[tt], 0, 0, 0); }
            if constexpr (NBE == 1 && SCAN_OSTAGE) {
#pragma unroll
              for (int tt = 0; tt < 2; ++tt) { u32x2 w; w.x = cvt_pk_bf16(oT[tt][0], oT[tt][1]); w.y = cvt_pk_bf16(oT[tt][2], oT[tt][3]);
                *(LAS u32x2*)(lds + SC_OST + (s & 1) * 8704 + (16 * tt + c) * 272 + wid * 32 + g * 8) = w; } }
            else if (!(a.var & 96)) { bf16_t* orow = O + ((size_t)b * SB + 32 * ci + c) * 3072 + h * 512 + esl * EW + be * 128 + 16 * wid + 4 * g;
#pragma unroll
              for (int tt = 0; tt < 2; ++tt) { u32x2 w; w.x = cvt_pk_bf16(oT[tt][0], oT[tt][1]); w.y = cvt_pk_bf16(oT[tt][2], oT[tt][3]); *(u32x2*)(orow + (size_t)(16 * tt) * 3072) = w; } }
#pragma unroll
            for (int t = 0; t < 8; ++t) St[be][t] = __builtin_amdgcn_mfma_f32_16x16x32_bf16(kf[t], vf[be], St[be][t] * gmv[t], 0, 0, 0);
        }
    }
    __builtin_amdgcn_s_waitcnt(0x0F70); __syncthreads();
    if constexpr (NBE == 1 && SCAN_OSTAGE) { const int cp = SC_CI(NC2 - 1); const int row = F.tid >> 4, ch = F.tid & 15;
        const u32x4 w = *(const LAS u32x4*)(lds + SC_OST + ((NC2 - 1) & 1) * 8704 + row * 272 + ch * 16);
        *(u32x4*)(O + ((size_t)b * SB + 32 * cp + row) * 3072 + h * 512 + esl * EW + ch * 8) = w; __syncthreads(); }
#undef SC_CI
#undef SC_DMA
}
#ifndef SCAN_PP_PRIO_R
#define SCAN_PP_PRIO_R 0
#endif
#ifndef SCAN_PP_PRIO_C
#define SCAN_PP_PRIO_C 3
#endif
template <int NBE>
__device__ __forceinline__ void gla_scan_wg_pp(const Frame& F, const Args& a, int dir, int b, int h, int dhalf, int esl) {
    constexpr int SC_OST = 136192;
    constexpr int SC_QT = 0, SC_KT = 8192, SC_VT = 16384, SC_AT = SC_VT + 8192 * NBE, SC_GAM = SC_AT + 2048, SC_STAGE = SC_GAM + 512, SC_NS = NBE == 2 ? 4 : 5, EW = 128 * NBE;
    unsigned char* ws = a.ws;
    const bf16_t* QT = (const bf16_t*)(ws + WS_QT); const bf16_t* KT = (const bf16_t*)(ws + WS_KT); const bf16_t* AT = (const bf16_t*)(ws + WS_AT); const float* GAM = (const float*)(ws + WS_GAM);
    const bf16_t* VT = (const bf16_t*)(ws + WS_VT);
    bf16_t* O = (bf16_t*)(ws + (dir ? (dhalf ? WS_O11 : WS_O10) : (dhalf ? WS_O01 : WS_O00)));
    const int lane = F.lane, wid = F.wave, c = lane & 15, g = lane >> 4;
    LAS unsigned char* lds = F.lds;
    unsigned qsrc, ksrc, vsrc[NBE], asrc;
    { const int P = wid * 64 + lane;
      { const int r = P >> 4, sp = P & 15; qsrc = (unsigned)(dhalf * 4096 + r * 128 + (sp ^ (r & 15)) * 8); }
      { const int dd = P >> 2, sp = P & 3; ksrc = (unsigned)(dhalf * 4096 + dd * 32 + (sp ^ swz4((dd >> 2) & 3)) * 8); }
#pragma unroll
      for (int be = 0; be < NBE; ++be) { const int Pv = (wid + 8 * be) * 64 + lane; const int e = Pv >> 2, sp = Pv & 3; vsrc[be] = (unsigned)((esl * EW + e) * 32 + (sp ^ swz4((e >> 2) & 3)) * 8); }
      { const int i = (P >> 2) & 31, sp = P & 3; asrc = (unsigned)(i * 32 + (sp ^ swz4((i >> 2) & 3)) * 8); } }
    const int sw = swz4(c >> 2);
    const int q_rd = c * 256;
    const int k_rd = SC_KT + c * 64 + ((g ^ sw) * 16);
    const int v_rd = SC_VT + (16 * wid + c) * 64 + ((g ^ sw) * 16);
    const int a_rd = SC_AT + c * 64 + ((g ^ sw) * 16);
    const int g_rd = SC_GAM + 16 * g;
    f32x4 St[NBE][8];
#pragma unroll
    for (int be = 0; be < NBE; ++be)
#pragma unroll
        for (int t = 0; t < 8; ++t) St[be][t] = (f32x4){0.f, 0.f, 0.f, 0.f};
#define SC_CI(s) (dir ? (NC2 - 1 - (s)) : (((s) + 256) % NC2))
#define SC_DMA(slot, ci_) do { const size_t x_ = gla_idx2(dir, b, h, (ci_)); const int so_ = (slot) * SC_STAGE; \
        __builtin_amdgcn_global_load_lds((const unsigned*)(QT + x_ * 8192 + qsrc), (LAS unsigned*)(lds + so_ + SC_QT + wid * 1024), 16, 0, 0); \
        __builtin_amdgcn_global_load_lds((const unsigned*)(KT + x_ * 8192 + ksrc), (LAS unsigned*)(lds + so_ + SC_KT + wid * 1024), 16, 0, 0); \
        _Pragma("unroll") for (int be = 0; be < NBE; ++be) \
            __builtin_amdgcn_global_load_lds((const unsigned*)(VT + ((size_t)((b * 6 + h) * NC2 + (ci_))) * 16384 + vsrc[be]), (LAS unsigned*)(lds + so_ + SC_VT + (wid + 8 * be) * 1024), 16, 0, 0); \
        if (wid < 2) __builtin_amdgcn_global_load_lds((const unsigned*)(AT + x_ * 1024 + asrc), (LAS unsigned*)(lds + so_ + SC_AT + wid * 1024), 16, 0, 0); \
        if (wid == 2) { if (lane < 32) __builtin_amdgcn_global_load_lds((const unsigned*)(GAM + x_ * 256 + dhalf * 128 + lane * 4), (LAS unsigned*)(lds + so_ + SC_GAM), 16, 0, 0); } } while (0)
    const int grp = wid >> 2, fl = grp ? 1 : 2;
    const int frow = F.tid >> 4, fch = F.tid & 15;
    __syncthreads();
#pragma unroll
    for (int p = 0; p < SC_NS - 1; ++p) SC_DMA(p, SC_CI(p));
    __builtin_amdgcn_s_waitcnt(0x0F70); __syncthreads();
    if (grp) __builtin_amdgcn_s_barrier();
#define SC_WAIT(s_) do { if ((s_) < SC_NS) __builtin_amdgcn_s_waitcnt(0x0F70); else if (wid < 3) __builtin_amdgcn_s_waitcnt(0x4F70); else __builtin_amdgcn_s_waitcnt(0x0F7D); } while (0)
#define SC_FLUSH(st_) do { const int cp_ = SC_CI(st_); \
        const u32x4 w_ = *(const LAS u32x4*)(lds + SC_OST + ((st_) & 1) * 8704 + frow * 272 + fch * 16); \
        *(u32x4*)(O + ((size_t)b * SB + 32 * cp_ + frow) * 3072 + h * 512 + esl * EW + fch * 8) = w_; } while (0)
    for (int s = 0; s < NC2; ++s) {
        const int ci = SC_CI(s); const int so = (s % SC_NS) * SC_STAGE;
        __builtin_amdgcn_s_setprio(SCAN_PP_PRIO_R);
        { const int sn = s + SC_NS - 1; const int cn = SC_CI(sn < NC2 ? sn : NC2 - 1); SC_DMA(sn % SC_NS, cn); }
        if (s >= fl) SC_FLUSH(s - fl);
        bf16x8 vf, qf[4][2], af[2], kf[8]; f32x4 gmv[8];
        vf = *(const LAS bf16x8*)(lds + so + v_rd);
#pragma unroll
        for (int ks = 0; ks < 4; ++ks) { const int chk = ((4 * ks + g) ^ c) * 16;
#pragma unroll
            for (int tt = 0; tt < 2; ++tt) qf[ks][tt] = *(const LAS bf16x8*)(lds + so + SC_QT + q_rd + tt * 4096 + chk); }
        if (dhalf == 0) {
#pragma unroll
            for (int tt = 0; tt < 2; ++tt) af[tt] = *(const LAS bf16x8*)(lds + so + a_rd + tt * 1024); }
#pragma unroll
        for (int t = 0; t < 8; ++t) { kf[t] = *(const LAS bf16x8*)(lds + so + k_rd + t * 1024); gmv[t] = *(const LAS f32x4*)(lds + so + g_rd + t * 64); }
        if (grp) SC_WAIT(s);
        LDS_WAIT();
        __builtin_amdgcn_s_barrier(); asm volatile("" ::: "memory");
        __builtin_amdgcn_sched_barrier(0);
        __builtin_amdgcn_s_setprio(SCAN_PP_PRIO_C);
        {
            f32x4 oT[2] = {(f32x4){0.f, 0.f, 0.f, 0.f}, (f32x4){0.f, 0.f, 0.f, 0.f}};
#pragma unroll
            for (int ks = 0; ks < 4; ++ks) {
                u32x4 aw; aw.x = cvt_pk_bf16(St[0][2 * ks][0], St[0][2 * ks][1]); aw.y = cvt_pk_bf16(St[0][2 * ks][2], St[0][2 * ks][3]);
                aw.z = cvt_pk_bf16(St[0][2 * ks + 1][0], St[0][2 * ks + 1][1]); aw.w = cvt_pk_bf16(St[0][2 * ks + 1][2], St[0][2 * ks + 1][3]);
                const bf16x8 Af = *reinterpret_cast<bf16x8*>(&aw);
#pragma unroll
                for (int tt = 0; tt < 2; ++tt) oT[tt] = __builtin_amdgcn_mfma_f32_16x16x32_bf16(Af, qf[ks][tt], oT[tt], 0, 0, 0); }
            if (dhalf == 0) {
#pragma unroll
                for (int tt = 0; tt < 2; ++tt) oT[tt] = __builtin_amdgcn_mfma_f32_16x16x32_bf16(vf, af[tt], oT[tt], 0, 0, 0); }
#pragma unroll
            for (int tt = 0; tt < 2; ++tt) { u32x2 w; w.x = cvt_pk_bf16(oT[tt][0], oT[tt][1]); w.y = cvt_pk_bf16(oT[tt][2], oT[tt][3]);
                *(LAS u32x2*)(lds + SC_OST + (s & 1) * 8704 + (16 * tt + c) * 272 + wid * 32 + g * 8) = w; }
#pragma unroll
            for (int t = 0; t < 8; ++t) St[0][t] = __builtin_amdgcn_mfma_f32_16x16x32_bf16(kf[t], vf, St[0][t] * gmv[t], 0, 0, 0);
        }
        if (!grp) SC_WAIT(s);
        LDS_WAIT();
        __builtin_amdgcn_s_barrier(); asm volatile("" ::: "memory");
    }
    if (!grp) __builtin_amdgcn_s_barrier();
    __builtin_amdgcn_s_setprio(0);
    __builtin_amdgcn_s_waitcnt(0x0F70); __syncthreads();
    if (!grp) SC_FLUSH(NC2 - 2);
    SC_FLUSH(NC2 - 1);
    __builtin_amdgcn_s_waitcnt(0x0F70); __syncthreads();
#undef SC_WAIT
#undef SC_FLUSH
#undef SC_CI
#undef SC_DMA
}
}
namespace fk {
constexpr int NPHASE = 14;
#ifndef SCAN_PP
#define SCAN_PP 0
#endif
#ifndef BF_TAIL
#define BF_TAIL 0
#endif
#ifndef STAGGER
#define STAGGER 0
#endif
__global__ void __launch_bounds__(NTHR, 2) fwd(Args args) {
    extern __shared__ __attribute__((aligned(16))) unsigned char lds_raw[];
    Frame F; F.lds = (LAS unsigned char*)lds_raw; F.tid = threadIdx.x; F.lane = F.tid & 63; F.wave = __builtin_amdgcn_readfirstlane(F.tid >> 6); F.G = gridDim.x; F.bid = blockIdx.x;
    unsigned char* ws = args.ws;
    volatile LAS unsigned* MISC = (volatile LAS unsigned*)(F.lds + LDS_MISC);
    if (F.tid < 64) MISC[F.tid] = 0u;
    __syncthreads();
    const int lo = args.ph_lo, hi = args.ph_hi;
    XcdBarrier bar; bar.bar = (unsigned*)(ws + WS_CTL) + CW_BAR; bar.x = 0; bar.st = MISC + 8;
    if (hi - lo > 1) bar = xcd_barrier_post((unsigned*)(ws + WS_CTL) + CW_BAR, MISC + 8);
#ifndef PHMASK
#define PHMASK 0xFFFF
#endif
#define IN(k) (((PHMASK >> (k)) & 1) && lo <= (k) && (k) < hi)
#define SEAM(k) do { if (IN(k) && IN((k) + 1)) xcd_barrier(bar); } while (0)
    float* mod = (float*)(ws + WS_MOD);
    float* x1c = (float*)(ws + WS_X1C);
    LAS float* XCH = (LAS float*)(F.lds + LDS_X);
    if (IN(0)) { p0_prologue(F, args); }
    SEAM(0);
    if (IN(1)) { hnorm_phase(F, args.in[0], args.in[2], args.in[4], mod, (bf16_t*)(ws + WS_H)); }
    SEAM(1);
    if (IN(2)) {
        Gemm g{(const bf16_t*)(ws + WS_H), (const bf16_t*)(ws + WS_W1T), 4096, 4096, 4096}; Order S_; S_.init(NPANEL, 35, F.G, F.bid, 0);
        EpiL0 E{(bf16_t*)(ws + WS_A1), (bf16_t*)(ws + WS_CQKV), (bf16_t*)(ws + WS_G0), (bf16_t*)(ws + WS_KR), (float*)(ws + WS_SSQ), args.in[8], args.in[9],
                (const float*)(ws + WS_ROPEA), (const float*)(ws + WS_ROPEB), XCH};
        const bool early = STAGGER && F.bid >= 6 && ((F.bid >> 3) & 1);
        if (early) { late_convert(F, args, 6 * NWAVES, (F.G - 6) * NWAVES, 0); __syncthreads(); }
        gemm_phase<EpiL0>(F.lds + LDS_STAGE, g, S_, E);
        if (!early) late_convert(F, args, 6 * NWAVES, (F.G - 6) * NWAVES, 0);
    }
    SEAM(2);
    if (IN(3)) {
        { Gemm g{(const bf16_t*)(ws + WS_CQKV), (const bf16_t*)(ws + WS_WUQ), 1024, 1536, 1024}; Order S_; S_.init(NPANEL, 12, F.G, F.bid, 0);
          EpiUp<0> E{(bf16_t*)(ws + WS_QB), 3072, (const float*)(ws + WS_SSQ), (const float*)(ws + WS_ROPEB)};
          gemm_phase<EpiUp<0>>(F.lds + LDS_STAGE, g, S_, E); }
        { Gemm g{(const bf16_t*)(ws + WS_CQKV) + 1024, (const bf16_t*)(ws + WS_WUKV), 512, 1536, 512}; Order S_; S_.init(NPANEL, 16, F.G, (F.bid + 128) & 255, 0);
          EpiUp<1> E{(bf16_t*)(ws + WS_KVB), 4096, (const float*)(ws + WS_SSQ), (const float*)(ws + WS_ROPEB)};
          gemm_phase<EpiUp<1>>(F.lds + LDS_STAGE, g, S_, E); }
    }
    SEAM(3);
    if (IN(4)) { attn_phase(F, args, lds_raw); }
    SEAM(4);
    if (IN(5)) {
        Gemm g{(const bf16_t*)(ws + WS_Y0), (const bf16_t*)(ws + WS_WO), 4096, 4096, 4096}; Order S_; S_.init(NPANEL, 16, F.G, F.bid, 0);
        EpiRes E{args.in[0], args.in[2], mod, args.out, x1c};
        const bool early = STAGGER && F.bid >= 32 && ((F.bid >> 3) & 1);
        if (early) { late_convert(F, args, 32 * NWAVES, (F.G - 32) * NWAVES, 1); __syncthreads(); }
        gemm_phase<EpiRes>(F.lds + LDS_STAGE, g, S_, E);
        if (!early) late_convert(F, args, 32 * NWAVES, (F.G - 32) * NWAVES, 1);
    }
    SEAM(5);
    const float* mod1 = mod + 3 * 12288;
    if (IN(6)) { hnorm_phase(F, args.out, x1c, args.in[4] + D, mod1, (bf16_t*)(ws + WS_H)); }
    SEAM(6);
    if (IN(7)) {
        Gemm g{(const bf16_t*)(ws + WS_H), (const bf16_t*)(ws + WS_W4T), 4096, 4096, 4096}; Order S_; S_.init(NPANEL, 45, F.G, F.bid, 0);
        EpiL1 E{(bf16_t*)(ws + WS_QK1), (bf16_t*)(ws + WS_VT), (bf16_t*)(ws + WS_U1), (bf16_t*)(ws + WS_G1), (float*)(ws + WS_GD), args.var & 1, F.lds + 131072};
        gemm_phase<EpiL1>(F.lds + LDS_STAGE, g, S_, E);
    }
    SEAM(7);
    if (IN(8)) {
        if (!(args.var & 1)) gla_prep_phase(F, args);
        __syncthreads();
        if (!(args.var & 2)) {
        int k8 = 256; asm volatile("" : "+s"(k8));
        Gemm g{(const bf16_t*)(ws + WS_U1), (const bf16_t*)(ws + WS_CS), k8, 256, 256}; Order S_; S_.init(M * 4 / 256, 2, F.G, (F.bid + 128) & 255, 0);
        EpiPlain E{(bf16_t*)(ws + WS_AB), 512};
        gemm_phase<EpiPlain>(F.lds + LDS_STAGE, g, S_, E); }
    }
    SEAM(8);
    if (IN(9)) {
#ifndef SCAN_NBE
#define SCAN_NBE 1
#endif
        constexpr int NSCAN = 192 / SCAN_NBE;
        const int x = F.bid & 7, j = F.bid >> 3;
        if (j < NSCAN / 8) { if (!(args.var & 1)) { constexpr int SPC = 8 / SCAN_NBE; const int combo = x * 3 + j / SPC, sub = j % SPC;
#if SCAN_PP
            gla_scan_wg_pp<1>(F, args, combo / 12, (combo % 12) / 6, combo % 6, sub / (SPC / 2), sub % (SPC / 2)); } }
#else
            gla_scan_wg<SCAN_NBE>(F, args, combo / 12, (combo % 12) / 6, combo % 6, sub / (SPC / 2), sub % (SPC / 2)); } }
#endif
        else { const int fw = F.bid - NSCAN;
            if (!(args.var & 2)) { if (fw < 32) f4096_phase(F, (const bf16_t*)(ws + WS_AB), (float*)(ws + WS_F4096), fw, 1.0f / 1448.1546878700494f);
                fold_phase(F, (const bf16_t*)(ws + WS_AB), (bf16_t*)(ws + WS_BF), NSCAN * NWAVES, (256 - NSCAN) * NWAVES); }
            if (!(args.var & 4)) dm_gen(F, (bf16_t*)(ws + WS_DM), fw, 256 - NSCAN);
            wo2_convert(F, args, NSCAN * NWAVES, (256 - NSCAN) * NWAVES); }
    }
    SEAM(9);
    if (IN(10)) {
        Gemm g{(const bf16_t*)(ws + WS_DM), (const bf16_t*)(ws + WS_BF), FKP, FKP, FKP}; OrderFn S_{F.bid};
        EpiPcs E{(bf16_t*)(ws + WS_PCS), 1.0f / 1448.1546878700494f};
        gemm_phase<EpiPcs>(F.lds + LDS_STAGE, g, S_, E);
        gla_finish_phase(F, (const bf16_t*)(ws + WS_O00), (const bf16_t*)(ws + WS_O01), (const bf16_t*)(ws + WS_O10), (const bf16_t*)(ws + WS_O11), (const bf16_t*)(ws + WS_G1), args.in[20], (bf16_t*)(ws + WS_Y1));
    }
    SEAM(10);
    if (IN(11)) { fnet_finish_phase(F, (const bf16_t*)(ws + WS_PCS), (const float*)(ws + WS_F4096), (const bf16_t*)(ws + WS_G1), (bf16_t*)(ws + WS_Y1)); }
    SEAM(11);
    if (IN(12)) {
        Gemm g{(const bf16_t*)(ws + WS_Y1), (const bf16_t*)(ws + WS_WO2), 4096, 4096, 4096}; Order S_; S_.init(64, 16, F.G, F.bid, 1);
#if BF_TAIL
        EpiResB E{args.out, mod1, (bf16_t*)(ws + WS_H)};
        gemm_phase<EpiResB>(F.lds + LDS_STAGE, g, S_, E);
#else
        EpiRes E{args.out, x1c, mod1, args.out, x1c};
        gemm_phase<EpiRes>(F.lds + LDS_STAGE, g, S_, E);
#endif
    }
    SEAM(12);
#if BF_TAIL
    if (IN(13)) { final_norm_b_phase(F, (const bf16_t*)(ws + WS_H), args.out, args.in[22]); }
#else
    if (IN(13)) { final_norm_phase(F, args.out, args.in[22]); }
#endif
#undef IN
#undef SEAM
}

static int g_state = 0;
static bool host_init(int n_in, size_t ws_size) {
    if (g_state == 0) {
        g_state = -1;
        if (n_in != 23 || ws_size < WS_TOTAL) { fprintf(stderr, "kernel_launch: n_in %d ws %zu (need %zu)\n", n_in, ws_size, (size_t)WS_TOTAL); return false; }
        int dev = 0, cus = 0;
        if (hipGetDevice(&dev) != hipSuccess || hipDeviceGetAttribute(&cus, hipDeviceAttributeMultiprocessorCount, dev) != hipSuccess || cus != 256) { fprintf(stderr, "kernel_launch: needs a 256-CU device (got %d)\n", cus); return false; }
        if (hipFuncSetAttribute((const void*)fwd, hipFuncAttributeMaxDynamicSharedMemorySize, LDS_BYTES) != hipSuccess) { fprintf(stderr, "hipFuncSetAttribute(fwd) failed\n"); return false; }
        int per_cu = 0;
        if (hipOccupancyMaxActiveBlocksPerMultiprocessor(&per_cu, (const void*)fwd, NTHR, LDS_BYTES) != hipSuccess || per_cu < 1) fprintf(stderr, "kernel_launch: occupancy query reports %d blocks per CU\n", per_cu);
        (void)hipGetLastError();
#if MODE != 4 && MODE != 3 && MODE != 5
        if (hipFuncSetAttribute((const void*)orc::k_attn, hipFuncAttributeMaxDynamicSharedMemorySize, 160 * 1024 - 256) != hipSuccess) { fprintf(stderr, "hipFuncSetAttribute(k_attn) failed\n"); return false; }
#endif
        g_state = 1;
    }
    return g_state > 0;
}
static void launch_phases(void* const* d_in, void* d_out, void* d_ws, hipStream_t stream, int lo, int hi, bool one_launch, int var = 0) {
    (void)hipMemsetAsync((char*)d_ws + WS_CTL, 0, MiB, stream);
    Args a{};
    for (int i = 0; i < 23; ++i) a.in[i] = (const float*)d_in[i];
    a.out = (float*)d_out; a.ws = (unsigned char*)d_ws; a.var = var;
    if (one_launch) { a.ph_lo = lo; a.ph_hi = hi; hipLaunchKernelGGL(fwd, dim3(256), dim3(NTHR), LDS_BYTES, stream, a); }
    else for (int p = lo; p < hi; ++p) { a.ph_lo = p; a.ph_hi = p + 1; hipLaunchKernelGGL(fwd, dim3(256), dim3(NTHR), LDS_BYTES, stream, a); }
    const hipError_t le = hipPeekAtLastError();
    if (le != hipSuccess) fprintf(stderr, "kernel_launch: launch failed: %s\n", hipGetErrorName(le));
}
}

#ifndef MODE
#define MODE 1
#endif
extern "C" void kernel_launch(void* const* d_in, const int* in_sizes, int n_in, void* d_out, int out_size, void* d_ws, size_t ws_size, hipStream_t stream) {
    if (!fk::host_init(n_in, ws_size)) return;
#if MODE != 4 && MODE != 3 && MODE != 5
    const orc::Ptrs p = orc::ptrs(d_in); (void)p;
#endif
#if MODE == 0
    orc::setup(p, (unsigned char*)d_ws, stream); orc::layer0(p, (float*)d_out, (unsigned char*)d_ws, stream); orc::layer1(p, (float*)d_out, (unsigned char*)d_ws, stream);
#elif MODE == 1
    fk::launch_phases(d_in, d_out, d_ws, stream, 0, 6, false);
    orc::setup(p, (unsigned char*)d_ws, stream); orc::layer1(p, (float*)d_out, (unsigned char*)d_ws, stream);
#elif MODE == 2
    orc::setup(p, (unsigned char*)d_ws, stream); orc::layer0(p, (float*)d_out, (unsigned char*)d_ws, stream);
    fk::launch_phases(d_in, d_out, d_ws, stream, 0, 1, false); fk::launch_phases(d_in, d_out, d_ws, stream, 6, 14, false);
#elif MODE == 3
    fk::launch_phases(d_in, d_out, d_ws, stream, 0, 14, false);
#elif MODE == 5
    { const int lst[] = {PHLIST}; for (unsigned i = 0; i < sizeof(lst) / sizeof(lst[0]); ++i) fk::launch_phases(d_in, d_out, d_ws, stream, lst[i] % 100, lst[i] % 100 + 1, false, lst[i] / 100); }
#elif MODE == 4
    fk::launch_phases(d_in, d_out, d_ws, stream, 0, 14, true);
#endif
}
```
